# Optimizing an MI355X kernel written in HIP

```python
import math
import jax, jax.numpy as jnp
from jax import lax
import numpy as np

D_MODEL = 1024
BATCH = 32
SEQ = 2048
DEPTH = 1
DEC_BATCH = 32
DEC_SEQ = 32
PAST_LEN = 4096

CHUNK = 64
A_HEADS = 16
A_KV_HEADS = 2
A_HEAD_DIM = 64
A_GROUP = A_HEADS // A_KV_HEADS
WINDOW = 128
WIN_CHUNKS = WINDOW // CHUNK
A_Q_W = A_HEADS * A_HEAD_DIM
A_KV_W = A_KV_HEADS * A_HEAD_DIM
NUM_BUCKETS = 32
MAX_DISTANCE = 128
B_HEADS = 8
B_KEY_DIM = 128
B_VAL_DIM = D_MODEL // B_HEADS
B_KEY_W = B_HEADS * B_KEY_DIM
B_VAL_W = B_HEADS * B_VAL_DIM
D_FF = 2816
CONV_W = 3
PLE_DIM = 256
EPS = 1e-6
NEG_INF = -1e30

_SPLIT_SIZES = (A_Q_W, A_KV_W, A_KV_W, B_KEY_W, B_KEY_W, B_VAL_W, B_VAL_W, D_MODEL, D_MODEL)
IN_COLS = sum(_SPLIT_SIZES)
SPLIT_POINTS = tuple(int(s) for s in np.cumsum(_SPLIT_SIZES)[:-1])

kernel_name = "hybrid_swa_hgrn2_convffn_stream_step"


def _rms_norm(x, g):
    xf = x.astype(jnp.float32)
    y = xf * lax.rsqrt(jnp.mean(xf * xf, axis=-1, keepdims=True) + EPS)
    return (y * g.astype(jnp.float32)).astype(x.dtype)


def _t5_bucket(rel):
    nb = NUM_BUCKETS // 2
    ret = jnp.where(rel > 0, nb, 0)
    n = jnp.abs(rel)
    max_exact = nb // 2
    large = max_exact + (jnp.log(jnp.maximum(n, max_exact).astype(jnp.float32) / max_exact)
                         / math.log(MAX_DISTANCE / max_exact) * (nb - max_exact)).astype(jnp.int32)
    large = jnp.minimum(large, nb - 1)
    return ret + jnp.where(n < max_exact, n, large)


def _rel_bias(table, q_pos, k_pos):
    buckets = _t5_bucket(k_pos[None, :] - q_pos[:, None])
    b = jnp.transpose(table[buckets], (2, 0, 1))
    return b.reshape(A_KV_HEADS, A_GROUP, q_pos.shape[0], k_pos.shape[0])


def _sink_attention(q, k, v, bias, mask, sinks):
    s = jnp.einsum('bnqkgd,bnskd->bnkgqs', q, k).astype(jnp.float32) * (A_HEAD_DIM ** -0.5)
    s = s + bias.astype(jnp.float32)[None, None]
    s = jnp.where(mask[None, :, None, None], s, NEG_INF)
    sink = sinks.astype(jnp.float32)[None, None, :, :, None, None]
    m = jnp.maximum(jnp.max(s, axis=-1, keepdims=True), sink)
    p = jnp.exp(s - m)
    denom = jnp.sum(p, axis=-1, keepdims=True) + jnp.exp(sink - m)
    return jnp.einsum('bnkgqs,bnskd->bnqkgd', (p / denom).astype(v.dtype), v)


def _hgrn2(q, f_logit, i_in, s0, lb, block):
    f32 = jnp.float32
    f = lb + (1.0 - lb) * jax.nn.sigmoid(f_logit.astype(f32))
    logf = jnp.log(f)
    k = 1.0 - f
    q = jax.nn.silu(q.astype(f32))
    v = i_in.astype(f32)
    bsz, t, h, dk = q.shape
    dv = v.shape[-1]
    nb = t // block

    def to_blocks(a):
        return a.reshape(bsz, nb, block, h, a.shape[-1]).transpose(1, 0, 3, 2, 4)

    qc, kc, vc = to_blocks(q), to_blocks(k), to_blocks(v)
    cum = jnp.cumsum(to_blocks(logf), axis=3)
    causal = jnp.tril(jnp.ones((block, block), dtype=bool))
    mid = block // 2

    def step(state, blk):
        q_, k_, v_, b_ = blk
        b_last = b_[:, :, -1:, :]
        b_mid = b_[:, :, mid:mid + 1, :]
        o = jnp.einsum('bhld,bhdv->bhlv', q_ * jnp.exp(b_), state)
        a = jnp.einsum('bhtd,bhsd->bhts', q_ * jnp.exp(b_ - b_mid), k_ * jnp.exp(b_mid - b_))
        o = o + jnp.einsum('bhts,bhsv->bhtv', jnp.where(causal, a, 0.0), v_)
        state = (jnp.exp(b_last)[:, :, 0, :, None] * state
                 + jnp.einsum('bhsd,bhsv->bhdv', k_ * jnp.exp(b_last - b_), v_))
        return state, o

    s_fin, o = lax.scan(step, s0.astype(f32), (qc, kc, vc, cum))
    o = o.transpose(1, 0, 3, 2, 4).reshape(bsz, t, h, dv)
    return o, s_fin


def _layer(x, pe, k_prev, v_prev, s_prev, conv_prev, rel_table, lb,
           g_pre_mix, w_in, sinks, g_hgrn_out, w_br_a, w_br_b, w_out, g_post_mix,
           g_pre_ffn, w_up, w_conv, b_conv, w_down, g_post_ffn, w_ple, w_ple_gate):
    prompt = k_prev is None
    bsz, t, _ = x.shape
    h = _rms_norm(x, g_pre_mix)
    z = h @ w_in
    qa, ka, va, qb, fb, ib, ob, ga, gb = jnp.split(z, SPLIT_POINTS, axis=-1)
    qa = qa.reshape(bsz, t, A_KV_HEADS, A_GROUP, A_HEAD_DIM)
    ka = ka.reshape(bsz, t, A_KV_HEADS, A_HEAD_DIM)
    va = va.reshape(bsz, t, A_KV_HEADS, A_HEAD_DIM)

    if prompt:
        nc = t // CHUNK
        lk = (WIN_CHUNKS + 1) * CHUNK
        qblk = qa.reshape(bsz, nc, CHUNK, A_KV_HEADS, A_GROUP, A_HEAD_DIM)
        pad = ((0, 0), (WIN_CHUNKS * CHUNK, 0), (0, 0), (0, 0))
        kp = jnp.pad(ka, pad).reshape(bsz, nc + WIN_CHUNKS, CHUNK, A_KV_HEADS, A_HEAD_DIM)
        vp = jnp.pad(va, pad).reshape(bsz, nc + WIN_CHUNKS, CHUNK, A_KV_HEADS, A_HEAD_DIM)
        kblk = jnp.concatenate([kp[:, j:j + nc] for j in range(WIN_CHUNKS + 1)], axis=2)
        vblk = jnp.concatenate([vp[:, j:j + nc] for j in range(WIN_CHUNKS + 1)], axis=2)
        q_pos = jnp.arange(CHUNK) + WIN_CHUNKS * CHUNK
        k_pos = jnp.arange(lk)
        valid = (jnp.arange(nc)[:, None] - WIN_CHUNKS + (k_pos // CHUNK)[None, :]) >= 0
        mask = jnp.broadcast_to(valid[:, None, :], (nc, CHUNK, lk))
        keep = min(WINDOW, t)
        new_k, new_v = ka[:, t - keep:], va[:, t - keep:]
    else:
        lc = k_prev.shape[1]
        qblk = qa[:, None]
        kblk = jnp.concatenate([k_prev.astype(ka.dtype), ka], axis=1)[:, None]
        vblk = jnp.concatenate([v_prev.astype(va.dtype), va], axis=1)[:, None]
        q_pos = jnp.arange(t) + lc
        k_pos = jnp.arange(lc + t)
        mask = jnp.ones((1, t, lc + t), dtype=bool)
        new_k, new_v = ka, va
    bias = _rel_bias(rel_table, q_pos, k_pos)
    ya = _sink_attention(qblk, kblk, vblk, bias, mask, sinks.reshape(A_KV_HEADS, A_GROUP))
    ya = ya.reshape(bsz, t, A_Q_W)

    s0 = jnp.zeros((bsz, B_HEADS, B_KEY_DIM, B_VAL_DIM), jnp.float32) if prompt else s_prev
    block = CHUNK if prompt else t
    yb, s_fin = _hgrn2(qb.reshape(bsz, t, B_HEADS, B_KEY_DIM), fb.reshape(bsz, t, B_HEADS, B_KEY_DIM),
                       ib.reshape(bsz, t, B_HEADS, B_VAL_DIM), s0, lb, block)
    yb = _rms_norm(yb.astype(x.dtype), g_hgrn_out) * jax.nn.silu(ob.reshape(bsz, t, B_HEADS, B_VAL_DIM))
    yb = yb.reshape(bsz, t, B_VAL_W)

    mix = jax.nn.sigmoid(ga) * (ya @ w_br_a) + jax.nn.sigmoid(gb) * (yb @ w_br_b)
    x = x + _rms_norm(mix @ w_out, g_post_mix)

    hf = _rms_norm(x, g_pre_ffn)
    a, u = jnp.split(hf @ w_up, 2, axis=-1)
    prev = jnp.zeros((bsz, CONV_W - 1, D_FF), a.dtype) if prompt else conv_prev.astype(a.dtype)
    ap = jnp.concatenate([prev, a], axis=1)
    ac = b_conv
    for j in range(CONV_W):
        ac = ac + ap[:, j:j + t] * w_conv[j]
    ffn = (jax.nn.gelu(ac, approximate=True) * u) @ w_down
    x = x + _rms_norm(ffn, g_post_ffn)
    conv_tail = ap[:, ap.shape[1] - (CONV_W - 1):]

    x = x + (pe @ w_ple) * jax.nn.sigmoid(x @ w_ple_gate)
    return x, new_k, new_v, s_fin.astype(x.dtype), conv_tail


def setup_inputs(seed: int = 0) -> dict:
    key = jax.random.key(seed)
    ks = jax.random.split(key, 32)
    f32 = jnp.float32

    def nrm(k, shape, scale):
        return jax.random.normal(k, shape, f32) * scale

    def gain(k, shape):
        return 1.0 + 0.05 * jax.random.normal(k, shape, f32)

    w_cache = min(WINDOW, PAST_LEN)
    return {
        "x_prompt": nrm(ks[0], (BATCH, SEQ, D_MODEL), 1.0),
        "x_sample": nrm(ks[1], (DEC_BATCH, DEC_SEQ, D_MODEL), 1.0),
        "cache_win_k": nrm(ks[2], (DEPTH, DEC_BATCH, w_cache, A_KV_HEADS, A_HEAD_DIM), 1.0),
        "cache_win_v": nrm(ks[3], (DEPTH, DEC_BATCH, w_cache, A_KV_HEADS, A_HEAD_DIM), 1.0),
        "state_hgrn": nrm(ks[4], (DEPTH, DEC_BATCH, B_HEADS, B_KEY_DIM, B_VAL_DIM), 0.5),
        "cache_ffn_conv": nrm(ks[5], (DEPTH, DEC_BATCH, CONV_W - 1, D_FF), 1.0),
        "p_prompt": nrm(ks[6], (DEPTH, BATCH, SEQ, PLE_DIM), 1.0),
        "p_sample": nrm(ks[7], (DEPTH, DEC_BATCH, DEC_SEQ, PLE_DIM), 1.0),
        "rel_bias_table": nrm(ks[8], (NUM_BUCKETS, A_HEADS), 0.5),
        "lb_logits": nrm(ks[9], (DEPTH + 1, B_KEY_W), 0.5),
        "g_pre_mix": gain(ks[10], (DEPTH, D_MODEL)),
        "w_in": nrm(ks[11], (DEPTH, D_MODEL, IN_COLS), D_MODEL ** -0.5),
        "attn_sinks": nrm(ks[12], (DEPTH, A_HEADS), 0.5),
        "g_hgrn_out": gain(ks[13], (DEPTH, B_VAL_DIM)),
        "w_br_a": nrm(ks[14], (DEPTH, A_Q_W, D_MODEL), A_Q_W ** -0.5),
        "w_br_b": nrm(ks[15], (DEPTH, B_VAL_W, D_MODEL), B_VAL_W ** -0.5),
        "w_out": nrm(ks[16], (DEPTH, D_MODEL, D_MODEL), D_MODEL ** -0.5),
        "g_post_mix": gain(ks[17], (DEPTH, D_MODEL)),
        "g_pre_ffn": gain(ks[18], (DEPTH, D_MODEL)),
        "w_up": nrm(ks[19], (DEPTH, D_MODEL, 2 * D_FF), D_MODEL ** -0.5),
        "w_conv": nrm(ks[20], (DEPTH, CONV_W, D_FF), CONV_W ** -0.5),
        "b_conv": nrm(ks[21], (DEPTH, D_FF), 0.02),
        "w_down": nrm(ks[22], (DEPTH, D_FF, D_MODEL), D_FF ** -0.5),
        "g_post_ffn": gain(ks[23], (DEPTH, D_MODEL)),
        "w_ple": nrm(ks[24], (DEPTH, PLE_DIM, D_MODEL), PLE_DIM ** -0.5),
        "w_ple_gate": nrm(ks[25], (DEPTH, D_MODEL, D_MODEL), D_MODEL ** -0.5),
    }


def reference(x_prompt, x_sample, cache_win_k, cache_win_v, state_hgrn, cache_ffn_conv,
              p_prompt, p_sample, rel_bias_table, lb_logits, g_pre_mix, w_in, attn_sinks,
              g_hgrn_out, w_br_a, w_br_b, w_out, g_post_mix, g_pre_ffn, w_up, w_conv, b_conv,
              w_down, g_post_ffn, w_ple, w_ple_gate):
    lbs = jnp.cumsum(jax.nn.softmax(lb_logits.astype(jnp.float32), axis=0), axis=0)
    yp, ys = x_prompt, x_sample
    outs_p, outs_s = [], []
    for i in range(DEPTH):
        lw = (g_pre_mix[i], w_in[i], attn_sinks[i], g_hgrn_out[i], w_br_a[i], w_br_b[i], w_out[i],
              g_post_mix[i], g_pre_ffn[i], w_up[i], w_conv[i], b_conv[i], w_down[i], g_post_ffn[i],
              w_ple[i], w_ple_gate[i])
        lb = lbs[i].reshape(B_HEADS, B_KEY_DIM)
        yp, pk, pv, ps, pc = _layer(yp, p_prompt[i], None, None, None, None, rel_bias_table, lb, *lw)
        ys, sk, sv, ss, sc = _layer(ys, p_sample[i], cache_win_k[i], cache_win_v[i], state_hgrn[i],
                                    cache_ffn_conv[i], rel_bias_table, lb, *lw)
        outs_p.append((pk, pv, ps, pc))
        outs_s.append((sk, sv, ss, sc))
    prompt_win_k = jnp.stack([o[0] for o in outs_p])
    prompt_win_v = jnp.stack([o[1] for o in outs_p])
    prompt_hgrn_state = jnp.stack([o[2] for o in outs_p])
    prompt_ffn_conv = jnp.stack([o[3] for o in outs_p])
    sample_win_k = jnp.stack([o[0] for o in outs_s])
    sample_win_v = jnp.stack([o[1] for o in outs_s])
    sample_hgrn_state = jnp.stack([o[2] for o in outs_s])
    sample_ffn_conv = jnp.stack([o[3] for o in outs_s])
    return (yp, ys, prompt_win_k, prompt_win_v, prompt_hgrn_state, prompt_ffn_conv,
            sample_win_k, sample_win_v, sample_hgrn_state, sample_ffn_conv)
```

```cpp
#include <hip/hip_runtime.h>
#include <hip/hip_cooperative_groups.h>
#include <cstdio>
namespace cg = cooperative_groups;
namespace pg8 {
#define PG8_LAS __attribute__((address_space(3)))
typedef unsigned short bf16_t;
typedef short bf16x8 __attribute__((ext_vector_type(8)));
typedef float f32x4 __attribute__((ext_vector_type(4)));
typedef unsigned u32x4 __attribute__((ext_vector_type(4)));
constexpr int BM = 256, BK = 64, HALF = 128, HTB = HALF * BK * 2  , STAGE_BYTES = 8 * HTB, NXCD = 8, WGM = 8;

__host__ __device__ __forceinline__ int lds_byte(int r, int c) { const int st = (r >> 4) * 2 + (c >> 5), rr = r & 15, cc = c & 31, ob = rr * 64 + cc * 2; return st * 1024 + (ob ^ (((ob >> 9) & 1) << 5)); }
__host__ __device__ __forceinline__ void stage_rc(int b, int& R, int& C) { const int st = b / 1024, sb = b % 1024, swz = sb ^ (((sb >> 9) & 1) << 5); R = (st >> 1) * 16 + swz / 64; C = (st & 1) * 32 + (swz % 64) / 2; }
__host__ __device__ __forceinline__ int perm32(int rho) { const int n = rho >> 4, i = rho & 15; return 8 * (i >> 2) + 4 * n + (i & 3); }

struct Unit { int pm, pn; };
struct Gemm { const bf16_t* A; const bf16_t* Bt; int M, N, K; };

struct StaticOrder {
    int nM, nN, nwg, G, c;
    __host__ __device__ void init(int M, int N, int G_, int c_) { nM = M / BM; nN = N / BM; nwg = nM * nN; G = G_; c = c_; }
    __host__ __device__ bool next(int i, Unit& u) const {
        const long L = (long)i * G + c; if (L >= nwg) return false;
        int wgid = (int)L; { const int q = nwg / NXCD, r = nwg % NXCD, xcd = wgid % NXCD, off = wgid / NXCD; wgid = (xcd < r ? xcd * (q + 1) : r * (q + 1) + (xcd - r) * q) + off; }
        const int nig = WGM * nN, gid = wgid / nig, fm = gid * WGM, gsz = (nM - fm) < WGM ? (nM - fm) : WGM;
        u.pm = fm + ((wgid % nig) % gsz); u.pn = (wgid % nig) / gsz; return true;
    }
    __device__ __forceinline__ void a_ready(const Unit&) const {}
    __device__ __forceinline__ void done(const Unit&) const {}
};
__device__ __forceinline__ unsigned cvt_pk_bf16(float lo, float hi) { unsigned r; asm volatile("v_cvt_pk_bf16_f32 %0, %1, %2" : "=v"(r) : "v"(lo), "v"(hi)); return r; }
template <class Epi, class Sched, bool STAMP = false>
__device__ __forceinline__ void gemm_phase(PG8_LAS unsigned char* lds, const Gemm g, const Sched& S, const Epi& E, unsigned long long* stamps) {
    const int tid = threadIdx.x, wid = __builtin_amdgcn_readfirstlane(tid >> 6), lane = tid & 63, wr = wid >> 2, wc = wid & 3, fr = lane & 15, fq = lane >> 4;
    const int K = g.K, nt = K / BK;
    int ts_lo = 0, ts_hi = 0, nts = 0; const unsigned long long rt_entry = STAMP ? (unsigned long long)wall_clock64() : 0ull;
#define PG8_STAMP() do { if (STAMP && wid == 0 && nts < 64) { const unsigned long long _c = (unsigned long long)clock64(); \
        ts_lo = (lane == nts) ? (int)(unsigned)_c : ts_lo; ts_hi = (lane == nts) ? (int)(unsigned)(_c >> 32) : ts_hi; ++nts; } } while (0)
    PG8_STAMP();
    unsigned voffA[2], voffB[2];
#pragma unroll
    for (int i = 0; i < 2; ++i) { int R, C; stage_rc(tid * 16 + i * 8192, R, C); const int Rb = Epi::PERM ? ((R & ~31) + perm32(R & 31)) : R;
        voffA[i] = (unsigned)(R * K + C) * 2u; voffB[i] = (unsigned)(Rb * K + C) * 2u; }
    const size_t kstep = (size_t)(BK * 2);
    const size_t hstep = (size_t)HALF * K * 2;
    const size_t tstep = 2 * hstep;
    const unsigned ldsw = (unsigned)wid * 1024u;
    const int aoff = lds_byte(wr * 64 + fr, fq * 8), boff = lds_byte(wc * 32 + fr, fq * 8);
#define PG8_SA(b, h) (((b) * 2 + (h)) * HTB)
#define PG8_SB(b, h) ((4 + (b) * 2 + (h)) * HTB)
#define PG8_STAGE(bufoff, gbase, voff) do { _Pragma("unroll") for (int _i = 0; _i < 2; ++_i) \
        __builtin_amdgcn_global_load_lds((const unsigned*)((const char*)(gbase) + (voff)[_i]), (PG8_LAS unsigned*)(lds + (bufoff) + ldsw + _i * 8192), 16, 0, 0); } while (0)
#define PG8_LDA(dst, b, h) do { _Pragma("unroll") for (int m = 0; m < 4; ++m) _Pragma("unroll") for (int k = 0; k < 2; ++k) dst[m][k] = *(const PG8_LAS bf16x8*)(lds + PG8_SA(b, h) + aoff + m * 2048 + k * 1024); } while (0)
#define PG8_LDB(dst, b, h) do { _Pragma("unroll") for (int n = 0; n < 2; ++n) _Pragma("unroll") for (int k = 0; k < 2; ++k) dst[n][k] = *(const PG8_LAS bf16x8*)(lds + PG8_SB(b, h) + boff + n * 2048 + k * 1024); } while (0)
#define PG8_MMA(ai, bj, At, Bt) do { __builtin_amdgcn_s_setprio(1); _Pragma("unroll") for (int m = 0; m < 4; ++m) _Pragma("unroll") for (int n = 0; n < 2; ++n) _Pragma("unroll") for (int k = 0; k < 2; ++k) \
        acc[ai][bj][m][n] = __builtin_amdgcn_mfma_f32_16x16x32_bf16(Bt[n][k], At[m][k], acc[ai][bj][m][n], 0, 0, 0); __builtin_amdgcn_s_setprio(0); } while (0)
#define PG8_WAIT_V(n) asm volatile("s_waitcnt vmcnt(" #n ")" ::: "memory")
#define PG8_WAIT_L(n) asm volatile("s_waitcnt lgkmcnt(" #n ")" ::: "memory")
#define PG8_BAR __builtin_amdgcn_s_barrier()
#define PG8_SCHED __builtin_amdgcn_sched_barrier(0)
    Unit cur, nxt; int ui = 0;
    if (!S.next(0, cur)) return;
    f32x4 acc[2][2][4][2];
#pragma unroll
    for (int a = 0; a < 2; ++a)
#pragma unroll
        for (int b = 0; b < 2; ++b)
#pragma unroll
            for (int m = 0; m < 4; ++m)
#pragma unroll
                for (int n = 0; n < 2; ++n) acc[a][b][m][n] = (f32x4){0.f, 0.f, 0.f, 0.f};
    bf16x8 At[4][2], B0[2][2], B1[2][2];
    const char* cA = (const char*)g.A + (size_t)cur.pm * tstep; const char* cB = (const char*)g.Bt + (size_t)cur.pn * tstep;
    S.a_ready(cur);
    PG8_STAGE(PG8_SB(0, 0), cB, voffB); PG8_STAGE(PG8_SA(0, 0), cA, voffA); PG8_STAGE(PG8_SB(0, 1), cB + hstep, voffB); PG8_STAGE(PG8_SA(0, 1), cA + hstep, voffA);
    if (wr == 1) PG8_BAR;
    PG8_WAIT_V(4); PG8_BAR;
    PG8_STAGE(PG8_SB(1, 0), cB + kstep, voffB); PG8_STAGE(PG8_SA(1, 0), cA + kstep, voffA); PG8_STAGE(PG8_SB(1, 1), cB + hstep + kstep, voffB);
    PG8_WAIT_V(6); PG8_BAR;
    PG8_STAMP();
    for (;;) {
        const bool has_next = S.next(ui + 1, nxt);
        const char* nA = has_next ? (const char*)g.A + (size_t)nxt.pm * tstep : cA; const char* nB = has_next ? (const char*)g.Bt + (size_t)nxt.pn * tstep : cB;
        for (int t = 0; t < nt; t += 2) {
            const bool last = (t == nt - 2);
            const char* a1 = cA + (size_t)(t + 1) * kstep;
            const char* a2 = last ? nA : cA + (size_t)(t + 2) * kstep; const char* b2 = last ? nB : cB + (size_t)(t + 2) * kstep;
            const char* a3 = a2 + kstep; const char* b3 = b2 + kstep;
            if (last && has_next) S.a_ready(nxt);
            PG8_LDB(B0, 0, 0); PG8_SCHED; PG8_LDA(At, 0, 0); PG8_STAGE(PG8_SA(1, 1), a1 + hstep, voffA);
            PG8_WAIT_L(8); PG8_BAR; PG8_WAIT_L(0); PG8_MMA(0, 0, At, B0); PG8_BAR; PG8_SCHED;
            PG8_LDB(B1, 0, 1); PG8_STAGE(PG8_SB(0, 0), b2, voffB);
            PG8_BAR; PG8_WAIT_L(0); PG8_MMA(0, 1, At, B1); PG8_BAR;
            PG8_LDA(At, 0, 1); PG8_STAGE(PG8_SA(0, 0), a2, voffA);
            PG8_BAR; PG8_WAIT_L(0); PG8_MMA(1, 0, At, B0); PG8_BAR; PG8_SCHED;
            PG8_STAGE(PG8_SB(0, 1), b2 + hstep, voffB);
            PG8_WAIT_V(6); PG8_BAR; PG8_MMA(1, 1, At, B1); PG8_BAR;
            PG8_LDB(B0, 1, 0); PG8_SCHED; PG8_LDA(At, 1, 0); PG8_STAGE(PG8_SA(0, 1), a2 + hstep, voffA);
            PG8_WAIT_L(8); PG8_BAR; PG8_WAIT_L(0); PG8_MMA(0, 0, At, B0); PG8_BAR; PG8_SCHED;
            PG8_LDB(B1, 1, 1); PG8_STAGE(PG8_SB(1, 0), b3, voffB);
            PG8_BAR; PG8_WAIT_L(0); PG8_MMA(0, 1, At, B1); PG8_BAR;
            PG8_LDA(At, 1, 1); PG8_STAGE(PG8_SA(1, 0), a3, voffA);
            PG8_BAR; PG8_WAIT_L(0); PG8_MMA(1, 0, At, B0); PG8_BAR; PG8_SCHED;
            PG8_STAGE(PG8_SB(1, 1), b3 + hstep, voffB);
            PG8_WAIT_V(6); PG8_BAR; PG8_MMA(1, 1, At, B1); PG8_BAR;
        }
        PG8_STAMP();
        if constexpr (!Epi::AFTER_DRAIN) { E(acc, cur, wr, wc, fr, fq); S.done(cur); }
        PG8_STAMP();
        if (!has_next) break;
#pragma unroll
        for (int a = 0; a < 2; ++a)
#pragma unroll
            for (int b = 0; b < 2; ++b)
#pragma unroll
                for (int m = 0; m < 4; ++m)
#pragma unroll
                    for (int n = 0; n < 2; ++n) acc[a][b][m][n] = (f32x4){0.f, 0.f, 0.f, 0.f};
        cur = nxt; cA = nA; cB = nB; ++ui;
    }
    PG8_WAIT_V(0);
    if (wr == 0) PG8_BAR;
    PG8_BAR;
    if constexpr (Epi::AFTER_DRAIN) { E.fused(acc, cur, wr, wc, fr, fq, lds, wid, lane); S.done(cur); }
    PG8_STAMP();
    if (STAMP && wid == 0) { stamps[lane] = lane < nts ? (((unsigned long long)(unsigned)ts_hi << 32) | (unsigned)ts_lo) : 0ull;
        if (lane == 62) stamps[62] = rt_entry; if (lane == 63) stamps[63] = (unsigned long long)wall_clock64(); }
#undef PG8_STAMP
#undef PG8_SA
#undef PG8_SB
#undef PG8_STAGE
#undef PG8_LDA
#undef PG8_LDB
#undef PG8_MMA
#undef PG8_WAIT_V
#undef PG8_WAIT_L
#undef PG8_BAR
#undef PG8_SCHED
}
}


using pg8::bf16_t; using pg8::bf16x8; using pg8::f32x4; using pg8::u32x4;
typedef unsigned u32x2 __attribute__((ext_vector_type(2)));
#define MFMA16(a, b, c) __builtin_amdgcn_mfma_f32_16x16x32_bf16((a), (b), (c), 0, 0, 0)

constexpr int MP = 65536, MS = 1024, MT = MP + MS, DM = 1024, DFF = 2816, NIN = 7424;
constexpr float EPS = 1e-6f;
constexpr size_t UB = (size_t)MT * 1024 * 2;
constexpr size_t WS_WIN = 0, WS_WBRA = WS_WIN + (size_t)NIN * 1024 * 2, WS_WBRB = WS_WBRA + 2097152, WS_WOUT = WS_WBRB + 2097152, WS_WPG = WS_WOUT + 2097152,
                 WS_WUP = WS_WPG + 2097152, WS_WDOWN = WS_WUP + (size_t)2 * DFF * 1024 * 2, WS_WPLE = WS_WDOWN + (size_t)1024 * DFF * 2, WS_KV = WS_WPLE + (size_t)1024 * 256 * 2,
                 WS_R0 = WS_KV + (size_t)MT * 256 * 2, WS_END = WS_R0 + 7 * UB;
constexpr size_t A_BYTES = (size_t)MT * DFF * 2;
constexpr size_t O_Y = 0, O_PWK = (size_t)MT * 1024, O_PWV = O_PWK + 524288, O_PST = O_PWV + 524288, O_PFC = O_PST + 4194304, O_SWK = O_PFC + 180224, O_SWV = O_SWK + 131072,
                 O_SST = O_SWV + 131072, O_SFC = O_SST + 4194304, O_END = O_SFC + 180224;
constexpr int LDS_BYTES = 147456;

struct Prm { const float* in[26]; float* out; unsigned char* ws; };
enum { I_XP = 0, I_XS, I_CK, I_CV, I_ST, I_CC, I_PP, I_PS, I_RB, I_LB, I_GPM, I_WIN, I_SINK, I_GH, I_WBRA, I_WBRB, I_WOUT, I_GPOST, I_GPF, I_WUP, I_WCONV, I_BCONV, I_WDOWN, I_GPFF, I_WPLE, I_WPG };

__device__ __forceinline__ unsigned pk2(float lo, float hi) { unsigned r; asm("v_cvt_pk_bf16_f32 %0, %1, %2" : "=v"(r) : "v"(lo), "v"(hi)); return r; }
__device__ __forceinline__ float bflo(unsigned w) { return __uint_as_float(w << 16); }
__device__ __forceinline__ float bfhi(unsigned w) { return __uint_as_float(w & 0xffff0000u); }
__device__ __forceinline__ float bf1(bf16_t b) { return __uint_as_float(((unsigned)b) << 16); }
__device__ __forceinline__ bf16_t f2bf(float f) { return (bf16_t)(pk2(f, 0.f) & 0xffffu); }
__device__ __forceinline__ float sigm(float x) { return __builtin_amdgcn_rcpf(1.0f + __expf(-x)); }
__device__ __forceinline__ float wsum(float v) { v += __shfl_xor(v, 32); v += __shfl_xor(v, 16); v += __shfl_xor(v, 8); v += __shfl_xor(v, 4); v += __shfl_xor(v, 2); v += __shfl_xor(v, 1); return v; }
__device__ __forceinline__ u32x4 pk8(f32x4 a, f32x4 b) { u32x4 w; w.x = pk2(a[0], a[1]); w.y = pk2(a[2], a[3]); w.z = pk2(b[0], b[1]); w.w = pk2(b[2], b[3]); return w; }
__device__ __forceinline__ u32x2 pk4(f32x4 a) { u32x2 w; w.x = pk2(a[0], a[1]); w.y = pk2(a[2], a[3]); return w; }
__device__ __forceinline__ void unpk8(u32x4 w, float (&f)[8]) { f[0] = bflo(w.x); f[1] = bfhi(w.x); f[2] = bflo(w.y); f[3] = bfhi(w.y); f[4] = bflo(w.z); f[5] = bfhi(w.z); f[6] = bflo(w.w); f[7] = bfhi(w.w); }

template <class F> struct EpiT {
    static constexpr bool PERM = true, AFTER_DRAIN = false; F f;
    __device__ __forceinline__ void operator()(const f32x4 (&acc)[2][2][4][2], const pg8::Unit& u, int wr, int wc, int fr, int fq) const {
        const int row0 = u.pm * 256 + wr * 64 + fr, col0 = u.pn * 256 + wc * 32 + 8 * fq;
#pragma unroll
        for (int ai = 0; ai < 2; ++ai)
#pragma unroll
            for (int m = 0; m < 4; ++m)
#pragma unroll
                for (int bj = 0; bj < 2; ++bj) f(row0 + ai * 128 + m * 16, col0 + bj * 128, u.pn, acc[ai][bj][m][0], acc[ai][bj][m][1]);
    }
};
struct F1 {
    bf16_t* r0; bf16_t* kv; float* out;
    __device__ __forceinline__ void operator()(int row, int col, int pn, f32x4 v0, f32x4 v1) const {
        const u32x4 w = pk8(v0, v1);
        if (pn < 4) { *(u32x4*)(r0 + (size_t)row * 1024 + col) = w; }
        else if (pn == 4) {
            const int c = col - 1024; *(u32x4*)(kv + (size_t)row * 256 + c) = w;
            float* o = nullptr;
            if (row >= MP) { o = out + (c < 128 ? O_SWK : O_SWV) + (size_t)(row - MP) * 128 + (c & 127); }
            else { const int t = row & 2047; if (t >= 1920) o = out + (c < 128 ? O_PWK : O_PWV) + (size_t)((row >> 11) * 128 + t - 1920) * 128 + (c & 127); }
            if (o) { *(f32x4*)o = v0; *(f32x4*)(o + 4) = v1; }
        } else { const int c2 = col - 1280, seg = c2 >> 10; *(u32x4*)(r0 + (size_t)(1 + seg) * (UB / 2) + (size_t)row * 1024 + (c2 & 1023)) = w; }
    }
};
struct F2 {
    const bf16_t* g; bf16_t* o;
    __device__ __forceinline__ void operator()(int row, int col, int, f32x4 v0, f32x4 v1) const {
        const size_t i = (size_t)row * 1024 + col; float gf[8]; unpk8(*(const u32x4*)(g + i), gf);
        f32x4 a, b;
#pragma unroll
        for (int j = 0; j < 4; ++j) { a[j] = v0[j] * sigm(gf[j]); b[j] = v1[j] * sigm(gf[4 + j]); }
        *(u32x4*)(o + i) = pk8(a, b);
    }
};
struct F3 {
    const bf16_t* g; const bf16_t* t; bf16_t* o;
    __device__ __forceinline__ void operator()(int row, int col, int, f32x4 v0, f32x4 v1) const {
        const size_t i = (size_t)row * 1024 + col; float gf[8], tf[8]; unpk8(*(const u32x4*)(g + i), gf); unpk8(*(const u32x4*)(t + i), tf);
        f32x4 a, b;
#pragma unroll
        for (int j = 0; j < 4; ++j) { a[j] = tf[j] + v0[j] * sigm(gf[j]); b[j] = tf[4 + j] + v1[j] * sigm(gf[4 + j]); }
        *(u32x4*)(o + i) = pk8(a, b);
    }
};
struct FF32 {
    float* o;
    __device__ __forceinline__ void operator()(int row, int col, int, f32x4 v0, f32x4 v1) const { float* d = o + (size_t)row * 1024 + col; *(f32x4*)d = v0; *(f32x4*)(d + 4) = v1; }
};
struct FBF {
    bf16_t* o;
    __device__ __forceinline__ void operator()(int row, int col, int, f32x4 v0, f32x4 v1) const { *(u32x4*)(o + (size_t)row * 1024 + col) = pk8(v0, v1); }
};
struct F6 {
    bf16_t* a; bf16_t* u; float* out;
    __device__ __forceinline__ void operator()(int row, int col, int pn, f32x4 v0, f32x4 v1) const {
        const u32x4 w = pk8(v0, v1);
        if (pn < 11) {
            *(u32x4*)(a + (size_t)row * DFF + col) = w;
            float* o = nullptr;
            if (row >= MP) { const int rs = row - MP, t = rs & 31; if (t >= 30) o = out + O_SFC + (size_t)((rs >> 5) * 2 + t - 30) * DFF + col; }
            else { const int t = row & 2047; if (t >= 2046) o = out + O_PFC + (size_t)((row >> 11) * 2 + t - 2046) * DFF + col; }
            if (o) { *(f32x4*)o = v0; *(f32x4*)(o + 4) = v1; }
        } else *(u32x4*)(u + (size_t)row * DFF + (col - DFF)) = w;
    }
};
struct F9 {
    const bf16_t* pe; float* y;
    __device__ __forceinline__ void operator()(int row, int col, int, f32x4 v0, f32x4 v1) const {
        const size_t i = (size_t)row * 1024 + col; float pf[8]; unpk8(*(const u32x4*)(pe + i), pf);
        f32x4 a = *(const f32x4*)(y + i), b = *(const f32x4*)(y + i + 4);
#pragma unroll
        for (int j = 0; j < 4; ++j) { a[j] += pf[j] * sigm(v0[j]); b[j] += pf[4 + j] * sigm(v1[j]); }
        *(f32x4*)(y + i) = a; *(f32x4*)(y + i + 4) = b;
    }
};
template <class F> __device__ __forceinline__ void run_gemm(unsigned char* lds, const bf16_t* A, const bf16_t* Bt, int N, int K, const F& f) {
    asm volatile("" : "+s"(K)); asm volatile("" : "+s"(N));
    pg8::Gemm g; g.A = A; g.Bt = Bt; g.M = MT; g.N = N; g.K = K;
    pg8::StaticOrder S; S.init(MT, N, (int)gridDim.x, (int)blockIdx.x);
    EpiT<F> E; E.f = f;
    pg8::gemm_phase<EpiT<F>, pg8::StaticOrder, false>((PG8_LAS unsigned char*)lds, g, S, E, nullptr);
    __syncthreads();
}

__device__ __forceinline__ void transpose_w(const float* W, bf16_t* Bt, int K, int N, const float* gain, float* tile, int& toff) {
    const int nnt = N / 64, ntiles = (K / 64) * nnt, tid = threadIdx.x, G = gridDim.x;
    int first = ((int)blockIdx.x - (toff % G) + G) % G;
    for (int t = first; t < ntiles; t += G) {
        const int kt = t / nnt, nt = t % nnt;
#pragma unroll
        for (int i = 0; i < 8; ++i) { const int r = (tid >> 6) + 8 * i, c = tid & 63; float v = W[(size_t)(kt * 64 + r) * N + nt * 64 + c]; if (gain) v *= gain[kt * 64 + r]; tile[r * 65 + c] = v; }
        __syncthreads();
#pragma unroll
        for (int i = 0; i < 8; ++i) { const int n = (tid >> 6) + 8 * i, k = tid & 63; Bt[(size_t)(nt * 64 + n) * K + kt * 64 + k] = f2bf(tile[k * 65 + n]); }
        __syncthreads();
    }
    toff += ntiles;
}
__device__ __forceinline__ const float* xrow(const Prm& p, int row) { return row < MP ? p.in[I_XP] + (size_t)row * 1024 : p.in[I_XS] + (size_t)(row - MP) * 1024; }

__device__ __forceinline__ void phase0(const Prm& p, unsigned char* lds) {
    float* tile = (float*)lds; int toff = 0; unsigned char* ws = p.ws;
    transpose_w(p.in[I_WIN], (bf16_t*)(ws + WS_WIN), 1024, NIN, p.in[I_GPM], tile, toff);
    transpose_w(p.in[I_WUP], (bf16_t*)(ws + WS_WUP), 1024, 2 * DFF, p.in[I_GPF], tile, toff);
    transpose_w(p.in[I_WDOWN], (bf16_t*)(ws + WS_WDOWN), DFF, 1024, nullptr, tile, toff);
    transpose_w(p.in[I_WBRA], (bf16_t*)(ws + WS_WBRA), 1024, 1024, nullptr, tile, toff);
    transpose_w(p.in[I_WBRB], (bf16_t*)(ws + WS_WBRB), 1024, 1024, nullptr, tile, toff);
    transpose_w(p.in[I_WOUT], (bf16_t*)(ws + WS_WOUT), 1024, 1024, nullptr, tile, toff);
    transpose_w(p.in[I_WPG], (bf16_t*)(ws + WS_WPG), 1024, 1024, nullptr, tile, toff);
    transpose_w(p.in[I_WPLE], (bf16_t*)(ws + WS_WPLE), 256, 1024, nullptr, tile, toff);
    bf16_t* xn = (bf16_t*)p.out;
    const int lane = threadIdx.x & 63, gw = blockIdx.x * 8 + (threadIdx.x >> 6), nw = gridDim.x * 8;
    for (int row = gw; row < MT; row += nw) {
        const float* xr = xrow(p, row); f32x4 v[4]; float ss = 0.f;
#pragma unroll
        for (int i = 0; i < 4; ++i) { v[i] = *(const f32x4*)(xr + i * 256 + lane * 4); ss += v[i][0] * v[i][0] + v[i][1] * v[i][1] + v[i][2] * v[i][2] + v[i][3] * v[i][3]; }
        ss = wsum(ss); const float rs = rsqrtf(ss * (1.0f / 1024.0f) + EPS);
#pragma unroll
        for (int i = 0; i < 4; ++i) *(u32x2*)(xn + (size_t)row * 1024 + i * 256 + lane * 4) = pk4(v[i] * rs);
    }
}

constexpr int AT_KS = 0, AT_VT = 27648, AT_BT = 53248;
__device__ __forceinline__ void attn_bias_table(const Prm& p, unsigned char* lds) {
    float* bT = (float*)(lds + AT_BT); const float* tab = p.in[I_RB];
    for (int i = threadIdx.x; i < 16 * 256; i += 512) {
        const int head = i >> 8, idx = i & 255, rel = idx - 191, n = rel < 0 ? -rel : rel;
        int bk = n < 8 ? n : min(15, 33 - __clz(n * n)); if (rel > 0) bk += 16;
        bT[i] = idx < 255 ? tab[bk * 16 + head] : 0.f;
    }
}
template <int NKT, int NQT, bool SAMPLE>
__device__ __forceinline__ void attn_item(const Prm& p, unsigned char* lds, int b, int c, int kvh) {
    bf16_t* Ks = (bf16_t*)(lds + AT_KS); bf16_t* Vt = (bf16_t*)(lds + AT_VT); const float* bT = (const float*)(lds + AT_BT);
    const bf16_t* kv = (const bf16_t*)(p.ws + WS_KV); bf16_t* R0 = (bf16_t*)(p.ws + WS_R0);
    const int tid = threadIdx.x, lane = tid & 63, w = tid >> 6, lr = lane & 15, lq = lane >> 4;
    __syncthreads();
    if (!SAMPLE) {
        const int tok0 = b * 2048 + (c - 2) * 64;
        for (int id = tid; id < 192 * 8; id += 512) {
            const int key = id >> 3, dc = id & 7; u32x4 v = {0u, 0u, 0u, 0u};
            if (c * 64 - 128 + key >= 0) v = *(const u32x4*)(kv + (size_t)(tok0 + key) * 256 + kvh * 64 + dc * 8);
            *(u32x4*)(Ks + key * 72 + dc * 8) = v;
        }
        for (int id = tid; id < 192 * 8; id += 512) {
            const int key = id % 192, dc = id / 192; u32x4 v = {0u, 0u, 0u, 0u};
            if (c * 64 - 128 + key >= 0) v = *(const u32x4*)(kv + (size_t)(tok0 + key) * 256 + 128 + kvh * 64 + dc * 8);
            bf16_t* d = Vt + (dc * 8) * 200 + key;
            d[0] = (bf16_t)(v.x & 0xffffu); d[200] = (bf16_t)(v.x >> 16); d[400] = (bf16_t)(v.y & 0xffffu); d[600] = (bf16_t)(v.y >> 16);
            d[800] = (bf16_t)(v.z & 0xffffu); d[1000] = (bf16_t)(v.z >> 16); d[1200] = (bf16_t)(v.w & 0xffffu); d[1400] = (bf16_t)(v.w >> 16);
        }
    } else {
        const float* ck = p.in[I_CK]; const float* cvp = p.in[I_CV];
        for (int id = tid; id < 160 * 8; id += 512) {
            const int key = id >> 3, dc = id & 7; u32x4 v;
            if (key < 128) { const float* s = ck + (size_t)(b * 128 + key) * 128 + kvh * 64 + dc * 8; v = pk8(*(const f32x4*)s, *(const f32x4*)(s + 4)); }
            else v = *(const u32x4*)(kv + (size_t)(MP + b * 32 + key - 128) * 256 + kvh * 64 + dc * 8);
            *(u32x4*)(Ks + key * 72 + dc * 8) = v;
        }
        for (int id = tid; id < 160 * 8; id += 512) {
            const int key = id % 160, dc = id / 160; u32x4 v;
            if (key < 128) { const float* s = cvp + (size_t)(b * 128 + key) * 128 + kvh * 64 + dc * 8; v = pk8(*(const f32x4*)s, *(const f32x4*)(s + 4)); }
            else v = *(const u32x4*)(kv + (size_t)(MP + b * 32 + key - 128) * 256 + 128 + kvh * 64 + dc * 8);
            bf16_t* d = Vt + (dc * 8) * 200 + key;
            d[0] = (bf16_t)(v.x & 0xffffu); d[200] = (bf16_t)(v.x >> 16); d[400] = (bf16_t)(v.y & 0xffffu); d[600] = (bf16_t)(v.y >> 16);
            d[800] = (bf16_t)(v.z & 0xffffu); d[1000] = (bf16_t)(v.z >> 16); d[1200] = (bf16_t)(v.w & 0xffffu); d[1400] = (bf16_t)(v.w >> 16);
        }
    }
    __syncthreads();
    const int head = kvh * 8 + w; const float sink = p.in[I_SINK][head];
    const int qrow0 = SAMPLE ? MP + b * 32 : b * 2048 + c * 64;
    const float* bTh = bT + head * 256;
#pragma unroll 1
    for (int qi = 0; qi < NQT; ++qi) {
        const int q = qi * 16 + lr;
        const size_t qoff = (size_t)(qrow0 + q) * 1024 + head * 64 + lq * 8;
        const bf16x8 qf0 = *(const bf16x8*)(R0 + qoff), qf1 = *(const bf16x8*)(R0 + qoff + 32);
        f32x4 s[NKT];
#pragma unroll
        for (int kt = 0; kt < NKT; ++kt) {
            const bf16_t* kp = Ks + (kt * 16 + lr) * 72 + lq * 8;
            const bf16x8 k0 = *(const bf16x8*)kp, k1 = *(const bf16x8*)(kp + 32);
            f32x4 a = {0.f, 0.f, 0.f, 0.f}; a = MFMA16(k0, qf0, a); a = MFMA16(k1, qf1, a); s[kt] = a;
        }
        float mx = sink;
#pragma unroll
        for (int kt = 0; kt < NKT; ++kt)
#pragma unroll
            for (int r = 0; r < 4; ++r) {
                const int key = kt * 16 + lq * 4 + r; float v = s[kt][r] * 0.125f + bTh[key - q + 63];
                if (!SAMPLE && (c * 64 - 128 + key < 0)) v = -1e30f;
                s[kt][r] = v; mx = fmaxf(mx, v);
            }
        mx = fmaxf(mx, __shfl_xor(mx, 16)); mx = fmaxf(mx, __shfl_xor(mx, 32));
        float sum = 0.f;
#pragma unroll
        for (int kt = 0; kt < NKT; ++kt)
#pragma unroll
            for (int r = 0; r < 4; ++r) { const float e = __expf(s[kt][r] - mx); s[kt][r] = e; sum += e; }
        sum += __shfl_xor(sum, 16); sum += __shfl_xor(sum, 32);
        const float inv = 1.0f / (sum + __expf(sink - mx));
        f32x4 o[4];
#pragma unroll
        for (int dt = 0; dt < 4; ++dt) o[dt] = (f32x4){0.f, 0.f, 0.f, 0.f};
#pragma unroll
        for (int ks = 0; ks < NKT / 2; ++ks) {
            const u32x4 pw = pk8(s[2 * ks], s[2 * ks + 1]); const bf16x8 pf = __builtin_bit_cast(bf16x8, pw);
#pragma unroll
            for (int dt = 0; dt < 4; ++dt) {
                const bf16_t* vp = Vt + (dt * 16 + lr) * 200 + ks * 32 + lq * 4;
                const u32x2 lo = *(const u32x2*)vp, hi = *(const u32x2*)(vp + 16);
                const u32x4 vw = {lo.x, lo.y, hi.x, hi.y};
                o[dt] = MFMA16(__builtin_bit_cast(bf16x8, vw), pf, o[dt]);
            }
        }
#pragma unroll
        for (int dt = 0; dt < 4; ++dt) *(u32x2*)(R0 + (size_t)(qrow0 + q) * 1024 + head * 64 + dt * 16 + lq * 4) = pk4(o[dt] * inv);
    }
}

template <int L, bool SAMPLE>
__device__ __forceinline__ void hgrn_seq(const Prm& p, unsigned char* lds, int b, int h) {
    constexpr int RPG = L / 4, NT = L / 16, NCH = SAMPLE ? 1 : 32, NP = 8 / NT;
    bf16_t* Qd = (bf16_t*)lds; bf16_t* Qm = Qd + 64 * 136; bf16_t* Km = Qm + 64 * 136; bf16_t* KlT = Km + 64 * 136; bf16_t* Vt = KlT + 128 * 72; bf16_t* St = Vt + 128 * 72; bf16_t* Al = St + 128 * 136;
    float* tot = (float*)(Al + 64 * 72); float* first = tot + 512; float* decay = first + 512; float* ssq = decay + 128;
    bf16_t* R1 = (bf16_t*)(p.ws + WS_R0 + UB); const bf16_t* R2 = (const bf16_t*)(p.ws + WS_R0 + 2 * UB); const bf16_t* R3 = (const bf16_t*)(p.ws + WS_R0 + 3 * UB); const bf16_t* R4 = (const bf16_t*)(p.ws + WS_R0 + 4 * UB);
    const int tid = threadIdx.x, lane = tid & 63, w = tid >> 6, lr = lane & 15, lq = lane >> 4, col = tid & 127, rg = tid >> 7;
    const float l0 = p.in[I_LB][h * 128 + col], l1 = p.in[I_LB][1024 + h * 128 + col];
    const float lb = 1.0f / (1.0f + __expf(l1 - l0));
    f32x4 S[8];
#pragma unroll
    for (int dvt = 0; dvt < 8; ++dvt) {
        if (SAMPLE) {
#pragma unroll
            for (int r = 0; r < 4; ++r) S[dvt][r] = p.in[I_ST][((size_t)(b * 8 + h) * 128 + 16 * w + 4 * lq + r) * 128 + 16 * dvt + lr];
        } else S[dvt] = (f32x4){0.f, 0.f, 0.f, 0.f};
    }
    const int tt = w % NT, dv0 = (w / NT) * NT;
#pragma unroll 1
    for (int ch = 0; ch < NCH; ++ch) {
        const int row0 = SAMPLE ? MP + b * 32 : b * 2048 + ch * 64;
        float qv[RPG], cv[RPG], vv[RPG], kk[RPG]; float run = 0.f, lf0 = 0.f;
#pragma unroll
        for (int i = 0; i < RPG; ++i) {
            const size_t idx = (size_t)(row0 + rg * RPG + i) * 1024 + h * 128 + col;
            const float q = bf1(R1[idx]), fl = bf1(R2[idx]), v = bf1(R3[idx]);
            const float f = lb + (1.0f - lb) * sigm(fl), lf = __logf(f);
            run += lf; cv[i] = run; kk[i] = 1.0f - f; qv[i] = q * sigm(q); vv[i] = v; if (i == 0) lf0 = lf;
        }
        tot[rg * 128 + col] = run; first[rg * 128 + col] = lf0;
        __syncthreads();
        {
            const float t0 = tot[col], t1 = tot[128 + col], t2 = tot[256 + col], t3 = tot[384 + col];
            const float pre = (rg > 0 ? t0 : 0.f) + (rg > 1 ? t1 : 0.f) + (rg > 2 ? t2 : 0.f), bmid = t0 + t1 + first[256 + col], blast = (t0 + t1) + (t2 + t3);
            float kl[RPG];
#pragma unroll
            for (int i = 0; i < RPG; ++i) {
                const float bi = pre + cv[i]; const int r = rg * RPG + i;
                Qd[r * 136 + col] = f2bf(qv[i] * __expf(bi)); Qm[r * 136 + col] = f2bf(qv[i] * __expf(bi - bmid)); Km[r * 136 + col] = f2bf(kk[i] * __expf(bmid - bi));
                kl[i] = kk[i] * __expf(blast - bi);
            }
#pragma unroll
            for (int i = 0; i < RPG; i += 8) {
                u32x4 a, c2; a.x = pk2(kl[i], kl[i + 1]); a.y = pk2(kl[i + 2], kl[i + 3]); a.z = pk2(kl[i + 4], kl[i + 5]); a.w = pk2(kl[i + 6], kl[i + 7]);
                c2.x = pk2(vv[i], vv[i + 1]); c2.y = pk2(vv[i + 2], vv[i + 3]); c2.z = pk2(vv[i + 4], vv[i + 5]); c2.w = pk2(vv[i + 6], vv[i + 7]);
                *(u32x4*)(KlT + col * 72 + rg * RPG + i) = a; *(u32x4*)(Vt + col * 72 + rg * RPG + i) = c2;
            }
            if (rg == 0) decay[col] = __expf(blast);
        }
#pragma unroll
        for (int dvt = 0; dvt < 8; ++dvt) *(u32x2*)(St + (16 * dvt + lr) * 136 + 16 * w + 4 * lq) = pk4(S[dvt]);
        __syncthreads();
        for (int id = w; id < NT * NT; id += 8) {
            const int st = id / NT, t2 = id % NT; f32x4 acc = {0.f, 0.f, 0.f, 0.f};
#pragma unroll
            for (int ks = 0; ks < 4; ++ks) acc = MFMA16(*(const bf16x8*)(Km + (st * 16 + lr) * 136 + ks * 32 + lq * 8), *(const bf16x8*)(Qm + (t2 * 16 + lr) * 136 + ks * 32 + lq * 8), acc);
            const int t = t2 * 16 + lr;
#pragma unroll
            for (int r = 0; r < 4; ++r) if (st * 16 + 4 * lq + r > t) acc[r] = 0.f;
            *(u32x2*)(Al + t * 72 + st * 16 + 4 * lq) = pk4(acc);
        }
        f32x4 o[NT];
#pragma unroll
        for (int i = 0; i < NT; ++i) {
            f32x4 acc = {0.f, 0.f, 0.f, 0.f};
#pragma unroll
            for (int ks = 0; ks < 4; ++ks) acc = MFMA16(*(const bf16x8*)(St + (16 * (dv0 + i) + lr) * 136 + ks * 32 + lq * 8), *(const bf16x8*)(Qd + (tt * 16 + lr) * 136 + ks * 32 + lq * 8), acc);
            o[i] = acc;
        }
        __syncthreads();
        float sq = 0.f;
#pragma unroll
        for (int i = 0; i < NT; ++i) {
#pragma unroll
            for (int ks = 0; ks < L / 32; ++ks) o[i] = MFMA16(*(const bf16x8*)(Vt + (16 * (dv0 + i) + lr) * 72 + ks * 32 + lq * 8), *(const bf16x8*)(Al + (tt * 16 + lr) * 72 + ks * 32 + lq * 8), o[i]);
            sq += o[i][0] * o[i][0] + o[i][1] * o[i][1] + o[i][2] * o[i][2] + o[i][3] * o[i][3];
        }
        sq += __shfl_xor(sq, 16); sq += __shfl_xor(sq, 32);
        if (lq == 0) ssq[(w / NT) * 64 + tt * 16 + lr] = sq;
        {
            const f32x4 dc = *(const f32x4*)(decay + 16 * w + 4 * lq);
#pragma unroll
            for (int dvt = 0; dvt < 8; ++dvt) {
                f32x4 acc = S[dvt] * dc;
#pragma unroll
                for (int ks = 0; ks < L / 32; ++ks) acc = MFMA16(*(const bf16x8*)(KlT + (16 * w + lr) * 72 + ks * 32 + lq * 8), *(const bf16x8*)(Vt + (16 * dvt + lr) * 72 + ks * 32 + lq * 8), acc);
                S[dvt] = acc;
            }
        }
        __syncthreads();
        {
            float tsq = 0.f;
#pragma unroll
            for (int j = 0; j < NP; ++j) tsq += ssq[j * 64 + tt * 16 + lr];
            const float rs = rsqrtf(tsq * (1.0f / 128.0f) + EPS);
            const size_t rbase = (size_t)(row0 + tt * 16 + lr) * 1024 + h * 128;
#pragma unroll
            for (int i = 0; i < NT; ++i) {
                const int dvb = 16 * (dv0 + i) + 4 * lq;
                const u32x2 ogw = *(const u32x2*)(R4 + rbase + dvb); const f32x4 gg = *(const f32x4*)(p.in[I_GH] + dvb);
                const float og0 = bflo(ogw.x), og1 = bfhi(ogw.x), og2 = bflo(ogw.y), og3 = bfhi(ogw.y);
                f32x4 y; y[0] = o[i][0] * rs * gg[0] * og0 * sigm(og0); y[1] = o[i][1] * rs * gg[1] * og1 * sigm(og1); y[2] = o[i][2] * rs * gg[2] * og2 * sigm(og2); y[3] = o[i][3] * rs * gg[3] * og3 * sigm(og3);
                *(u32x2*)(R1 + rbase + dvb) = pk4(y);
            }
        }
    }
    float* so = p.out + (SAMPLE ? O_SST : O_PST) + (size_t)(b * 8 + h) * 16384;
#pragma unroll
    for (int dvt = 0; dvt < 8; ++dvt)
#pragma unroll
        for (int r = 0; r < 4; ++r) so[(16 * w + 4 * lq + r) * 128 + 16 * dvt + lr] = S[dvt][r];
    __syncthreads();
}

__device__ __forceinline__ void phase_rp5(const Prm& p) {
    const float* O = (const float*)(p.ws + WS_R0 + 4 * UB); bf16_t* hf = (bf16_t*)(p.ws + WS_R0); const float* g = p.in[I_GPOST];
    const int lane = threadIdx.x & 63, gw = blockIdx.x * 8 + (threadIdx.x >> 6), nw = gridDim.x * 8;
    for (int row = gw; row < MT; row += nw) {
        const float* xr = xrow(p, row); const float* orow = O + (size_t)row * 1024; f32x4 v[4], x[4]; float ss = 0.f;
#pragma unroll
        for (int i = 0; i < 4; ++i) { v[i] = *(const f32x4*)(orow + i * 256 + lane * 4); x[i] = *(const f32x4*)(xr + i * 256 + lane * 4); ss += v[i][0] * v[i][0] + v[i][1] * v[i][1] + v[i][2] * v[i][2] + v[i][3] * v[i][3]; }
        ss = wsum(ss); const float rs = rsqrtf(ss * (1.0f / 1024.0f) + EPS); float s2 = 0.f;
#pragma unroll
        for (int i = 0; i < 4; ++i) { const f32x4 gg = *(const f32x4*)(g + i * 256 + lane * 4); x[i] += v[i] * rs * gg; s2 += x[i][0] * x[i][0] + x[i][1] * x[i][1] + x[i][2] * x[i][2] + x[i][3] * x[i][3];
            *(f32x4*)(p.out + (size_t)row * 1024 + i * 256 + lane * 4) = x[i]; }
        s2 = wsum(s2); const float r2 = rsqrtf(s2 * (1.0f / 1024.0f) + EPS);
#pragma unroll
        for (int i = 0; i < 4; ++i) *(u32x2*)(hf + (size_t)row * 1024 + i * 256 + lane * 4) = pk4(x[i] * r2);
    }
    bf16_t* pbf = (bf16_t*)(p.ws + WS_KV);
    for (int id = blockIdx.x * 512 + threadIdx.x; id < MT * 32; id += gridDim.x * 512) {
        const int row = id >> 5, c = (id & 31) * 8;
        const float* s = (row < MP ? p.in[I_PP] + (size_t)row * 256 : p.in[I_PS] + (size_t)(row - MP) * 256) + c;
        *(u32x4*)(pbf + (size_t)row * 256 + c) = pk8(*(const f32x4*)s, *(const f32x4*)(s + 4));
    }
}
__device__ __forceinline__ void phase_rp8(const Prm& p) {
    const float* O = (const float*)(p.ws + WS_R0 + UB); bf16_t* xb = (bf16_t*)(p.ws + WS_R0 + 3 * UB); const float* g = p.in[I_GPFF];
    const int lane = threadIdx.x & 63, gw = blockIdx.x * 8 + (threadIdx.x >> 6), nw = gridDim.x * 8;
    for (int row = gw; row < MT; row += nw) {
        float* xr = p.out + (size_t)row * 1024; const float* orow = O + (size_t)row * 1024; f32x4 v[4], x[4]; float ss = 0.f;
#pragma unroll
        for (int i = 0; i < 4; ++i) { v[i] = *(const f32x4*)(orow + i * 256 + lane * 4); x[i] = *(const f32x4*)(xr + i * 256 + lane * 4); ss += v[i][0] * v[i][0] + v[i][1] * v[i][1] + v[i][2] * v[i][2] + v[i][3] * v[i][3]; }
        ss = wsum(ss); const float rs = rsqrtf(ss * (1.0f / 1024.0f) + EPS);
#pragma unroll
        for (int i = 0; i < 4; ++i) { const f32x4 gg = *(const f32x4*)(g + i * 256 + lane * 4); x[i] += v[i] * rs * gg;
            *(f32x4*)(xr + i * 256 + lane * 4) = x[i]; *(u32x2*)(xb + (size_t)row * 1024 + i * 256 + lane * 4) = pk4(x[i]); }
    }
}
__device__ __forceinline__ void phase_conv(const Prm& p) {
    const bf16_t* A = (const bf16_t*)(p.ws + WS_R0 + UB); bf16_t* Ug = (bf16_t*)(p.ws + WS_R0 + UB + A_BYTES);
    const float* wc = p.in[I_WCONV]; const float* bc = p.in[I_BCONV]; const float* cc = p.in[I_CC];
    for (int id = blockIdx.x * 512 + threadIdx.x; id < (MT / 32) * 352; id += gridDim.x * 512) {
        const int rb = id / 352, c0 = (id % 352) * 8, row0 = rb * 32;
        float w0[8], w1[8], w2[8], bb[8], am2[8], am1[8];
#pragma unroll
        for (int j = 0; j < 8; ++j) { w0[j] = wc[c0 + j]; w1[j] = wc[DFF + c0 + j]; w2[j] = wc[2 * DFF + c0 + j]; bb[j] = bc[c0 + j]; am2[j] = 0.f; am1[j] = 0.f; }
        if (row0 < MP) { if ((row0 & 2047) != 0) { unpk8(*(const u32x4*)(A + (size_t)(row0 - 2) * DFF + c0), am2); unpk8(*(const u32x4*)(A + (size_t)(row0 - 1) * DFF + c0), am1); } }
        else { const int b = (row0 - MP) >> 5;
#pragma unroll
            for (int j = 0; j < 8; ++j) { am2[j] = cc[(size_t)(b * 2) * DFF + c0 + j]; am1[j] = cc[(size_t)(b * 2 + 1) * DFF + c0 + j]; } }
        for (int r = 0; r < 32; ++r) {
            const size_t off = (size_t)(row0 + r) * DFF + c0; float a[8], u[8], gq[8];
            unpk8(*(const u32x4*)(A + off), a); unpk8(*(const u32x4*)(Ug + off), u);
#pragma unroll
            for (int j = 0; j < 8; ++j) {
                const float ac = bb[j] + w0[j] * am2[j] + w1[j] * am1[j] + w2[j] * a[j];
                const float y = 1.5957691216f * (ac + 0.044715f * ac * ac * ac);
                gq[j] = ac * sigm(y) * u[j]; am2[j] = am1[j]; am1[j] = a[j];
            }
            u32x4 wv; wv.x = pk2(gq[0], gq[1]); wv.y = pk2(gq[2], gq[3]); wv.z = pk2(gq[4], gq[5]); wv.w = pk2(gq[6], gq[7]);
            *(u32x4*)(Ug + off) = wv;
        }
    }
}

#ifndef P2M
#define P2M 15
#endif
#ifndef PHM
#define PHM 0xfff
#endif
__global__ void __launch_bounds__(512, 2) fwd_mega(Prm p, int ph_lo, int ph_hi) {
    extern __shared__ __attribute__((aligned(16))) unsigned char lds[];
    cg::grid_group grid = cg::this_grid();
    unsigned char* ws = p.ws;
    bf16_t* R0 = (bf16_t*)(ws + WS_R0);
#define REG(i) ((bf16_t*)(ws + WS_R0 + (size_t)(i) * UB))
#define PH_BEGIN(n) if (ph_lo <= (n) && (n) < ph_hi) { if ((n) > ph_lo) grid.sync();
#define PH_END }
#if (PHM >> 0) & 1
        PH_BEGIN(0) phase0(p, lds); PH_END
#else
#endif
#if (PHM >> 1) & 1
        PH_BEGIN(1) { F1 f; f.r0 = R0; f.kv = (bf16_t*)(ws + WS_KV); f.out = p.out; run_gemm(lds, (const bf16_t*)p.out, (const bf16_t*)(ws + WS_WIN), NIN, 1024, f); } PH_END
#else
#endif
#if (PHM >> 2) & 1
        PH_BEGIN(2) {
            const int G = gridDim.x;
#if P2M & 1
#pragma unroll 1
            for (int s = blockIdx.x; s < 256; s += G) hgrn_seq<64, false>(p, lds, s >> 3, s & 7);
#endif
#if P2M & 2
#pragma unroll 1
            for (int s = blockIdx.x; s < 256; s += G) hgrn_seq<32, true>(p, lds, s >> 3, s & 7);
#endif
            __syncthreads(); attn_bias_table(p, lds); __syncthreads();
#if P2M & 4
#pragma unroll 1
            for (int it = blockIdx.x; it < 2048; it += G) attn_item<12, 4, false>(p, lds, it >> 6, (it >> 1) & 31, it & 1);
#endif
#if P2M & 8
#pragma unroll 1
            for (int it = blockIdx.x; it < 64; it += G) attn_item<10, 2, true>(p, lds, it >> 1, 0, it & 1);
#endif
        } PH_END
#else
#endif
#if (PHM >> 3) & 1
        PH_BEGIN(3) { F2 f; f.g = REG(5); f.o = REG(2); run_gemm(lds, REG(0), (const bf16_t*)(ws + WS_WBRA), 1024, 1024, f); } PH_END
#else
#endif
#if (PHM >> 4) & 1
        PH_BEGIN(4) { F3 f; f.g = REG(6); f.t = REG(2); f.o = REG(3); run_gemm(lds, REG(1), (const bf16_t*)(ws + WS_WBRB), 1024, 1024, f); } PH_END
#else
#endif
#if (PHM >> 5) & 1
        PH_BEGIN(5) { FF32 f; f.o = (float*)REG(4); run_gemm(lds, REG(3), (const bf16_t*)(ws + WS_WOUT), 1024, 1024, f); } PH_END
#else
#endif
#if (PHM >> 6) & 1
        PH_BEGIN(6) phase_rp5(p); PH_END
#else
#endif
#if (PHM >> 7) & 1
        PH_BEGIN(7) { F6 f; f.a = REG(1); f.u = (bf16_t*)(ws + WS_R0 + UB + A_BYTES); f.out = p.out; run_gemm(lds, REG(0), (const bf16_t*)(ws + WS_WUP), 2 * DFF, 1024, f); } PH_END
#else
#endif
#if (PHM >> 8) & 1
        PH_BEGIN(8) phase_conv(p); PH_END
#else
#endif
        PH_BEGIN(9) { FF32 f; f.o = (float*)REG(1); run_gemm(lds, (const bf16_t*)(ws + WS_R0 + UB + A_BYTES), (const bf16_t*)(ws + WS_WDOWN), 1024, DFF, f);
                  FBF f2; f2.o = REG(0); run_gemm(lds, (const bf16_t*)(ws + WS_KV), (const bf16_t*)(ws + WS_WPLE), 1024, 256, f2); } PH_END
#if (PHM >> 10) & 1
        PH_BEGIN(10) phase_rp8(p); PH_END
#else
#endif
#if (PHM >> 11) & 1
        PH_BEGIN(11) { F9 f; f.pe = REG(0); f.y = p.out; run_gemm(lds, REG(3), (const bf16_t*)(ws + WS_WPG), 1024, 1024, f); } PH_END
#else
#endif
#undef REG
}

extern "C" void kernel_launch(void* const* d_in, const int* in_sizes, int n_in, void* d_out, int out_size, void* d_ws, size_t ws_size, hipStream_t stream) {
    static int grid = 0;
    if (grid == 0) {
        if (n_in != 26 || (size_t)out_size != O_END || ws_size < WS_END) { fprintf(stderr, "kernel_launch: unexpected shapes n_in %d out %d ws %zu (need %zu)\n", n_in, out_size, ws_size, (size_t)WS_END); grid = -1; return; }
        int dev = 0, cus = 0, per_cu = 0;
        hipGetDevice(&dev); hipDeviceGetAttribute(&cus, hipDeviceAttributeMultiprocessorCount, dev);
        if (hipFuncSetAttribute((const void*)fwd_mega, hipFuncAttributeMaxDynamicSharedMemorySize, LDS_BYTES) != hipSuccess) { fprintf(stderr, "kernel_launch: hipFuncSetAttribute failed\n"); grid = -1; return; }
        if (hipOccupancyMaxActiveBlocksPerMultiprocessor(&per_cu, (const void*)fwd_mega, 512, LDS_BYTES) != hipSuccess || per_cu < 1) { fprintf(stderr, "kernel_launch: occupancy query says %d\n", per_cu); per_cu = 1; }
        (void)hipGetLastError();
        grid = cus;
    }
    if (grid < 0) return;
    Prm p{};
    for (int i = 0; i < 26; ++i) p.in[i] = (const float*)d_in[i];
    p.out = (float*)d_out; p.ws = (unsigned char*)d_ws;
    int lo = 0, hi = 12;
    void* args[] = {&p, &lo, &hi};
    hipError_t e = hipLaunchCooperativeKernel((const void*)fwd_mega, dim3(grid), dim3(512), args, LDS_BYTES, stream);
    if (e != hipSuccess) fprintf(stderr, "kernel_launch: cooperative launch failed: %s (grid %d)\n", hipGetErrorString(e), grid);
}
```

```cpp
#include <hip/hip_runtime.h>
#include <hip/hip_cooperative_groups.h>
#include <cstdio>
namespace cg = cooperative_groups;
namespace pg8 {
#define PG8_LAS __attribute__((address_space(3)))
typedef unsigned short bf16_t;
typedef short bf16x8 __attribute__((ext_vector_type(8)));
typedef float f32x4 __attribute__((ext_vector_type(4)));
typedef unsigned u32x4 __attribute__((ext_vector_type(4)));
constexpr int BM = 256, BK = 64, HALF = 128, HTB = HALF * BK * 2  , STAGE_BYTES = 8 * HTB, NXCD = 8, WGM = 8;

__host__ __device__ __forceinline__ int lds_byte(int r, int c) { const int st = (r >> 4) * 2 + (c >> 5), rr = r & 15, cc = c & 31, ob = rr * 64 + cc * 2; return st * 1024 + (ob ^ (((ob >> 9) & 1) << 5)); }
__host__ __device__ __forceinline__ void stage_rc(int b, int& R, int& C) { const int st = b / 1024, sb = b % 1024, swz = sb ^ (((sb >> 9) & 1) << 5); R = (st >> 1) * 16 + swz / 64; C = (st & 1) * 32 + (swz % 64) / 2; }
__host__ __device__ __forceinline__ int perm32(int rho) { const int n = rho >> 4, i = rho & 15; return 8 * (i >> 2) + 4 * n + (i & 3); }

struct Unit { int pm, pn; };
struct Gemm { const bf16_t* A; const bf16_t* Bt; int M, N, K; };

struct StaticOrder {
    int nM, nN, nwg, G, c;
    __host__ __device__ void init(int M, int N, int G_, int c_) { nM = M / BM; nN = N / BM; nwg = nM * nN; G = G_; c = c_; }
    __host__ __device__ bool next(int i, Unit& u) const {
        const long L = (long)i * G + c; if (L >= nwg) return false;
        int wgid = (int)L; { const int q = nwg / NXCD, r = nwg % NXCD, xcd = wgid % NXCD, off = wgid / NXCD; wgid = (xcd < r ? xcd * (q + 1) : r * (q + 1) + (xcd - r) * q) + off; }
        const int nig = WGM * nN, gid = wgid / nig, fm = gid * WGM, gsz = (nM - fm) < WGM ? (nM - fm) : WGM;
        u.pm = fm + ((wgid % nig) % gsz); u.pn = (wgid % nig) / gsz; return true;
    }
    __device__ __forceinline__ void a_ready(const Unit&) const {}
    __device__ __forceinline__ void done(const Unit&) const {}
};
__device__ __forceinline__ unsigned cvt_pk_bf16(float lo, float hi) { unsigned r; asm volatile("v_cvt_pk_bf16_f32 %0, %1, %2" : "=v"(r) : "v"(lo), "v"(hi)); return r; }
template <class Epi, class Sched, bool STAMP = false>
__device__ __forceinline__ void gemm_phase(PG8_LAS unsigned char* lds, const Gemm g, const Sched& S, const Epi& E, unsigned long long* stamps) {
    const int tid = threadIdx.x, wid = __builtin_amdgcn_readfirstlane(tid >> 6), lane = tid & 63, wr = wid >> 2, wc = wid & 3, fr = lane & 15, fq = lane >> 4;
    const int K = g.K, nt = K / BK;
    int ts_lo = 0, ts_hi = 0, nts = 0; const unsigned long long rt_entry = STAMP ? (unsigned long long)wall_clock64() : 0ull;
#define PG8_STAMP() do { if (STAMP && wid == 0 && nts < 64) { const unsigned long long _c = (unsigned long long)clock64(); \
        ts_lo = (lane == nts) ? (int)(unsigned)_c : ts_lo; ts_hi = (lane == nts) ? (int)(unsigned)(_c >> 32) : ts_hi; ++nts; } } while (0)
    PG8_STAMP();
    unsigned voffA[2], voffB[2];
#pragma unroll
    for (int i = 0; i < 2; ++i) { int R, C; stage_rc(tid * 16 + i * 8192, R, C); const int Rb = Epi::PERM ? ((R & ~31) + perm32(R & 31)) : R;
        voffA[i] = (unsigned)(R * K + C) * 2u; voffB[i] = (unsigned)(Rb * K + C) * 2u; }
    const size_t kstep = (size_t)(BK * 2);
    const size_t hstep = (size_t)HALF * K * 2;
    const size_t tstep = 2 * hstep;
    const unsigned ldsw = (unsigned)wid * 1024u;
    const int aoff = lds_byte(wr * 64 + fr, fq * 8), boff = lds_byte(wc * 32 + fr, fq * 8);
#define PG8_SA(b, h) (((b) * 2 + (h)) * HTB)
#define PG8_SB(b, h) ((4 + (b) * 2 + (h)) * HTB)
#define PG8_STAGE(bufoff, gbase, voff) do { _Pragma("unroll") for (int _i = 0; _i < 2; ++_i) \
        __builtin_amdgcn_global_load_lds((const unsigned*)((const char*)(gbase) + (voff)[_i]), (PG8_LAS unsigned*)(lds + (bufoff) + ldsw + _i * 8192), 16, 0, 0); } while (0)
#define PG8_LDA(dst, b, h) do { _Pragma("unroll") for (int m = 0; m < 4; ++m) _Pragma("unroll") for (int k = 0; k < 2; ++k) dst[m][k] = *(const PG8_LAS bf16x8*)(lds + PG8_SA(b, h) + aoff + m * 2048 + k * 1024); } while (0)
#define PG8_LDB(dst, b, h) do { _Pragma("unroll") for (int n = 0; n < 2; ++n) _Pragma("unroll") for (int k = 0; k < 2; ++k) dst[n][k] = *(const PG8_LAS bf16x8*)(lds + PG8_SB(b, h) + boff + n * 2048 + k * 1024); } while (0)
#define PG8_MMA(ai, bj, At, Bt) do { __builtin_amdgcn_s_setprio(1); _Pragma("unroll") for (int m = 0; m < 4; ++m) _Pragma("unroll") for (int n = 0; n < 2; ++n) _Pragma("unroll") for (int k = 0; k < 2; ++k) \
        acc[ai][bj][m][n] = __builtin_amdgcn_mfma_f32_16x16x32_bf16(Bt[n][k], At[m][k], acc[ai][bj][m][n], 0, 0, 0); __builtin_amdgcn_s_setprio(0); } while (0)
#define PG8_WAIT_V(n) asm volatile("s_waitcnt vmcnt(" #n ")" ::: "memory")
#define PG8_WAIT_L(n) asm volatile("s_waitcnt lgkmcnt(" #n ")" ::: "memory")
#define PG8_BAR __builtin_amdgcn_s_barrier()
#define PG8_SCHED __builtin_amdgcn_sched_barrier(0)
    Unit cur, nxt; int ui = 0;
    if (!S.next(0, cur)) return;
    f32x4 acc[2][2][4][2];
#pragma unroll
    for (int a = 0; a < 2; ++a)
#pragma unroll
        for (int b = 0; b < 2; ++b)
#pragma unroll
            for (int m = 0; m < 4; ++m)
#pragma unroll
                for (int n = 0; n < 2; ++n) acc[a][b][m][n] = (f32x4){0.f, 0.f, 0.f, 0.f};
    bf16x8 At[4][2], B0[2][2], B1[2][2];
    const char* cA = (const char*)g.A + (size_t)cur.pm * tstep; const char* cB = (const char*)g.Bt + (size_t)cur.pn * tstep;
    S.a_ready(cur);
    PG8_STAGE(PG8_SB(0, 0), cB, voffB); PG8_STAGE(PG8_SA(0, 0), cA, voffA); PG8_STAGE(PG8_SB(0, 1), cB + hstep, voffB); PG8_STAGE(PG8_SA(0, 1), cA + hstep, voffA);
    if (wr == 1) PG8_BAR;
    PG8_WAIT_V(4); PG8_BAR;
    PG8_STAGE(PG8_SB(1, 0), cB + kstep, voffB); PG8_STAGE(PG8_SA(1, 0), cA + kstep, voffA); PG8_STAGE(PG8_SB(1, 1), cB + hstep + kstep, voffB);
    PG8_WAIT_V(6); PG8_BAR;
    PG8_STAMP();
    for (;;) {
        const bool has_next = S.next(ui + 1, nxt);
        const char* nA = has_next ? (const char*)g.A + (size_t)nxt.pm * tstep : cA; const char* nB = has_next ? (const char*)g.Bt + (size_t)nxt.pn * tstep : cB;
        for (int t = 0; t < nt; t += 2) {
            const bool last = (t == nt - 2);
            const char* a1 = cA + (size_t)(t + 1) * kstep;
            const char* a2 = last ? nA : cA + (size_t)(t + 2) * kstep; const char* b2 = last ? nB : cB + (size_t)(t + 2) * kstep;
            const char* a3 = a2 + kstep; const char* b3 = b2 + kstep;
            if (last && has_next) S.a_ready(nxt);
            PG8_LDB(B0, 0, 0); PG8_SCHED; PG8_LDA(At, 0, 0); PG8_STAGE(PG8_SA(1, 1), a1 + hstep, voffA);
            PG8_WAIT_L(8); PG8_BAR; PG8_WAIT_L(0); PG8_MMA(0, 0, At, B0); PG8_BAR; PG8_SCHED;
            PG8_LDB(B1, 0, 1); PG8_STAGE(PG8_SB(0, 0), b2, voffB);
            PG8_BAR; PG8_WAIT_L(0); PG8_MMA(0, 1, At, B1); PG8_BAR;
            PG8_LDA(At, 0, 1); PG8_STAGE(PG8_SA(0, 0), a2, voffA);
            PG8_BAR; PG8_WAIT_L(0); PG8_MMA(1, 0, At, B0); PG8_BAR; PG8_SCHED;
            PG8_STAGE(PG8_SB(0, 1), b2 + hstep, voffB);
            PG8_WAIT_V(6); PG8_BAR; PG8_MMA(1, 1, At, B1); PG8_BAR;
            PG8_LDB(B0, 1, 0); PG8_SCHED; PG8_LDA(At, 1, 0); PG8_STAGE(PG8_SA(0, 1), a2 + hstep, voffA);
            PG8_WAIT_L(8); PG8_BAR; PG8_WAIT_L(0); PG8_MMA(0, 0, At, B0); PG8_BAR; PG8_SCHED;
            PG8_LDB(B1, 1, 1); PG8_STAGE(PG8_SB(1, 0), b3, voffB);
            PG8_BAR; PG8_WAIT_L(0); PG8_MMA(0, 1, At, B1); PG8_BAR;
            PG8_LDA(At, 1, 1); PG8_STAGE(PG8_SA(1, 0), a3, voffA);
            PG8_BAR; PG8_WAIT_L(0); PG8_MMA(1, 0, At, B0); PG8_BAR; PG8_SCHED;
            PG8_STAGE(PG8_SB(1, 1), b3 + hstep, voffB);
            PG8_WAIT_V(6); PG8_BAR; PG8_MMA(1, 1, At, B1); PG8_BAR;
        }
        PG8_STAMP();
        if constexpr (!Epi::AFTER_DRAIN) { E(acc, cur, wr, wc, fr, fq); S.done(cur); }
        PG8_STAMP();
        if (!has_next) break;
#pragma unroll
        for (int a = 0; a < 2; ++a)
#pragma unroll
            for (int b = 0; b < 2; ++b)
#pragma unroll
                for (int m = 0; m < 4; ++m)
#pragma unroll
                    for (int n = 0; n < 2; ++n) acc[a][b][m][n] = (f32x4){0.f, 0.f, 0.f, 0.f};
        cur = nxt; cA = nA; cB = nB; ++ui;
    }
    PG8_WAIT_V(0);
    if (wr == 0) PG8_BAR;
    PG8_BAR;
    if constexpr (Epi::AFTER_DRAIN) { E.fused(acc, cur, wr, wc, fr, fq, lds, wid, lane); S.done(cur); }
    PG8_STAMP();
    if (STAMP && wid == 0) { stamps[lane] = lane < nts ? (((unsigned long long)(unsigned)ts_hi << 32) | (unsigned)ts_lo) : 0ull;
        if (lane == 62) stamps[62] = rt_entry; if (lane == 63) stamps[63] = (unsigned long long)wall_clock64(); }
#undef PG8_STAMP
#undef PG8_SA
#undef PG8_SB
#undef PG8_STAGE
#undef PG8_LDA
#undef PG8_LDB
#undef PG8_MMA
#undef PG8_WAIT_V
#undef PG8_WAIT_L
#undef PG8_BAR
#undef PG8_SCHED
}
}


using pg8::bf16_t; using pg8::bf16x8; using pg8::f32x4; using pg8::u32x4;
typedef unsigned u32x2 __attribute__((ext_vector_type(2)));
typedef float f32x2v __attribute__((ext_vector_type(2)));
#define MFMA16(a, b, c) __builtin_amdgcn_mfma_f32_16x16x32_bf16((a), (b), (c), 0, 0, 0)

constexpr int MP = 65536, MS = 1024, MT = MP + MS, DM = 1024, DFF = 2816, NIN = 7424;
constexpr float EPS = 1e-6f;
constexpr size_t UB = (size_t)MT * 1024 * 2;
constexpr size_t WS_WIN = 0, WS_WBRA = WS_WIN + (size_t)NIN * 1024 * 2, WS_WBRB = WS_WBRA + 2097152, WS_WOUT = WS_WBRB + 2097152, WS_WPG = WS_WOUT + 2097152,
                 WS_WUP = WS_WPG + 2097152, WS_WDOWN = WS_WUP + (size_t)2 * DFF * 1024 * 2, WS_WPLE = WS_WDOWN + (size_t)1024 * DFF * 2, WS_KV = WS_WPLE + (size_t)1024 * 256 * 2,
                 WS_R0 = WS_KV + (size_t)MT * 256 * 2, WS_END = WS_R0 + 7 * UB;
constexpr size_t A_BYTES = (size_t)MT * DFF * 2;
constexpr size_t O_Y = 0, O_PWK = (size_t)MT * 1024, O_PWV = O_PWK + 524288, O_PST = O_PWV + 524288, O_PFC = O_PST + 4194304, O_SWK = O_PFC + 180224, O_SWV = O_SWK + 131072,
                 O_SST = O_SWV + 131072, O_SFC = O_SST + 4194304, O_END = O_SFC + 180224;
constexpr int LDS_BYTES = 147456;

struct Prm { const float* in[26]; float* out; unsigned char* ws; };
enum { I_XP = 0, I_XS, I_CK, I_CV, I_ST, I_CC, I_PP, I_PS, I_RB, I_LB, I_GPM, I_WIN, I_SINK, I_GH, I_WBRA, I_WBRB, I_WOUT, I_GPOST, I_GPF, I_WUP, I_WCONV, I_BCONV, I_WDOWN, I_GPFF, I_WPLE, I_WPG };

__device__ __forceinline__ unsigned pk2(float lo, float hi) { unsigned r; asm("v_cvt_pk_bf16_f32 %0, %1, %2" : "=v"(r) : "v"(lo), "v"(hi)); return r; }
__device__ __forceinline__ float bflo(unsigned w) { return __uint_as_float(w << 16); }
__device__ __forceinline__ float bfhi(unsigned w) { return __uint_as_float(w & 0xffff0000u); }
__device__ __forceinline__ float bf1(bf16_t b) { return __uint_as_float(((unsigned)b) << 16); }
__device__ __forceinline__ bf16_t f2bf(float f) { return (bf16_t)(pk2(f, 0.f) & 0xffffu); }
__device__ __forceinline__ float sigm(float x) { return __builtin_amdgcn_rcpf(1.0f + __expf(-x)); }
__device__ __forceinline__ float wsum(float v) { v += __shfl_xor(v, 32); v += __shfl_xor(v, 16); v += __shfl_xor(v, 8); v += __shfl_xor(v, 4); v += __shfl_xor(v, 2); v += __shfl_xor(v, 1); return v; }
__device__ __forceinline__ u32x4 pk8(f32x4 a, f32x4 b) { u32x4 w; w.x = pk2(a[0], a[1]); w.y = pk2(a[2], a[3]); w.z = pk2(b[0], b[1]); w.w = pk2(b[2], b[3]); return w; }
__device__ __forceinline__ u32x2 pk4(f32x4 a) { u32x2 w; w.x = pk2(a[0], a[1]); w.y = pk2(a[2], a[3]); return w; }
__device__ __forceinline__ void unpk8(u32x4 w, float (&f)[8]) { f[0] = bflo(w.x); f[1] = bfhi(w.x); f[2] = bflo(w.y); f[3] = bfhi(w.y); f[4] = bflo(w.z); f[5] = bfhi(w.z); f[6] = bflo(w.w); f[7] = bfhi(w.w); }

template <class F> struct EpiT {
    static constexpr bool PERM = true, AFTER_DRAIN = false; F f;
    __device__ __forceinline__ void operator()(const f32x4 (&acc)[2][2][4][2], const pg8::Unit& u, int wr, int wc, int fr, int fq) const {
        const int row0 = u.pm * 256 + wr * 64 + fr, col0 = u.pn * 256 + wc * 32 + 8 * fq;
#pragma unroll
        for (int ai = 0; ai < 2; ++ai)
#pragma unroll
            for (int m = 0; m < 4; ++m)
#pragma unroll
                for (int bj = 0; bj < 2; ++bj) f(row0 + ai * 128 + m * 16, col0 + bj * 128, u.pn, acc[ai][bj][m][0], acc[ai][bj][m][1]);
    }
};
struct F1 {
    bf16_t* r0; bf16_t* kv; float* out;
    __device__ __forceinline__ void operator()(int row, int col, int pn, f32x4 v0, f32x4 v1) const {
        const u32x4 w = pk8(v0, v1);
        if (pn < 4) { *(u32x4*)(r0 + (size_t)row * 1024 + col) = w; }
        else if (pn == 4) {
            const int c = col - 1024; *(u32x4*)(kv + (size_t)row * 256 + c) = w;
            float* o = nullptr;
            if (row >= MP) { o = out + (c < 128 ? O_SWK : O_SWV) + (size_t)(row - MP) * 128 + (c & 127); }
            else { const int t = row & 2047; if (t >= 1920) o = out + (c < 128 ? O_PWK : O_PWV) + (size_t)((row >> 11) * 128 + t - 1920) * 128 + (c & 127); }
            if (o) { *(f32x4*)o = v0; *(f32x4*)(o + 4) = v1; }
        } else { const int c2 = col - 1280, seg = c2 >> 10; *(u32x4*)(r0 + (size_t)(1 + seg) * (UB / 2) + (size_t)row * 1024 + (c2 & 1023)) = w; }
    }
};
struct F2 {
    const bf16_t* g; bf16_t* o;
    __device__ __forceinline__ void operator()(int row, int col, int, f32x4 v0, f32x4 v1) const {
        const size_t i = (size_t)row * 1024 + col; float gf[8]; unpk8(*(const u32x4*)(g + i), gf);
        f32x4 a, b;
#pragma unroll
        for (int j = 0; j < 4; ++j) { a[j] = v0[j] * sigm(gf[j]); b[j] = v1[j] * sigm(gf[4 + j]); }
        *(u32x4*)(o + i) = pk8(a, b);
    }
};
struct F3 {
    const bf16_t* g; const bf16_t* t; bf16_t* o;
    __device__ __forceinline__ void operator()(int row, int col, int, f32x4 v0, f32x4 v1) const {
        const size_t i = (size_t)row * 1024 + col; float gf[8], tf[8]; unpk8(*(const u32x4*)(g + i), gf); unpk8(*(const u32x4*)(t + i), tf);
        f32x4 a, b;
#pragma unroll
        for (int j = 0; j < 4; ++j) { a[j] = tf[j] + v0[j] * sigm(gf[j]); b[j] = tf[4 + j] + v1[j] * sigm(gf[4 + j]); }
        *(u32x4*)(o + i) = pk8(a, b);
    }
};
struct FF32 {
    float* o;
    __device__ __forceinline__ void operator()(int row, int col, int, f32x4 v0, f32x4 v1) const { float* d = o + (size_t)row * 1024 + col; *(f32x4*)d = v0; *(f32x4*)(d + 4) = v1; }
};
struct FBF {
    bf16_t* o;
    __device__ __forceinline__ void operator()(int row, int col, int, f32x4 v0, f32x4 v1) const { *(u32x4*)(o + (size_t)row * 1024 + col) = pk8(v0, v1); }
};
struct F6 {
    bf16_t* a; bf16_t* u; float* out;
    __device__ __forceinline__ void operator()(int row, int col, int pn, f32x4 v0, f32x4 v1) const {
        const u32x4 w = pk8(v0, v1);
        if (pn < 11) {
            *(u32x4*)(a + (size_t)row * DFF + col) = w;
            float* o = nullptr;
            if (row >= MP) { const int rs = row - MP, t = rs & 31; if (t >= 30) o = out + O_SFC + (size_t)((rs >> 5) * 2 + t - 30) * DFF + col; }
            else { const int t = row & 2047; if (t >= 2046) o = out + O_PFC + (size_t)((row >> 11) * 2 + t - 2046) * DFF + col; }
            if (o) { *(f32x4*)o = v0; *(f32x4*)(o + 4) = v1; }
        } else *(u32x4*)(u + (size_t)row * DFF + (col - DFF)) = w;
    }
};
struct F9 {
    const bf16_t* pe; float* y;
    __device__ __forceinline__ void operator()(int row, int col, int, f32x4 v0, f32x4 v1) const {
        const size_t i = (size_t)row * 1024 + col; float pf[8]; unpk8(*(const u32x4*)(pe + i), pf);
        f32x4 a = *(const f32x4*)(y + i), b = *(const f32x4*)(y + i + 4);
#pragma unroll
        for (int j = 0; j < 4; ++j) { a[j] += pf[j] * sigm(v0[j]); b[j] += pf[4 + j] * sigm(v1[j]); }
        *(f32x4*)(y + i) = a; *(f32x4*)(y + i + 4) = b;
    }
};
template <class F> __device__ __forceinline__ void run_gemm(unsigned char* lds, const bf16_t* A, const bf16_t* Bt, int N, int K, const F& f) {
    asm volatile("" : "+s"(K)); asm volatile("" : "+s"(N));
    pg8::Gemm g; g.A = A; g.Bt = Bt; g.M = MT; g.N = N; g.K = K;
    pg8::StaticOrder S; S.init(MT, N, (int)gridDim.x, (int)blockIdx.x);
    EpiT<F> E; E.f = f;
    pg8::gemm_phase<EpiT<F>, pg8::StaticOrder, false>((PG8_LAS unsigned char*)lds, g, S, E, nullptr);
    __syncthreads();
}

__device__ __forceinline__ void transpose_w(const float* W, bf16_t* Bt, int K, int N, const float* gain, float* tile, int& toff) {
    const int nnt = N / 64, ntiles = (K / 64) * nnt, tid = threadIdx.x, G = gridDim.x;
    int first = ((int)blockIdx.x - (toff % G) + G) % G;
    for (int t = first; t < ntiles; t += G) {
        const int kt = t / nnt, nt = t % nnt;
#pragma unroll
        for (int i = 0; i < 8; ++i) { const int r = (tid >> 6) + 8 * i, c = tid & 63; float v = W[(size_t)(kt * 64 + r) * N + nt * 64 + c]; if (gain) v *= gain[kt * 64 + r]; tile[r * 65 + c] = v; }
        __syncthreads();
        { const int n = tid >> 3, k8 = (tid & 7) * 8; u32x4 wv;
          wv.x = pk2(tile[(k8 + 0) * 65 + n], tile[(k8 + 1) * 65 + n]); wv.y = pk2(tile[(k8 + 2) * 65 + n], tile[(k8 + 3) * 65 + n]);
          wv.z = pk2(tile[(k8 + 4) * 65 + n], tile[(k8 + 5) * 65 + n]); wv.w = pk2(tile[(k8 + 6) * 65 + n], tile[(k8 + 7) * 65 + n]);
          *(u32x4*)(Bt + (size_t)(nt * 64 + n) * K + kt * 64 + k8) = wv; }
        __syncthreads();
    }
    toff += ntiles;
}
__device__ __forceinline__ const float* xrow(const Prm& p, int row) { return row < MP ? p.in[I_XP] + (size_t)row * 1024 : p.in[I_XS] + (size_t)(row - MP) * 1024; }

__device__ __forceinline__ void phase0(const Prm& p, unsigned char* lds) {
    float* tile = (float*)lds; int toff = 0; unsigned char* ws = p.ws;
    transpose_w(p.in[I_WIN], (bf16_t*)(ws + WS_WIN), 1024, NIN, p.in[I_GPM], tile, toff);
    transpose_w(p.in[I_WUP], (bf16_t*)(ws + WS_WUP), 1024, 2 * DFF, p.in[I_GPF], tile, toff);
    transpose_w(p.in[I_WDOWN], (bf16_t*)(ws + WS_WDOWN), DFF, 1024, nullptr, tile, toff);
    transpose_w(p.in[I_WBRA], (bf16_t*)(ws + WS_WBRA), 1024, 1024, nullptr, tile, toff);
    transpose_w(p.in[I_WBRB], (bf16_t*)(ws + WS_WBRB), 1024, 1024, nullptr, tile, toff);
    transpose_w(p.in[I_WOUT], (bf16_t*)(ws + WS_WOUT), 1024, 1024, nullptr, tile, toff);
    transpose_w(p.in[I_WPG], (bf16_t*)(ws + WS_WPG), 1024, 1024, nullptr, tile, toff);
    transpose_w(p.in[I_WPLE], (bf16_t*)(ws + WS_WPLE), 256, 1024, nullptr, tile, toff);
    bf16_t* xn = (bf16_t*)p.out;
    const int lane = threadIdx.x & 63, gw = blockIdx.x * 8 + (threadIdx.x >> 6), nw = gridDim.x * 8;
    for (int row = gw; row < MT; row += nw) {
        const float* xr = xrow(p, row); f32x4 v[4]; float ss = 0.f;
#pragma unroll
        for (int i = 0; i < 4; ++i) { v[i] = *(const f32x4*)(xr + i * 256 + lane * 4); ss += v[i][0] * v[i][0] + v[i][1] * v[i][1] + v[i][2] * v[i][2] + v[i][3] * v[i][3]; }
        ss = wsum(ss); const float rs = rsqrtf(ss * (1.0f / 1024.0f) + EPS);
#pragma unroll
        for (int i = 0; i < 4; ++i) *(u32x2*)(xn + (size_t)row * 1024 + i * 256 + lane * 4) = pk4(v[i] * rs);
    }
}

constexpr int AT_KS = 0, AT_VT = 27648, AT_BT = 53248;
__device__ __forceinline__ void attn_bias_table(const Prm& p, unsigned char* lds) {
    float* bT = (float*)(lds + AT_BT); const float* tab = p.in[I_RB];
    for (int i = threadIdx.x; i < 16 * 256; i += 512) {
        const int head = i >> 8, idx = i & 255, rel = idx - 191, n = rel < 0 ? -rel : rel;
        int bk = n < 8 ? n : min(15, 33 - __clz(n * n)); if (rel > 0) bk += 16;
        bT[i] = idx < 255 ? tab[bk * 16 + head] : 0.f;
    }
}
template <int NKT, int NQT, bool SAMPLE>
__device__ __forceinline__ void attn_item(const Prm& p, unsigned char* lds, int b, int c, int kvh, bf16_t* YA) {
    bf16_t* Ks = (bf16_t*)(lds + AT_KS); bf16_t* Vt = (bf16_t*)(lds + AT_VT); const float* bT = (const float*)(lds + AT_BT);
    const bf16_t* kv = (const bf16_t*)(p.ws + WS_KV); bf16_t* R0 = (bf16_t*)(p.ws + WS_R0);
    const int tid = threadIdx.x, lane = tid & 63, w = tid >> 6, lr = lane & 15, lq = lane >> 4;
    __syncthreads();
    if (!SAMPLE) {
        const int tok0 = b * 2048 + (c - 2) * 64;
        for (int id = tid; id < 192 * 8; id += 512) {
            const int key = id >> 3, dc = id & 7; u32x4 v = {0u, 0u, 0u, 0u};
            if (c * 64 - 128 + key >= 0) v = *(const u32x4*)(kv + (size_t)(tok0 + key) * 256 + kvh * 64 + dc * 8);
            *(u32x4*)(Ks + key * 72 + dc * 8) = v;
        }
        for (int id = tid; id < 192 * 8; id += 512) {
            const int key = id % 192, dc = id / 192; u32x4 v = {0u, 0u, 0u, 0u};
            if (c * 64 - 128 + key >= 0) v = *(const u32x4*)(kv + (size_t)(tok0 + key) * 256 + 128 + kvh * 64 + dc * 8);
            bf16_t* d = Vt + (dc * 8) * 200 + key;
            d[0] = (bf16_t)(v.x & 0xffffu); d[200] = (bf16_t)(v.x >> 16); d[400] = (bf16_t)(v.y & 0xffffu); d[600] = (bf16_t)(v.y >> 16);
            d[800] = (bf16_t)(v.z & 0xffffu); d[1000] = (bf16_t)(v.z >> 16); d[1200] = (bf16_t)(v.w & 0xffffu); d[1400] = (bf16_t)(v.w >> 16);
        }
    } else {
        const float* ck = p.in[I_CK]; const float* cvp = p.in[I_CV];
        for (int id = tid; id < 160 * 8; id += 512) {
            const int key = id >> 3, dc = id & 7; u32x4 v;
            if (key < 128) { const float* s = ck + (size_t)(b * 128 + key) * 128 + kvh * 64 + dc * 8; v = pk8(*(const f32x4*)s, *(const f32x4*)(s + 4)); }
            else v = *(const u32x4*)(kv + (size_t)(MP + b * 32 + key - 128) * 256 + kvh * 64 + dc * 8);
            *(u32x4*)(Ks + key * 72 + dc * 8) = v;
        }
        for (int id = tid; id < 160 * 8; id += 512) {
            const int key = id % 160, dc = id / 160; u32x4 v;
            if (key < 128) { const float* s = cvp + (size_t)(b * 128 + key) * 128 + kvh * 64 + dc * 8; v = pk8(*(const f32x4*)s, *(const f32x4*)(s + 4)); }
            else v = *(const u32x4*)(kv + (size_t)(MP + b * 32 + key - 128) * 256 + 128 + kvh * 64 + dc * 8);
            bf16_t* d = Vt + (dc * 8) * 200 + key;
            d[0] = (bf16_t)(v.x & 0xffffu); d[200] = (bf16_t)(v.x >> 16); d[400] = (bf16_t)(v.y & 0xffffu); d[600] = (bf16_t)(v.y >> 16);
            d[800] = (bf16_t)(v.z & 0xffffu); d[1000] = (bf16_t)(v.z >> 16); d[1200] = (bf16_t)(v.w & 0xffffu); d[1400] = (bf16_t)(v.w >> 16);
        }
    }
    __syncthreads();
    const int head = kvh * 8 + w; const float sink = p.in[I_SINK][head];
    const int qrow0 = SAMPLE ? MP + b * 32 : b * 2048 + c * 64;
    const float* bTh = bT + head * 256;
#pragma unroll 1
    for (int qi = 0; qi < NQT; ++qi) {
        const int q = qi * 16 + lr;
        const size_t qoff = (size_t)(qrow0 + q) * 1024 + head * 64 + lq * 8;
        const bf16x8 qf0 = *(const bf16x8*)(R0 + qoff), qf1 = *(const bf16x8*)(R0 + qoff + 32);
        f32x4 s[NKT];
#pragma unroll
        for (int kt = 0; kt < NKT; ++kt) {
            const bf16_t* kp = Ks + (kt * 16 + lr) * 72 + lq * 8;
            const bf16x8 k0 = *(const bf16x8*)kp, k1 = *(const bf16x8*)(kp + 32);
            f32x4 a = {0.f, 0.f, 0.f, 0.f}; a = MFMA16(k0, qf0, a); a = MFMA16(k1, qf1, a); s[kt] = a;
        }
        float mx = sink;
#pragma unroll
        for (int kt = 0; kt < NKT; ++kt)
#pragma unroll
            for (int r = 0; r < 4; ++r) {
                const int key = kt * 16 + lq * 4 + r; float v = s[kt][r] * 0.125f + bTh[key - q + 63];
                if (!SAMPLE && (c * 64 - 128 + key < 0)) v = -1e30f;
                s[kt][r] = v; mx = fmaxf(mx, v);
            }
        mx = fmaxf(mx, __shfl_xor(mx, 16)); mx = fmaxf(mx, __shfl_xor(mx, 32));
        float sum = 0.f;
#pragma unroll
        for (int kt = 0; kt < NKT; ++kt)
#pragma unroll
            for (int r = 0; r < 4; ++r) { const float e = __expf(s[kt][r] - mx); s[kt][r] = e; sum += e; }
        sum += __shfl_xor(sum, 16); sum += __shfl_xor(sum, 32);
        const float inv = 1.0f / (sum + __expf(sink - mx));
        f32x4 o[4];
#pragma unroll
        for (int dt = 0; dt < 4; ++dt) o[dt] = (f32x4){0.f, 0.f, 0.f, 0.f};
#pragma unroll
        for (int ks = 0; ks < NKT / 2; ++ks) {
            const u32x4 pw = pk8(s[2 * ks], s[2 * ks + 1]); const bf16x8 pf = __builtin_bit_cast(bf16x8, pw);
#pragma unroll
            for (int dt = 0; dt < 4; ++dt) {
                const bf16_t* vp = Vt + (dt * 16 + lr) * 200 + ks * 32 + lq * 4;
                const u32x2 lo = *(const u32x2*)vp, hi = *(const u32x2*)(vp + 16);
                const u32x4 vw = {lo.x, lo.y, hi.x, hi.y};
                o[dt] = MFMA16(__builtin_bit_cast(bf16x8, vw), pf, o[dt]);
            }
        }
#pragma unroll
        for (int dt = 0; dt < 4; ++dt) *(u32x2*)(YA + (size_t)(qrow0 + q) * 1024 + head * 64 + dt * 16 + lq * 4) = pk4(o[dt] * inv);
    }
}

template <int L, bool SAMPLE>
__device__ __forceinline__ void hgrn_seq(const Prm& p, unsigned char* lds, int b, int h, bf16_t* YB) {
    constexpr int RPG = L / 8, NT = L / 16, NCH = SAMPLE ? 1 : 32, NP = 8 / NT;
    bf16_t* Qd = (bf16_t*)lds; bf16_t* Qm = Qd + 64 * 136; bf16_t* Km = Qm + 64 * 136; bf16_t* KlT = Km + 64 * 136; bf16_t* Vt = KlT + 128 * 72; bf16_t* St = Vt + 128 * 72; bf16_t* Al = St + 128 * 136;
    float* tot = (float*)(Al + 64 * 72); float* first = tot + 1024; float* decay = first + 1024; float* ssq = decay + 128;
    const bf16_t* R1 = (const bf16_t*)(p.ws + WS_R0 + UB); const bf16_t* R2 = (const bf16_t*)(p.ws + WS_R0 + 2 * UB); const bf16_t* R3 = (const bf16_t*)(p.ws + WS_R0 + 3 * UB); const bf16_t* R4 = (const bf16_t*)(p.ws + WS_R0 + 4 * UB);
    const int tid = threadIdx.x, lane = tid & 63, w = tid >> 6, lr = lane & 15, lq = lane >> 4, cp = lane, rg = w, c0 = 2 * cp;
    float lb[2];
#pragma unroll
    for (int c = 0; c < 2; ++c) { const float l0 = p.in[I_LB][h * 128 + c0 + c], l1 = p.in[I_LB][1024 + h * 128 + c0 + c]; lb[c] = 1.0f / (1.0f + __expf(l1 - l0)); }
    f32x4 S[8];
#pragma unroll
    for (int dvt = 0; dvt < 8; ++dvt) {
        if (SAMPLE) {
#pragma unroll
            for (int r = 0; r < 4; ++r) S[dvt][r] = p.in[I_ST][((size_t)(b * 8 + h) * 128 + 16 * w + 4 * lq + r) * 128 + 16 * dvt + lr];
        } else S[dvt] = (f32x4){0.f, 0.f, 0.f, 0.f};
    }
    const int tt = w % NT, dv0 = (w / NT) * NT;
    const int rowbase = SAMPLE ? MP + b * 32 : b * 2048;
    unsigned qw[RPG], fw[RPG], vw[RPG];
#pragma unroll
    for (int i = 0; i < RPG; ++i) { const size_t idx = (size_t)(rowbase + rg * RPG + i) * 1024 + h * 128 + c0; qw[i] = *(const unsigned*)(R1 + idx); fw[i] = *(const unsigned*)(R2 + idx); vw[i] = *(const unsigned*)(R3 + idx); }
#pragma unroll 1
    for (int ch = 0; ch < NCH; ++ch) {
        const int row0 = rowbase + ch * L;
        float qv[2][RPG], cv[2][RPG], kk[2][RPG]; unsigned vkeep[RPG]; float run[2] = {0.f, 0.f}, lf0[2] = {0.f, 0.f};
#pragma unroll
        for (int i = 0; i < RPG; ++i) {
            vkeep[i] = vw[i];
#pragma unroll
            for (int c = 0; c < 2; ++c) {
                const float q = c ? bfhi(qw[i]) : bflo(qw[i]), fl = c ? bfhi(fw[i]) : bflo(fw[i]);
                const float f = lb[c] + (1.0f - lb[c]) * sigm(fl), lf = __logf(f);
                run[c] += lf; cv[c][i] = run[c]; kk[c][i] = 1.0f - f; qv[c][i] = q * sigm(q); if (i == 0) lf0[c] = lf;
            }
        }
        *(f32x2v*)(tot + rg * 128 + c0) = (f32x2v){run[0], run[1]}; *(f32x2v*)(first + rg * 128 + c0) = (f32x2v){lf0[0], lf0[1]};
        if (ch + 1 < NCH) {
#pragma unroll
            for (int i = 0; i < RPG; ++i) { const size_t idx = (size_t)(row0 + L + rg * RPG + i) * 1024 + h * 128 + c0; qw[i] = *(const unsigned*)(R1 + idx); fw[i] = *(const unsigned*)(R2 + idx); vw[i] = *(const unsigned*)(R3 + idx); }
        }
        const size_t rbase = (size_t)(row0 + tt * 16 + lr) * 1024 + h * 128;
        u32x2 ogw[NT];
#pragma unroll
        for (int i = 0; i < NT; ++i) ogw[i] = *(const u32x2*)(R4 + rbase + 16 * (dv0 + i) + 4 * lq);
        __syncthreads();
        {
            float pre[2] = {0.f, 0.f}, bmid[2], blast[2], emid[2], elm[2];
#pragma unroll
            for (int c = 0; c < 2; ++c) {
                float acc = 0.f, half = 0.f;
#pragma unroll
                for (int j = 0; j < 8; ++j) { const float t = tot[j * 128 + c0 + c]; if (j < rg) pre[c] += t; if (j < 4) half += t; acc += t; }
                bmid[c] = half + first[4 * 128 + c0 + c]; blast[c] = acc; emid[c] = __expf(bmid[c]); elm[c] = __expf(blast[c] - bmid[c]);
            }
            float kl[2][RPG];
#pragma unroll
            for (int i = 0; i < RPG; ++i) {
                const int r = rg * RPG + i; float qd[2], qm[2], km[2];
#pragma unroll
                for (int c = 0; c < 2; ++c) {
                    const float E = __expf(pre[c] + cv[c][i] - bmid[c]), Ei = __builtin_amdgcn_rcpf(E);
                    qm[c] = qv[c][i] * E; qd[c] = qm[c] * emid[c]; km[c] = kk[c][i] * Ei; kl[c][i] = km[c] * elm[c];
                }
                *(unsigned*)(Qd + r * 136 + c0) = pk2(qd[0], qd[1]); *(unsigned*)(Qm + r * 136 + c0) = pk2(qm[0], qm[1]); *(unsigned*)(Km + r * 136 + c0) = pk2(km[0], km[1]);
            }
#pragma unroll
            for (int c = 0; c < 2; ++c) {
#pragma unroll
                for (int i = 0; i < RPG; i += 4) {
                    u32x2 a, v2; a.x = pk2(kl[c][i], kl[c][i + 1]); a.y = pk2(kl[c][i + 2], kl[c][i + 3]);
                    if (c == 0) { v2.x = (vkeep[i] & 0xffffu) | (vkeep[i + 1] << 16); v2.y = (vkeep[i + 2] & 0xffffu) | (vkeep[i + 3] << 16); }
                    else { v2.x = (vkeep[i] >> 16) | (vkeep[i + 1] & 0xffff0000u); v2.y = (vkeep[i + 2] >> 16) | (vkeep[i + 3] & 0xffff0000u); }
                    *(u32x2*)(KlT + (c0 + c) * 72 + rg * RPG + i) = a; *(u32x2*)(Vt + (c0 + c) * 72 + rg * RPG + i) = v2;
                }
            }
            if (rg == 0) *(f32x2v*)(decay + c0) = (f32x2v){__expf(blast[0]), __expf(blast[1])};
        }
#pragma unroll
        for (int dvt = 0; dvt < 8; ++dvt) *(u32x2*)(St + (16 * dvt + lr) * 136 + 16 * w + 4 * lq) = pk4(S[dvt]);
        __syncthreads();
        for (int id = w; id < NT * NT; id += 8) {
            const int st = id / NT, t2 = id % NT; f32x4 acc = {0.f, 0.f, 0.f, 0.f};
#pragma unroll
            for (int ks = 0; ks < 4; ++ks) acc = MFMA16(*(const bf16x8*)(Km + (st * 16 + lr) * 136 + ks * 32 + lq * 8), *(const bf16x8*)(Qm + (t2 * 16 + lr) * 136 + ks * 32 + lq * 8), acc);
            const int t = t2 * 16 + lr;
#pragma unroll
            for (int r = 0; r < 4; ++r) if (st * 16 + 4 * lq + r > t) acc[r] = 0.f;
            *(u32x2*)(Al + t * 72 + st * 16 + 4 * lq) = pk4(acc);
        }
        f32x4 o[NT];
#pragma unroll
        for (int i = 0; i < NT; ++i) {
            f32x4 acc = {0.f, 0.f, 0.f, 0.f};
#pragma unroll
            for (int ks = 0; ks < 4; ++ks) acc = MFMA16(*(const bf16x8*)(St + (16 * (dv0 + i) + lr) * 136 + ks * 32 + lq * 8), *(const bf16x8*)(Qd + (tt * 16 + lr) * 136 + ks * 32 + lq * 8), acc);
            o[i] = acc;
        }
        __syncthreads();
        float sq = 0.f;
#pragma unroll
        for (int i = 0; i < NT; ++i) {
#pragma unroll
            for (int ks = 0; ks < L / 32; ++ks) o[i] = MFMA16(*(const bf16x8*)(Vt + (16 * (dv0 + i) + lr) * 72 + ks * 32 + lq * 8), *(const bf16x8*)(Al + (tt * 16 + lr) * 72 + ks * 32 + lq * 8), o[i]);
            sq += o[i][0] * o[i][0] + o[i][1] * o[i][1] + o[i][2] * o[i][2] + o[i][3] * o[i][3];
        }
        sq += __shfl_xor(sq, 16); sq += __shfl_xor(sq, 32);
        if (lq == 0) ssq[(w / NT) * 64 + tt * 16 + lr] = sq;
        {
            const f32x4 dc = *(const f32x4*)(decay + 16 * w + 4 * lq);
#pragma unroll
            for (int dvt = 0; dvt < 8; ++dvt) {
                f32x4 acc = S[dvt] * dc;
#pragma unroll
                for (int ks = 0; ks < L / 32; ++ks) acc = MFMA16(*(const bf16x8*)(KlT + (16 * w + lr) * 72 + ks * 32 + lq * 8), *(const bf16x8*)(Vt + (16 * dvt + lr) * 72 + ks * 32 + lq * 8), acc);
                S[dvt] = acc;
            }
        }
        __syncthreads();
        {
            float tsq = 0.f;
#pragma unroll
            for (int j = 0; j < NP; ++j) tsq += ssq[j * 64 + tt * 16 + lr];
            const float rs = rsqrtf(tsq * (1.0f / 128.0f) + EPS);
#pragma unroll
            for (int i = 0; i < NT; ++i) {
                const int dvb = 16 * (dv0 + i) + 4 * lq;
                const f32x4 gg = *(const f32x4*)(p.in[I_GH] + dvb);
                const float og0 = bflo(ogw[i].x), og1 = bfhi(ogw[i].x), og2 = bflo(ogw[i].y), og3 = bfhi(ogw[i].y);
                f32x4 y; y[0] = o[i][0] * rs * gg[0] * og0 * sigm(og0); y[1] = o[i][1] * rs * gg[1] * og1 * sigm(og1); y[2] = o[i][2] * rs * gg[2] * og2 * sigm(og2); y[3] = o[i][3] * rs * gg[3] * og3 * sigm(og3);
                *(u32x2*)(YB + rbase + dvb) = pk4(y);
            }
        }
    }
    float* so = p.out + (SAMPLE ? O_SST : O_PST) + (size_t)(b * 8 + h) * 16384;
#pragma unroll
    for (int dvt = 0; dvt < 8; ++dvt)
#pragma unroll
        for (int r = 0; r < 4; ++r) so[(16 * w + 4 * lq + r) * 128 + 16 * dvt + lr] = S[dvt][r];
    __syncthreads();
}

__device__ __forceinline__ void phase_rp5(const Prm& p) {
    const bf16_t* O = (const bf16_t*)(p.ws + WS_R0 + 4 * UB); bf16_t* hf = (bf16_t*)(p.ws + WS_R0); const float* g = p.in[I_GPOST];
    const int lane = threadIdx.x & 63, gw = blockIdx.x * 8 + (threadIdx.x >> 6), nw = gridDim.x * 8;
    for (int row = gw; row < MT; row += nw) {
        const float* xr = xrow(p, row); const bf16_t* orow = O + (size_t)row * 1024; f32x4 v[4], x[4]; float ss = 0.f;
#pragma unroll
        for (int i = 0; i < 4; ++i) { { const u32x2 ow = *(const u32x2*)(orow + i * 256 + lane * 4); v[i] = (f32x4){bflo(ow.x), bfhi(ow.x), bflo(ow.y), bfhi(ow.y)}; } x[i] = *(const f32x4*)(xr + i * 256 + lane * 4); ss += v[i][0] * v[i][0] + v[i][1] * v[i][1] + v[i][2] * v[i][2] + v[i][3] * v[i][3]; }
        ss = wsum(ss); const float rs = rsqrtf(ss * (1.0f / 1024.0f) + EPS); float s2 = 0.f;
#pragma unroll
        for (int i = 0; i < 4; ++i) { const f32x4 gg = *(const f32x4*)(g + i * 256 + lane * 4); x[i] += v[i] * rs * gg; s2 += x[i][0] * x[i][0] + x[i][1] * x[i][1] + x[i][2] * x[i][2] + x[i][3] * x[i][3];
            *(f32x4*)(p.out + (size_t)row * 1024 + i * 256 + lane * 4) = x[i]; }
        s2 = wsum(s2); const float r2 = rsqrtf(s2 * (1.0f / 1024.0f) + EPS);
#pragma unroll
        for (int i = 0; i < 4; ++i) *(u32x2*)(hf + (size_t)row * 1024 + i * 256 + lane * 4) = pk4(x[i] * r2);
    }
    bf16_t* pbf = (bf16_t*)(p.ws + WS_KV);
    for (int id = blockIdx.x * 512 + threadIdx.x; id < MT * 32; id += gridDim.x * 512) {
        const int row = id >> 5, c = (id & 31) * 8;
        const float* s = (row < MP ? p.in[I_PP] + (size_t)row * 256 : p.in[I_PS] + (size_t)(row - MP) * 256) + c;
        *(u32x4*)(pbf + (size_t)row * 256 + c) = pk8(*(const f32x4*)s, *(const f32x4*)(s + 4));
    }
}
__device__ __forceinline__ void phase_rp8(const Prm& p) {
    const bf16_t* O = (const bf16_t*)(p.ws + WS_R0 + UB); bf16_t* xb = (bf16_t*)(p.ws + WS_R0 + 3 * UB); const float* g = p.in[I_GPFF];
    const int lane = threadIdx.x & 63, gw = blockIdx.x * 8 + (threadIdx.x >> 6), nw = gridDim.x * 8;
    for (int row = gw; row < MT; row += nw) {
        float* xr = p.out + (size_t)row * 1024; const bf16_t* orow = O + (size_t)row * 1024; f32x4 v[4], x[4]; float ss = 0.f;
#pragma unroll
        for (int i = 0; i < 4; ++i) { { const u32x2 ow = *(const u32x2*)(orow + i * 256 + lane * 4); v[i] = (f32x4){bflo(ow.x), bfhi(ow.x), bflo(ow.y), bfhi(ow.y)}; } x[i] = *(const f32x4*)(xr + i * 256 + lane * 4); ss += v[i][0] * v[i][0] + v[i][1] * v[i][1] + v[i][2] * v[i][2] + v[i][3] * v[i][3]; }
        ss = wsum(ss); const float rs = rsqrtf(ss * (1.0f / 1024.0f) + EPS);
#pragma unroll
        for (int i = 0; i < 4; ++i) { const f32x4 gg = *(const f32x4*)(g + i * 256 + lane * 4); x[i] += v[i] * rs * gg;
            *(f32x4*)(xr + i * 256 + lane * 4) = x[i]; *(u32x2*)(xb + (size_t)row * 1024 + i * 256 + lane * 4) = pk4(x[i]); }
    }
}
__device__ __forceinline__ void phase_conv(const Prm& p) {
    const bf16_t* A = (const bf16_t*)(p.ws + WS_R0 + UB); bf16_t* Ug = (bf16_t*)(p.ws + WS_R0 + UB + A_BYTES);
    const float* wc = p.in[I_WCONV]; const float* bc = p.in[I_BCONV]; const float* cc = p.in[I_CC];
    for (int id = blockIdx.x * 512 + threadIdx.x; id < (MT / 32) * 352; id += gridDim.x * 512) {
        const int rb = id / 352, c0 = (id % 352) * 8, row0 = rb * 32;
        float w0[8], w1[8], w2[8], bb[8], am2[8], am1[8];
#pragma unroll
        for (int j = 0; j < 8; ++j) { w0[j] = wc[c0 + j]; w1[j] = wc[DFF + c0 + j]; w2[j] = wc[2 * DFF + c0 + j]; bb[j] = bc[c0 + j]; am2[j] = 0.f; am1[j] = 0.f; }
        if (row0 < MP) { if ((row0 & 2047) != 0) { unpk8(*(const u32x4*)(A + (size_t)(row0 - 2) * DFF + c0), am2); unpk8(*(const u32x4*)(A + (size_t)(row0 - 1) * DFF + c0), am1); } }
        else { const int b = (row0 - MP) >> 5;
#pragma unroll
            for (int j = 0; j < 8; ++j) { am2[j] = cc[(size_t)(b * 2) * DFF + c0 + j]; am1[j] = cc[(size_t)(b * 2 + 1) * DFF + c0 + j]; } }
        for (int r = 0; r < 32; ++r) {
            const size_t off = (size_t)(row0 + r) * DFF + c0; float a[8], u[8], gq[8];
            unpk8(*(const u32x4*)(A + off), a); unpk8(*(const u32x4*)(Ug + off), u);
#pragma unroll
            for (int j = 0; j < 8; ++j) {
                const float ac = bb[j] + w0[j] * am2[j] + w1[j] * am1[j] + w2[j] * a[j];
                const float y = 1.5957691216f * (ac + 0.044715f * ac * ac * ac);
                gq[j] = ac * sigm(y) * u[j]; am2[j] = am1[j]; am1[j] = a[j];
            }
            u32x4 wv; wv.x = pk2(gq[0], gq[1]); wv.y = pk2(gq[2], gq[3]); wv.z = pk2(gq[4], gq[5]); wv.w = pk2(gq[6], gq[7]);
            *(u32x4*)(Ug + off) = wv;
        }
    }
}

#ifndef PROBE_DUP
#define PROBE_DUP 0
#endif
#ifndef P2M
#define P2M 15
#endif
#ifndef PHM
#define PHM 0xfff
#endif
__global__ void __launch_bounds__(512, 2) fwd_mega(Prm p, int ph_lo, int ph_hi) {
    extern __shared__ __attribute__((aligned(16))) unsigned char lds[];
    cg::grid_group grid = cg::this_grid();
    unsigned char* ws = p.ws;
    bf16_t* R0 = (bf16_t*)(ws + WS_R0);
#define REG(i) ((bf16_t*)(ws + WS_R0 + (size_t)(i) * UB))
#define PH_BEGIN(n) if (ph_lo <= (n) && (n) < ph_hi) { if ((n) > ph_lo) grid.sync();
#define PH_END }
#if (PHM >> 0) & 1
        PH_BEGIN(0) phase0(p, lds);
#if PROBE_DUP == 1
        grid.sync(); phase0(p, lds);
#endif
        PH_END
#else
#endif
#if (PHM >> 1) & 1
        PH_BEGIN(1) { F1 f; f.r0 = R0; f.kv = (bf16_t*)(ws + WS_KV); f.out = p.out; run_gemm(lds, (const bf16_t*)p.out, (const bf16_t*)(ws + WS_WIN), NIN, 1024, f);
#if PROBE_DUP == 3
            grid.sync(); run_gemm(lds, (const bf16_t*)p.out, (const bf16_t*)(ws + WS_WIN), NIN, 1024, f);
#endif
        } PH_END
#else
#endif
#if (PHM >> 2) & 1
        PH_BEGIN(2) {
#if PROBE_DUP == 2
            { bf16_t* YA = (bf16_t*)p.out; bf16_t* YB = (bf16_t*)p.out + UB / 2;
            const int G = gridDim.x;
#if P2M & 1
#pragma unroll 1
            for (int s = blockIdx.x; s < 256; s += G) hgrn_seq<64, false>(p, lds, s >> 3, s & 7, YB);
#endif
#if P2M & 2
#pragma unroll 1
            for (int s = blockIdx.x; s < 256; s += G) hgrn_seq<32, true>(p, lds, s >> 3, s & 7, YB);
#endif
            __syncthreads(); attn_bias_table(p, lds); __syncthreads();
#if P2M & 4
#pragma unroll 1
            for (int it = blockIdx.x; it < 2048; it += G) attn_item<12, 4, false>(p, lds, it >> 6, (it >> 1) & 31, it & 1, YA);
#endif
#if P2M & 8
#pragma unroll 1
            for (int it = blockIdx.x; it < 64; it += G) attn_item<10, 2, true>(p, lds, it >> 1, 0, it & 1, YA);
#endif
            __syncthreads(); }
#endif
            { bf16_t* YA = REG(0); bf16_t* YB = REG(1);
            const int G = gridDim.x;
#if P2M & 1
#pragma unroll 1
            for (int s = blockIdx.x; s < 256; s += G) hgrn_seq<64, false>(p, lds, s >> 3, s & 7, YB);
#endif
#if P2M & 2
#pragma unroll 1
            for (int s = blockIdx.x; s < 256; s += G) hgrn_seq<32, true>(p, lds, s >> 3, s & 7, YB);
#endif
            __syncthreads(); attn_bias_table(p, lds); __syncthreads();
#if P2M & 4
#pragma unroll 1
            for (int it = blockIdx.x; it < 2048; it += G) attn_item<12, 4, false>(p, lds, it >> 6, (it >> 1) & 31, it & 1, YA);
#endif
#if P2M & 8
#pragma unroll 1
            for (int it = blockIdx.x; it < 64; it += G) attn_item<10, 2, true>(p, lds, it >> 1, 0, it & 1, YA);
#endif
            }
        } PH_END
#else
#endif
#if (PHM >> 3) & 1
        PH_BEGIN(3) { F2 f; f.g = REG(5); f.o = REG(2); run_gemm(lds, REG(0), (const bf16_t*)(ws + WS_WBRA), 1024, 1024, f); } PH_END
#else
#endif
#if (PHM >> 4) & 1
        PH_BEGIN(4) { F3 f; f.g = REG(6); f.t = REG(2); f.o = REG(3); run_gemm(lds, REG(1), (const bf16_t*)(ws + WS_WBRB), 1024, 1024, f); } PH_END
#else
#endif
#if (PHM >> 5) & 1
        PH_BEGIN(5) { FBF f; f.o = REG(4); run_gemm(lds, REG(3), (const bf16_t*)(ws + WS_WOUT), 1024, 1024, f); } PH_END
#else
#endif
#if (PHM >> 6) & 1
        PH_BEGIN(6) phase_rp5(p); PH_END
#else
#endif
#if (PHM >> 7) & 1
        PH_BEGIN(7) { F6 f; f.a = REG(1); f.u = (bf16_t*)(ws + WS_R0 + UB + A_BYTES); f.out = p.out; run_gemm(lds, REG(0), (const bf16_t*)(ws + WS_WUP), 2 * DFF, 1024, f); } PH_END
#else
#endif
#if (PHM >> 8) & 1
        PH_BEGIN(8) phase_conv(p); PH_END
#else
#endif
        PH_BEGIN(9) { FBF f; f.o = REG(1); run_gemm(lds, (const bf16_t*)(ws + WS_R0 + UB + A_BYTES), (const bf16_t*)(ws + WS_WDOWN), 1024, DFF, f);
                  FBF f2; f2.o = REG(0); run_gemm(lds, (const bf16_t*)(ws + WS_KV), (const bf16_t*)(ws + WS_WPLE), 1024, 256, f2); } PH_END
#if (PHM >> 10) & 1
        PH_BEGIN(10) phase_rp8(p); PH_END
#else
#endif
#if (PHM >> 11) & 1
        PH_BEGIN(11) { F9 f; f.pe = REG(0); f.y = p.out; run_gemm(lds, REG(3), (const bf16_t*)(ws + WS_WPG), 1024, 1024, f); } PH_END
#else
#endif
#undef REG
}

extern "C" void kernel_launch(void* const* d_in, const int* in_sizes, int n_in, void* d_out, int out_size, void* d_ws, size_t ws_size, hipStream_t stream) {
    static int grid = 0;
    if (grid == 0) {
        if (n_in != 26 || (size_t)out_size != O_END || ws_size < WS_END) { fprintf(stderr, "kernel_launch: unexpected shapes n_in %d out %d ws %zu (need %zu)\n", n_in, out_size, ws_size, (size_t)WS_END); grid = -1; return; }
        int dev = 0, cus = 0, per_cu = 0;
        hipGetDevice(&dev); hipDeviceGetAttribute(&cus, hipDeviceAttributeMultiprocessorCount, dev);
        if (hipFuncSetAttribute((const void*)fwd_mega, hipFuncAttributeMaxDynamicSharedMemorySize, LDS_BYTES) != hipSuccess) { fprintf(stderr, "kernel_launch: hipFuncSetAttribute failed\n"); grid = -1; return; }
        if (hipOccupancyMaxActiveBlocksPerMultiprocessor(&per_cu, (const void*)fwd_mega, 512, LDS_BYTES) != hipSuccess || per_cu < 1) { fprintf(stderr, "kernel_launch: occupancy query says %d\n", per_cu); per_cu = 1; }
        (void)hipGetLastError();
        grid = cus;
    }
    if (grid < 0) return;
    Prm p{};
    for (int i = 0; i < 26; ++i) p.in[i] = (const float*)d_in[i];
    p.out = (float*)d_out; p.ws = (unsigned char*)d_ws;
    int lo = 0, hi = 12;
    void* args[] = {&p, &lo, &hi};
    hipError_t e = hipLaunchCooperativeKernel((const void*)fwd_mega, dim3(grid), dim3(512), args, LDS_BYTES, stream);
    if (e != hipSuccess) fprintf(stderr, "kernel_launch: cooperative launch failed: %s (grid %d)\n", hipGetErrorString(e), grid);
}
```

```cpp
#include <hip/hip_runtime.h>
#include <hip/hip_cooperative_groups.h>
#include <cstdio>
namespace cg = cooperative_groups;
namespace pg8 {
#define PG8_LAS __attribute__((address_space(3)))
typedef unsigned short bf16_t;
typedef short bf16x8 __attribute__((ext_vector_type(8)));
typedef float f32x4 __attribute__((ext_vector_type(4)));
typedef unsigned u32x4 __attribute__((ext_vector_type(4)));
constexpr int BM = 256, BK = 64, HALF = 128, HTB = HALF * BK * 2  , STAGE_BYTES = 8 * HTB, NXCD = 8, WGM = 8;

__host__ __device__ __forceinline__ int lds_byte(int r, int c) { const int st = (r >> 4) * 2 + (c >> 5), rr = r & 15, cc = c & 31, ob = rr * 64 + cc * 2; return st * 1024 + (ob ^ (((ob >> 9) & 1) << 5)); }
__host__ __device__ __forceinline__ void stage_rc(int b, int& R, int& C) { const int st = b / 1024, sb = b % 1024, swz = sb ^ (((sb >> 9) & 1) << 5); R = (st >> 1) * 16 + swz / 64; C = (st & 1) * 32 + (swz % 64) / 2; }
__host__ __device__ __forceinline__ int perm32(int rho) { const int n = rho >> 4, i = rho & 15; return 8 * (i >> 2) + 4 * n + (i & 3); }

struct Unit { int pm, pn; };
struct Gemm { const bf16_t* A; const bf16_t* Bt; int M, N, K; };

struct StaticOrder {
    int nM, nN, nwg, G, c;
    __host__ __device__ void init(int M, int N, int G_, int c_) { nM = M / BM; nN = N / BM; nwg = nM * nN; G = G_; c = c_; }
    __host__ __device__ bool next(int i, Unit& u) const {
        const long L = (long)i * G + c; if (L >= nwg) return false;
        int wgid = (int)L; { const int q = nwg / NXCD, r = nwg % NXCD, xcd = wgid % NXCD, off = wgid / NXCD; wgid = (xcd < r ? xcd * (q + 1) : r * (q + 1) + (xcd - r) * q) + off; }
        const int nig = WGM * nN, gid = wgid / nig, fm = gid * WGM, gsz = (nM - fm) < WGM ? (nM - fm) : WGM;
        u.pm = fm + ((wgid % nig) % gsz); u.pn = (wgid % nig) / gsz; return true;
    }
    __device__ __forceinline__ void a_ready(const Unit&) const {}
    __device__ __forceinline__ void done(const Unit&) const {}
};
__device__ __forceinline__ unsigned cvt_pk_bf16(float lo, float hi) { unsigned r; asm volatile("v_cvt_pk_bf16_f32 %0, %1, %2" : "=v"(r) : "v"(lo), "v"(hi)); return r; }
template <class Epi, class Sched, bool STAMP = false>
__device__ __forceinline__ void gemm_phase(PG8_LAS unsigned char* lds, const Gemm g, const Sched& S, const Epi& E, unsigned long long* stamps) {
    const int tid = threadIdx.x, wid = __builtin_amdgcn_readfirstlane(tid >> 6), lane = tid & 63, wr = wid >> 2, wc = wid & 3, fr = lane & 15, fq = lane >> 4;
    const int K = g.K, nt = K / BK;
    int ts_lo = 0, ts_hi = 0, nts = 0; const unsigned long long rt_entry = STAMP ? (unsigned long long)wall_clock64() : 0ull;
#define PG8_STAMP() do { if (STAMP && wid == 0 && nts < 64) { const unsigned long long _c = (unsigned long long)clock64(); \
        ts_lo = (lane == nts) ? (int)(unsigned)_c : ts_lo; ts_hi = (lane == nts) ? (int)(unsigned)(_c >> 32) : ts_hi; ++nts; } } while (0)
    PG8_STAMP();
    unsigned voffA[2], voffB[2];
#pragma unroll
    for (int i = 0; i < 2; ++i) { int R, C; stage_rc(tid * 16 + i * 8192, R, C); const int Rb = Epi::PERM ? ((R & ~31) + perm32(R & 31)) : R;
        voffA[i] = (unsigned)(R * K + C) * 2u; voffB[i] = (unsigned)(Rb * K + C) * 2u; }
    const size_t kstep = (size_t)(BK * 2);
    const size_t hstep = (size_t)HALF * K * 2;
    const size_t tstep = 2 * hstep;
    const unsigned ldsw = (unsigned)wid * 1024u;
    const int aoff = lds_byte(wr * 64 + fr, fq * 8), boff = lds_byte(wc * 32 + fr, fq * 8);
#define PG8_SA(b, h) (((b) * 2 + (h)) * HTB)
#define PG8_SB(b, h) ((4 + (b) * 2 + (h)) * HTB)
#define PG8_STAGE(bufoff, gbase, voff) do { _Pragma("unroll") for (int _i = 0; _i < 2; ++_i) \
        __builtin_amdgcn_global_load_lds((const unsigned*)((const char*)(gbase) + (voff)[_i]), (PG8_LAS unsigned*)(lds + (bufoff) + ldsw + _i * 8192), 16, 0, 0); } while (0)
#define PG8_LDA(dst, b, h) do { _Pragma("unroll") for (int m = 0; m < 4; ++m) _Pragma("unroll") for (int k = 0; k < 2; ++k) dst[m][k] = *(const PG8_LAS bf16x8*)(lds + PG8_SA(b, h) + aoff + m * 2048 + k * 1024); } while (0)
#define PG8_LDB(dst, b, h) do { _Pragma("unroll") for (int n = 0; n < 2; ++n) _Pragma("unroll") for (int k = 0; k < 2; ++k) dst[n][k] = *(const PG8_LAS bf16x8*)(lds + PG8_SB(b, h) + boff + n * 2048 + k * 1024); } while (0)
#define PG8_MMA(ai, bj, At, Bt) do { __builtin_amdgcn_s_setprio(1); _Pragma("unroll") for (int m = 0; m < 4; ++m) _Pragma("unroll") for (int n = 0; n < 2; ++n) _Pragma("unroll") for (int k = 0; k < 2; ++k) \
        acc[ai][bj][m][n] = __builtin_amdgcn_mfma_f32_16x16x32_bf16(Bt[n][k], At[m][k], acc[ai][bj][m][n], 0, 0, 0); __builtin_amdgcn_s_setprio(0); } while (0)
#define PG8_WAIT_V(n) asm volatile("s_waitcnt vmcnt(" #n ")" ::: "memory")
#define PG8_WAIT_L(n) asm volatile("s_waitcnt lgkmcnt(" #n ")" ::: "memory")
#define PG8_BAR __builtin_amdgcn_s_barrier()
#define PG8_SCHED __builtin_amdgcn_sched_barrier(0)
    Unit cur, nxt; int ui = 0;
    if (!S.next(0, cur)) return;
    f32x4 acc[2][2][4][2];
#pragma unroll
    for (int a = 0; a < 2; ++a)
#pragma unroll
        for (int b = 0; b < 2; ++b)
#pragma unroll
            for (int m = 0; m < 4; ++m)
#pragma unroll
                for (int n = 0; n < 2; ++n) acc[a][b][m][n] = (f32x4){0.f, 0.f, 0.f, 0.f};
    bf16x8 At[4][2], B0[2][2], B1[2][2];
    const char* cA = (const char*)g.A + (size_t)cur.pm * tstep; const char* cB = (const char*)g.Bt + (size_t)cur.pn * tstep;
    S.a_ready(cur);
    PG8_STAGE(PG8_SB(0, 0), cB, voffB); PG8_STAGE(PG8_SA(0, 0), cA, voffA); PG8_STAGE(PG8_SB(0, 1), cB + hstep, voffB); PG8_STAGE(PG8_SA(0, 1), cA + hstep, voffA);
    if (wr == 1) PG8_BAR;
    PG8_WAIT_V(4); PG8_BAR;
    PG8_STAGE(PG8_SB(1, 0), cB + kstep, voffB); PG8_STAGE(PG8_SA(1, 0), cA + kstep, voffA); PG8_STAGE(PG8_SB(1, 1), cB + hstep + kstep, voffB);
    PG8_WAIT_V(6); PG8_BAR;
    PG8_STAMP();
    for (;;) {
        const bool has_next = S.next(ui + 1, nxt);
        const char* nA = has_next ? (const char*)g.A + (size_t)nxt.pm * tstep : cA; const char* nB = has_next ? (const char*)g.Bt + (size_t)nxt.pn * tstep : cB;
        for (int t = 0; t < nt; t += 2) {
            const bool last = (t == nt - 2);
            const char* a1 = cA + (size_t)(t + 1) * kstep;
            const char* a2 = last ? nA : cA + (size_t)(t + 2) * kstep; const char* b2 = last ? nB : cB + (size_t)(t + 2) * kstep;
            const char* a3 = a2 + kstep; const char* b3 = b2 + kstep;
            if (last && has_next) S.a_ready(nxt);
            PG8_LDB(B0, 0, 0); PG8_SCHED; PG8_LDA(At, 0, 0); PG8_STAGE(PG8_SA(1, 1), a1 + hstep, voffA);
            PG8_WAIT_L(8); PG8_BAR; PG8_WAIT_L(0); PG8_MMA(0, 0, At, B0); PG8_BAR; PG8_SCHED;
            PG8_LDB(B1, 0, 1); PG8_STAGE(PG8_SB(0, 0), b2, voffB);
            PG8_BAR; PG8_WAIT_L(0); PG8_MMA(0, 1, At, B1); PG8_BAR;
            PG8_LDA(At, 0, 1); PG8_STAGE(PG8_SA(0, 0), a2, voffA);
            PG8_BAR; PG8_WAIT_L(0); PG8_MMA(1, 0, At, B0); PG8_BAR; PG8_SCHED;
            PG8_STAGE(PG8_SB(0, 1), b2 + hstep, voffB);
            PG8_WAIT_V(6); PG8_BAR; PG8_MMA(1, 1, At, B1); PG8_BAR;
            PG8_LDB(B0, 1, 0); PG8_SCHED; PG8_LDA(At, 1, 0); PG8_STAGE(PG8_SA(0, 1), a2 + hstep, voffA);
            PG8_WAIT_L(8); PG8_BAR; PG8_WAIT_L(0); PG8_MMA(0, 0, At, B0); PG8_BAR; PG8_SCHED;
            PG8_LDB(B1, 1, 1); PG8_STAGE(PG8_SB(1, 0), b3, voffB);
            PG8_BAR; PG8_WAIT_L(0); PG8_MMA(0, 1, At, B1); PG8_BAR;
            PG8_LDA(At, 1, 1); PG8_STAGE(PG8_SA(1, 0), a3, voffA);
            PG8_BAR; PG8_WAIT_L(0); PG8_MMA(1, 0, At, B0); PG8_BAR; PG8_SCHED;
            PG8_STAGE(PG8_SB(1, 1), b3 + hstep, voffB);
            PG8_WAIT_V(6); PG8_BAR; PG8_MMA(1, 1, At, B1); PG8_BAR;
        }
        PG8_STAMP();
        if constexpr (!Epi::AFTER_DRAIN) { E(acc, cur, wr, wc, fr, fq); S.done(cur); }
        PG8_STAMP();
        if (!has_next) break;
#pragma unroll
        for (int a = 0; a < 2; ++a)
#pragma unroll
            for (int b = 0; b < 2; ++b)
#pragma unroll
                for (int m = 0; m < 4; ++m)
#pragma unroll
                    for (int n = 0; n < 2; ++n) acc[a][b][m][n] = (f32x4){0.f, 0.f, 0.f, 0.f};
        cur = nxt; cA = nA; cB = nB; ++ui;
    }
    PG8_WAIT_V(0);
    if (wr == 0) PG8_BAR;
    PG8_BAR;
    if constexpr (Epi::AFTER_DRAIN) { E.fused(acc, cur, wr, wc, fr, fq, lds, wid, lane); S.done(cur); }
    PG8_STAMP();
    if (STAMP && wid == 0) { stamps[lane] = lane < nts ? (((unsigned long long)(unsigned)ts_hi << 32) | (unsigned)ts_lo) : 0ull;
        if (lane == 62) stamps[62] = rt_entry; if (lane == 63) stamps[63] = (unsigned long long)wall_clock64(); }
#undef PG8_STAMP
#undef PG8_SA
#undef PG8_SB
#undef PG8_STAGE
#undef PG8_LDA
#undef PG8_LDB
#undef PG8_MMA
#undef PG8_WAIT_V
#undef PG8_WAIT_L
#undef PG8_BAR
#undef PG8_SCHED
}
}


using pg8::bf16_t; using pg8::bf16x8; using pg8::f32x4; using pg8::u32x4;
typedef unsigned u32x2 __attribute__((ext_vector_type(2)));
typedef float f32x2v __attribute__((ext_vector_type(2)));
#define MFMA16(a, b, c) __builtin_amdgcn_mfma_f32_16x16x32_bf16((a), (b), (c), 0, 0, 0)

constexpr int MP = 65536, MS = 1024, MT = MP + MS, DM = 1024, DFF = 2816, NIN = 7424;
constexpr float EPS = 1e-6f;
constexpr size_t UB = (size_t)MT * 1024 * 2;
constexpr size_t WS_WIN = 0, WS_WBRA = WS_WIN + (size_t)NIN * 1024 * 2, WS_WBRB = WS_WBRA + 2097152, WS_WOUT = WS_WBRB + 2097152, WS_WPG = WS_WOUT + 2097152,
                 WS_WUP = WS_WPG + 2097152, WS_WDOWN = WS_WUP + (size_t)2 * DFF * 1024 * 2, WS_WPLE = WS_WDOWN + (size_t)1024 * DFF * 2, WS_KV = WS_WPLE + (size_t)1024 * 256 * 2,
                 WS_R0 = WS_KV + (size_t)MT * 256 * 2, WS_END = WS_R0 + 7 * UB;
constexpr size_t A_BYTES = (size_t)MT * DFF * 2;
constexpr size_t O_Y = 0, O_PWK = (size_t)MT * 1024, O_PWV = O_PWK + 524288, O_PST = O_PWV + 524288, O_PFC = O_PST + 4194304, O_SWK = O_PFC + 180224, O_SWV = O_SWK + 131072,
                 O_SST = O_SWV + 131072, O_SFC = O_SST + 4194304, O_END = O_SFC + 180224;
constexpr int LDS_BYTES = 147456;

struct Prm { const float* in[26]; float* out; unsigned char* ws; };
enum { I_XP = 0, I_XS, I_CK, I_CV, I_ST, I_CC, I_PP, I_PS, I_RB, I_LB, I_GPM, I_WIN, I_SINK, I_GH, I_WBRA, I_WBRB, I_WOUT, I_GPOST, I_GPF, I_WUP, I_WCONV, I_BCONV, I_WDOWN, I_GPFF, I_WPLE, I_WPG };

__device__ __forceinline__ unsigned pk2(float lo, float hi) { unsigned r; asm("v_cvt_pk_bf16_f32 %0, %1, %2" : "=v"(r) : "v"(lo), "v"(hi)); return r; }
__device__ __forceinline__ float bflo(unsigned w) { return __uint_as_float(w << 16); }
__device__ __forceinline__ float bfhi(unsigned w) { return __uint_as_float(w & 0xffff0000u); }
__device__ __forceinline__ float bf1(bf16_t b) { return __uint_as_float(((unsigned)b) << 16); }
__device__ __forceinline__ bf16_t f2bf(float f) { return (bf16_t)(pk2(f, 0.f) & 0xffffu); }
__device__ __forceinline__ float sigm(float x) { return __builtin_amdgcn_rcpf(1.0f + __expf(-x)); }
__device__ __forceinline__ float wsum(float v) { v += __shfl_xor(v, 32); v += __shfl_xor(v, 16); v += __shfl_xor(v, 8); v += __shfl_xor(v, 4); v += __shfl_xor(v, 2); v += __shfl_xor(v, 1); return v; }
__device__ __forceinline__ u32x4 pk8(f32x4 a, f32x4 b) { u32x4 w; w.x = pk2(a[0], a[1]); w.y = pk2(a[2], a[3]); w.z = pk2(b[0], b[1]); w.w = pk2(b[2], b[3]); return w; }
__device__ __forceinline__ u32x2 pk4(f32x4 a) { u32x2 w; w.x = pk2(a[0], a[1]); w.y = pk2(a[2], a[3]); return w; }
__device__ __forceinline__ void unpk8(u32x4 w, float (&f)[8]) { f[0] = bflo(w.x); f[1] = bfhi(w.x); f[2] = bflo(w.y); f[3] = bfhi(w.y); f[4] = bflo(w.z); f[5] = bfhi(w.z); f[6] = bflo(w.w); f[7] = bfhi(w.w); }

struct NoPre {};
template <class F> struct EpiT {
    static constexpr bool PERM = true, AFTER_DRAIN = false; F f;
    __device__ __forceinline__ void operator()(const f32x4 (&acc)[2][2][4][2], const pg8::Unit& u, int wr, int wc, int fr, int fq) const {
        const int row0 = u.pm * 256 + wr * 64 + fr, col0 = u.pn * 256 + wc * 32 + 8 * fq;
        constexpr int MB = F::MB;
#pragma unroll
        for (int a0 = 0; a0 < 8; a0 += MB) {
            typename F::Pre pre[MB][2];
#pragma unroll
            for (int mm = 0; mm < MB; ++mm)
#pragma unroll
                for (int bj = 0; bj < 2; ++bj) pre[mm][bj] = f.load(row0 + ((a0 + mm) >> 2) * 128 + ((a0 + mm) & 3) * 16, col0 + bj * 128);
#pragma unroll
            for (int mm = 0; mm < MB; ++mm)
#pragma unroll
                for (int bj = 0; bj < 2; ++bj) f(row0 + ((a0 + mm) >> 2) * 128 + ((a0 + mm) & 3) * 16, col0 + bj * 128, u.pn, acc[(a0 + mm) >> 2][bj][(a0 + mm) & 3][0], acc[(a0 + mm) >> 2][bj][(a0 + mm) & 3][1], pre[mm][bj]);
        }
    }
};
struct F1 {
    bf16_t* r0; bf16_t* kv; float* out; typedef NoPre Pre; static constexpr int MB = 1;
    __device__ __forceinline__ NoPre load(int, int) const { return NoPre(); }
    __device__ __forceinline__ void operator()(int row, int col, int pn, f32x4 v0, f32x4 v1, NoPre) const {
        const u32x4 w = pk8(v0, v1);
        if (pn < 4) { *(u32x4*)(r0 + (size_t)row * 1024 + col) = w; }
        else if (pn == 4) {
            const int c = col - 1024; *(u32x4*)(kv + (size_t)row * 256 + c) = w;
            float* o = nullptr;
            if (row >= MP) { o = out + (c < 128 ? O_SWK : O_SWV) + (size_t)(row - MP) * 128 + (c & 127); }
            else { const int t = row & 2047; if (t >= 1920) o = out + (c < 128 ? O_PWK : O_PWV) + (size_t)((row >> 11) * 128 + t - 1920) * 128 + (c & 127); }
            if (o) { *(f32x4*)o = v0; *(f32x4*)(o + 4) = v1; }
        } else { const int c2 = col - 1280, seg = c2 >> 10; *(u32x4*)(r0 + (size_t)(1 + seg) * (UB / 2) + (size_t)row * 1024 + (c2 & 1023)) = w; }
    }
};
struct F2 {
    const bf16_t* g; bf16_t* o; typedef u32x4 Pre; static constexpr int MB = 8;
    __device__ __forceinline__ u32x4 load(int row, int col) const { return *(const u32x4*)(g + (size_t)row * 1024 + col); }
    __device__ __forceinline__ void operator()(int row, int col, int, f32x4 v0, f32x4 v1, u32x4 gw) const {
        const size_t i = (size_t)row * 1024 + col; float gf[8]; unpk8(gw, gf);
        f32x4 a, b;
#pragma unroll
        for (int j = 0; j < 4; ++j) { a[j] = v0[j] * sigm(gf[j]); b[j] = v1[j] * sigm(gf[4 + j]); }
        *(u32x4*)(o + i) = pk8(a, b);
    }
};
struct F3 {
    const bf16_t* g; const bf16_t* t; bf16_t* o; struct Pre { u32x4 g, t; }; static constexpr int MB = 4;
    __device__ __forceinline__ Pre load(int row, int col) const { const size_t i = (size_t)row * 1024 + col; Pre r; r.g = *(const u32x4*)(g + i); r.t = *(const u32x4*)(t + i); return r; }
    __device__ __forceinline__ void operator()(int row, int col, int, f32x4 v0, f32x4 v1, Pre pr) const {
        const size_t i = (size_t)row * 1024 + col; float gf[8], tf[8]; unpk8(pr.g, gf); unpk8(pr.t, tf);
        f32x4 a, b;
#pragma unroll
        for (int j = 0; j < 4; ++j) { a[j] = tf[j] + v0[j] * sigm(gf[j]); b[j] = tf[4 + j] + v1[j] * sigm(gf[4 + j]); }
        *(u32x4*)(o + i) = pk8(a, b);
    }
};
struct FF32 {
    float* o; typedef NoPre Pre; static constexpr int MB = 1;
    __device__ __forceinline__ NoPre load(int, int) const { return NoPre(); }
    __device__ __forceinline__ void operator()(int row, int col, int, f32x4 v0, f32x4 v1, NoPre) const { float* d = o + (size_t)row * 1024 + col; *(f32x4*)d = v0; *(f32x4*)(d + 4) = v1; }
};
struct FBF {
    bf16_t* o; typedef NoPre Pre; static constexpr int MB = 1;
    __device__ __forceinline__ NoPre load(int, int) const { return NoPre(); }
    __device__ __forceinline__ void operator()(int row, int col, int, f32x4 v0, f32x4 v1, NoPre) const { *(u32x4*)(o + (size_t)row * 1024 + col) = pk8(v0, v1); }
};
struct F6 {
    bf16_t* a; bf16_t* u; float* out; typedef NoPre Pre; static constexpr int MB = 1;
    __device__ __forceinline__ NoPre load(int, int) const { return NoPre(); }
    __device__ __forceinline__ void operator()(int row, int col, int pn, f32x4 v0, f32x4 v1, NoPre) const {
        const u32x4 w = pk8(v0, v1);
        if (pn < 11) {
            *(u32x4*)(a + (size_t)row * DFF + col) = w;
            float* o = nullptr;
            if (row >= MP) { const int rs = row - MP, t = rs & 31; if (t >= 30) o = out + O_SFC + (size_t)((rs >> 5) * 2 + t - 30) * DFF + col; }
            else { const int t = row & 2047; if (t >= 2046) o = out + O_PFC + (size_t)((row >> 11) * 2 + t - 2046) * DFF + col; }
            if (o) { *(f32x4*)o = v0; *(f32x4*)(o + 4) = v1; }
        } else *(u32x4*)(u + (size_t)row * DFF + (col - DFF)) = w;
    }
};
struct F9 {
    const bf16_t* pe; const bf16_t* xb; float* y; struct Pre { u32x4 p, x; }; static constexpr int MB = 4;
    __device__ __forceinline__ Pre load(int row, int col) const { const size_t i = (size_t)row * 1024 + col; Pre r; r.p = *(const u32x4*)(pe + i); r.x = *(const u32x4*)(xb + i); return r; }
    __device__ __forceinline__ void operator()(int row, int col, int, f32x4 v0, f32x4 v1, Pre pr) const {
        const size_t i = (size_t)row * 1024 + col; float pf[8], xf[8]; unpk8(pr.p, pf); unpk8(pr.x, xf);
        f32x4 a, b;
#pragma unroll
        for (int j = 0; j < 4; ++j) { a[j] = xf[j] + pf[j] * sigm(v0[j]); b[j] = xf[4 + j] + pf[4 + j] * sigm(v1[j]); }
        *(f32x4*)(y + i) = a; *(f32x4*)(y + i + 4) = b;
    }
};
template <class F> __device__ __forceinline__ void run_gemm(unsigned char* lds, const bf16_t* A, const bf16_t* Bt, int N, int K, const F& f) {
    asm volatile("" : "+s"(K)); asm volatile("" : "+s"(N));
    pg8::Gemm g; g.A = A; g.Bt = Bt; g.M = MT; g.N = N; g.K = K;
    pg8::StaticOrder S; S.init(MT, N, (int)gridDim.x, (int)blockIdx.x);
    EpiT<F> E; E.f = f;
    pg8::gemm_phase<EpiT<F>, pg8::StaticOrder, false>((PG8_LAS unsigned char*)lds, g, S, E, nullptr);
    __syncthreads();
}

__device__ __forceinline__ void transpose_w(const float* W, bf16_t* Bt, int K, int N, const float* gain, float* tile, int& toff) {
    const int nnt = N / 64, ntiles = (K / 64) * nnt, tid = threadIdx.x, G = gridDim.x;
    int first = ((int)blockIdx.x - (toff % G) + G) % G;
    for (int t = first; t < ntiles; t += G) {
        const int kt = t / nnt, nt = t % nnt;
#pragma unroll
        for (int i = 0; i < 8; ++i) { const int r = (tid >> 6) + 8 * i, c = tid & 63; float v = W[(size_t)(kt * 64 + r) * N + nt * 64 + c]; if (gain) v *= gain[kt * 64 + r]; tile[r * 65 + c] = v; }
        __syncthreads();
        { const int n = tid >> 3, k8 = (tid & 7) * 8; u32x4 wv;
          wv.x = pk2(tile[(k8 + 0) * 65 + n], tile[(k8 + 1) * 65 + n]); wv.y = pk2(tile[(k8 + 2) * 65 + n], tile[(k8 + 3) * 65 + n]);
          wv.z = pk2(tile[(k8 + 4) * 65 + n], tile[(k8 + 5) * 65 + n]); wv.w = pk2(tile[(k8 + 6) * 65 + n], tile[(k8 + 7) * 65 + n]);
          *(u32x4*)(Bt + (size_t)(nt * 64 + n) * K + kt * 64 + k8) = wv; }
        __syncthreads();
    }
    toff += ntiles;
}
__device__ __forceinline__ const float* xrow(const Prm& p, int row) { return row < MP ? p.in[I_XP] + (size_t)row * 1024 : p.in[I_XS] + (size_t)(row - MP) * 1024; }

__device__ __forceinline__ void phase0(const Prm& p, unsigned char* lds) {
    float* tile = (float*)lds; int toff = 0; unsigned char* ws = p.ws;
    transpose_w(p.in[I_WIN], (bf16_t*)(ws + WS_WIN), 1024, NIN, p.in[I_GPM], tile, toff);
    transpose_w(p.in[I_WUP], (bf16_t*)(ws + WS_WUP), 1024, 2 * DFF, p.in[I_GPF], tile, toff);
    transpose_w(p.in[I_WDOWN], (bf16_t*)(ws + WS_WDOWN), DFF, 1024, nullptr, tile, toff);
    transpose_w(p.in[I_WBRA], (bf16_t*)(ws + WS_WBRA), 1024, 1024, nullptr, tile, toff);
    transpose_w(p.in[I_WBRB], (bf16_t*)(ws + WS_WBRB), 1024, 1024, nullptr, tile, toff);
    transpose_w(p.in[I_WOUT], (bf16_t*)(ws + WS_WOUT), 1024, 1024, nullptr, tile, toff);
    transpose_w(p.in[I_WPG], (bf16_t*)(ws + WS_WPG), 1024, 1024, nullptr, tile, toff);
    transpose_w(p.in[I_WPLE], (bf16_t*)(ws + WS_WPLE), 256, 1024, nullptr, tile, toff);
    bf16_t* xn = (bf16_t*)p.out;
    const int lane = threadIdx.x & 63, gw = blockIdx.x * 8 + (threadIdx.x >> 6), nw = gridDim.x * 8;
    for (int row = gw; row < MT; row += nw) {
        const float* xr = xrow(p, row); f32x4 v[4]; float ss = 0.f;
#pragma unroll
        for (int i = 0; i < 4; ++i) { v[i] = *(const f32x4*)(xr + i * 256 + lane * 4); ss += v[i][0] * v[i][0] + v[i][1] * v[i][1] + v[i][2] * v[i][2] + v[i][3] * v[i][3]; }
        ss = wsum(ss); const float rs = rsqrtf(ss * (1.0f / 1024.0f) + EPS);
#pragma unroll
        for (int i = 0; i < 4; ++i) *(u32x2*)(xn + (size_t)row * 1024 + i * 256 + lane * 4) = pk4(v[i] * rs);
    }
}

constexpr int AT_KS = 0, AT_VT = 27648, AT_BT = 53248;
__device__ __forceinline__ void attn_bias_table(const Prm& p, unsigned char* lds) {
    float* bT = (float*)(lds + AT_BT); const float* tab = p.in[I_RB];
    for (int i = threadIdx.x; i < 16 * 256; i += 512) {
        const int head = i >> 8, idx = i & 255, rel = idx - 191, n = rel < 0 ? -rel : rel;
        int bk = n < 8 ? n : min(15, 33 - __clz(n * n)); if (rel > 0) bk += 16;
        bT[i] = idx < 255 ? tab[bk * 16 + head] : 0.f;
    }
}
template <int NKT, int NQT, bool SAMPLE>
__device__ __forceinline__ void attn_item(const Prm& p, unsigned char* lds, int b, int c, int kvh, bf16_t* YA) {
    bf16_t* Ks = (bf16_t*)(lds + AT_KS); bf16_t* Vt = (bf16_t*)(lds + AT_VT); const float* bT = (const float*)(lds + AT_BT);
    const bf16_t* kv = (const bf16_t*)(p.ws + WS_KV); bf16_t* R0 = (bf16_t*)(p.ws + WS_R0);
    const int tid = threadIdx.x, lane = tid & 63, w = tid >> 6, lr = lane & 15, lq = lane >> 4;
    __syncthreads();
    if (!SAMPLE) {
        const int tok0 = b * 2048 + (c - 2) * 64;
        for (int id = tid; id < 192 * 8; id += 512) {
            const int key = id >> 3, dc = id & 7; u32x4 v = {0u, 0u, 0u, 0u};
            if (c * 64 - 128 + key >= 0) v = *(const u32x4*)(kv + (size_t)(tok0 + key) * 256 + kvh * 64 + dc * 8);
            *(u32x4*)(Ks + key * 72 + dc * 8) = v;
        }
        for (int id = tid; id < 192 * 8; id += 512) {
            const int key = id % 192, dc = id / 192; u32x4 v = {0u, 0u, 0u, 0u};
            if (c * 64 - 128 + key >= 0) v = *(const u32x4*)(kv + (size_t)(tok0 + key) * 256 + 128 + kvh * 64 + dc * 8);
            bf16_t* d = Vt + (dc * 8) * 200 + key;
            d[0] = (bf16_t)(v.x & 0xffffu); d[200] = (bf16_t)(v.x >> 16); d[400] = (bf16_t)(v.y & 0xffffu); d[600] = (bf16_t)(v.y >> 16);
            d[800] = (bf16_t)(v.z & 0xffffu); d[1000] = (bf16_t)(v.z >> 16); d[1200] = (bf16_t)(v.w & 0xffffu); d[1400] = (bf16_t)(v.w >> 16);
        }
    } else {
        const float* ck = p.in[I_CK]; const float* cvp = p.in[I_CV];
        for (int id = tid; id < 160 * 8; id += 512) {
            const int key = id >> 3, dc = id & 7; u32x4 v;
            if (key < 128) { const float* s = ck + (size_t)(b * 128 + key) * 128 + kvh * 64 + dc * 8; v = pk8(*(const f32x4*)s, *(const f32x4*)(s + 4)); }
            else v = *(const u32x4*)(kv + (size_t)(MP + b * 32 + key - 128) * 256 + kvh * 64 + dc * 8);
            *(u32x4*)(Ks + key * 72 + dc * 8) = v;
        }
        for (int id = tid; id < 160 * 8; id += 512) {
            const int key = id % 160, dc = id / 160; u32x4 v;
            if (key < 128) { const float* s = cvp + (size_t)(b * 128 + key) * 128 + kvh * 64 + dc * 8; v = pk8(*(const f32x4*)s, *(const f32x4*)(s + 4)); }
            else v = *(const u32x4*)(kv + (size_t)(MP + b * 32 + key - 128) * 256 + 128 + kvh * 64 + dc * 8);
            bf16_t* d = Vt + (dc * 8) * 200 + key;
            d[0] = (bf16_t)(v.x & 0xffffu); d[200] = (bf16_t)(v.x >> 16); d[400] = (bf16_t)(v.y & 0xffffu); d[600] = (bf16_t)(v.y >> 16);
            d[800] = (bf16_t)(v.z & 0xffffu); d[1000] = (bf16_t)(v.z >> 16); d[1200] = (bf16_t)(v.w & 0xffffu); d[1400] = (bf16_t)(v.w >> 16);
        }
    }
    __syncthreads();
    const int head = kvh * 8 + w; const float sink = p.in[I_SINK][head];
    const int qrow0 = SAMPLE ? MP + b * 32 : b * 2048 + c * 64;
    const float* bTh = bT + head * 256;
#pragma unroll 1
    for (int qi = 0; qi < NQT; ++qi) {
        const int q = qi * 16 + lr;
        const size_t qoff = (size_t)(qrow0 + q) * 1024 + head * 64 + lq * 8;
        const bf16x8 qf0 = *(const bf16x8*)(R0 + qoff), qf1 = *(const bf16x8*)(R0 + qoff + 32);
        f32x4 s[NKT];
#pragma unroll
        for (int kt = 0; kt < NKT; ++kt) {
            const bf16_t* kp = Ks + (kt * 16 + lr) * 72 + lq * 8;
            const bf16x8 k0 = *(const bf16x8*)kp, k1 = *(const bf16x8*)(kp + 32);
            f32x4 a = {0.f, 0.f, 0.f, 0.f}; a = MFMA16(k0, qf0, a); a = MFMA16(k1, qf1, a); s[kt] = a;
        }
        float mx = sink;
#pragma unroll
        for (int kt = 0; kt < NKT; ++kt)
#pragma unroll
            for (int r = 0; r < 4; ++r) {
                const int key = kt * 16 + lq * 4 + r; float v = s[kt][r] * 0.125f + bTh[key - q + 63];
                if (!SAMPLE && (c * 64 - 128 + key < 0)) v = -1e30f;
                s[kt][r] = v; mx = fmaxf(mx, v);
            }
        mx = fmaxf(mx, __shfl_xor(mx, 16)); mx = fmaxf(mx, __shfl_xor(mx, 32));
        float sum = 0.f;
#pragma unroll
        for (int kt = 0; kt < NKT; ++kt)
#pragma unroll
            for (int r = 0; r < 4; ++r) { const float e = __expf(s[kt][r] - mx); s[kt][r] = e; sum += e; }
        sum += __shfl_xor(sum, 16); sum += __shfl_xor(sum, 32);
        const float inv = 1.0f / (sum + __expf(sink - mx));
        f32x4 o[4];
#pragma unroll
        for (int dt = 0; dt < 4; ++dt) o[dt] = (f32x4){0.f, 0.f, 0.f, 0.f};
#pragma unroll
        for (int ks = 0; ks < NKT / 2; ++ks) {
            const u32x4 pw = pk8(s[2 * ks], s[2 * ks + 1]); const bf16x8 pf = __builtin_bit_cast(bf16x8, pw);
#pragma unroll
            for (int dt = 0; dt < 4; ++dt) {
                const bf16_t* vp = Vt + (dt * 16 + lr) * 200 + ks * 32 + lq * 4;
                const u32x2 lo = *(const u32x2*)vp, hi = *(const u32x2*)(vp + 16);
                const u32x4 vw = {lo.x, lo.y, hi.x, hi.y};
                o[dt] = MFMA16(__builtin_bit_cast(bf16x8, vw), pf, o[dt]);
            }
        }
#pragma unroll
        for (int dt = 0; dt < 4; ++dt) *(u32x2*)(YA + (size_t)(qrow0 + q) * 1024 + head * 64 + dt * 16 + lq * 4) = pk4(o[dt] * inv);
    }
}

template <int L, bool SAMPLE>
__device__ __forceinline__ void hgrn_seq(const Prm& p, unsigned char* lds, int b, int h, bf16_t* YB) {
    constexpr int RPG = L / 8, NT = L / 16, NCH = SAMPLE ? 1 : 32, NP = 8 / NT;
    bf16_t* Qd = (bf16_t*)lds; bf16_t* Qm = Qd + 64 * 136; bf16_t* Km = Qm + 64 * 136; bf16_t* KlT = Km + 64 * 136; bf16_t* Vt = KlT + 128 * 72; bf16_t* St = Vt + 128 * 72; bf16_t* Al = St + 128 * 136;
    float* tot = (float*)(Al + 64 * 72); float* first = tot + 1024; float* decay = first + 1024; float* ssq = decay + 128;
    const bf16_t* R1 = (const bf16_t*)(p.ws + WS_R0 + UB); const bf16_t* R2 = (const bf16_t*)(p.ws + WS_R0 + 2 * UB); const bf16_t* R3 = (const bf16_t*)(p.ws + WS_R0 + 3 * UB); const bf16_t* R4 = (const bf16_t*)(p.ws + WS_R0 + 4 * UB);
    const int tid = threadIdx.x, lane = tid & 63, w = tid >> 6, lr = lane & 15, lq = lane >> 4, cp = lane, rg = w, c0 = 2 * cp;
    float lb[2];
#pragma unroll
    for (int c = 0; c < 2; ++c) { const float l0 = p.in[I_LB][h * 128 + c0 + c], l1 = p.in[I_LB][1024 + h * 128 + c0 + c]; lb[c] = 1.0f / (1.0f + __expf(l1 - l0)); }
    f32x4 S[8];
#pragma unroll
    for (int dvt = 0; dvt < 8; ++dvt) {
        if (SAMPLE) {
#pragma unroll
            for (int r = 0; r < 4; ++r) S[dvt][r] = p.in[I_ST][((size_t)(b * 8 + h) * 128 + 16 * w + 4 * lq + r) * 128 + 16 * dvt + lr];
        } else S[dvt] = (f32x4){0.f, 0.f, 0.f, 0.f};
    }
    const int tt = w % NT, dv0 = (w / NT) * NT;
    const int rowbase = SAMPLE ? MP + b * 32 : b * 2048;
    unsigned qw[RPG], fw[RPG], vw[RPG];
#pragma unroll
    for (int i = 0; i < RPG; ++i) { const size_t idx = (size_t)(rowbase + rg * RPG + i) * 1024 + h * 128 + c0; qw[i] = *(const unsigned*)(R1 + idx); fw[i] = *(const unsigned*)(R2 + idx); vw[i] = *(const unsigned*)(R3 + idx); }
#pragma unroll 1
    for (int ch = 0; ch < NCH; ++ch) {
        const int row0 = rowbase + ch * L;
        float qv[2][RPG], cv[2][RPG], kk[2][RPG]; unsigned vkeep[RPG]; float run[2] = {0.f, 0.f}, lf0[2] = {0.f, 0.f};
#pragma unroll
        for (int i = 0; i < RPG; ++i) {
            vkeep[i] = vw[i];
#pragma unroll
            for (int c = 0; c < 2; ++c) {
                const float q = c ? bfhi(qw[i]) : bflo(qw[i]), fl = c ? bfhi(fw[i]) : bflo(fw[i]);
                const float f = lb[c] + (1.0f - lb[c]) * sigm(fl), lf = __logf(f);
                run[c] += lf; cv[c][i] = run[c]; kk[c][i] = 1.0f - f; qv[c][i] = q * sigm(q); if (i == 0) lf0[c] = lf;
            }
        }
        *(f32x2v*)(tot + rg * 128 + c0) = (f32x2v){run[0], run[1]}; *(f32x2v*)(first + rg * 128 + c0) = (f32x2v){lf0[0], lf0[1]};
        if (ch + 1 < NCH) {
#pragma unroll
            for (int i = 0; i < RPG; ++i) { const size_t idx = (size_t)(row0 + L + rg * RPG + i) * 1024 + h * 128 + c0; qw[i] = *(const unsigned*)(R1 + idx); fw[i] = *(const unsigned*)(R2 + idx); vw[i] = *(const unsigned*)(R3 + idx); }
        }
        const size_t rbase = (size_t)(row0 + tt * 16 + lr) * 1024 + h * 128;
        u32x2 ogw[NT];
#pragma unroll
        for (int i = 0; i < NT; ++i) ogw[i] = *(const u32x2*)(R4 + rbase + 16 * (dv0 + i) + 4 * lq);
        __syncthreads();
        {
            float pre[2] = {0.f, 0.f}, bmid[2], blast[2], emid[2], elm[2];
#pragma unroll
            for (int c = 0; c < 2; ++c) {
                float acc = 0.f, half = 0.f;
#pragma unroll
                for (int j = 0; j < 8; ++j) { const float t = tot[j * 128 + c0 + c]; if (j < rg) pre[c] += t; if (j < 4) half += t; acc += t; }
                bmid[c] = half + first[4 * 128 + c0 + c]; blast[c] = acc; emid[c] = __expf(bmid[c]); elm[c] = __expf(blast[c] - bmid[c]);
            }
            float kl[2][RPG];
#pragma unroll
            for (int i = 0; i < RPG; ++i) {
                const int r = rg * RPG + i; float qd[2], qm[2], km[2];
#pragma unroll
                for (int c = 0; c < 2; ++c) {
                    const float E = __expf(pre[c] + cv[c][i] - bmid[c]), Ei = __builtin_amdgcn_rcpf(E);
                    qm[c] = qv[c][i] * E; qd[c] = qm[c] * emid[c]; km[c] = kk[c][i] * Ei; kl[c][i] = km[c] * elm[c];
                }
                *(unsigned*)(Qd + r * 136 + c0) = pk2(qd[0], qd[1]); *(unsigned*)(Qm + r * 136 + c0) = pk2(qm[0], qm[1]); *(unsigned*)(Km + r * 136 + c0) = pk2(km[0], km[1]);
            }
#pragma unroll
            for (int c = 0; c < 2; ++c) {
#pragma unroll
                for (int i = 0; i < RPG; i += 4) {
                    u32x2 a, v2; a.x = pk2(kl[c][i], kl[c][i + 1]); a.y = pk2(kl[c][i + 2], kl[c][i + 3]);
                    if (c == 0) { v2.x = (vkeep[i] & 0xffffu) | (vkeep[i + 1] << 16); v2.y = (vkeep[i + 2] & 0xffffu) | (vkeep[i + 3] << 16); }
                    else { v2.x = (vkeep[i] >> 16) | (vkeep[i + 1] & 0xffff0000u); v2.y = (vkeep[i + 2] >> 16) | (vkeep[i + 3] & 0xffff0000u); }
                    *(u32x2*)(KlT + (c0 + c) * 72 + rg * RPG + i) = a; *(u32x2*)(Vt + (c0 + c) * 72 + rg * RPG + i) = v2;
                }
            }
            if (rg == 0) *(f32x2v*)(decay + c0) = (f32x2v){__expf(blast[0]), __expf(blast[1])};
        }
#pragma unroll
        for (int dvt = 0; dvt < 8; ++dvt) *(u32x2*)(St + (16 * dvt + lr) * 136 + 16 * w + 4 * lq) = pk4(S[dvt]);
        __syncthreads();
        for (int id = w; id < NT * NT; id += 8) {
            const int st = id / NT, t2 = id % NT; f32x4 acc = {0.f, 0.f, 0.f, 0.f};
#pragma unroll
            for (int ks = 0; ks < 4; ++ks) acc = MFMA16(*(const bf16x8*)(Km + (st * 16 + lr) * 136 + ks * 32 + lq * 8), *(const bf16x8*)(Qm + (t2 * 16 + lr) * 136 + ks * 32 + lq * 8), acc);
            const int t = t2 * 16 + lr;
#pragma unroll
            for (int r = 0; r < 4; ++r) if (st * 16 + 4 * lq + r > t) acc[r] = 0.f;
            *(u32x2*)(Al + t * 72 + st * 16 + 4 * lq) = pk4(acc);
        }
        f32x4 o[NT];
#pragma unroll
        for (int i = 0; i < NT; ++i) {
            f32x4 acc = {0.f, 0.f, 0.f, 0.f};
#pragma unroll
            for (int ks = 0; ks < 4; ++ks) acc = MFMA16(*(const bf16x8*)(St + (16 * (dv0 + i) + lr) * 136 + ks * 32 + lq * 8), *(const bf16x8*)(Qd + (tt * 16 + lr) * 136 + ks * 32 + lq * 8), acc);
            o[i] = acc;
        }
        __syncthreads();
        float sq = 0.f;
#pragma unroll
        for (int i = 0; i < NT; ++i) {
#pragma unroll
            for (int ks = 0; ks < L / 32; ++ks) o[i] = MFMA16(*(const bf16x8*)(Vt + (16 * (dv0 + i) + lr) * 72 + ks * 32 + lq * 8), *(const bf16x8*)(Al + (tt * 16 + lr) * 72 + ks * 32 + lq * 8), o[i]);
            sq += o[i][0] * o[i][0] + o[i][1] * o[i][1] + o[i][2] * o[i][2] + o[i][3] * o[i][3];
        }
        sq += __shfl_xor(sq, 16); sq += __shfl_xor(sq, 32);
        if (lq == 0) ssq[(w / NT) * 64 + tt * 16 + lr] = sq;
        {
            const f32x4 dc = *(const f32x4*)(decay + 16 * w + 4 * lq);
#pragma unroll
            for (int dvt = 0; dvt < 8; ++dvt) {
                f32x4 acc = S[dvt] * dc;
#pragma unroll
                for (int ks = 0; ks < L / 32; ++ks) acc = MFMA16(*(const bf16x8*)(KlT + (16 * w + lr) * 72 + ks * 32 + lq * 8), *(const bf16x8*)(Vt + (16 * dvt + lr) * 72 + ks * 32 + lq * 8), acc);
                S[dvt] = acc;
            }
        }
        __syncthreads();
        {
            float tsq = 0.f;
#pragma unroll
            for (int j = 0; j < NP; ++j) tsq += ssq[j * 64 + tt * 16 + lr];
            const float rs = rsqrtf(tsq * (1.0f / 128.0f) + EPS);
#pragma unroll
            for (int i = 0; i < NT; ++i) {
                const int dvb = 16 * (dv0 + i) + 4 * lq;
                const f32x4 gg = *(const f32x4*)(p.in[I_GH] + dvb);
                const float og0 = bflo(ogw[i].x), og1 = bfhi(ogw[i].x), og2 = bflo(ogw[i].y), og3 = bfhi(ogw[i].y);
                f32x4 y; y[0] = o[i][0] * rs * gg[0] * og0 * sigm(og0); y[1] = o[i][1] * rs * gg[1] * og1 * sigm(og1); y[2] = o[i][2] * rs * gg[2] * og2 * sigm(og2); y[3] = o[i][3] * rs * gg[3] * og3 * sigm(og3);
                *(u32x2*)(YB + rbase + dvb) = pk4(y);
            }
        }
    }
    float* so = p.out + (SAMPLE ? O_SST : O_PST) + (size_t)(b * 8 + h) * 16384;
#pragma unroll
    for (int dvt = 0; dvt < 8; ++dvt)
#pragma unroll
        for (int r = 0; r < 4; ++r) so[(16 * w + 4 * lq + r) * 128 + 16 * dvt + lr] = S[dvt][r];
    __syncthreads();
}

__device__ __forceinline__ void phase_rp5(const Prm& p) {
    const bf16_t* O = (const bf16_t*)(p.ws + WS_R0 + 4 * UB); bf16_t* hf = (bf16_t*)(p.ws + WS_R0); const float* g = p.in[I_GPOST];
    const int lane = threadIdx.x & 63, gw = blockIdx.x * 8 + (threadIdx.x >> 6), nw = gridDim.x * 8;
    for (int row = gw; row < MT; row += nw) {
        const float* xr = xrow(p, row); const bf16_t* orow = O + (size_t)row * 1024; f32x4 v[4], x[4]; float ss = 0.f;
#pragma unroll
        for (int i = 0; i < 4; ++i) { { const u32x2 ow = *(const u32x2*)(orow + i * 256 + lane * 4); v[i] = (f32x4){bflo(ow.x), bfhi(ow.x), bflo(ow.y), bfhi(ow.y)}; } x[i] = *(const f32x4*)(xr + i * 256 + lane * 4); ss += v[i][0] * v[i][0] + v[i][1] * v[i][1] + v[i][2] * v[i][2] + v[i][3] * v[i][3]; }
        ss = wsum(ss); const float rs = rsqrtf(ss * (1.0f / 1024.0f) + EPS); float s2 = 0.f;
#pragma unroll
        for (int i = 0; i < 4; ++i) { const f32x4 gg = *(const f32x4*)(g + i * 256 + lane * 4); x[i] += v[i] * rs * gg; s2 += x[i][0] * x[i][0] + x[i][1] * x[i][1] + x[i][2] * x[i][2] + x[i][3] * x[i][3];
            *(u32x2*)((bf16_t*)p.out + (size_t)row * 1024 + i * 256 + lane * 4) = pk4(x[i]); }
        s2 = wsum(s2); const float r2 = rsqrtf(s2 * (1.0f / 1024.0f) + EPS);
#pragma unroll
        for (int i = 0; i < 4; ++i) *(u32x2*)(hf + (size_t)row * 1024 + i * 256 + lane * 4) = pk4(x[i] * r2);
    }
    bf16_t* pbf = (bf16_t*)(p.ws + WS_KV);
    for (int id = blockIdx.x * 512 + threadIdx.x; id < MT * 32; id += gridDim.x * 512) {
        const int row = id >> 5, c = (id & 31) * 8;
        const float* s = (row < MP ? p.in[I_PP] + (size_t)row * 256 : p.in[I_PS] + (size_t)(row - MP) * 256) + c;
        *(u32x4*)(pbf + (size_t)row * 256 + c) = pk8(*(const f32x4*)s, *(const f32x4*)(s + 4));
    }
}
__device__ __forceinline__ void phase_rp8(const Prm& p) {
    const bf16_t* O = (const bf16_t*)(p.ws + WS_R0 + UB); bf16_t* xb = (bf16_t*)(p.ws + WS_R0 + 3 * UB); const float* g = p.in[I_GPFF];
    const int lane = threadIdx.x & 63, gw = blockIdx.x * 8 + (threadIdx.x >> 6), nw = gridDim.x * 8;
    for (int row = gw; row < MT; row += nw) {
        const bf16_t* xr = (const bf16_t*)p.out + (size_t)row * 1024; const bf16_t* orow = O + (size_t)row * 1024; f32x4 v[4], x[4]; float ss = 0.f;
#pragma unroll
        for (int i = 0; i < 4; ++i) { { const u32x2 ow = *(const u32x2*)(orow + i * 256 + lane * 4); v[i] = (f32x4){bflo(ow.x), bfhi(ow.x), bflo(ow.y), bfhi(ow.y)}; } { const u32x2 xw = *(const u32x2*)(xr + i * 256 + lane * 4); x[i] = (f32x4){bflo(xw.x), bfhi(xw.x), bflo(xw.y), bfhi(xw.y)}; } ss += v[i][0] * v[i][0] + v[i][1] * v[i][1] + v[i][2] * v[i][2] + v[i][3] * v[i][3]; }
        ss = wsum(ss); const float rs = rsqrtf(ss * (1.0f / 1024.0f) + EPS);
#pragma unroll
        for (int i = 0; i < 4; ++i) { const f32x4 gg = *(const f32x4*)(g + i * 256 + lane * 4); x[i] += v[i] * rs * gg;
            *(u32x2*)(xb + (size_t)row * 1024 + i * 256 + lane * 4) = pk4(x[i]); }
    }
}
__device__ __forceinline__ void phase_conv(const Prm& p) {
    const bf16_t* A = (const bf16_t*)(p.ws + WS_R0 + UB); bf16_t* Ug = (bf16_t*)(p.ws + WS_R0 + UB + A_BYTES);
    const float* wc = p.in[I_WCONV]; const float* bc = p.in[I_BCONV]; const float* cc = p.in[I_CC];
    for (int id = blockIdx.x * 512 + threadIdx.x; id < (MT / 32) * 352; id += gridDim.x * 512) {
        const int rb = id / 352, c0 = (id % 352) * 8, row0 = rb * 32;
        float w0[8], w1[8], w2[8], bb[8], am2[8], am1[8];
#pragma unroll
        for (int j = 0; j < 8; ++j) { w0[j] = wc[c0 + j]; w1[j] = wc[DFF + c0 + j]; w2[j] = wc[2 * DFF + c0 + j]; bb[j] = bc[c0 + j]; am2[j] = 0.f; am1[j] = 0.f; }
        if (row0 < MP) { if ((row0 & 2047) != 0) { unpk8(*(const u32x4*)(A + (size_t)(row0 - 2) * DFF + c0), am2); unpk8(*(const u32x4*)(A + (size_t)(row0 - 1) * DFF + c0), am1); } }
        else { const int b = (row0 - MP) >> 5;
#pragma unroll
            for (int j = 0; j < 8; ++j) { am2[j] = cc[(size_t)(b * 2) * DFF + c0 + j]; am1[j] = cc[(size_t)(b * 2 + 1) * DFF + c0 + j]; } }
        for (int r = 0; r < 32; ++r) {
            const size_t off = (size_t)(row0 + r) * DFF + c0; float a[8], u[8], gq[8];
            unpk8(*(const u32x4*)(A + off), a); unpk8(*(const u32x4*)(Ug + off), u);
#pragma unroll
            for (int j = 0; j < 8; ++j) {
                const float ac = bb[j] + w0[j] * am2[j] + w1[j] * am1[j] + w2[j] * a[j];
                const float y = 1.5957691216f * (ac + 0.044715f * ac * ac * ac);
                gq[j] = ac * sigm(y) * u[j]; am2[j] = am1[j]; am1[j] = a[j];
            }
            u32x4 wv; wv.x = pk2(gq[0], gq[1]); wv.y = pk2(gq[2], gq[3]); wv.z = pk2(gq[4], gq[5]); wv.w = pk2(gq[6], gq[7]);
            *(u32x4*)(Ug + off) = wv;
        }
    }
}

#ifndef PROBE_DUP
#define PROBE_DUP 0
#endif
#ifndef P2M
#define P2M 15
#endif
#ifndef PHM
#define PHM 0xfff
#endif
__global__ void __launch_bounds__(512, 2) fwd_mega(Prm p, int ph_lo, int ph_hi) {
    extern __shared__ __attribute__((aligned(16))) unsigned char lds[];
    cg::grid_group grid = cg::this_grid();
    unsigned char* ws = p.ws;
    bf16_t* R0 = (bf16_t*)(ws + WS_R0);
#define REG(i) ((bf16_t*)(ws + WS_R0 + (size_t)(i) * UB))
#define PH_BEGIN(n) if (ph_lo <= (n) && (n) < ph_hi) { if ((n) > ph_lo) grid.sync();
#define PH_END }
#if (PHM >> 0) & 1
        PH_BEGIN(0) phase0(p, lds);
#if PROBE_DUP == 1
        grid.sync(); phase0(p, lds);
#endif
        PH_END
#else
#endif
#if (PHM >> 1) & 1
        PH_BEGIN(1) { F1 f; f.r0 = R0; f.kv = (bf16_t*)(ws + WS_KV); f.out = p.out; run_gemm(lds, (const bf16_t*)p.out, (const bf16_t*)(ws + WS_WIN), NIN, 1024, f);
#if PROBE_DUP == 3
            grid.sync(); run_gemm(lds, (const bf16_t*)p.out, (const bf16_t*)(ws + WS_WIN), NIN, 1024, f);
#endif
        } PH_END
#else
#endif
#if (PHM >> 2) & 1
        PH_BEGIN(2) {
#if PROBE_DUP == 2
            { bf16_t* YA = (bf16_t*)p.out; bf16_t* YB = (bf16_t*)p.out + UB / 2;
            const int G = gridDim.x;
#if P2M & 1
#pragma unroll 1
            for (int s = blockIdx.x; s < 256; s += G) hgrn_seq<64, false>(p, lds, s >> 3, s & 7, YB);
#endif
#if P2M & 2
#pragma unroll 1
            for (int s = blockIdx.x; s < 256; s += G) hgrn_seq<32, true>(p, lds, s >> 3, s & 7, YB);
#endif
            __syncthreads(); attn_bias_table(p, lds); __syncthreads();
#if P2M & 4
#pragma unroll 1
            for (int it = blockIdx.x; it < 2048; it += G) attn_item<12, 4, false>(p, lds, it >> 6, (it >> 1) & 31, it & 1, YA);
#endif
#if P2M & 8
#pragma unroll 1
            for (int it = blockIdx.x; it < 64; it += G) attn_item<10, 2, true>(p, lds, it >> 1, 0, it & 1, YA);
#endif
            __syncthreads(); }
#endif
            { bf16_t* YA = REG(0); bf16_t* YB = REG(1);
            const int G = gridDim.x;
#if P2M & 1
#pragma unroll 1
            for (int s = blockIdx.x; s < 256; s += G) hgrn_seq<64, false>(p, lds, s >> 3, s & 7, YB);
#endif
#if P2M & 2
#pragma unroll 1
            for (int s = blockIdx.x; s < 256; s += G) hgrn_seq<32, true>(p, lds, s >> 3, s & 7, YB);
#endif
            __syncthreads(); attn_bias_table(p, lds); __syncthreads();
#if P2M & 4
#pragma unroll 1
            for (int it = blockIdx.x; it < 2048; it += G) attn_item<12, 4, false>(p, lds, it >> 6, (it >> 1) & 31, it & 1, YA);
#endif
#if P2M & 8
#pragma unroll 1
            for (int it = blockIdx.x; it < 64; it += G) attn_item<10, 2, true>(p, lds, it >> 1, 0, it & 1, YA);
#endif
            }
        } PH_END
#else
#endif
#if (PHM >> 3) & 1
        PH_BEGIN(3) { F2 f; f.g = REG(5); f.o = REG(2); run_gemm(lds, REG(0), (const bf16_t*)(ws + WS_WBRA), 1024, 1024, f);
#if PROBE_DUP == 4
            grid.sync(); run_gemm(lds, REG(0), (const bf16_t*)(ws + WS_WBRA), 1024, 1024, f);
#endif
        } PH_END
#else
#endif
#if (PHM >> 4) & 1
        PH_BEGIN(4) { F3 f; f.g = REG(6); f.t = REG(2); f.o = REG(3); run_gemm(lds, REG(1), (const bf16_t*)(ws + WS_WBRB), 1024, 1024, f); } PH_END
#else
#endif
#if (PHM >> 5) & 1
        PH_BEGIN(5) { FBF f; f.o = REG(4); run_gemm(lds, REG(3), (const bf16_t*)(ws + WS_WOUT), 1024, 1024, f);
#if PROBE_DUP == 5
            grid.sync(); run_gemm(lds, REG(3), (const bf16_t*)(ws + WS_WOUT), 1024, 1024, f);
#endif
        } PH_END
#else
#endif
#if (PHM >> 6) & 1
        PH_BEGIN(6) phase_rp5(p); PH_END
#else
#endif
#if (PHM >> 7) & 1
        PH_BEGIN(7) { F6 f; f.a = REG(1); f.u = (bf16_t*)(ws + WS_R0 + UB + A_BYTES); f.out = p.out; run_gemm(lds, REG(0), (const bf16_t*)(ws + WS_WUP), 2 * DFF, 1024, f); } PH_END
#else
#endif
#if (PHM >> 8) & 1
        PH_BEGIN(8) phase_conv(p); PH_END
#else
#endif
        PH_BEGIN(9) { FBF f; f.o = REG(1); run_gemm(lds, (const bf16_t*)(ws + WS_R0 + UB + A_BYTES), (const bf16_t*)(ws + WS_WDOWN), 1024, DFF, f);
                  FBF f2; f2.o = REG(0); run_gemm(lds, (const bf16_t*)(ws + WS_KV), (const bf16_t*)(ws + WS_WPLE), 1024, 256, f2); } PH_END
#if (PHM >> 10) & 1
        PH_BEGIN(10) phase_rp8(p); PH_END
#else
#endif
#if (PHM >> 11) & 1
        PH_BEGIN(11) { F9 f; f.pe = REG(0); f.xb = REG(3); f.y = p.out; run_gemm(lds, REG(3), (const bf16_t*)(ws + WS_WPG), 1024, 1024, f); } PH_END
#else
#endif
#undef REG
}

extern "C" void kernel_launch(void* const* d_in, const int* in_sizes, int n_in, void* d_out, int out_size, void* d_ws, size_t ws_size, hipStream_t stream) {
    static int grid = 0;
    if (grid == 0) {
        if (n_in != 26 || (size_t)out_size != O_END || ws_size < WS_END) { fprintf(stderr, "kernel_launch: unexpected shapes n_in %d out %d ws %zu (need %zu)\n", n_in, out_size, ws_size, (size_t)WS_END); grid = -1; return; }
        int dev = 0, cus = 0, per_cu = 0;
        hipGetDevice(&dev); hipDeviceGetAttribute(&cus, hipDeviceAttributeMultiprocessorCount, dev);
        if (hipFuncSetAttribute((const void*)fwd_mega, hipFuncAttributeMaxDynamicSharedMemorySize, LDS_BYTES) != hipSuccess) { fprintf(stderr, "kernel_launch: hipFuncSetAttribute failed\n"); grid = -1; return; }
        if (hipOccupancyMaxActiveBlocksPerMultiprocessor(&per_cu, (const void*)fwd_mega, 512, LDS_BYTES) != hipSuccess || per_cu < 1) { fprintf(stderr, "kernel_launch: occupancy query says %d\n", per_cu); per_cu = 1; }
        (void)hipGetLastError();
        grid = cus;
    }
    if (grid < 0) return;
    Prm p{};
    for (int i = 0; i < 26; ++i) p.in[i] = (const float*)d_in[i];
    p.out = (float*)d_out; p.ws = (unsigned char*)d_ws;
    int lo = 0, hi = 12;
    void* args[] = {&p, &lo, &hi};
    hipError_t e = hipLaunchCooperativeKernel((const void*)fwd_mega, dim3(grid), dim3(512), args, LDS_BYTES, stream);
    if (e != hipSuccess) fprintf(stderr, "kernel_launch: cooperative launch failed: %s (grid %d)\n", hipGetErrorString(e), grid);
}
```

```cpp
#include <hip/hip_runtime.h>
#include <hip/hip_cooperative_groups.h>
#include <cstdio>
namespace cg = cooperative_groups;
namespace pg8 {
#define PG8_LAS __attribute__((address_space(3)))
typedef unsigned short bf16_t;
typedef short bf16x8 __attribute__((ext_vector_type(8)));
typedef float f32x4 __attribute__((ext_vector_type(4)));
typedef unsigned u32x4 __attribute__((ext_vector_type(4)));
constexpr int BM = 256, BK = 64, HALF = 128, HTB = HALF * BK * 2  , STAGE_BYTES = 8 * HTB, NXCD = 8, WGM = 8;

__host__ __device__ __forceinline__ int lds_byte(int r, int c) { const int st = (r >> 4) * 2 + (c >> 5), rr = r & 15, cc = c & 31, ob = rr * 64 + cc * 2; return st * 1024 + (ob ^ (((ob >> 9) & 1) << 5)); }
__host__ __device__ __forceinline__ void stage_rc(int b, int& R, int& C) { const int st = b / 1024, sb = b % 1024, swz = sb ^ (((sb >> 9) & 1) << 5); R = (st >> 1) * 16 + swz / 64; C = (st & 1) * 32 + (swz % 64) / 2; }
__host__ __device__ __forceinline__ int perm32(int rho) { const int n = rho >> 4, i = rho & 15; return 8 * (i >> 2) + 4 * n + (i & 3); }

struct Unit { int pm, pn; };
struct Gemm { const bf16_t* A; const bf16_t* Bt; int M, N, K; };

struct StaticOrder {
    int nM, nN, nwg, G, c;
    __host__ __device__ void init(int M, int N, int G_, int c_) { nM = M / BM; nN = N / BM; nwg = nM * nN; G = G_; c = c_; }
    __host__ __device__ bool next(int i, Unit& u) const {
        const long L = (long)i * G + c; if (L >= nwg) return false;
        int wgid = (int)L; { const int q = nwg / NXCD, r = nwg % NXCD, xcd = wgid % NXCD, off = wgid / NXCD; wgid = (xcd < r ? xcd * (q + 1) : r * (q + 1) + (xcd - r) * q) + off; }
        const int nig = WGM * nN, gid = wgid / nig, fm = gid * WGM, gsz = (nM - fm) < WGM ? (nM - fm) : WGM;
        u.pm = fm + ((wgid % nig) % gsz); u.pn = (wgid % nig) / gsz; return true;
    }
    __device__ __forceinline__ void a_ready(const Unit&) const {}
    __device__ __forceinline__ void done(const Unit&) const {}
};
__device__ __forceinline__ unsigned cvt_pk_bf16(float lo, float hi) { unsigned r; asm volatile("v_cvt_pk_bf16_f32 %0, %1, %2" : "=v"(r) : "v"(lo), "v"(hi)); return r; }
template <class Epi, class Sched, bool STAMP = false>
__device__ __forceinline__ void gemm_phase(PG8_LAS unsigned char* lds, const Gemm g, const Sched& S, const Epi& E, unsigned long long* stamps) {
    const int tid = threadIdx.x, wid = __builtin_amdgcn_readfirstlane(tid >> 6), lane = tid & 63, wr = wid >> 2, wc = wid & 3, fr = lane & 15, fq = lane >> 4;
    const int K = g.K, nt = K / BK;
    int ts_lo = 0, ts_hi = 0, nts = 0; const unsigned long long rt_entry = STAMP ? (unsigned long long)wall_clock64() : 0ull;
#define PG8_STAMP() do { if (STAMP && wid == 0 && nts < 64) { const unsigned long long _c = (unsigned long long)clock64(); \
        ts_lo = (lane == nts) ? (int)(unsigned)_c : ts_lo; ts_hi = (lane == nts) ? (int)(unsigned)(_c >> 32) : ts_hi; ++nts; } } while (0)
    PG8_STAMP();
    unsigned voffA[2], voffB[2];
#pragma unroll
    for (int i = 0; i < 2; ++i) { int R, C; stage_rc(tid * 16 + i * 8192, R, C); const int Rb = Epi::PERM ? ((R & ~31) + perm32(R & 31)) : R;
        voffA[i] = (unsigned)(R * K + C) * 2u; voffB[i] = (unsigned)(Rb * K + C) * 2u; }
    const size_t kstep = (size_t)(BK * 2);
    const size_t hstep = (size_t)HALF * K * 2;
    const size_t tstep = 2 * hstep;
    const unsigned ldsw = (unsigned)wid * 1024u;
    const int aoff = lds_byte(wr * 64 + fr, fq * 8), boff = lds_byte(wc * 32 + fr, fq * 8);
#define PG8_SA(b, h) (((b) * 2 + (h)) * HTB)
#define PG8_SB(b, h) ((4 + (b) * 2 + (h)) * HTB)
#define PG8_STAGE(bufoff, gbase, voff) do { _Pragma("unroll") for (int _i = 0; _i < 2; ++_i) \
        __builtin_amdgcn_global_load_lds((const unsigned*)((const char*)(gbase) + (voff)[_i]), (PG8_LAS unsigned*)(lds + (bufoff) + ldsw + _i * 8192), 16, 0, 0); } while (0)
#define PG8_LDA(dst, b, h) do { _Pragma("unroll") for (int m = 0; m < 4; ++m) _Pragma("unroll") for (int k = 0; k < 2; ++k) dst[m][k] = *(const PG8_LAS bf16x8*)(lds + PG8_SA(b, h) + aoff + m * 2048 + k * 1024); } while (0)
#define PG8_LDB(dst, b, h) do { _Pragma("unroll") for (int n = 0; n < 2; ++n) _Pragma("unroll") for (int k = 0; k < 2; ++k) dst[n][k] = *(const PG8_LAS bf16x8*)(lds + PG8_SB(b, h) + boff + n * 2048 + k * 1024); } while (0)
#define PG8_MMA(ai, bj, At, Bt) do { __builtin_amdgcn_s_setprio(1); _Pragma("unroll") for (int m = 0; m < 4; ++m) _Pragma("unroll") for (int n = 0; n < 2; ++n) _Pragma("unroll") for (int k = 0; k < 2; ++k) \
        acc[ai][bj][m][n] = __builtin_amdgcn_mfma_f32_16x16x32_bf16(Bt[n][k], At[m][k], acc[ai][bj][m][n], 0, 0, 0); __builtin_amdgcn_s_setprio(0); } while (0)
#define PG8_WAIT_V(n) asm volatile("s_waitcnt vmcnt(" #n ")" ::: "memory")
#define PG8_WAIT_L(n) asm volatile("s_waitcnt lgkmcnt(" #n ")" ::: "memory")
#define PG8_BAR __builtin_amdgcn_s_barrier()
#define PG8_SCHED __builtin_amdgcn_sched_barrier(0)
    Unit cur, nxt; int ui = 0;
    if (!S.next(0, cur)) return;
    f32x4 acc[2][2][4][2];
#pragma unroll
    for (int a = 0; a < 2; ++a)
#pragma unroll
        for (int b = 0; b < 2; ++b)
#pragma unroll
            for (int m = 0; m < 4; ++m)
#pragma unroll
                for (int n = 0; n < 2; ++n) acc[a][b][m][n] = (f32x4){0.f, 0.f, 0.f, 0.f};
    bf16x8 At[4][2], B0[2][2], B1[2][2];
    const char* cA = (const char*)g.A + (size_t)cur.pm * tstep; const char* cB = (const char*)g.Bt + (size_t)cur.pn * tstep;
    S.a_ready(cur);
    PG8_STAGE(PG8_SB(0, 0), cB, voffB); PG8_STAGE(PG8_SA(0, 0), cA, voffA); PG8_STAGE(PG8_SB(0, 1), cB + hstep, voffB); PG8_STAGE(PG8_SA(0, 1), cA + hstep, voffA);
    if (wr == 1) PG8_BAR;
    PG8_WAIT_V(4); PG8_BAR;
    PG8_STAGE(PG8_SB(1, 0), cB + kstep, voffB); PG8_STAGE(PG8_SA(1, 0), cA + kstep, voffA); PG8_STAGE(PG8_SB(1, 1), cB + hstep + kstep, voffB);
    PG8_WAIT_V(6); PG8_BAR;
    PG8_STAMP();
    for (;;) {
        const bool has_next = S.next(ui + 1, nxt);
        const char* nA = has_next ? (const char*)g.A + (size_t)nxt.pm * tstep : cA; const char* nB = has_next ? (const char*)g.Bt + (size_t)nxt.pn * tstep : cB;
        for (int t = 0; t < nt; t += 2) {
            const bool last = (t == nt - 2);
            const char* a1 = cA + (size_t)(t + 1) * kstep;
            const char* a2 = last ? nA : cA + (size_t)(t + 2) * kstep; const char* b2 = last ? nB : cB + (size_t)(t + 2) * kstep;
            const char* a3 = a2 + kstep; const char* b3 = b2 + kstep;
            if (last && has_next) S.a_ready(nxt);
            PG8_LDB(B0, 0, 0); PG8_SCHED; PG8_LDA(At, 0, 0); PG8_STAGE(PG8_SA(1, 1), a1 + hstep, voffA);
            PG8_WAIT_L(8); PG8_BAR; PG8_WAIT_L(0); PG8_MMA(0, 0, At, B0); PG8_BAR; PG8_SCHED;
            PG8_LDB(B1, 0, 1); PG8_STAGE(PG8_SB(0, 0), b2, voffB);
            PG8_BAR; PG8_WAIT_L(0); PG8_MMA(0, 1, At, B1); PG8_BAR;
            PG8_LDA(At, 0, 1); PG8_STAGE(PG8_SA(0, 0), a2, voffA);
            PG8_BAR; PG8_WAIT_L(0); PG8_MMA(1, 0, At, B0); PG8_BAR; PG8_SCHED;
            PG8_STAGE(PG8_SB(0, 1), b2 + hstep, voffB);
            PG8_WAIT_V(6); PG8_BAR; PG8_MMA(1, 1, At, B1); PG8_BAR;
            PG8_LDB(B0, 1, 0); PG8_SCHED; PG8_LDA(At, 1, 0); PG8_STAGE(PG8_SA(0, 1), a2 + hstep, voffA);
            PG8_WAIT_L(8); PG8_BAR; PG8_WAIT_L(0); PG8_MMA(0, 0, At, B0); PG8_BAR; PG8_SCHED;
            PG8_LDB(B1, 1, 1); PG8_STAGE(PG8_SB(1, 0), b3, voffB);
            PG8_BAR; PG8_WAIT_L(0); PG8_MMA(0, 1, At, B1); PG8_BAR;
            PG8_LDA(At, 1, 1); PG8_STAGE(PG8_SA(1, 0), a3, voffA);
            PG8_BAR; PG8_WAIT_L(0); PG8_MMA(1, 0, At, B0); PG8_BAR; PG8_SCHED;
            PG8_STAGE(PG8_SB(1, 1), b3 + hstep, voffB);
            PG8_WAIT_V(6); PG8_BAR; PG8_MMA(1, 1, At, B1); PG8_BAR;
        }
        PG8_STAMP();
        if constexpr (!Epi::AFTER_DRAIN) { E(acc, cur, wr, wc, fr, fq); S.done(cur); }
        PG8_STAMP();
        if (!has_next) break;
#pragma unroll
        for (int a = 0; a < 2; ++a)
#pragma unroll
            for (int b = 0; b < 2; ++b)
#pragma unroll
                for (int m = 0; m < 4; ++m)
#pragma unroll
                    for (int n = 0; n < 2; ++n) acc[a][b][m][n] = (f32x4){0.f, 0.f, 0.f, 0.f};
        cur = nxt; cA = nA; cB = nB; ++ui;
    }
    PG8_WAIT_V(0);
    if (wr == 0) PG8_BAR;
    PG8_BAR;
    if constexpr (Epi::AFTER_DRAIN) { E.fused(acc, cur, wr, wc, fr, fq, lds, wid, lane); S.done(cur); }
    PG8_STAMP();
    if (STAMP && wid == 0) { stamps[lane] = lane < nts ? (((unsigned long long)(unsigned)ts_hi << 32) | (unsigned)ts_lo) : 0ull;
        if (lane == 62) stamps[62] = rt_entry; if (lane == 63) stamps[63] = (unsigned long long)wall_clock64(); }
#undef PG8_STAMP
#undef PG8_SA
#undef PG8_SB
#undef PG8_STAGE
#undef PG8_LDA
#undef PG8_LDB
#undef PG8_MMA
#undef PG8_WAIT_V
#undef PG8_WAIT_L
#undef PG8_BAR
#undef PG8_SCHED
}
}


using pg8::bf16_t; using pg8::bf16x8; using pg8::f32x4; using pg8::u32x4;
typedef unsigned u32x2 __attribute__((ext_vector_type(2)));
typedef float f32x2v __attribute__((ext_vector_type(2)));
#define MFMA16(a, b, c) __builtin_amdgcn_mfma_f32_16x16x32_bf16((a), (b), (c), 0, 0, 0)

constexpr int MP = 65536, MS = 1024, MT = MP + MS, DM = 1024, DFF = 2816, NIN = 7424;
constexpr float EPS = 1e-6f;
constexpr size_t UB = (size_t)MT * 1024 * 2;
constexpr size_t WS_WIN = 0, WS_WBRA = WS_WIN + (size_t)NIN * 1024 * 2, WS_WBRB = WS_WBRA + 2097152, WS_WOUT = WS_WBRB + 2097152, WS_WPG = WS_WOUT + 2097152,
                 WS_WUP = WS_WPG + 2097152, WS_WDOWN = WS_WUP + (size_t)2 * DFF * 1024 * 2, WS_WPLE = WS_WDOWN + (size_t)1024 * DFF * 2, WS_KV = WS_WPLE + (size_t)1024 * 256 * 2,
                 WS_R0 = WS_KV + (size_t)MT * 256 * 2, WS_END = WS_R0 + 7 * UB;
constexpr size_t A_BYTES = (size_t)MT * DFF * 2;
constexpr size_t O_Y = 0, O_PWK = (size_t)MT * 1024, O_PWV = O_PWK + 524288, O_PST = O_PWV + 524288, O_PFC = O_PST + 4194304, O_SWK = O_PFC + 180224, O_SWV = O_SWK + 131072,
                 O_SST = O_SWV + 131072, O_SFC = O_SST + 4194304, O_END = O_SFC + 180224;
constexpr int LDS_BYTES = 147456;

struct Prm { const float* in[26]; float* out; unsigned char* ws; };
enum { I_XP = 0, I_XS, I_CK, I_CV, I_ST, I_CC, I_PP, I_PS, I_RB, I_LB, I_GPM, I_WIN, I_SINK, I_GH, I_WBRA, I_WBRB, I_WOUT, I_GPOST, I_GPF, I_WUP, I_WCONV, I_BCONV, I_WDOWN, I_GPFF, I_WPLE, I_WPG };

__device__ __forceinline__ unsigned pk2(float lo, float hi) { unsigned r; asm("v_cvt_pk_bf16_f32 %0, %1, %2" : "=v"(r) : "v"(lo), "v"(hi)); return r; }
__device__ __forceinline__ float bflo(unsigned w) { return __uint_as_float(w << 16); }
__device__ __forceinline__ float bfhi(unsigned w) { return __uint_as_float(w & 0xffff0000u); }
__device__ __forceinline__ float bf1(bf16_t b) { return __uint_as_float(((unsigned)b) << 16); }
__device__ __forceinline__ bf16_t f2bf(float f) { return (bf16_t)(pk2(f, 0.f) & 0xffffu); }
__device__ __forceinline__ float sigm(float x) { return __builtin_amdgcn_rcpf(1.0f + __expf(-x)); }
__device__ __forceinline__ float wsum(float v) { v += __shfl_xor(v, 32); v += __shfl_xor(v, 16); v += __shfl_xor(v, 8); v += __shfl_xor(v, 4); v += __shfl_xor(v, 2); v += __shfl_xor(v, 1); return v; }
__device__ __forceinline__ u32x4 pk8(f32x4 a, f32x4 b) { u32x4 w; w.x = pk2(a[0], a[1]); w.y = pk2(a[2], a[3]); w.z = pk2(b[0], b[1]); w.w = pk2(b[2], b[3]); return w; }
__device__ __forceinline__ u32x2 pk4(f32x4 a) { u32x2 w; w.x = pk2(a[0], a[1]); w.y = pk2(a[2], a[3]); return w; }
__device__ __forceinline__ void unpk8(u32x4 w, float (&f)[8]) { f[0] = bflo(w.x); f[1] = bfhi(w.x); f[2] = bflo(w.y); f[3] = bfhi(w.y); f[4] = bflo(w.z); f[5] = bfhi(w.z); f[6] = bflo(w.w); f[7] = bfhi(w.w); }

struct NoPre {};
template <class F> struct EpiT {
    static constexpr bool PERM = true, AFTER_DRAIN = false; F f;
    __device__ __forceinline__ void operator()(const f32x4 (&acc)[2][2][4][2], const pg8::Unit& u, int wr, int wc, int fr, int fq) const {
        const int row0 = u.pm * 256 + wr * 64 + fr, col0 = u.pn * 256 + wc * 32 + 8 * fq;
        constexpr int MB = F::MB;
#pragma unroll
        for (int a0 = 0; a0 < 8; a0 += MB) {
            typename F::Pre pre[MB][2];
#pragma unroll
            for (int mm = 0; mm < MB; ++mm)
#pragma unroll
                for (int bj = 0; bj < 2; ++bj) pre[mm][bj] = f.load(row0 + ((a0 + mm) >> 2) * 128 + ((a0 + mm) & 3) * 16, col0 + bj * 128);
#pragma unroll
            for (int mm = 0; mm < MB; ++mm)
#pragma unroll
                for (int bj = 0; bj < 2; ++bj) f(row0 + ((a0 + mm) >> 2) * 128 + ((a0 + mm) & 3) * 16, col0 + bj * 128, u.pn, acc[(a0 + mm) >> 2][bj][(a0 + mm) & 3][0], acc[(a0 + mm) >> 2][bj][(a0 + mm) & 3][1], pre[mm][bj]);
        }
    }
};
struct F1 {
    bf16_t* r0; bf16_t* kv; float* out; typedef NoPre Pre; static constexpr int MB = 1;
    __device__ __forceinline__ NoPre load(int, int) const { return NoPre(); }
    __device__ __forceinline__ void operator()(int row, int col, int pn, f32x4 v0, f32x4 v1, NoPre) const {
        const u32x4 w = pk8(v0, v1);
        if (pn < 4) { *(u32x4*)(r0 + (size_t)row * 1024 + col) = w; }
        else if (pn == 4) {
            const int c = col - 1024; *(u32x4*)(kv + (size_t)row * 256 + c) = w;
            float* o = nullptr;
            if (row >= MP) { o = out + (c < 128 ? O_SWK : O_SWV) + (size_t)(row - MP) * 128 + (c & 127); }
            else { const int t = row & 2047; if (t >= 1920) o = out + (c < 128 ? O_PWK : O_PWV) + (size_t)((row >> 11) * 128 + t - 1920) * 128 + (c & 127); }
            if (o) { *(f32x4*)o = v0; *(f32x4*)(o + 4) = v1; }
        } else { const int c2 = col - 1280, seg = c2 >> 10; *(u32x4*)(r0 + (size_t)(1 + seg) * (UB / 2) + (size_t)row * 1024 + (c2 & 1023)) = w; }
    }
};
struct F2 {
    const bf16_t* g; bf16_t* o; typedef u32x4 Pre; static constexpr int MB = 8;
    __device__ __forceinline__ u32x4 load(int row, int col) const { return *(const u32x4*)(g + (size_t)row * 1024 + col); }
    __device__ __forceinline__ void operator()(int row, int col, int, f32x4 v0, f32x4 v1, u32x4 gw) const {
        const size_t i = (size_t)row * 1024 + col; float gf[8]; unpk8(gw, gf);
        f32x4 a, b;
#pragma unroll
        for (int j = 0; j < 4; ++j) { a[j] = v0[j] * sigm(gf[j]); b[j] = v1[j] * sigm(gf[4 + j]); }
        *(u32x4*)(o + i) = pk8(a, b);
    }
};
struct F3 {
    const bf16_t* g; const bf16_t* t; bf16_t* o; struct Pre { u32x4 g, t; }; static constexpr int MB = 4;
    __device__ __forceinline__ Pre load(int row, int col) const { const size_t i = (size_t)row * 1024 + col; Pre r; r.g = *(const u32x4*)(g + i); r.t = *(const u32x4*)(t + i); return r; }
    __device__ __forceinline__ void operator()(int row, int col, int, f32x4 v0, f32x4 v1, Pre pr) const {
        const size_t i = (size_t)row * 1024 + col; float gf[8], tf[8]; unpk8(pr.g, gf); unpk8(pr.t, tf);
        f32x4 a, b;
#pragma unroll
        for (int j = 0; j < 4; ++j) { a[j] = tf[j] + v0[j] * sigm(gf[j]); b[j] = tf[4 + j] + v1[j] * sigm(gf[4 + j]); }
        *(u32x4*)(o + i) = pk8(a, b);
    }
};
struct FF32 {
    float* o; typedef NoPre Pre; static constexpr int MB = 1;
    __device__ __forceinline__ NoPre load(int, int) const { return NoPre(); }
    __device__ __forceinline__ void operator()(int row, int col, int, f32x4 v0, f32x4 v1, NoPre) const { float* d = o + (size_t)row * 1024 + col; *(f32x4*)d = v0; *(f32x4*)(d + 4) = v1; }
};
struct FBF {
    bf16_t* o; typedef NoPre Pre; static constexpr int MB = 1;
    __device__ __forceinline__ NoPre load(int, int) const { return NoPre(); }
    __device__ __forceinline__ void operator()(int row, int col, int, f32x4 v0, f32x4 v1, NoPre) const { *(u32x4*)(o + (size_t)row * 1024 + col) = pk8(v0, v1); }
};
struct EpiUp {
    static constexpr bool PERM = true, AFTER_DRAIN = false;
    bf16_t* g; bf16_t* araw; float* out; const float* wcv; const float* bcv;
    __device__ __forceinline__ void operator()(const f32x4 (&acc)[2][2][4][2], const pg8::Unit& u, int wr, int wc, int fr, int fq) const {
        const int c0 = u.pn * 128 + wc * 32 + 8 * fq;
        float w0[8], w1[8], w2[8], bb[8];
        { const f32x4 t0 = *(const f32x4*)(wcv + c0), t1 = *(const f32x4*)(wcv + c0 + 4), t2 = *(const f32x4*)(wcv + DFF + c0), t3 = *(const f32x4*)(wcv + DFF + c0 + 4),
                      t4 = *(const f32x4*)(wcv + 2 * DFF + c0), t5 = *(const f32x4*)(wcv + 2 * DFF + c0 + 4), t6 = *(const f32x4*)(bcv + c0), t7 = *(const f32x4*)(bcv + c0 + 4);
#pragma unroll
          for (int j = 0; j < 4; ++j) { w0[j] = t0[j]; w0[4 + j] = t1[j]; w1[j] = t2[j]; w1[4 + j] = t3[j]; w2[j] = t4[j]; w2[4 + j] = t5[j]; bb[j] = t6[j]; bb[4 + j] = t7[j]; } }
        const int lane = (fq << 4) | fr, src1 = (fq << 4) | ((fr + 15) & 15), src2 = (fq << 4) | ((fr + 14) & 15);
        (void)lane;
#pragma unroll
        for (int ai = 0; ai < 2; ++ai) {
            float p1[8], p2[8];
#pragma unroll
            for (int j = 0; j < 8; ++j) { p1[j] = 0.f; p2[j] = 0.f; }
#pragma unroll
            for (int m = 0; m < 4; ++m) {
                const int row = u.pm * 256 + ai * 128 + wr * 64 + m * 16 + fr;
                float a[8], uu[8], r1[8], r2[8], gq[8];
#pragma unroll
                for (int j = 0; j < 4; ++j) { a[j] = acc[ai][0][m][0][j]; a[4 + j] = acc[ai][0][m][1][j]; uu[j] = acc[ai][1][m][0][j]; uu[4 + j] = acc[ai][1][m][1][j]; }
#pragma unroll
                for (int j = 0; j < 8; ++j) { r1[j] = __shfl(a[j], src1); r2[j] = __shfl(a[j], src2); }
                const bool sample = row >= MP;
                const bool boundary = (m == 0 && fr < 2) || (sample && ((m & 1) == 0) && fr < 2);
                const bool keep_a = boundary || (m == 3 && fr >= 14);
#pragma unroll
                for (int j = 0; j < 8; ++j) {
                    const float am1 = fr >= 1 ? r1[j] : p1[j], am2 = fr >= 2 ? r2[j] : p2[j];
                    const float ac = bb[j] + w0[j] * am2 + w1[j] * am1 + w2[j] * a[j];
                    const float y = 1.5957691216f * (ac + 0.044715f * ac * ac * ac);
                    gq[j] = boundary ? uu[j] : ac * sigm(y) * uu[j];
                    p1[j] = r1[j]; p2[j] = r2[j];
                }
                u32x4 wv; wv.x = pk2(gq[0], gq[1]); wv.y = pk2(gq[2], gq[3]); wv.z = pk2(gq[4], gq[5]); wv.w = pk2(gq[6], gq[7]);
                *(u32x4*)(g + (size_t)row * DFF + c0) = wv;
                if (keep_a) { u32x4 av; av.x = pk2(a[0], a[1]); av.y = pk2(a[2], a[3]); av.z = pk2(a[4], a[5]); av.w = pk2(a[6], a[7]); *(u32x4*)(araw + (size_t)row * DFF + c0) = av; }
                float* o = nullptr;
                if (sample) { const int rs = row - MP, t = rs & 31; if (t >= 30) o = out + O_SFC + (size_t)((rs >> 5) * 2 + t - 30) * DFF + c0; }
                else { const int t = row & 2047; if (t >= 2046) o = out + O_PFC + (size_t)((row >> 11) * 2 + t - 2046) * DFF + c0; }
                if (o) { *(f32x4*)o = acc[ai][0][m][0]; *(f32x4*)(o + 4) = acc[ai][0][m][1]; }
            }
        }
    }
};
struct F9 {
    const bf16_t* pe; const bf16_t* xb; float* y; struct Pre { u32x4 p, x; }; static constexpr int MB = 4;
    __device__ __forceinline__ Pre load(int row, int col) const { const size_t i = (size_t)row * 1024 + col; Pre r; r.p = *(const u32x4*)(pe + i); r.x = *(const u32x4*)(xb + i); return r; }
    __device__ __forceinline__ void operator()(int row, int col, int, f32x4 v0, f32x4 v1, Pre pr) const {
        const size_t i = (size_t)row * 1024 + col; float pf[8], xf[8]; unpk8(pr.p, pf); unpk8(pr.x, xf);
        f32x4 a, b;
#pragma unroll
        for (int j = 0; j < 4; ++j) { a[j] = xf[j] + pf[j] * sigm(v0[j]); b[j] = xf[4 + j] + pf[4 + j] * sigm(v1[j]); }
        *(f32x4*)(y + i) = a; *(f32x4*)(y + i + 4) = b;
    }
};
template <class E> __device__ __forceinline__ void run_gemm_epi(unsigned char* lds, const bf16_t* A, const bf16_t* Bt, int N, int K, const E& e) {
    asm volatile("" : "+s"(K)); asm volatile("" : "+s"(N));
    pg8::Gemm g; g.A = A; g.Bt = Bt; g.M = MT; g.N = N; g.K = K;
    pg8::StaticOrder S; S.init(MT, N, (int)gridDim.x, (int)blockIdx.x);
    pg8::gemm_phase<E, pg8::StaticOrder, false>((PG8_LAS unsigned char*)lds, g, S, e, nullptr);
    __syncthreads();
}
template <class F> __device__ __forceinline__ void run_gemm(unsigned char* lds, const bf16_t* A, const bf16_t* Bt, int N, int K, const F& f) {
    asm volatile("" : "+s"(K)); asm volatile("" : "+s"(N));
    pg8::Gemm g; g.A = A; g.Bt = Bt; g.M = MT; g.N = N; g.K = K;
    pg8::StaticOrder S; S.init(MT, N, (int)gridDim.x, (int)blockIdx.x);
    EpiT<F> E; E.f = f;
    pg8::gemm_phase<EpiT<F>, pg8::StaticOrder, false>((PG8_LAS unsigned char*)lds, g, S, E, nullptr);
    __syncthreads();
}

template <bool ILV = false> __device__ __forceinline__ void transpose_w(const float* W, bf16_t* Bt, int K, int N, const float* gain, float* tile, int& toff) {
    const int nnt = N / 64, ntiles = (K / 64) * nnt, tid = threadIdx.x, G = gridDim.x;
    int first = ((int)blockIdx.x - (toff % G) + G) % G;
    for (int t = first; t < ntiles; t += G) {
        const int kt = t / nnt, nt = t % nnt;
        const int d0 = nt * 64, sc0 = ILV ? (((d0 & 255) < 128) ? (d0 >> 8) * 128 + (d0 & 127) : DFF + (d0 >> 8) * 128 + (d0 & 127)) : d0;
#pragma unroll
        for (int i = 0; i < 8; ++i) { const int r = (tid >> 6) + 8 * i, c = tid & 63; float v = W[(size_t)(kt * 64 + r) * N + sc0 + c]; if (gain) v *= gain[kt * 64 + r]; tile[r * 65 + c] = v; }
        __syncthreads();
        { const int n = tid >> 3, k8 = (tid & 7) * 8; u32x4 wv;
          wv.x = pk2(tile[(k8 + 0) * 65 + n], tile[(k8 + 1) * 65 + n]); wv.y = pk2(tile[(k8 + 2) * 65 + n], tile[(k8 + 3) * 65 + n]);
          wv.z = pk2(tile[(k8 + 4) * 65 + n], tile[(k8 + 5) * 65 + n]); wv.w = pk2(tile[(k8 + 6) * 65 + n], tile[(k8 + 7) * 65 + n]);
          *(u32x4*)(Bt + (size_t)(nt * 64 + n) * K + kt * 64 + k8) = wv; }
        __syncthreads();
    }
    toff += ntiles;
}
__device__ __forceinline__ const float* xrow(const Prm& p, int row) { return row < MP ? p.in[I_XP] + (size_t)row * 1024 : p.in[I_XS] + (size_t)(row - MP) * 1024; }

__device__ __forceinline__ void phase0(const Prm& p, unsigned char* lds) {
    float* tile = (float*)lds; int toff = 0; unsigned char* ws = p.ws;
    transpose_w(p.in[I_WIN], (bf16_t*)(ws + WS_WIN), 1024, NIN, p.in[I_GPM], tile, toff);
    transpose_w<true>(p.in[I_WUP], (bf16_t*)(ws + WS_WUP), 1024, 2 * DFF, p.in[I_GPF], tile, toff);
    transpose_w(p.in[I_WDOWN], (bf16_t*)(ws + WS_WDOWN), DFF, 1024, nullptr, tile, toff);
    transpose_w(p.in[I_WBRA], (bf16_t*)(ws + WS_WBRA), 1024, 1024, nullptr, tile, toff);
    transpose_w(p.in[I_WBRB], (bf16_t*)(ws + WS_WBRB), 1024, 1024, nullptr, tile, toff);
    transpose_w(p.in[I_WOUT], (bf16_t*)(ws + WS_WOUT), 1024, 1024, nullptr, tile, toff);
    transpose_w(p.in[I_WPG], (bf16_t*)(ws + WS_WPG), 1024, 1024, nullptr, tile, toff);
    transpose_w(p.in[I_WPLE], (bf16_t*)(ws + WS_WPLE), 256, 1024, nullptr, tile, toff);
    bf16_t* xn = (bf16_t*)p.out;
    const int lane = threadIdx.x & 63, gw = blockIdx.x * 8 + (threadIdx.x >> 6), nw = gridDim.x * 8;
    for (int row = gw; row < MT; row += nw) {
        const float* xr = xrow(p, row); f32x4 v[4]; float ss = 0.f;
#pragma unroll
        for (int i = 0; i < 4; ++i) { v[i] = *(const f32x4*)(xr + i * 256 + lane * 4); ss += v[i][0] * v[i][0] + v[i][1] * v[i][1] + v[i][2] * v[i][2] + v[i][3] * v[i][3]; }
        ss = wsum(ss); const float rs = rsqrtf(ss * (1.0f / 1024.0f) + EPS);
#pragma unroll
        for (int i = 0; i < 4; ++i) *(u32x2*)(xn + (size_t)row * 1024 + i * 256 + lane * 4) = pk4(v[i] * rs);
    }
}

constexpr int AT_KS = 0, AT_VT = 27648, AT_BT = 53248;
__device__ __forceinline__ void attn_bias_table(const Prm& p, unsigned char* lds) {
    float* bT = (float*)(lds + AT_BT); const float* tab = p.in[I_RB];
    for (int i = threadIdx.x; i < 16 * 256; i += 512) {
        const int head = i >> 8, idx = i & 255, rel = idx - 191, n = rel < 0 ? -rel : rel;
        int bk = n < 8 ? n : min(15, 33 - __clz(n * n)); if (rel > 0) bk += 16;
        bT[i] = idx < 255 ? tab[bk * 16 + head] : 0.f;
    }
}
template <int NKT, int NQT, bool SAMPLE>
__device__ __forceinline__ void attn_item(const Prm& p, unsigned char* lds, int b, int c, int kvh, bf16_t* YA) {
    bf16_t* Ks = (bf16_t*)(lds + AT_KS); bf16_t* Vt = (bf16_t*)(lds + AT_VT); const float* bT = (const float*)(lds + AT_BT);
    const bf16_t* kv = (const bf16_t*)(p.ws + WS_KV); bf16_t* R0 = (bf16_t*)(p.ws + WS_R0);
    const int tid = threadIdx.x, lane = tid & 63, w = tid >> 6, lr = lane & 15, lq = lane >> 4;
    const int head = kvh * 8 + w; const int qrow0 = SAMPLE ? MP + b * 32 : b * 2048 + c * 64;
    const size_t qoff0 = (size_t)(qrow0 + lr) * 1024 + head * 64 + lq * 8;
    bf16x8 qn0 = *(const bf16x8*)(R0 + qoff0), qn1 = *(const bf16x8*)(R0 + qoff0 + 32);
    __syncthreads();
    if (!SAMPLE) {
        const int tok0 = b * 2048 + (c - 2) * 64;
        for (int id = tid; id < 192 * 8; id += 512) {
            const int key = id >> 3, dc = id & 7; u32x4 v = {0u, 0u, 0u, 0u};
            if (c * 64 - 128 + key >= 0) v = *(const u32x4*)(kv + (size_t)(tok0 + key) * 256 + kvh * 64 + dc * 8);
            *(u32x4*)(Ks + key * 72 + dc * 8) = v;
        }
        for (int id = tid; id < 192 * 8; id += 512) {
            const int key = id % 192, dc = id / 192; u32x4 v = {0u, 0u, 0u, 0u};
            if (c * 64 - 128 + key >= 0) v = *(const u32x4*)(kv + (size_t)(tok0 + key) * 256 + 128 + kvh * 64 + dc * 8);
            bf16_t* d = Vt + (dc * 8) * 200 + key;
            d[0] = (bf16_t)(v.x & 0xffffu); d[200] = (bf16_t)(v.x >> 16); d[400] = (bf16_t)(v.y & 0xffffu); d[600] = (bf16_t)(v.y >> 16);
            d[800] = (bf16_t)(v.z & 0xffffu); d[1000] = (bf16_t)(v.z >> 16); d[1200] = (bf16_t)(v.w & 0xffffu); d[1400] = (bf16_t)(v.w >> 16);
        }
    } else {
        const float* ck = p.in[I_CK]; const float* cvp = p.in[I_CV];
        for (int id = tid; id < 160 * 8; id += 512) {
            const int key = id >> 3, dc = id & 7; u32x4 v;
            if (key < 128) { const float* s = ck + (size_t)(b * 128 + key) * 128 + kvh * 64 + dc * 8; v = pk8(*(const f32x4*)s, *(const f32x4*)(s + 4)); }
            else v = *(const u32x4*)(kv + (size_t)(MP + b * 32 + key - 128) * 256 + kvh * 64 + dc * 8);
            *(u32x4*)(Ks + key * 72 + dc * 8) = v;
        }
        for (int id = tid; id < 160 * 8; id += 512) {
            const int key = id % 160, dc = id / 160; u32x4 v;
            if (key < 128) { const float* s = cvp + (size_t)(b * 128 + key) * 128 + kvh * 64 + dc * 8; v = pk8(*(const f32x4*)s, *(const f32x4*)(s + 4)); }
            else v = *(const u32x4*)(kv + (size_t)(MP + b * 32 + key - 128) * 256 + 128 + kvh * 64 + dc * 8);
            bf16_t* d = Vt + (dc * 8) * 200 + key;
            d[0] = (bf16_t)(v.x & 0xffffu); d[200] = (bf16_t)(v.x >> 16); d[400] = (bf16_t)(v.y & 0xffffu); d[600] = (bf16_t)(v.y >> 16);
            d[800] = (bf16_t)(v.z & 0xffffu); d[1000] = (bf16_t)(v.z >> 16); d[1200] = (bf16_t)(v.w & 0xffffu); d[1400] = (bf16_t)(v.w >> 16);
        }
    }
    __syncthreads();
    const float sink = p.in[I_SINK][head];
    const float* bTh = bT + head * 256;
#pragma unroll 1
    for (int qi = 0; qi < NQT; ++qi) {
        const int q = qi * 16 + lr;
        const bf16x8 qf0 = qn0, qf1 = qn1;
        if (qi + 1 < NQT) { qn0 = *(const bf16x8*)(R0 + qoff0 + (size_t)(qi + 1) * 16384); qn1 = *(const bf16x8*)(R0 + qoff0 + (size_t)(qi + 1) * 16384 + 32); }
        f32x4 s[NKT];
#pragma unroll
        for (int kt = 0; kt < NKT; ++kt) {
            const bf16_t* kp = Ks + (kt * 16 + lr) * 72 + lq * 8;
            const bf16x8 k0 = *(const bf16x8*)kp, k1 = *(const bf16x8*)(kp + 32);
            f32x4 a = {0.f, 0.f, 0.f, 0.f}; a = MFMA16(k0, qf0, a); a = MFMA16(k1, qf1, a); s[kt] = a;
        }
        float mx = sink;
#pragma unroll
        for (int kt = 0; kt < NKT; ++kt)
#pragma unroll
            for (int r = 0; r < 4; ++r) {
                const int key = kt * 16 + lq * 4 + r; float v = s[kt][r] * 0.125f + bTh[key - q + 63];
                if (!SAMPLE && (c * 64 - 128 + key < 0)) v = -1e30f;
                s[kt][r] = v; mx = fmaxf(mx, v);
            }
        mx = fmaxf(mx, __shfl_xor(mx, 16)); mx = fmaxf(mx, __shfl_xor(mx, 32));
        float sum = 0.f;
#pragma unroll
        for (int kt = 0; kt < NKT; ++kt)
#pragma unroll
            for (int r = 0; r < 4; ++r) { const float e = __expf(s[kt][r] - mx); s[kt][r] = e; sum += e; }
        sum += __shfl_xor(sum, 16); sum += __shfl_xor(sum, 32);
        const float inv = 1.0f / (sum + __expf(sink - mx));
        f32x4 o[4];
#pragma unroll
        for (int dt = 0; dt < 4; ++dt) o[dt] = (f32x4){0.f, 0.f, 0.f, 0.f};
#pragma unroll
        for (int ks = 0; ks < NKT / 2; ++ks) {
            const u32x4 pw = pk8(s[2 * ks], s[2 * ks + 1]); const bf16x8 pf = __builtin_bit_cast(bf16x8, pw);
#pragma unroll
            for (int dt = 0; dt < 4; ++dt) {
                const bf16_t* vp = Vt + (dt * 16 + lr) * 200 + ks * 32 + lq * 4;
                const u32x2 lo = *(const u32x2*)vp, hi = *(const u32x2*)(vp + 16);
                const u32x4 vw = {lo.x, lo.y, hi.x, hi.y};
                o[dt] = MFMA16(__builtin_bit_cast(bf16x8, vw), pf, o[dt]);
            }
        }
#pragma unroll
        for (int dt = 0; dt < 4; ++dt) *(u32x2*)(YA + (size_t)(qrow0 + q) * 1024 + head * 64 + dt * 16 + lq * 4) = pk4(o[dt] * inv);
    }
}

template <int L, bool SAMPLE>
__device__ __forceinline__ void hgrn_seq(const Prm& p, unsigned char* lds, int b, int h, bf16_t* YB) {
    constexpr int RPG = L / 8, NT = L / 16, NCH = SAMPLE ? 1 : 32, NP = 8 / NT;
    bf16_t* Qd = (bf16_t*)lds; bf16_t* Qm = Qd + 64 * 136; bf16_t* Km = Qm + 64 * 136; bf16_t* KlT = Km + 64 * 136; bf16_t* Vt = KlT + 128 * 72; bf16_t* St = Vt + 128 * 72; bf16_t* Al = St + 128 * 136;
    float* tot = (float*)(Al + 64 * 72); float* first = tot + 1024; float* decay = first + 1024; float* ssq = decay + 128;
    const bf16_t* R1 = (const bf16_t*)(p.ws + WS_R0 + UB); const bf16_t* R2 = (const bf16_t*)(p.ws + WS_R0 + 2 * UB); const bf16_t* R3 = (const bf16_t*)(p.ws + WS_R0 + 3 * UB); const bf16_t* R4 = (const bf16_t*)(p.ws + WS_R0 + 4 * UB);
    const int tid = threadIdx.x, lane = tid & 63, w = tid >> 6, lr = lane & 15, lq = lane >> 4, cp = lane, rg = w, c0 = 2 * cp;
    float lb[2];
#pragma unroll
    for (int c = 0; c < 2; ++c) { const float l0 = p.in[I_LB][h * 128 + c0 + c], l1 = p.in[I_LB][1024 + h * 128 + c0 + c]; lb[c] = 1.0f / (1.0f + __expf(l1 - l0)); }
    f32x4 S[8];
#pragma unroll
    for (int dvt = 0; dvt < 8; ++dvt) {
        if (SAMPLE) {
#pragma unroll
            for (int r = 0; r < 4; ++r) S[dvt][r] = p.in[I_ST][((size_t)(b * 8 + h) * 128 + 16 * w + 4 * lq + r) * 128 + 16 * dvt + lr];
        } else S[dvt] = (f32x4){0.f, 0.f, 0.f, 0.f};
    }
    const int tt = w % NT, dv0 = (w / NT) * NT;
    const int rowbase = SAMPLE ? MP + b * 32 : b * 2048;
    f32x4 ggv[NT];
#pragma unroll
    for (int i = 0; i < NT; ++i) ggv[i] = *(const f32x4*)(p.in[I_GH] + 16 * (dv0 + i) + 4 * lq);
    unsigned qw[RPG], fw[RPG], vw[RPG];
#pragma unroll
    for (int i = 0; i < RPG; ++i) { const size_t idx = (size_t)(rowbase + rg * RPG + i) * 1024 + h * 128 + c0; qw[i] = *(const unsigned*)(R1 + idx); fw[i] = *(const unsigned*)(R2 + idx); vw[i] = *(const unsigned*)(R3 + idx); }
#pragma unroll 1
    for (int ch = 0; ch < NCH; ++ch) {
        const int row0 = rowbase + ch * L;
        float qv[2][RPG], cv[2][RPG], kk[2][RPG]; unsigned vkeep[RPG]; float run[2] = {0.f, 0.f}, lf0[2] = {0.f, 0.f};
#pragma unroll
        for (int i = 0; i < RPG; ++i) {
            vkeep[i] = vw[i];
#pragma unroll
            for (int c = 0; c < 2; ++c) {
                const float q = c ? bfhi(qw[i]) : bflo(qw[i]), fl = c ? bfhi(fw[i]) : bflo(fw[i]);
                const float f = lb[c] + (1.0f - lb[c]) * sigm(fl), lf = __logf(f);
                run[c] += lf; cv[c][i] = run[c]; kk[c][i] = 1.0f - f; qv[c][i] = q * sigm(q); if (i == 0) lf0[c] = lf;
            }
        }
        *(f32x2v*)(tot + rg * 128 + c0) = (f32x2v){run[0], run[1]}; *(f32x2v*)(first + rg * 128 + c0) = (f32x2v){lf0[0], lf0[1]};
        if (ch + 1 < NCH) {
#pragma unroll
            for (int i = 0; i < RPG; ++i) { const size_t idx = (size_t)(row0 + L + rg * RPG + i) * 1024 + h * 128 + c0; qw[i] = *(const unsigned*)(R1 + idx); fw[i] = *(const unsigned*)(R2 + idx); vw[i] = *(const unsigned*)(R3 + idx); }
        }
        const size_t rbase = (size_t)(row0 + tt * 16 + lr) * 1024 + h * 128;
        u32x2 ogw[NT];
#pragma unroll
        for (int i = 0; i < NT; ++i) ogw[i] = *(const u32x2*)(R4 + rbase + 16 * (dv0 + i) + 4 * lq);
        __syncthreads();
        {
            float pre[2] = {0.f, 0.f}, bmid[2], blast[2], emid[2], elm[2];
#pragma unroll
            for (int c = 0; c < 2; ++c) {
                float acc = 0.f, half = 0.f;
#pragma unroll
                for (int j = 0; j < 8; ++j) { const float t = tot[j * 128 + c0 + c]; if (j < rg) pre[c] += t; if (j < 4) half += t; acc += t; }
                bmid[c] = half + first[4 * 128 + c0 + c]; blast[c] = acc; emid[c] = __expf(bmid[c]); elm[c] = __expf(blast[c] - bmid[c]);
            }
            float kl[2][RPG];
#pragma unroll
            for (int i = 0; i < RPG; ++i) {
                const int r = rg * RPG + i; float qd[2], qm[2], km[2];
#pragma unroll
                for (int c = 0; c < 2; ++c) {
                    const float E = __expf(pre[c] + cv[c][i] - bmid[c]), Ei = __builtin_amdgcn_rcpf(E);
                    qm[c] = qv[c][i] * E; qd[c] = qm[c] * emid[c]; km[c] = kk[c][i] * Ei; kl[c][i] = km[c] * elm[c];
                }
                *(unsigned*)(Qd + r * 136 + c0) = pk2(qd[0], qd[1]); *(unsigned*)(Qm + r * 136 + c0) = pk2(qm[0], qm[1]); *(unsigned*)(Km + r * 136 + c0) = pk2(km[0], km[1]);
            }
#pragma unroll
            for (int c = 0; c < 2; ++c) {
#pragma unroll
                for (int i = 0; i < RPG; i += 4) {
                    u32x2 a, v2; a.x = pk2(kl[c][i], kl[c][i + 1]); a.y = pk2(kl[c][i + 2], kl[c][i + 3]);
                    if (c == 0) { v2.x = (vkeep[i] & 0xffffu) | (vkeep[i + 1] << 16); v2.y = (vkeep[i + 2] & 0xffffu) | (vkeep[i + 3] << 16); }
                    else { v2.x = (vkeep[i] >> 16) | (vkeep[i + 1] & 0xffff0000u); v2.y = (vkeep[i + 2] >> 16) | (vkeep[i + 3] & 0xffff0000u); }
                    *(u32x2*)(KlT + (c0 + c) * 72 + rg * RPG + i) = a; *(u32x2*)(Vt + (c0 + c) * 72 + rg * RPG + i) = v2;
                }
            }
            if (rg == 0) *(f32x2v*)(decay + c0) = (f32x2v){__expf(blast[0]), __expf(blast[1])};
        }
#pragma unroll
        for (int dvt = 0; dvt < 8; ++dvt) *(u32x2*)(St + (16 * dvt + lr) * 136 + 16 * w + 4 * lq) = pk4(S[dvt]);
        __syncthreads();
        for (int id = w; id < NT * NT; id += 8) {
            const int st = id / NT, t2 = id % NT; f32x4 acc = {0.f, 0.f, 0.f, 0.f};
#pragma unroll
            for (int ks = 0; ks < 4; ++ks) acc = MFMA16(*(const bf16x8*)(Km + (st * 16 + lr) * 136 + ks * 32 + lq * 8), *(const bf16x8*)(Qm + (t2 * 16 + lr) * 136 + ks * 32 + lq * 8), acc);
            const int t = t2 * 16 + lr;
#pragma unroll
            for (int r = 0; r < 4; ++r) if (st * 16 + 4 * lq + r > t) acc[r] = 0.f;
            *(u32x2*)(Al + t * 72 + st * 16 + 4 * lq) = pk4(acc);
        }
        f32x4 o[NT];
#pragma unroll
        for (int i = 0; i < NT; ++i) {
            f32x4 acc = {0.f, 0.f, 0.f, 0.f};
#pragma unroll
            for (int ks = 0; ks < 4; ++ks) acc = MFMA16(*(const bf16x8*)(St + (16 * (dv0 + i) + lr) * 136 + ks * 32 + lq * 8), *(const bf16x8*)(Qd + (tt * 16 + lr) * 136 + ks * 32 + lq * 8), acc);
            o[i] = acc;
        }
        __syncthreads();
        float sq = 0.f;
#pragma unroll
        for (int i = 0; i < NT; ++i) {
#pragma unroll
            for (int ks = 0; ks < L / 32; ++ks) o[i] = MFMA16(*(const bf16x8*)(Vt + (16 * (dv0 + i) + lr) * 72 + ks * 32 + lq * 8), *(const bf16x8*)(Al + (tt * 16 + lr) * 72 + ks * 32 + lq * 8), o[i]);
            sq += o[i][0] * o[i][0] + o[i][1] * o[i][1] + o[i][2] * o[i][2] + o[i][3] * o[i][3];
        }
        sq += __shfl_xor(sq, 16); sq += __shfl_xor(sq, 32);
        if (lq == 0) ssq[(w / NT) * 64 + tt * 16 + lr] = sq;
        {
            const f32x4 dc = *(const f32x4*)(decay + 16 * w + 4 * lq);
#pragma unroll
            for (int dvt = 0; dvt < 8; ++dvt) {
                f32x4 acc = S[dvt] * dc;
#pragma unroll
                for (int ks = 0; ks < L / 32; ++ks) acc = MFMA16(*(const bf16x8*)(KlT + (16 * w + lr) * 72 + ks * 32 + lq * 8), *(const bf16x8*)(Vt + (16 * dvt + lr) * 72 + ks * 32 + lq * 8), acc);
                S[dvt] = acc;
            }
        }
        __syncthreads();
        {
            float tsq = 0.f;
#pragma unroll
            for (int j = 0; j < NP; ++j) tsq += ssq[j * 64 + tt * 16 + lr];
            const float rs = rsqrtf(tsq * (1.0f / 128.0f) + EPS);
#pragma unroll
            for (int i = 0; i < NT; ++i) {
                const int dvb = 16 * (dv0 + i) + 4 * lq;
                const f32x4 gg = ggv[i];
                const float og0 = bflo(ogw[i].x), og1 = bfhi(ogw[i].x), og2 = bflo(ogw[i].y), og3 = bfhi(ogw[i].y);
                f32x4 y; y[0] = o[i][0] * rs * gg[0] * og0 * sigm(og0); y[1] = o[i][1] * rs * gg[1] * og1 * sigm(og1); y[2] = o[i][2] * rs * gg[2] * og2 * sigm(og2); y[3] = o[i][3] * rs * gg[3] * og3 * sigm(og3);
                *(u32x2*)(YB + rbase + dvb) = pk4(y);
            }
        }
    }
    float* so = p.out + (SAMPLE ? O_SST : O_PST) + (size_t)(b * 8 + h) * 16384;
#pragma unroll
    for (int dvt = 0; dvt < 8; ++dvt)
#pragma unroll
        for (int r = 0; r < 4; ++r) so[(16 * w + 4 * lq + r) * 128 + 16 * dvt + lr] = S[dvt][r];
    __syncthreads();
}

__device__ __forceinline__ void phase_rp5(const Prm& p) {
    const bf16_t* O = (const bf16_t*)(p.ws + WS_R0 + 4 * UB); bf16_t* hf = (bf16_t*)(p.ws + WS_R0); const float* g = p.in[I_GPOST];
    const int lane = threadIdx.x & 63, gw = blockIdx.x * 8 + (threadIdx.x >> 6), nw = gridDim.x * 8;
    for (int row = gw; row < MT; row += nw) {
        const float* xr = xrow(p, row); const bf16_t* orow = O + (size_t)row * 1024; f32x4 v[4], x[4]; float ss = 0.f;
#pragma unroll
        for (int i = 0; i < 4; ++i) { { const u32x2 ow = *(const u32x2*)(orow + i * 256 + lane * 4); v[i] = (f32x4){bflo(ow.x), bfhi(ow.x), bflo(ow.y), bfhi(ow.y)}; } x[i] = *(const f32x4*)(xr + i * 256 + lane * 4); ss += v[i][0] * v[i][0] + v[i][1] * v[i][1] + v[i][2] * v[i][2] + v[i][3] * v[i][3]; }
        ss = wsum(ss); const float rs = rsqrtf(ss * (1.0f / 1024.0f) + EPS); float s2 = 0.f;
#pragma unroll
        for (int i = 0; i < 4; ++i) { const f32x4 gg = *(const f32x4*)(g + i * 256 + lane * 4); x[i] += v[i] * rs * gg; s2 += x[i][0] * x[i][0] + x[i][1] * x[i][1] + x[i][2] * x[i][2] + x[i][3] * x[i][3];
            *(u32x2*)((bf16_t*)p.out + (size_t)row * 1024 + i * 256 + lane * 4) = pk4(x[i]); }
        s2 = wsum(s2); const float r2 = rsqrtf(s2 * (1.0f / 1024.0f) + EPS);
#pragma unroll
        for (int i = 0; i < 4; ++i) *(u32x2*)(hf + (size_t)row * 1024 + i * 256 + lane * 4) = pk4(x[i] * r2);
    }
    bf16_t* pbf = (bf16_t*)(p.ws + WS_KV);
    for (int id = blockIdx.x * 512 + threadIdx.x; id < MT * 32; id += gridDim.x * 512) {
        const int row = id >> 5, c = (id & 31) * 8;
        const float* s = (row < MP ? p.in[I_PP] + (size_t)row * 256 : p.in[I_PS] + (size_t)(row - MP) * 256) + c;
        *(u32x4*)(pbf + (size_t)row * 256 + c) = pk8(*(const f32x4*)s, *(const f32x4*)(s + 4));
    }
}
__device__ __forceinline__ void phase_rp8(const Prm& p) {
    const bf16_t* O = (const bf16_t*)(p.ws + WS_R0 + UB); bf16_t* xb = (bf16_t*)(p.ws + WS_R0 + 3 * UB); const float* g = p.in[I_GPFF];
    const int lane = threadIdx.x & 63, gw = blockIdx.x * 8 + (threadIdx.x >> 6), nw = gridDim.x * 8;
    for (int row = gw; row < MT; row += nw) {
        const bf16_t* xr = (const bf16_t*)p.out + (size_t)row * 1024; const bf16_t* orow = O + (size_t)row * 1024; f32x4 v[4], x[4]; float ss = 0.f;
#pragma unroll
        for (int i = 0; i < 4; ++i) { { const u32x2 ow = *(const u32x2*)(orow + i * 256 + lane * 4); v[i] = (f32x4){bflo(ow.x), bfhi(ow.x), bflo(ow.y), bfhi(ow.y)}; } { const u32x2 xw = *(const u32x2*)(xr + i * 256 + lane * 4); x[i] = (f32x4){bflo(xw.x), bfhi(xw.x), bflo(xw.y), bfhi(xw.y)}; } ss += v[i][0] * v[i][0] + v[i][1] * v[i][1] + v[i][2] * v[i][2] + v[i][3] * v[i][3]; }
        ss = wsum(ss); const float rs = rsqrtf(ss * (1.0f / 1024.0f) + EPS);
#pragma unroll
        for (int i = 0; i < 4; ++i) { const f32x4 gg = *(const f32x4*)(g + i * 256 + lane * 4); x[i] += v[i] * rs * gg;
            *(u32x2*)(xb + (size_t)row * 1024 + i * 256 + lane * 4) = pk4(x[i]); }
    }
}
__device__ __forceinline__ void phase_conv(const Prm& p) {
    const bf16_t* A = (const bf16_t*)(p.ws + WS_R0 + UB); bf16_t* Ug = (bf16_t*)(p.ws + WS_R0 + UB + A_BYTES);
    const float* wc = p.in[I_WCONV]; const float* bc = p.in[I_BCONV]; const float* cc = p.in[I_CC];
    for (int id = blockIdx.x * 512 + threadIdx.x; id < 2112 * 352; id += gridDim.x * 512) {
        const int ri = id / 352, c0 = (id % 352) * 8;
        int row; if (ri < 2048) row = (ri >> 1) * 64 + (ri & 1); else { const int j = ri - 2048; row = MP + (j >> 1) * 32 + (j & 1); }
        float am2[8], am1[8], a[8], u[8], gq[8];
#pragma unroll
        for (int j = 0; j < 8; ++j) { am2[j] = 0.f; am1[j] = 0.f; }
        if (row < MP) {
            const int t = row & 2047;
            if (t >= 1) unpk8(*(const u32x4*)(A + (size_t)(row - 1) * DFF + c0), am1);
            if (t >= 2) unpk8(*(const u32x4*)(A + (size_t)(row - 2) * DFF + c0), am2);
        } else {
            const int rs = row - MP, b = rs >> 5, t = rs & 31;
            if (t == 0) {
#pragma unroll
                for (int j = 0; j < 8; ++j) { am2[j] = cc[(size_t)(b * 2) * DFF + c0 + j]; am1[j] = cc[(size_t)(b * 2 + 1) * DFF + c0 + j]; }
            } else {
#pragma unroll
                for (int j = 0; j < 8; ++j) am2[j] = cc[(size_t)(b * 2 + 1) * DFF + c0 + j];
                unpk8(*(const u32x4*)(A + (size_t)(row - 1) * DFF + c0), am1);
            }
        }
        const size_t off = (size_t)row * DFF + c0;
        unpk8(*(const u32x4*)(A + off), a); unpk8(*(const u32x4*)(Ug + off), u);
#pragma unroll
        for (int j = 0; j < 8; ++j) {
            const float ac = bc[c0 + j] + wc[c0 + j] * am2[j] + wc[DFF + c0 + j] * am1[j] + wc[2 * DFF + c0 + j] * a[j];
            const float y = 1.5957691216f * (ac + 0.044715f * ac * ac * ac);
            gq[j] = ac * sigm(y) * u[j];
        }
        u32x4 wv; wv.x = pk2(gq[0], gq[1]); wv.y = pk2(gq[2], gq[3]); wv.z = pk2(gq[4], gq[5]); wv.w = pk2(gq[6], gq[7]);
        *(u32x4*)(Ug + off) = wv;
    }
}

#ifndef PROBE_DUP
#define PROBE_DUP 0
#endif
#ifndef P2M
#define P2M 15
#endif
#ifndef PHM
#define PHM 0xfff
#endif
__global__ void __launch_bounds__(512, 2) fwd_mega(Prm p, int ph_lo, int ph_hi) {
    extern __shared__ __attribute__((aligned(16))) unsigned char lds[];
    cg::grid_group grid = cg::this_grid();
    unsigned char* ws = p.ws;
    bf16_t* R0 = (bf16_t*)(ws + WS_R0);
#define REG(i) ((bf16_t*)(ws + WS_R0 + (size_t)(i) * UB))
#define PH_BEGIN(n) if (ph_lo <= (n) && (n) < ph_hi) { if ((n) > ph_lo) grid.sync();
#define PH_END }
#if (PHM >> 0) & 1
        PH_BEGIN(0) phase0(p, lds);
#if PROBE_DUP == 1
        grid.sync(); phase0(p, lds);
#endif
        PH_END
#else
#endif
#if (PHM >> 1) & 1
        PH_BEGIN(1) { F1 f; f.r0 = R0; f.kv = (bf16_t*)(ws + WS_KV); f.out = p.out; run_gemm(lds, (const bf16_t*)p.out, (const bf16_t*)(ws + WS_WIN), NIN, 1024, f);
#if PROBE_DUP == 3
            grid.sync(); run_gemm(lds, (const bf16_t*)p.out, (const bf16_t*)(ws + WS_WIN), NIN, 1024, f);
#endif
        } PH_END
#else
#endif
#if (PHM >> 2) & 1
        PH_BEGIN(2) {
#if PROBE_DUP == 2
            { bf16_t* YA = (bf16_t*)p.out; bf16_t* YB = (bf16_t*)p.out + UB / 2;
            const int G = gridDim.x;
#if P2M & 1
#pragma unroll 1
            for (int s = blockIdx.x; s < 256; s += G) hgrn_seq<64, false>(p, lds, s >> 3, s & 7, YB);
#endif
#if P2M & 2
#pragma unroll 1
            for (int s = blockIdx.x; s < 256; s += G) hgrn_seq<32, true>(p, lds, s >> 3, s & 7, YB);
#endif
            __syncthreads(); attn_bias_table(p, lds); __syncthreads();
#if P2M & 4
#pragma unroll 1
            for (int it = blockIdx.x; it < 2048; it += G) attn_item<12, 4, false>(p, lds, it >> 6, (it >> 1) & 31, it & 1, YA);
#endif
#if P2M & 8
#pragma unroll 1
            for (int it = blockIdx.x; it < 64; it += G) attn_item<10, 2, true>(p, lds, it >> 1, 0, it & 1, YA);
#endif
            __syncthreads(); }
#endif
            { bf16_t* YA = REG(0); bf16_t* YB = REG(1);
            const int G = gridDim.x;
#if P2M & 1
#pragma unroll 1
            for (int s = blockIdx.x; s < 256; s += G) hgrn_seq<64, false>(p, lds, s >> 3, s & 7, YB);
#endif
#if P2M & 2
#pragma unroll 1
            for (int s = blockIdx.x; s < 256; s += G) hgrn_seq<32, true>(p, lds, s >> 3, s & 7, YB);
#endif
            __syncthreads(); attn_bias_table(p, lds); __syncthreads();
#if P2M & 4
#pragma unroll 1
            for (int it = blockIdx.x; it < 2048; it += G) attn_item<12, 4, false>(p, lds, it >> 6, (it >> 1) & 31, it & 1, YA);
#endif
#if P2M & 8
#pragma unroll 1
            for (int it = blockIdx.x; it < 64; it += G) attn_item<10, 2, true>(p, lds, it >> 1, 0, it & 1, YA);
#endif
            }
        } PH_END
#else
#endif
#if (PHM >> 3) & 1
        PH_BEGIN(3) { F2 f; f.g = REG(5); f.o = REG(2); run_gemm(lds, REG(0), (const bf16_t*)(ws + WS_WBRA), 1024, 1024, f);
#if PROBE_DUP == 4
            grid.sync(); run_gemm(lds, REG(0), (const bf16_t*)(ws + WS_WBRA), 1024, 1024, f);
#endif
        } PH_END
#else
#endif
#if (PHM >> 4) & 1
        PH_BEGIN(4) { F3 f; f.g = REG(6); f.t = REG(2); f.o = REG(3); run_gemm(lds, REG(1), (const bf16_t*)(ws + WS_WBRB), 1024, 1024, f); } PH_END
#else
#endif
#if (PHM >> 5) & 1
        PH_BEGIN(5) { FBF f; f.o = REG(4); run_gemm(lds, REG(3), (const bf16_t*)(ws + WS_WOUT), 1024, 1024, f);
#if PROBE_DUP == 5
            grid.sync(); run_gemm(lds, REG(3), (const bf16_t*)(ws + WS_WOUT), 1024, 1024, f);
#endif
        } PH_END
#else
#endif
#if (PHM >> 6) & 1
        PH_BEGIN(6) phase_rp5(p); PH_END
#else
#endif
#if (PHM >> 7) & 1
        PH_BEGIN(7) { EpiUp e; e.g = (bf16_t*)(ws + WS_R0 + UB + A_BYTES); e.araw = REG(1); e.out = p.out; e.wcv = p.in[I_WCONV]; e.bcv = p.in[I_BCONV]; run_gemm_epi(lds, REG(0), (const bf16_t*)(ws + WS_WUP), 2 * DFF, 1024, e); } PH_END
#else
#endif
#if (PHM >> 8) & 1
        PH_BEGIN(8) phase_conv(p); PH_END
#else
#endif
        PH_BEGIN(9) { FBF f; f.o = REG(1); run_gemm(lds, (const bf16_t*)(ws + WS_R0 + UB + A_BYTES), (const bf16_t*)(ws + WS_WDOWN), 1024, DFF, f);
                  FBF f2; f2.o = REG(0); run_gemm(lds, (const bf16_t*)(ws + WS_KV), (const bf16_t*)(ws + WS_WPLE), 1024, 256, f2); } PH_END
#if (PHM >> 10) & 1
        PH_BEGIN(10) phase_rp8(p); PH_END
#else
#endif
#if (PHM >> 11) & 1
        PH_BEGIN(11) { F9 f; f.pe = REG(0); f.xb = REG(3); f.y = p.out; run_gemm(lds, REG(3), (const bf16_t*)(ws + WS_WPG), 1024, 1024, f); } PH_END
#else
#endif
#undef REG
}

extern "C" void kernel_launch(void* const* d_in, const int* in_sizes, int n_in, void* d_out, int out_size, void* d_ws, size_t ws_size, hipStream_t stream) {
    static int grid = 0;
    if (grid == 0) {
        if (n_in != 26 || (size_t)out_size != O_END || ws_size < WS_END) { fprintf(stderr, "kernel_launch: unexpected shapes n_in %d out %d ws %zu (need %zu)\n", n_in, out_size, ws_size, (size_t)WS_END); grid = -1; return; }
        int dev = 0, cus = 0, per_cu = 0;
        hipGetDevice(&dev); hipDeviceGetAttribute(&cus, hipDeviceAttributeMultiprocessorCount, dev);
        if (hipFuncSetAttribute((const void*)fwd_mega, hipFuncAttributeMaxDynamicSharedMemorySize, LDS_BYTES) != hipSuccess) { fprintf(stderr, "kernel_launch: hipFuncSetAttribute failed\n"); grid = -1; return; }
        if (hipOccupancyMaxActiveBlocksPerMultiprocessor(&per_cu, (const void*)fwd_mega, 512, LDS_BYTES) != hipSuccess || per_cu < 1) { fprintf(stderr, "kernel_launch: occupancy query says %d\n", per_cu); per_cu = 1; }
        (void)hipGetLastError();
        grid = cus;
    }
    if (grid < 0) return;
    Prm p{};
    for (int i = 0; i < 26; ++i) p.in[i] = (const float*)d_in[i];
    p.out = (float*)d_out; p.ws = (unsigned char*)d_ws;
    int lo = 0, hi = 12;
    void* args[] = {&p, &lo, &hi};
    hipError_t e = hipLaunchCooperativeKernel((const void*)fwd_mega, dim3(grid), dim3(512), args, LDS_BYTES, stream);
    if (e != hipSuccess) fprintf(stderr, "kernel_launch: cooperative launch failed: %s (grid %d)\n", hipGetErrorString(e), grid);
}
```

```cpp
#include <hip/hip_runtime.h>
#include <hip/hip_cooperative_groups.h>
#include <cstdio>
namespace cg = cooperative_groups;
namespace pg8 {
#define PG8_LAS __attribute__((address_space(3)))
typedef unsigned short bf16_t;
typedef short bf16x8 __attribute__((ext_vector_type(8)));
typedef float f32x4 __attribute__((ext_vector_type(4)));
typedef unsigned u32x4 __attribute__((ext_vector_type(4)));
constexpr int BM = 256, BK = 64, HALF = 128, HTB = HALF * BK * 2  , STAGE_BYTES = 8 * HTB, NXCD = 8, WGM = 8;

__host__ __device__ __forceinline__ int lds_byte(int r, int c) { const int st = (r >> 4) * 2 + (c >> 5), rr = r & 15, cc = c & 31, ob = rr * 64 + cc * 2; return st * 1024 + (ob ^ (((ob >> 9) & 1) << 5)); }
__host__ __device__ __forceinline__ void stage_rc(int b, int& R, int& C) { const int st = b / 1024, sb = b % 1024, swz = sb ^ (((sb >> 9) & 1) << 5); R = (st >> 1) * 16 + swz / 64; C = (st & 1) * 32 + (swz % 64) / 2; }
__host__ __device__ __forceinline__ int perm32(int rho) { const int n = rho >> 4, i = rho & 15; return 8 * (i >> 2) + 4 * n + (i & 3); }

struct Unit { int pm, pn; };
struct Gemm { const bf16_t* A; const bf16_t* Bt; int M, N, K; };

struct StaticOrder {
    int nM, nN, nwg, G, c;
    __host__ __device__ void init(int M, int N, int G_, int c_) { nM = M / BM; nN = N / BM; nwg = nM * nN; G = G_; c = c_; }
    __host__ __device__ bool next(int i, Unit& u) const {
        const long L = (long)i * G + c; if (L >= nwg) return false;
        int wgid = (int)L; { const int q = nwg / NXCD, r = nwg % NXCD, xcd = wgid % NXCD, off = wgid / NXCD; wgid = (xcd < r ? xcd * (q + 1) : r * (q + 1) + (xcd - r) * q) + off; }
        const int nig = WGM * nN, gid = wgid / nig, fm = gid * WGM, gsz = (nM - fm) < WGM ? (nM - fm) : WGM;
        u.pm = fm + ((wgid % nig) % gsz); u.pn = (wgid % nig) / gsz; return true;
    }
    __device__ __forceinline__ void a_ready(const Unit&) const {}
    __device__ __forceinline__ void done(const Unit&) const {}
};
__device__ __forceinline__ unsigned cvt_pk_bf16(float lo, float hi) { unsigned r; asm volatile("v_cvt_pk_bf16_f32 %0, %1, %2" : "=v"(r) : "v"(lo), "v"(hi)); return r; }
template <class Epi, class Sched, bool STAMP = false>
__device__ __forceinline__ void gemm_phase(PG8_LAS unsigned char* lds, const Gemm g, const Sched& S, const Epi& E, unsigned long long* stamps) {
    const int tid = threadIdx.x, wid = __builtin_amdgcn_readfirstlane(tid >> 6), lane = tid & 63, wr = wid >> 2, wc = wid & 3, fr = lane & 15, fq = lane >> 4;
    const int K = g.K, nt = K / BK;
    int ts_lo = 0, ts_hi = 0, nts = 0; const unsigned long long rt_entry = STAMP ? (unsigned long long)wall_clock64() : 0ull;
#define PG8_STAMP() do { if (STAMP && wid == 0 && nts < 64) { const unsigned long long _c = (unsigned long long)clock64(); \
        ts_lo = (lane == nts) ? (int)(unsigned)_c : ts_lo; ts_hi = (lane == nts) ? (int)(unsigned)(_c >> 32) : ts_hi; ++nts; } } while (0)
    PG8_STAMP();
    unsigned voffA[2], voffB[2];
#pragma unroll
    for (int i = 0; i < 2; ++i) { int R, C; stage_rc(tid * 16 + i * 8192, R, C); const int Rb = Epi::PERM ? ((R & ~31) + perm32(R & 31)) : R;
        voffA[i] = (unsigned)(R * K + C) * 2u; voffB[i] = (unsigned)(Rb * K + C) * 2u; }
    const size_t kstep = (size_t)(BK * 2);
    const size_t hstep = (size_t)HALF * K * 2;
    const size_t tstep = 2 * hstep;
    const unsigned ldsw = (unsigned)wid * 1024u;
    const int aoff = lds_byte(wr * 64 + fr, fq * 8), boff = lds_byte(wc * 32 + fr, fq * 8);
#define PG8_SA(b, h) (((b) * 2 + (h)) * HTB)
#define PG8_SB(b, h) ((4 + (b) * 2 + (h)) * HTB)
#define PG8_STAGE(bufoff, gbase, voff) do { _Pragma("unroll") for (int _i = 0; _i < 2; ++_i) \
        __builtin_amdgcn_global_load_lds((const unsigned*)((const char*)(gbase) + (voff)[_i]), (PG8_LAS unsigned*)(lds + (bufoff) + ldsw + _i * 8192), 16, 0, 0); } while (0)
#define PG8_LDA(dst, b, h) do { _Pragma("unroll") for (int m = 0; m < 4; ++m) _Pragma("unroll") for (int k = 0; k < 2; ++k) dst[m][k] = *(const PG8_LAS bf16x8*)(lds + PG8_SA(b, h) + aoff + m * 2048 + k * 1024); } while (0)
#define PG8_LDB(dst, b, h) do { _Pragma("unroll") for (int n = 0; n < 2; ++n) _Pragma("unroll") for (int k = 0; k < 2; ++k) dst[n][k] = *(const PG8_LAS bf16x8*)(lds + PG8_SB(b, h) + boff + n * 2048 + k * 1024); } while (0)
#define PG8_MMA(ai, bj, At, Bt) do { __builtin_amdgcn_s_setprio(1); _Pragma("unroll") for (int m = 0; m < 4; ++m) _Pragma("unroll") for (int n = 0; n < 2; ++n) _Pragma("unroll") for (int k = 0; k < 2; ++k) \
        acc[ai][bj][m][n] = __builtin_amdgcn_mfma_f32_16x16x32_bf16(Bt[n][k], At[m][k], acc[ai][bj][m][n], 0, 0, 0); __builtin_amdgcn_s_setprio(0); } while (0)
#define PG8_WAIT_V(n) asm volatile("s_waitcnt vmcnt(" #n ")" ::: "memory")
#define PG8_WAIT_L(n) asm volatile("s_waitcnt lgkmcnt(" #n ")" ::: "memory")
#define PG8_BAR __builtin_amdgcn_s_barrier()
#define PG8_SCHED __builtin_amdgcn_sched_barrier(0)
    Unit cur, nxt; int ui = 0;
    if (!S.next(0, cur)) return;
    f32x4 acc[2][2][4][2];
#pragma unroll
    for (int a = 0; a < 2; ++a)
#pragma unroll
        for (int b = 0; b < 2; ++b)
#pragma unroll
            for (int m = 0; m < 4; ++m)
#pragma unroll
                for (int n = 0; n < 2; ++n) acc[a][b][m][n] = (f32x4){0.f, 0.f, 0.f, 0.f};
    bf16x8 At[4][2], B0[2][2], B1[2][2];
    const char* cA = (const char*)g.A + (size_t)cur.pm * tstep; const char* cB = (const char*)g.Bt + (size_t)cur.pn * tstep;
    S.a_ready(cur);
    PG8_STAGE(PG8_SB(0, 0), cB, voffB); PG8_STAGE(PG8_SA(0, 0), cA, voffA); PG8_STAGE(PG8_SB(0, 1), cB + hstep, voffB); PG8_STAGE(PG8_SA(0, 1), cA + hstep, voffA);
    if (wr == 1) PG8_BAR;
    PG8_WAIT_V(4); PG8_BAR;
    PG8_STAGE(PG8_SB(1, 0), cB + kstep, voffB); PG8_STAGE(PG8_SA(1, 0), cA + kstep, voffA); PG8_STAGE(PG8_SB(1, 1), cB + hstep + kstep, voffB);
    PG8_WAIT_V(6); PG8_BAR;
    PG8_STAMP();
    for (;;) {
        const bool has_next = S.next(ui + 1, nxt);
        const char* nA = has_next ? (const char*)g.A + (size_t)nxt.pm * tstep : cA; const char* nB = has_next ? (const char*)g.Bt + (size_t)nxt.pn * tstep : cB;
        for (int t = 0; t < nt; t += 2) {
            const bool last = (t == nt - 2);
            const char* a1 = cA + (size_t)(t + 1) * kstep;
            const char* a2 = last ? nA : cA + (size_t)(t + 2) * kstep; const char* b2 = last ? nB : cB + (size_t)(t + 2) * kstep;
            const char* a3 = a2 + kstep; const char* b3 = b2 + kstep;
            if (last && has_next) S.a_ready(nxt);
            PG8_LDB(B0, 0, 0); PG8_SCHED; PG8_LDA(At, 0, 0); PG8_STAGE(PG8_SA(1, 1), a1 + hstep, voffA);
            PG8_WAIT_L(8); PG8_BAR; PG8_WAIT_L(0); PG8_MMA(0, 0, At, B0); PG8_BAR; PG8_SCHED;
            PG8_LDB(B1, 0, 1); PG8_STAGE(PG8_SB(0, 0), b2, voffB);
            PG8_BAR; PG8_WAIT_L(0); PG8_MMA(0, 1, At, B1); PG8_BAR;
            PG8_LDA(At, 0, 1); PG8_STAGE(PG8_SA(0, 0), a2, voffA);
            PG8_BAR; PG8_WAIT_L(0); PG8_MMA(1, 0, At, B0); PG8_BAR; PG8_SCHED;
            PG8_STAGE(PG8_SB(0, 1), b2 + hstep, voffB);
            PG8_WAIT_V(6); PG8_BAR; PG8_MMA(1, 1, At, B1); PG8_BAR;
            PG8_LDB(B0, 1, 0); PG8_SCHED; PG8_LDA(At, 1, 0); PG8_STAGE(PG8_SA(0, 1), a2 + hstep, voffA);
            PG8_WAIT_L(8); PG8_BAR; PG8_WAIT_L(0); PG8_MMA(0, 0, At, B0); PG8_BAR; PG8_SCHED;
            PG8_LDB(B1, 1, 1); PG8_STAGE(PG8_SB(1, 0), b3, voffB);
            PG8_BAR; PG8_WAIT_L(0); PG8_MMA(0, 1, At, B1); PG8_BAR;
            PG8_LDA(At, 1, 1); PG8_STAGE(PG8_SA(1, 0), a3, voffA);
            PG8_BAR; PG8_WAIT_L(0); PG8_MMA(1, 0, At, B0); PG8_BAR; PG8_SCHED;
            PG8_STAGE(PG8_SB(1, 1), b3 + hstep, voffB);
            PG8_WAIT_V(6); PG8_BAR; PG8_MMA(1, 1, At, B1); PG8_BAR;
        }
        PG8_STAMP();
        if constexpr (!Epi::AFTER_DRAIN) { E(acc, cur, wr, wc, fr, fq); S.done(cur); }
        PG8_STAMP();
        if (!has_next) break;
#pragma unroll
        for (int a = 0; a < 2; ++a)
#pragma unroll
            for (int b = 0; b < 2; ++b)
#pragma unroll
                for (int m = 0; m < 4; ++m)
#pragma unroll
                    for (int n = 0; n < 2; ++n) acc[a][b][m][n] = (f32x4){0.f, 0.f, 0.f, 0.f};
        cur = nxt; cA = nA; cB = nB; ++ui;
    }
    PG8_WAIT_V(0);
    if (wr == 0) PG8_BAR;
    PG8_BAR;
    if constexpr (Epi::AFTER_DRAIN) { E.fused(acc, cur, wr, wc, fr, fq, lds, wid, lane); S.done(cur); }
    PG8_STAMP();
    if (STAMP && wid == 0) { stamps[lane] = lane < nts ? (((unsigned long long)(unsigned)ts_hi << 32) | (unsigned)ts_lo) : 0ull;
        if (lane == 62) stamps[62] = rt_entry; if (lane == 63) stamps[63] = (unsigned long long)wall_clock64(); }
#undef PG8_STAMP
#undef PG8_SA
#undef PG8_SB
#undef PG8_STAGE
#undef PG8_LDA
#undef PG8_LDB
#undef PG8_MMA
#undef PG8_WAIT_V
#undef PG8_WAIT_L
#undef PG8_BAR
#undef PG8_SCHED
}
}


using pg8::bf16_t; using pg8::bf16x8; using pg8::f32x4; using pg8::u32x4;
typedef unsigned u32x2 __attribute__((ext_vector_type(2)));
typedef float f32x2v __attribute__((ext_vector_type(2)));
#define MFMA16(a, b, c) __builtin_amdgcn_mfma_f32_16x16x32_bf16((a), (b), (c), 0, 0, 0)

constexpr int MP = 65536, MS = 1024, MT = MP + MS, DM = 1024, DFF = 2816, NIN = 7424;
constexpr float EPS = 1e-6f;
constexpr size_t UB = (size_t)MT * 1024 * 2;
constexpr size_t WS_WIN = 0, WS_WBRA = WS_WIN + (size_t)NIN * 1024 * 2, WS_WBRB = WS_WBRA + 2097152, WS_WOUT = WS_WBRB + 2097152, WS_WPG = WS_WOUT + 2097152,
                 WS_WUP = WS_WPG + 2097152, WS_WDOWN = WS_WUP + (size_t)2 * DFF * 1024 * 2, WS_WPLE = WS_WDOWN + (size_t)1024 * DFF * 2, WS_KV = WS_WPLE + (size_t)1024 * 256 * 2,
                 WS_R0 = WS_KV + (size_t)MT * 256 * 2, WS_END = WS_R0 + 7 * UB;
constexpr size_t A_BYTES = (size_t)MT * DFF * 2;
constexpr size_t O_Y = 0, O_PWK = (size_t)MT * 1024, O_PWV = O_PWK + 524288, O_PST = O_PWV + 524288, O_PFC = O_PST + 4194304, O_SWK = O_PFC + 180224, O_SWV = O_SWK + 131072,
                 O_SST = O_SWV + 131072, O_SFC = O_SST + 4194304, O_END = O_SFC + 180224;
constexpr int LDS_BYTES = 147456;

struct Prm { const float* in[26]; float* out; unsigned char* ws; };
enum { I_XP = 0, I_XS, I_CK, I_CV, I_ST, I_CC, I_PP, I_PS, I_RB, I_LB, I_GPM, I_WIN, I_SINK, I_GH, I_WBRA, I_WBRB, I_WOUT, I_GPOST, I_GPF, I_WUP, I_WCONV, I_BCONV, I_WDOWN, I_GPFF, I_WPLE, I_WPG };

__device__ __forceinline__ unsigned pk2(float lo, float hi) { unsigned r; asm("v_cvt_pk_bf16_f32 %0, %1, %2" : "=v"(r) : "v"(lo), "v"(hi)); return r; }
__device__ __forceinline__ float bflo(unsigned w) { return __uint_as_float(w << 16); }
__device__ __forceinline__ float bfhi(unsigned w) { return __uint_as_float(w & 0xffff0000u); }
__device__ __forceinline__ float bf1(bf16_t b) { return __uint_as_float(((unsigned)b) << 16); }
__device__ __forceinline__ bf16_t f2bf(float f) { return (bf16_t)(pk2(f, 0.f) & 0xffffu); }
__device__ __forceinline__ float sigm(float x) { return __builtin_amdgcn_rcpf(1.0f + __expf(-x)); }
__device__ __forceinline__ float wsum(float v) { v += __shfl_xor(v, 32); v += __shfl_xor(v, 16); v += __shfl_xor(v, 8); v += __shfl_xor(v, 4); v += __shfl_xor(v, 2); v += __shfl_xor(v, 1); return v; }
__device__ __forceinline__ u32x4 pk8(f32x4 a, f32x4 b) { u32x4 w; w.x = pk2(a[0], a[1]); w.y = pk2(a[2], a[3]); w.z = pk2(b[0], b[1]); w.w = pk2(b[2], b[3]); return w; }
__device__ __forceinline__ u32x2 pk4(f32x4 a) { u32x2 w; w.x = pk2(a[0], a[1]); w.y = pk2(a[2], a[3]); return w; }
__device__ __forceinline__ void unpk8(u32x4 w, float (&f)[8]) { f[0] = bflo(w.x); f[1] = bfhi(w.x); f[2] = bflo(w.y); f[3] = bfhi(w.y); f[4] = bflo(w.z); f[5] = bfhi(w.z); f[6] = bflo(w.w); f[7] = bfhi(w.w); }

struct NoPre {};
template <class F> struct EpiT {
    static constexpr bool PERM = true, AFTER_DRAIN = false; F f;
    __device__ __forceinline__ void operator()(const f32x4 (&acc)[2][2][4][2], const pg8::Unit& u, int wr, int wc, int fr, int fq) const {
        const int row0 = u.pm * 256 + wr * 64 + fr, col0 = u.pn * 256 + wc * 32 + 8 * fq;
        constexpr int MB = F::MB;
#pragma unroll
        for (int a0 = 0; a0 < 8; a0 += MB) {
            typename F::Pre pre[MB][2];
#pragma unroll
            for (int mm = 0; mm < MB; ++mm)
#pragma unroll
                for (int bj = 0; bj < 2; ++bj) pre[mm][bj] = f.load(row0 + ((a0 + mm) >> 2) * 128 + ((a0 + mm) & 3) * 16, col0 + bj * 128);
#pragma unroll
            for (int mm = 0; mm < MB; ++mm)
#pragma unroll
                for (int bj = 0; bj < 2; ++bj) f(row0 + ((a0 + mm) >> 2) * 128 + ((a0 + mm) & 3) * 16, col0 + bj * 128, u.pn, acc[(a0 + mm) >> 2][bj][(a0 + mm) & 3][0], acc[(a0 + mm) >> 2][bj][(a0 + mm) & 3][1], pre[mm][bj]);
        }
    }
};
struct F1 {
    bf16_t* r0; bf16_t* kv; float* out; typedef NoPre Pre; static constexpr int MB = 1;
    __device__ __forceinline__ NoPre load(int, int) const { return NoPre(); }
    __device__ __forceinline__ void operator()(int row, int col, int pn, f32x4 v0, f32x4 v1, NoPre) const {
        const u32x4 w = pk8(v0, v1);
        if (pn < 4) { __builtin_nontemporal_store(w, (u32x4*)(r0 + (size_t)row * 1024 + col)); }
        else if (pn == 4) {
            const int c = col - 1024; *(u32x4*)(kv + (size_t)row * 256 + c) = w;
            float* o = nullptr;
            if (row >= MP) { o = out + (c < 128 ? O_SWK : O_SWV) + (size_t)(row - MP) * 128 + (c & 127); }
            else { const int t = row & 2047; if (t >= 1920) o = out + (c < 128 ? O_PWK : O_PWV) + (size_t)((row >> 11) * 128 + t - 1920) * 128 + (c & 127); }
            if (o) { *(f32x4*)o = v0; *(f32x4*)(o + 4) = v1; }
        } else { const int c2 = col - 1280, seg = c2 >> 10; __builtin_nontemporal_store(w, (u32x4*)(r0 + (size_t)(1 + seg) * (UB / 2) + (size_t)row * 1024 + (c2 & 1023))); }
    }
};
struct F2 {
    const bf16_t* g; bf16_t* o; typedef u32x4 Pre; static constexpr int MB = 8;
    __device__ __forceinline__ u32x4 load(int row, int col) const { return *(const u32x4*)(g + (size_t)row * 1024 + col); }
    __device__ __forceinline__ void operator()(int row, int col, int, f32x4 v0, f32x4 v1, u32x4 gw) const {
        const size_t i = (size_t)row * 1024 + col; float gf[8]; unpk8(gw, gf);
        f32x4 a, b;
#pragma unroll
        for (int j = 0; j < 4; ++j) { a[j] = v0[j] * sigm(gf[j]); b[j] = v1[j] * sigm(gf[4 + j]); }
        *(u32x4*)(o + i) = pk8(a, b);
    }
};
struct F3 {
    const bf16_t* g; const bf16_t* t; bf16_t* o; struct Pre { u32x4 g, t; }; static constexpr int MB = 4;
    __device__ __forceinline__ Pre load(int row, int col) const { const size_t i = (size_t)row * 1024 + col; Pre r; r.g = *(const u32x4*)(g + i); r.t = *(const u32x4*)(t + i); return r; }
    __device__ __forceinline__ void operator()(int row, int col, int, f32x4 v0, f32x4 v1, Pre pr) const {
        const size_t i = (size_t)row * 1024 + col; float gf[8], tf[8]; unpk8(pr.g, gf); unpk8(pr.t, tf);
        f32x4 a, b;
#pragma unroll
        for (int j = 0; j < 4; ++j) { a[j] = tf[j] + v0[j] * sigm(gf[j]); b[j] = tf[4 + j] + v1[j] * sigm(gf[4 + j]); }
        *(u32x4*)(o + i) = pk8(a, b);
    }
};
struct FF32 {
    float* o; typedef NoPre Pre; static constexpr int MB = 1;
    __device__ __forceinline__ NoPre load(int, int) const { return NoPre(); }
    __device__ __forceinline__ void operator()(int row, int col, int, f32x4 v0, f32x4 v1, NoPre) const { float* d = o + (size_t)row * 1024 + col; *(f32x4*)d = v0; *(f32x4*)(d + 4) = v1; }
};
struct FBF {
    bf16_t* o; typedef NoPre Pre; static constexpr int MB = 1;
    __device__ __forceinline__ NoPre load(int, int) const { return NoPre(); }
    __device__ __forceinline__ void operator()(int row, int col, int, f32x4 v0, f32x4 v1, NoPre) const { *(u32x4*)(o + (size_t)row * 1024 + col) = pk8(v0, v1); }
};
struct EpiUp {
    static constexpr bool PERM = true, AFTER_DRAIN = false;
    bf16_t* g; bf16_t* araw; float* out; const float* wcv; const float* bcv;
    __device__ __forceinline__ void operator()(const f32x4 (&acc)[2][2][4][2], const pg8::Unit& u, int wr, int wc, int fr, int fq) const {
        const int c0 = u.pn * 128 + wc * 32 + 8 * fq;
        float w0[8], w1[8], w2[8], bb[8];
        { const f32x4 t0 = *(const f32x4*)(wcv + c0), t1 = *(const f32x4*)(wcv + c0 + 4), t2 = *(const f32x4*)(wcv + DFF + c0), t3 = *(const f32x4*)(wcv + DFF + c0 + 4),
                      t4 = *(const f32x4*)(wcv + 2 * DFF + c0), t5 = *(const f32x4*)(wcv + 2 * DFF + c0 + 4), t6 = *(const f32x4*)(bcv + c0), t7 = *(const f32x4*)(bcv + c0 + 4);
#pragma unroll
          for (int j = 0; j < 4; ++j) { w0[j] = t0[j]; w0[4 + j] = t1[j]; w1[j] = t2[j]; w1[4 + j] = t3[j]; w2[j] = t4[j]; w2[4 + j] = t5[j]; bb[j] = t6[j]; bb[4 + j] = t7[j]; } }
        const int lane = (fq << 4) | fr, src1 = (fq << 4) | ((fr + 15) & 15), src2 = (fq << 4) | ((fr + 14) & 15);
        (void)lane;
#pragma unroll
        for (int ai = 0; ai < 2; ++ai) {
            float p1[8], p2[8];
#pragma unroll
            for (int j = 0; j < 8; ++j) { p1[j] = 0.f; p2[j] = 0.f; }
#pragma unroll
            for (int m = 0; m < 4; ++m) {
                const int row = u.pm * 256 + ai * 128 + wr * 64 + m * 16 + fr;
                float a[8], uu[8], r1[8], r2[8], gq[8];
#pragma unroll
                for (int j = 0; j < 4; ++j) { a[j] = acc[ai][0][m][0][j]; a[4 + j] = acc[ai][0][m][1][j]; uu[j] = acc[ai][1][m][0][j]; uu[4 + j] = acc[ai][1][m][1][j]; }
#pragma unroll
                for (int j = 0; j < 8; ++j) { r1[j] = __shfl(a[j], src1); r2[j] = __shfl(a[j], src2); }
                const bool sample = row >= MP;
                const bool boundary = (m == 0 && fr < 2) || (sample && ((m & 1) == 0) && fr < 2);
                const bool keep_a = boundary || (m == 3 && fr >= 14);
#pragma unroll
                for (int j = 0; j < 8; ++j) {
                    const float am1 = fr >= 1 ? r1[j] : p1[j], am2 = fr >= 2 ? r2[j] : p2[j];
                    const float ac = bb[j] + w0[j] * am2 + w1[j] * am1 + w2[j] * a[j];
                    const float y = 1.5957691216f * (ac + 0.044715f * ac * ac * ac);
                    gq[j] = boundary ? uu[j] : ac * sigm(y) * uu[j];
                    p1[j] = r1[j]; p2[j] = r2[j];
                }
                u32x4 wv; wv.x = pk2(gq[0], gq[1]); wv.y = pk2(gq[2], gq[3]); wv.z = pk2(gq[4], gq[5]); wv.w = pk2(gq[6], gq[7]);
                __builtin_nontemporal_store(wv, (u32x4*)(g + (size_t)row * DFF + c0));
                if (keep_a) { u32x4 av; av.x = pk2(a[0], a[1]); av.y = pk2(a[2], a[3]); av.z = pk2(a[4], a[5]); av.w = pk2(a[6], a[7]); *(u32x4*)(araw + (size_t)row * DFF + c0) = av; }
                float* o = nullptr;
                if (sample) { const int rs = row - MP, t = rs & 31; if (t >= 30) o = out + O_SFC + (size_t)((rs >> 5) * 2 + t - 30) * DFF + c0; }
                else { const int t = row & 2047; if (t >= 2046) o = out + O_PFC + (size_t)((row >> 11) * 2 + t - 2046) * DFF + c0; }
                if (o) { *(f32x4*)o = acc[ai][0][m][0]; *(f32x4*)(o + 4) = acc[ai][0][m][1]; }
            }
        }
    }
};
struct F9 {
    const bf16_t* pe; const bf16_t* xb; float* y; struct Pre { u32x4 p, x; }; static constexpr int MB = 4;
    __device__ __forceinline__ Pre load(int row, int col) const { const size_t i = (size_t)row * 1024 + col; Pre r; r.p = *(const u32x4*)(pe + i); r.x = *(const u32x4*)(xb + i); return r; }
    __device__ __forceinline__ void operator()(int row, int col, int, f32x4 v0, f32x4 v1, Pre pr) const {
        const size_t i = (size_t)row * 1024 + col; float pf[8], xf[8]; unpk8(pr.p, pf); unpk8(pr.x, xf);
        f32x4 a, b;
#pragma unroll
        for (int j = 0; j < 4; ++j) { a[j] = xf[j] + pf[j] * sigm(v0[j]); b[j] = xf[4 + j] + pf[4 + j] * sigm(v1[j]); }
        *(f32x4*)(y + i) = a; *(f32x4*)(y + i + 4) = b;
    }
};
template <class E> __device__ __forceinline__ void run_gemm_epi(unsigned char* lds, const bf16_t* A, const bf16_t* Bt, int N, int K, const E& e) {
    asm volatile("" : "+s"(K)); asm volatile("" : "+s"(N));
    pg8::Gemm g; g.A = A; g.Bt = Bt; g.M = MT; g.N = N; g.K = K;
    pg8::StaticOrder S; S.init(MT, N, (int)gridDim.x, (int)blockIdx.x);
    pg8::gemm_phase<E, pg8::StaticOrder, false>((PG8_LAS unsigned char*)lds, g, S, e, nullptr);
    __syncthreads();
}
template <class F> __device__ __forceinline__ void run_gemm(unsigned char* lds, const bf16_t* A, const bf16_t* Bt, int N, int K, const F& f) {
    asm volatile("" : "+s"(K)); asm volatile("" : "+s"(N));
    pg8::Gemm g; g.A = A; g.Bt = Bt; g.M = MT; g.N = N; g.K = K;
    pg8::StaticOrder S; S.init(MT, N, (int)gridDim.x, (int)blockIdx.x);
    EpiT<F> E; E.f = f;
    pg8::gemm_phase<EpiT<F>, pg8::StaticOrder, false>((PG8_LAS unsigned char*)lds, g, S, E, nullptr);
    __syncthreads();
}

template <bool ILV = false> __device__ __forceinline__ void transpose_w(const float* W, bf16_t* Bt, int K, int N, const float* gain, float* tile, int& toff) {
    const int nnt = N / 64, ntiles = (K / 64) * nnt, tid = threadIdx.x, G = gridDim.x;
    int first = ((int)blockIdx.x - (toff % G) + G) % G;
    for (int t = first; t < ntiles; t += G) {
        const int kt = t / nnt, nt = t % nnt;
        const int d0 = nt * 64, sc0 = ILV ? (((d0 & 255) < 128) ? (d0 >> 8) * 128 + (d0 & 127) : DFF + (d0 >> 8) * 128 + (d0 & 127)) : d0;
#pragma unroll
        for (int i = 0; i < 8; ++i) { const int r = (tid >> 6) + 8 * i, c = tid & 63; float v = W[(size_t)(kt * 64 + r) * N + sc0 + c]; if (gain) v *= gain[kt * 64 + r]; tile[r * 65 + c] = v; }
        __syncthreads();
        { const int n = tid >> 3, k8 = (tid & 7) * 8; u32x4 wv;
          wv.x = pk2(tile[(k8 + 0) * 65 + n], tile[(k8 + 1) * 65 + n]); wv.y = pk2(tile[(k8 + 2) * 65 + n], tile[(k8 + 3) * 65 + n]);
          wv.z = pk2(tile[(k8 + 4) * 65 + n], tile[(k8 + 5) * 65 + n]); wv.w = pk2(tile[(k8 + 6) * 65 + n], tile[(k8 + 7) * 65 + n]);
          *(u32x4*)(Bt + (size_t)(nt * 64 + n) * K + kt * 64 + k8) = wv; }
        __syncthreads();
    }
    toff += ntiles;
}
__device__ __forceinline__ const float* xrow(const Prm& p, int row) { return row < MP ? p.in[I_XP] + (size_t)row * 1024 : p.in[I_XS] + (size_t)(row - MP) * 1024; }

__device__ __forceinline__ void phase0(const Prm& p, unsigned char* lds) {
    float* tile = (float*)lds; int toff = 0; unsigned char* ws = p.ws;
    transpose_w(p.in[I_WIN], (bf16_t*)(ws + WS_WIN), 1024, NIN, p.in[I_GPM], tile, toff);
    transpose_w<true>(p.in[I_WUP], (bf16_t*)(ws + WS_WUP), 1024, 2 * DFF, p.in[I_GPF], tile, toff);
    transpose_w(p.in[I_WDOWN], (bf16_t*)(ws + WS_WDOWN), DFF, 1024, nullptr, tile, toff);
    transpose_w(p.in[I_WBRA], (bf16_t*)(ws + WS_WBRA), 1024, 1024, nullptr, tile, toff);
    transpose_w(p.in[I_WBRB], (bf16_t*)(ws + WS_WBRB), 1024, 1024, nullptr, tile, toff);
    transpose_w(p.in[I_WOUT], (bf16_t*)(ws + WS_WOUT), 1024, 1024, nullptr, tile, toff);
    transpose_w(p.in[I_WPG], (bf16_t*)(ws + WS_WPG), 1024, 1024, nullptr, tile, toff);
    transpose_w(p.in[I_WPLE], (bf16_t*)(ws + WS_WPLE), 256, 1024, nullptr, tile, toff);
    bf16_t* xn = (bf16_t*)p.out;
    const int lane = threadIdx.x & 63, gw = blockIdx.x * 8 + (threadIdx.x >> 6), nw = gridDim.x * 8;
    for (int row = gw; row < MT; row += nw) {
        const float* xr = xrow(p, row); f32x4 v[4]; float ss = 0.f;
#pragma unroll
        for (int i = 0; i < 4; ++i) { v[i] = *(const f32x4*)(xr + i * 256 + lane * 4); ss += v[i][0] * v[i][0] + v[i][1] * v[i][1] + v[i][2] * v[i][2] + v[i][3] * v[i][3]; }
        ss = wsum(ss); const float rs = rsqrtf(ss * (1.0f / 1024.0f) + EPS);
#pragma unroll
        for (int i = 0; i < 4; ++i) *(u32x2*)(xn + (size_t)row * 1024 + i * 256 + lane * 4) = pk4(v[i] * rs);
    }
}

constexpr int AT_KS = 0, AT_VT = 27648, AT_BT = 53248;
__device__ __forceinline__ void attn_bias_table(const Prm& p, unsigned char* lds) {
    float* bT = (float*)(lds + AT_BT); const float* tab = p.in[I_RB];
    for (int i = threadIdx.x; i < 16 * 256; i += 512) {
        const int head = i >> 8, idx = i & 255, rel = idx - 191, n = rel < 0 ? -rel : rel;
        int bk = n < 8 ? n : min(15, 33 - __clz(n * n)); if (rel > 0) bk += 16;
        bT[i] = idx < 255 ? tab[bk * 16 + head] : 0.f;
    }
}
template <int NKT, int NQT, bool SAMPLE>
__device__ __forceinline__ void attn_item(const Prm& p, unsigned char* lds, int b, int c, int kvh, bf16_t* YA) {
    bf16_t* Ks = (bf16_t*)(lds + AT_KS); bf16_t* Vt = (bf16_t*)(lds + AT_VT); const float* bT = (const float*)(lds + AT_BT);
    const bf16_t* kv = (const bf16_t*)(p.ws + WS_KV); bf16_t* R0 = (bf16_t*)(p.ws + WS_R0);
    const int tid = threadIdx.x, lane = tid & 63, w = tid >> 6, lr = lane & 15, lq = lane >> 4;
    const int head = kvh * 8 + w; const int qrow0 = SAMPLE ? MP + b * 32 : b * 2048 + c * 64;
    const size_t qoff0 = (size_t)(qrow0 + lr) * 1024 + head * 64 + lq * 8;
    bf16x8 qn0 = *(const bf16x8*)(R0 + qoff0), qn1 = *(const bf16x8*)(R0 + qoff0 + 32);
    __syncthreads();
    if (!SAMPLE) {
        const int tok0 = b * 2048 + (c - 2) * 64;
        for (int id = tid; id < 192 * 8; id += 512) {
            const int key = id >> 3, dc = id & 7; u32x4 v = {0u, 0u, 0u, 0u};
            if (c * 64 - 128 + key >= 0) v = *(const u32x4*)(kv + (size_t)(tok0 + key) * 256 + kvh * 64 + dc * 8);
            *(u32x4*)(Ks + key * 72 + dc * 8) = v;
        }
        for (int id = tid; id < 192 * 8; id += 512) {
            const int key = id % 192, dc = id / 192; u32x4 v = {0u, 0u, 0u, 0u};
            if (c * 64 - 128 + key >= 0) v = *(const u32x4*)(kv + (size_t)(tok0 + key) * 256 + 128 + kvh * 64 + dc * 8);
            bf16_t* d = Vt + (dc * 8) * 200 + key;
            d[0] = (bf16_t)(v.x & 0xffffu); d[200] = (bf16_t)(v.x >> 16); d[400] = (bf16_t)(v.y & 0xffffu); d[600] = (bf16_t)(v.y >> 16);
            d[800] = (bf16_t)(v.z & 0xffffu); d[1000] = (bf16_t)(v.z >> 16); d[1200] = (bf16_t)(v.w & 0xffffu); d[1400] = (bf16_t)(v.w >> 16);
        }
    } else {
        const float* ck = p.in[I_CK]; const float* cvp = p.in[I_CV];
        for (int id = tid; id < 160 * 8; id += 512) {
            const int key = id >> 3, dc = id & 7; u32x4 v;
            if (key < 128) { const float* s = ck + (size_t)(b * 128 + key) * 128 + kvh * 64 + dc * 8; v = pk8(*(const f32x4*)s, *(const f32x4*)(s + 4)); }
            else v = *(const u32x4*)(kv + (size_t)(MP + b * 32 + key - 128) * 256 + kvh * 64 + dc * 8);
            *(u32x4*)(Ks + key * 72 + dc * 8) = v;
        }
        for (int id = tid; id < 160 * 8; id += 512) {
            const int key = id % 160, dc = id / 160; u32x4 v;
            if (key < 128) { const float* s = cvp + (size_t)(b * 128 + key) * 128 + kvh * 64 + dc * 8; v = pk8(*(const f32x4*)s, *(const f32x4*)(s + 4)); }
            else v = *(const u32x4*)(kv + (size_t)(MP + b * 32 + key - 128) * 256 + 128 + kvh * 64 + dc * 8);
            bf16_t* d = Vt + (dc * 8) * 200 + key;
            d[0] = (bf16_t)(v.x & 0xffffu); d[200] = (bf16_t)(v.x >> 16); d[400] = (bf16_t)(v.y & 0xffffu); d[600] = (bf16_t)(v.y >> 16);
            d[800] = (bf16_t)(v.z & 0xffffu); d[1000] = (bf16_t)(v.z >> 16); d[1200] = (bf16_t)(v.w & 0xffffu); d[1400] = (bf16_t)(v.w >> 16);
        }
    }
    __syncthreads();
    const float sink = p.in[I_SINK][head];
    const float* bTh = bT + head * 256;
#pragma unroll 1
    for (int qi = 0; qi < NQT; ++qi) {
        const int q = qi * 16 + lr;
        const bf16x8 qf0 = qn0, qf1 = qn1;
        if (qi + 1 < NQT) { qn0 = *(const bf16x8*)(R0 + qoff0 + (size_t)(qi + 1) * 16384); qn1 = *(const bf16x8*)(R0 + qoff0 + (size_t)(qi + 1) * 16384 + 32); }
        f32x4 s[NKT];
#pragma unroll
        for (int kt = 0; kt < NKT; ++kt) {
            const bf16_t* kp = Ks + (kt * 16 + lr) * 72 + lq * 8;
            const bf16x8 k0 = *(const bf16x8*)kp, k1 = *(const bf16x8*)(kp + 32);
            f32x4 a = {0.f, 0.f, 0.f, 0.f}; a = MFMA16(k0, qf0, a); a = MFMA16(k1, qf1, a); s[kt] = a;
        }
        float mx = sink;
#pragma unroll
        for (int kt = 0; kt < NKT; ++kt)
#pragma unroll
            for (int r = 0; r < 4; ++r) {
                const int key = kt * 16 + lq * 4 + r; float v = s[kt][r] * 0.125f + bTh[key - q + 63];
                if (!SAMPLE && (c * 64 - 128 + key < 0)) v = -1e30f;
                s[kt][r] = v; mx = fmaxf(mx, v);
            }
        mx = fmaxf(mx, __shfl_xor(mx, 16)); mx = fmaxf(mx, __shfl_xor(mx, 32));
        float sum = 0.f;
#pragma unroll
        for (int kt = 0; kt < NKT; ++kt)
#pragma unroll
            for (int r = 0; r < 4; ++r) { const float e = __expf(s[kt][r] - mx); s[kt][r] = e; sum += e; }
        sum += __shfl_xor(sum, 16); sum += __shfl_xor(sum, 32);
        const float inv = 1.0f / (sum + __expf(sink - mx));
        f32x4 o[4];
#pragma unroll
        for (int dt = 0; dt < 4; ++dt) o[dt] = (f32x4){0.f, 0.f, 0.f, 0.f};
#pragma unroll
        for (int ks = 0; ks < NKT / 2; ++ks) {
            const u32x4 pw = pk8(s[2 * ks], s[2 * ks + 1]); const bf16x8 pf = __builtin_bit_cast(bf16x8, pw);
#pragma unroll
            for (int dt = 0; dt < 4; ++dt) {
                const bf16_t* vp = Vt + (dt * 16 + lr) * 200 + ks * 32 + lq * 4;
                const u32x2 lo = *(const u32x2*)vp, hi = *(const u32x2*)(vp + 16);
                const u32x4 vw = {lo.x, lo.y, hi.x, hi.y};
                o[dt] = MFMA16(__builtin_bit_cast(bf16x8, vw), pf, o[dt]);
            }
        }
#pragma unroll
        for (int dt = 0; dt < 4; ++dt) *(u32x2*)(YA + (size_t)(qrow0 + q) * 1024 + head * 64 + dt * 16 + lq * 4) = pk4(o[dt] * inv);
    }
}

template <int L, bool SAMPLE>
__device__ __forceinline__ void hgrn_seq(const Prm& p, unsigned char* lds, int b, int h, bf16_t* YB) {
    constexpr int RPG = L / 8, NT = L / 16, NCH = SAMPLE ? 1 : 32, NP = 8 / NT;
    bf16_t* Qd = (bf16_t*)lds; bf16_t* Qm = Qd + 64 * 136; bf16_t* Km = Qm + 64 * 136; bf16_t* KlT = Km + 64 * 136; bf16_t* Vt = KlT + 128 * 72; bf16_t* St = Vt + 128 * 72; bf16_t* Al = St + 128 * 136;
    float* tot = (float*)(Al + 64 * 72); float* first = tot + 1024; float* decay = first + 1024; float* ssq = decay + 128;
    const bf16_t* R1 = (const bf16_t*)(p.ws + WS_R0 + UB); const bf16_t* R2 = (const bf16_t*)(p.ws + WS_R0 + 2 * UB); const bf16_t* R3 = (const bf16_t*)(p.ws + WS_R0 + 3 * UB); const bf16_t* R4 = (const bf16_t*)(p.ws + WS_R0 + 4 * UB);
    const int tid = threadIdx.x, lane = tid & 63, w = tid >> 6, lr = lane & 15, lq = lane >> 4, cp = lane, rg = w, c0 = 2 * cp;
    float lb[2];
#pragma unroll
    for (int c = 0; c < 2; ++c) { const float l0 = p.in[I_LB][h * 128 + c0 + c], l1 = p.in[I_LB][1024 + h * 128 + c0 + c]; lb[c] = 1.0f / (1.0f + __expf(l1 - l0)); }
    f32x4 S[8];
#pragma unroll
    for (int dvt = 0; dvt < 8; ++dvt) {
        if (SAMPLE) {
#pragma unroll
            for (int r = 0; r < 4; ++r) S[dvt][r] = p.in[I_ST][((size_t)(b * 8 + h) * 128 + 16 * w + 4 * lq + r) * 128 + 16 * dvt + lr];
        } else S[dvt] = (f32x4){0.f, 0.f, 0.f, 0.f};
    }
    const int tt = w % NT, dv0 = (w / NT) * NT;
    const int rowbase = SAMPLE ? MP + b * 32 : b * 2048;
    f32x4 ggv[NT];
#pragma unroll
    for (int i = 0; i < NT; ++i) ggv[i] = *(const f32x4*)(p.in[I_GH] + 16 * (dv0 + i) + 4 * lq);
    unsigned qw[RPG], fw[RPG], vw[RPG];
#pragma unroll
    for (int i = 0; i < RPG; ++i) { const size_t idx = (size_t)(rowbase + rg * RPG + i) * 1024 + h * 128 + c0; qw[i] = *(const unsigned*)(R1 + idx); fw[i] = *(const unsigned*)(R2 + idx); vw[i] = *(const unsigned*)(R3 + idx); }
#pragma unroll 1
    for (int ch = 0; ch < NCH; ++ch) {
        const int row0 = rowbase + ch * L;
        float qv[2][RPG], cv[2][RPG], kk[2][RPG]; unsigned vkeep[RPG]; float run[2] = {0.f, 0.f}, lf0[2] = {0.f, 0.f};
#pragma unroll
        for (int i = 0; i < RPG; ++i) {
            vkeep[i] = vw[i];
#pragma unroll
            for (int c = 0; c < 2; ++c) {
                const float q = c ? bfhi(qw[i]) : bflo(qw[i]), fl = c ? bfhi(fw[i]) : bflo(fw[i]);
                const float f = lb[c] + (1.0f - lb[c]) * sigm(fl), lf = __logf(f);
                run[c] += lf; cv[c][i] = run[c]; kk[c][i] = 1.0f - f; qv[c][i] = q * sigm(q); if (i == 0) lf0[c] = lf;
            }
        }
        *(f32x2v*)(tot + rg * 128 + c0) = (f32x2v){run[0], run[1]}; *(f32x2v*)(first + rg * 128 + c0) = (f32x2v){lf0[0], lf0[1]};
        if (ch + 1 < NCH) {
#pragma unroll
            for (int i = 0; i < RPG; ++i) { const size_t idx = (size_t)(row0 + L + rg * RPG + i) * 1024 + h * 128 + c0; qw[i] = *(const unsigned*)(R1 + idx); fw[i] = *(const unsigned*)(R2 + idx); vw[i] = *(const unsigned*)(R3 + idx); }
        }
        const size_t rbase = (size_t)(row0 + tt * 16 + lr) * 1024 + h * 128;
        u32x2 ogw[NT];
#pragma unroll
        for (int i = 0; i < NT; ++i) ogw[i] = *(const u32x2*)(R4 + rbase + 16 * (dv0 + i) + 4 * lq);
        __syncthreads();
        {
            float pre[2] = {0.f, 0.f}, bmid[2], blast[2], emid[2], elm[2];
#pragma unroll
            for (int c = 0; c < 2; ++c) {
                float acc = 0.f, half = 0.f;
#pragma unroll
                for (int j = 0; j < 8; ++j) { const float t = tot[j * 128 + c0 + c]; if (j < rg) pre[c] += t; if (j < 4) half += t; acc += t; }
                bmid[c] = half + first[4 * 128 + c0 + c]; blast[c] = acc; emid[c] = __expf(bmid[c]); elm[c] = __expf(blast[c] - bmid[c]);
            }
            float kl[2][RPG];
#pragma unroll
            for (int i = 0; i < RPG; ++i) {
                const int r = rg * RPG + i; float qd[2], qm[2], km[2];
#pragma unroll
                for (int c = 0; c < 2; ++c) {
                    const float E = __expf(pre[c] + cv[c][i] - bmid[c]), Ei = __builtin_amdgcn_rcpf(E);
                    qm[c] = qv[c][i] * E; qd[c] = qm[c] * emid[c]; km[c] = kk[c][i] * Ei; kl[c][i] = km[c] * elm[c];
                }
                *(unsigned*)(Qd + r * 136 + c0) = pk2(qd[0], qd[1]); *(unsigned*)(Qm + r * 136 + c0) = pk2(qm[0], qm[1]); *(unsigned*)(Km + r * 136 + c0) = pk2(km[0], km[1]);
            }
#pragma unroll
            for (int c = 0; c < 2; ++c) {
#pragma unroll
                for (int i = 0; i < RPG; i += 4) {
                    u32x2 a, v2; a.x = pk2(kl[c][i], kl[c][i + 1]); a.y = pk2(kl[c][i + 2], kl[c][i + 3]);
                    if (c == 0) { v2.x = (vkeep[i] & 0xffffu) | (vkeep[i + 1] << 16); v2.y = (vkeep[i + 2] & 0xffffu) | (vkeep[i + 3] << 16); }
                    else { v2.x = (vkeep[i] >> 16) | (vkeep[i + 1] & 0xffff0000u); v2.y = (vkeep[i + 2] >> 16) | (vkeep[i + 3] & 0xffff0000u); }
                    *(u32x2*)(KlT + (c0 + c) * 72 + rg * RPG + i) = a; *(u32x2*)(Vt + (c0 + c) * 72 + rg * RPG + i) = v2;
                }
            }
            if (rg == 0) *(f32x2v*)(decay + c0) = (f32x2v){__expf(blast[0]), __expf(blast[1])};
        }
#pragma unroll
        for (int dvt = 0; dvt < 8; ++dvt) *(u32x2*)(St + (16 * dvt + lr) * 136 + 16 * w + 4 * lq) = pk4(S[dvt]);
        __syncthreads();
        for (int id = w; id < NT * NT; id += 8) {
            const int st = id / NT, t2 = id % NT; f32x4 acc = {0.f, 0.f, 0.f, 0.f};
#pragma unroll
            for (int ks = 0; ks < 4; ++ks) acc = MFMA16(*(const bf16x8*)(Km + (st * 16 + lr) * 136 + ks * 32 + lq * 8), *(const bf16x8*)(Qm + (t2 * 16 + lr) * 136 + ks * 32 + lq * 8), acc);
            const int t = t2 * 16 + lr;
#pragma unroll
            for (int r = 0; r < 4; ++r) if (st * 16 + 4 * lq + r > t) acc[r] = 0.f;
            *(u32x2*)(Al + t * 72 + st * 16 + 4 * lq) = pk4(acc);
        }
        f32x4 o[NT];
#pragma unroll
        for (int i = 0; i < NT; ++i) {
            f32x4 acc = {0.f, 0.f, 0.f, 0.f};
#pragma unroll
            for (int ks = 0; ks < 4; ++ks) acc = MFMA16(*(const bf16x8*)(St + (16 * (dv0 + i) + lr) * 136 + ks * 32 + lq * 8), *(const bf16x8*)(Qd + (tt * 16 + lr) * 136 + ks * 32 + lq * 8), acc);
            o[i] = acc;
        }
        __syncthreads();
        float sq = 0.f;
#pragma unroll
        for (int i = 0; i < NT; ++i) {
#pragma unroll
            for (int ks = 0; ks < L / 32; ++ks) o[i] = MFMA16(*(const bf16x8*)(Vt + (16 * (dv0 + i) + lr) * 72 + ks * 32 + lq * 8), *(const bf16x8*)(Al + (tt * 16 + lr) * 72 + ks * 32 + lq * 8), o[i]);
            sq += o[i][0] * o[i][0] + o[i][1] * o[i][1] + o[i][2] * o[i][2] + o[i][3] * o[i][3];
        }
        sq += __shfl_xor(sq, 16); sq += __shfl_xor(sq, 32);
        if (lq == 0) ssq[(w / NT) * 64 + tt * 16 + lr] = sq;
        {
            const f32x4 dc = *(const f32x4*)(decay + 16 * w + 4 * lq);
#pragma unroll
            for (int dvt = 0; dvt < 8; ++dvt) {
                f32x4 acc = S[dvt] * dc;
#pragma unroll
                for (int ks = 0; ks < L / 32; ++ks) acc = MFMA16(*(const bf16x8*)(KlT + (16 * w + lr) * 72 + ks * 32 + lq * 8), *(const bf16x8*)(Vt + (16 * dvt + lr) * 72 + ks * 32 + lq * 8), acc);
                S[dvt] = acc;
            }
        }
        __syncthreads();
        {
            float tsq = 0.f;
#pragma unroll
            for (int j = 0; j < NP; ++j) tsq += ssq[j * 64 + tt * 16 + lr];
            const float rs = rsqrtf(tsq * (1.0f / 128.0f) + EPS);
#pragma unroll
            for (int i = 0; i < NT; ++i) {
                const int dvb = 16 * (dv0 + i) + 4 * lq;
                const f32x4 gg = ggv[i];
                const float og0 = bflo(ogw[i].x), og1 = bfhi(ogw[i].x), og2 = bflo(ogw[i].y), og3 = bfhi(ogw[i].y);
                f32x4 y; y[0] = o[i][0] * rs * gg[0] * og0 * sigm(og0); y[1] = o[i][1] * rs * gg[1] * og1 * sigm(og1); y[2] = o[i][2] * rs * gg[2] * og2 * sigm(og2); y[3] = o[i][3] * rs * gg[3] * og3 * sigm(og3);
                *(u32x2*)(YB + rbase + dvb) = pk4(y);
            }
        }
    }
    float* so = p.out + (SAMPLE ? O_SST : O_PST) + (size_t)(b * 8 + h) * 16384;
#pragma unroll
    for (int dvt = 0; dvt < 8; ++dvt)
#pragma unroll
        for (int r = 0; r < 4; ++r) so[(16 * w + 4 * lq + r) * 128 + 16 * dvt + lr] = S[dvt][r];
    __syncthreads();
}

__device__ __forceinline__ void phase_rp5(const Prm& p) {
    const bf16_t* O = (const bf16_t*)(p.ws + WS_R0 + 4 * UB); bf16_t* hf = (bf16_t*)(p.ws + WS_R0); const float* g = p.in[I_GPOST];
    const int lane = threadIdx.x & 63, gw = blockIdx.x * 8 + (threadIdx.x >> 6), nw = gridDim.x * 8;
    for (int row = gw; row < MT; row += nw) {
        const float* xr = xrow(p, row); const bf16_t* orow = O + (size_t)row * 1024; f32x4 v[4], x[4]; float ss = 0.f;
#pragma unroll
        for (int i = 0; i < 4; ++i) { { const u32x2 ow = *(const u32x2*)(orow + i * 256 + lane * 4); v[i] = (f32x4){bflo(ow.x), bfhi(ow.x), bflo(ow.y), bfhi(ow.y)}; } x[i] = *(const f32x4*)(xr + i * 256 + lane * 4); ss += v[i][0] * v[i][0] + v[i][1] * v[i][1] + v[i][2] * v[i][2] + v[i][3] * v[i][3]; }
        ss = wsum(ss); const float rs = rsqrtf(ss * (1.0f / 1024.0f) + EPS); float s2 = 0.f;
#pragma unroll
        for (int i = 0; i < 4; ++i) { const f32x4 gg = *(const f32x4*)(g + i * 256 + lane * 4); x[i] += v[i] * rs * gg; s2 += x[i][0] * x[i][0] + x[i][1] * x[i][1] + x[i][2] * x[i][2] + x[i][3] * x[i][3];
            *(u32x2*)((bf16_t*)p.out + (size_t)row * 1024 + i * 256 + lane * 4) = pk4(x[i]); }
        s2 = wsum(s2); const float r2 = rsqrtf(s2 * (1.0f / 1024.0f) + EPS);
#pragma unroll
        for (int i = 0; i < 4; ++i) *(u32x2*)(hf + (size_t)row * 1024 + i * 256 + lane * 4) = pk4(x[i] * r2);
    }
    bf16_t* pbf = (bf16_t*)(p.ws + WS_KV);
    for (int id = blockIdx.x * 512 + threadIdx.x; id < MT * 32; id += gridDim.x * 512) {
        const int row = id >> 5, c = (id & 31) * 8;
        const float* s = (row < MP ? p.in[I_PP] + (size_t)row * 256 : p.in[I_PS] + (size_t)(row - MP) * 256) + c;
        *(u32x4*)(pbf + (size_t)row * 256 + c) = pk8(*(const f32x4*)s, *(const f32x4*)(s + 4));
    }
}
__device__ __forceinline__ void phase_rp8(const Prm& p) {
    const bf16_t* O = (const bf16_t*)(p.ws + WS_R0 + UB); bf16_t* xb = (bf16_t*)(p.ws + WS_R0 + 3 * UB); const float* g = p.in[I_GPFF];
    const int lane = threadIdx.x & 63, gw = blockIdx.x * 8 + (threadIdx.x >> 6), nw = gridDim.x * 8;
    for (int row = gw; row < MT; row += nw) {
        const bf16_t* xr = (const bf16_t*)p.out + (size_t)row * 1024; const bf16_t* orow = O + (size_t)row * 1024; f32x4 v[4], x[4]; float ss = 0.f;
#pragma unroll
        for (int i = 0; i < 4; ++i) { { const u32x2 ow = *(const u32x2*)(orow + i * 256 + lane * 4); v[i] = (f32x4){bflo(ow.x), bfhi(ow.x), bflo(ow.y), bfhi(ow.y)}; } { const u32x2 xw = *(const u32x2*)(xr + i * 256 + lane * 4); x[i] = (f32x4){bflo(xw.x), bfhi(xw.x), bflo(xw.y), bfhi(xw.y)}; } ss += v[i][0] * v[i][0] + v[i][1] * v[i][1] + v[i][2] * v[i][2] + v[i][3] * v[i][3]; }
        ss = wsum(ss); const float rs = rsqrtf(ss * (1.0f / 1024.0f) + EPS);
#pragma unroll
        for (int i = 0; i < 4; ++i) { const f32x4 gg = *(const f32x4*)(g + i * 256 + lane * 4); x[i] += v[i] * rs * gg;
            *(u32x2*)(xb + (size_t)row * 1024 + i * 256 + lane * 4) = pk4(x[i]); }
    }
}
__device__ __forceinline__ void phase_conv(const Prm& p) {
    const bf16_t* A = (const bf16_t*)(p.ws + WS_R0 + UB); bf16_t* Ug = (bf16_t*)(p.ws + WS_R0 + UB + A_BYTES);
    const float* wc = p.in[I_WCONV]; const float* bc = p.in[I_BCONV]; const float* cc = p.in[I_CC];
    for (int id = blockIdx.x * 512 + threadIdx.x; id < 2112 * 352; id += gridDim.x * 512) {
        const int ri = id / 352, c0 = (id % 352) * 8;
        int row; if (ri < 2048) row = (ri >> 1) * 64 + (ri & 1); else { const int j = ri - 2048; row = MP + (j >> 1) * 32 + (j & 1); }
        float am2[8], am1[8], a[8], u[8], gq[8];
#pragma unroll
        for (int j = 0; j < 8; ++j) { am2[j] = 0.f; am1[j] = 0.f; }
        if (row < MP) {
            const int t = row & 2047;
            if (t >= 1) unpk8(*(const u32x4*)(A + (size_t)(row - 1) * DFF + c0), am1);
            if (t >= 2) unpk8(*(const u32x4*)(A + (size_t)(row - 2) * DFF + c0), am2);
        } else {
            const int rs = row - MP, b = rs >> 5, t = rs & 31;
            if (t == 0) {
#pragma unroll
                for (int j = 0; j < 8; ++j) { am2[j] = cc[(size_t)(b * 2) * DFF + c0 + j]; am1[j] = cc[(size_t)(b * 2 + 1) * DFF + c0 + j]; }
            } else {
#pragma unroll
                for (int j = 0; j < 8; ++j) am2[j] = cc[(size_t)(b * 2 + 1) * DFF + c0 + j];
                unpk8(*(const u32x4*)(A + (size_t)(row - 1) * DFF + c0), am1);
            }
        }
        const size_t off = (size_t)row * DFF + c0;
        unpk8(*(const u32x4*)(A + off), a); unpk8(*(const u32x4*)(Ug + off), u);
#pragma unroll
        for (int j = 0; j < 8; ++j) {
            const float ac = bc[c0 + j] + wc[c0 + j] * am2[j] + wc[DFF + c0 + j] * am1[j] + wc[2 * DFF + c0 + j] * a[j];
            const float y = 1.5957691216f * (ac + 0.044715f * ac * ac * ac);
            gq[j] = ac * sigm(y) * u[j];
        }
        u32x4 wv; wv.x = pk2(gq[0], gq[1]); wv.y = pk2(gq[2], gq[3]); wv.z = pk2(gq[4], gq[5]); wv.w = pk2(gq[6], gq[7]);
        *(u32x4*)(Ug + off) = wv;
    }
}

#ifndef PROBE_DUP
#define PROBE_DUP 0
#endif
#ifndef P2M
#define P2M 15
#endif
#ifndef PHM
#define PHM 0xfff
#endif

#define XB_TMO      128
#define XB_XCNT(j)  (256  + 64 * (j))
#define XB_XSUB(j)  (1280 + 64 * (j))
#define XB_XGEN(j)  (2304 + 64 * (j))
#define XB_TOP      3328
#define XB_TOPGEN   3392
#define XCD_BAR_WORDS 3456
#define XB_SPIN_CAP (1u << 18)
#define LAS __attribute__((address_space(3)))

__device__ __forceinline__ unsigned xb_ld(unsigned* p)              { return __hip_atomic_load(p, __ATOMIC_RELAXED, __HIP_MEMORY_SCOPE_AGENT); }
__device__ __forceinline__ unsigned xb_add(unsigned* p, unsigned v) { return __hip_atomic_fetch_add(p, v, __ATOMIC_RELAXED, __HIP_MEMORY_SCOPE_AGENT); }
__device__ __forceinline__ unsigned xb_xcc_id() { return (unsigned)__builtin_amdgcn_s_getreg((3 << 11) | 20) & 0xFu; }
#define XB_SPIN(cond, bar) do { unsigned _sp = 0; while (cond) { __builtin_amdgcn_s_sleep(1); \
    if ((++_sp & 255u) == 0u) { if (xb_ld(&(bar)[XB_TMO])) break; if (_sp > XB_SPIN_CAP) { atomicAdd(&(bar)[XB_TMO], 1u); break; } } } } while (0)
struct XcdBarrier {
    unsigned* bar; unsigned x;
    volatile LAS unsigned* st;
};

__device__ __forceinline__ XcdBarrier xcd_barrier_post(unsigned* bar, volatile LAS unsigned* st) {
    XcdBarrier b; b.bar = bar; b.x = xb_xcc_id(); b.st = st;
    if (threadIdx.x == 0) (void)xb_add(&bar[XB_XCNT(b.x)], 1u);
    return b;
}
__device__ __forceinline__ void xcd_barrier_complete(unsigned* bar, unsigned x, unsigned& nloc, unsigned& nx) {
    const unsigned G = gridDim.x * gridDim.y * gridDim.z;
    unsigned sum, cnt, mine, sp = 0u;
    for (;;) {
        sum = 0u; cnt = 0u; mine = 0u;
#pragma unroll
        for (unsigned j = 0; j < 16; ++j) { const unsigned c = xb_ld(&bar[XB_XCNT(j)]); sum += c; cnt += (c > 0u) ? 1u : 0u; mine = (j == x) ? c : mine; }
        if (sum == G) break;
        __builtin_amdgcn_s_sleep(1);
        if ((++sp & 255u) == 0u) { if (xb_ld(&bar[XB_TMO])) break; if (sp > XB_SPIN_CAP) { atomicAdd(&bar[XB_TMO], 1u); break; } }
    }
    nloc = mine > 0u ? mine : 1u; nx = cnt > 0u ? cnt : 1u;
}

__device__ __forceinline__ void xcd_barrier(const XcdBarrier& b) {
    asm volatile("s_waitcnt vmcnt(0)" ::: "memory");
    __syncthreads();
    if (threadIdx.x == 0) {
        unsigned* bar = b.bar;
        __builtin_amdgcn_s_waitcnt(0);
        unsigned nloc = b.st[0], nx = b.st[1];
        if (nloc == 0u) { xcd_barrier_complete(bar, b.x, nloc, nx); b.st[0] = nloc; b.st[1] = nx; }
        const unsigned old = xb_add(&bar[XB_XSUB(b.x)], 1u);
        const unsigned gen = old / nloc;
        if (old + 1u == (gen + 1u) * nloc) {
            __builtin_amdgcn_fence(__ATOMIC_RELEASE, "agent");
            asm volatile("s_waitcnt vmcnt(0)" ::: "memory");
            const unsigned og = xb_add(&bar[XB_TOP], 1u);
            const unsigned tg = og / nx;
            if (og + 1u == (tg + 1u) * nx) xb_add(&bar[XB_TOPGEN], 1u);
            else XB_SPIN(xb_ld(&bar[XB_TOPGEN]) == tg, bar);
            __builtin_amdgcn_fence(__ATOMIC_ACQUIRE, "agent");
            xb_add(&bar[XB_XGEN(b.x)], 1u);
            asm volatile("s_waitcnt vmcnt(0)" ::: "memory");
        } else {
            XB_SPIN(xb_ld(&bar[XB_XGEN(b.x)]) == gen, bar);
            __builtin_amdgcn_fence(__ATOMIC_ACQUIRE, "agent");
            asm volatile("s_waitcnt vmcnt(0)" ::: "memory");
        }
    }
    __syncthreads();
}

__global__ void __launch_bounds__(512, 2) fwd_mega(Prm p, int ph_lo, int ph_hi) {
    extern __shared__ __attribute__((aligned(16))) unsigned char lds[];
    cg::grid_group grid = cg::this_grid();
    unsigned char* ws = p.ws;
    bf16_t* R0 = (bf16_t*)(ws + WS_R0);
#define REG(i) ((bf16_t*)(ws + WS_R0 + (size_t)(i) * UB))
    unsigned* barw = (unsigned*)(ws + WS_END);
    if (blockIdx.x == 0) for (int i = threadIdx.x; i < XCD_BAR_WORDS; i += 512) barw[i] = 0u;
    volatile LAS unsigned* xst = (volatile LAS unsigned*)((PG8_LAS unsigned char*)lds + (LDS_BYTES - 16));
    if (threadIdx.x < 4) xst[threadIdx.x] = 0u;
    __syncthreads();
    XcdBarrier xb; xb.bar = barw; xb.x = 0u; xb.st = xst;
    unsigned bar_k = 0;
#define GRID_SEAM() do { if (bar_k == 0) { grid.sync(); xb = xcd_barrier_post(barw, xst); } else xcd_barrier(xb); ++bar_k; } while (0)
#define PH_BEGIN(n) if (ph_lo <= (n) && (n) < ph_hi) { if ((n) > ph_lo) GRID_SEAM();
#define PH_END }
#if (PHM >> 0) & 1
        PH_BEGIN(0) phase0(p, lds);
#if PROBE_DUP == 1
        grid.sync(); phase0(p, lds);
#endif
        PH_END
#else
#endif
#if (PHM >> 1) & 1
        PH_BEGIN(1) { F1 f; f.r0 = R0; f.kv = (bf16_t*)(ws + WS_KV); f.out = p.out; run_gemm(lds, (const bf16_t*)p.out, (const bf16_t*)(ws + WS_WIN), NIN, 1024, f);
#if PROBE_DUP == 3
            grid.sync(); run_gemm(lds, (const bf16_t*)p.out, (const bf16_t*)(ws + WS_WIN), NIN, 1024, f);
#endif
        } PH_END
#else
#endif
#if (PHM >> 2) & 1
        PH_BEGIN(2) {
#if PROBE_DUP == 2
            { bf16_t* YA = (bf16_t*)p.out; bf16_t* YB = (bf16_t*)p.out + UB / 2;
            const int G = gridDim.x;
#if P2M & 1
#pragma unroll 1
            for (int s = blockIdx.x; s < 256; s += G) hgrn_seq<64, false>(p, lds, s >> 3, s & 7, YB);
#endif
#if P2M & 2
#pragma unroll 1
            for (int s = blockIdx.x; s < 256; s += G) hgrn_seq<32, true>(p, lds, s >> 3, s & 7, YB);
#endif
            __syncthreads(); attn_bias_table(p, lds); __syncthreads();
#if P2M & 4
#pragma unroll 1
            for (int it = blockIdx.x; it < 2048; it += G) attn_item<12, 4, false>(p, lds, it >> 6, (it >> 1) & 31, it & 1, YA);
#endif
#if P2M & 8
#pragma unroll 1
            for (int it = blockIdx.x; it < 64; it += G) attn_item<10, 2, true>(p, lds, it >> 1, 0, it & 1, YA);
#endif
            __syncthreads(); }
#endif
            { bf16_t* YA = REG(0); bf16_t* YB = REG(1);
            const int G = gridDim.x;
#if P2M & 1
#pragma unroll 1
            for (int s = blockIdx.x; s < 256; s += G) hgrn_seq<64, false>(p, lds, s >> 3, s & 7, YB);
#endif
#if P2M & 2
#pragma unroll 1
            for (int s = blockIdx.x; s < 256; s += G) hgrn_seq<32, true>(p, lds, s >> 3, s & 7, YB);
#endif
            __syncthreads(); attn_bias_table(p, lds); __syncthreads();
#if P2M & 4
#pragma unroll 1
            for (int it = blockIdx.x; it < 2048; it += G) attn_item<12, 4, false>(p, lds, it >> 6, (it >> 1) & 31, it & 1, YA);
#endif
#if P2M & 8
#pragma unroll 1
            for (int it = blockIdx.x; it < 64; it += G) attn_item<10, 2, true>(p, lds, it >> 1, 0, it & 1, YA);
#endif
            }
        } PH_END
#else
#endif
#if (PHM >> 3) & 1
        PH_BEGIN(3) { F2 f; f.g = REG(5); f.o = REG(2); run_gemm(lds, REG(0), (const bf16_t*)(ws + WS_WBRA), 1024, 1024, f);
#if PROBE_DUP == 4
            grid.sync(); run_gemm(lds, REG(0), (const bf16_t*)(ws + WS_WBRA), 1024, 1024, f);
#endif
        } PH_END
#else
#endif
#if (PHM >> 4) & 1
        PH_BEGIN(4) { F3 f; f.g = REG(6); f.t = REG(2); f.o = REG(3); run_gemm(lds, REG(1), (const bf16_t*)(ws + WS_WBRB), 1024, 1024, f); } PH_END
#else
#endif
#if (PHM >> 5) & 1
        PH_BEGIN(5) { FBF f; f.o = REG(4); run_gemm(lds, REG(3), (const bf16_t*)(ws + WS_WOUT), 1024, 1024, f);
#if PROBE_DUP == 5
            grid.sync(); run_gemm(lds, REG(3), (const bf16_t*)(ws + WS_WOUT), 1024, 1024, f);
#endif
        } PH_END
#else
#endif
#if (PHM >> 6) & 1
        PH_BEGIN(6) phase_rp5(p); PH_END
#else
#endif
#if (PHM >> 7) & 1
        PH_BEGIN(7) { EpiUp e; e.g = (bf16_t*)(ws + WS_R0 + UB + A_BYTES); e.araw = REG(1); e.out = p.out; e.wcv = p.in[I_WCONV]; e.bcv = p.in[I_BCONV]; run_gemm_epi(lds, REG(0), (const bf16_t*)(ws + WS_WUP), 2 * DFF, 1024, e); } PH_END
#else
#endif
#if (PHM >> 8) & 1
        PH_BEGIN(8) phase_conv(p); PH_END
#else
#endif
        PH_BEGIN(9) { FBF f; f.o = REG(1); run_gemm(lds, (const bf16_t*)(ws + WS_R0 + UB + A_BYTES), (const bf16_t*)(ws + WS_WDOWN), 1024, DFF, f);
                  FBF f2; f2.o = REG(0); run_gemm(lds, (const bf16_t*)(ws + WS_KV), (const bf16_t*)(ws + WS_WPLE), 1024, 256, f2); } PH_END
#if (PHM >> 10) & 1
        PH_BEGIN(10) phase_rp8(p); PH_END
#else
#endif
#if (PHM >> 11) & 1
        PH_BEGIN(11) { F9 f; f.pe = REG(0); f.xb = REG(3); f.y = p.out; run_gemm(lds, REG(3), (const bf16_t*)(ws + WS_WPG), 1024, 1024, f); } PH_END
#else
#endif
#undef REG
}

extern "C" void kernel_launch(void* const* d_in, const int* in_sizes, int n_in, void* d_out, int out_size, void* d_ws, size_t ws_size, hipStream_t stream) {
    static int grid = 0;
    if (grid == 0) {
        if (n_in != 26 || (size_t)out_size != O_END || ws_size < WS_END) { fprintf(stderr, "kernel_launch: unexpected shapes n_in %d out %d ws %zu (need %zu)\n", n_in, out_size, ws_size, (size_t)WS_END); grid = -1; return; }
        int dev = 0, cus = 0, per_cu = 0;
        hipGetDevice(&dev); hipDeviceGetAttribute(&cus, hipDeviceAttributeMultiprocessorCount, dev);
        if (hipFuncSetAttribute((const void*)fwd_mega, hipFuncAttributeMaxDynamicSharedMemorySize, LDS_BYTES) != hipSuccess) { fprintf(stderr, "kernel_launch: hipFuncSetAttribute failed\n"); grid = -1; return; }
        if (hipOccupancyMaxActiveBlocksPerMultiprocessor(&per_cu, (const void*)fwd_mega, 512, LDS_BYTES) != hipSuccess || per_cu < 1) { fprintf(stderr, "kernel_launch: occupancy query says %d\n", per_cu); per_cu = 1; }
        (void)hipGetLastError();
        grid = cus;
    }
    if (grid < 0) return;
    Prm p{};
    for (int i = 0; i < 26; ++i) p.in[i] = (const float*)d_in[i];
    p.out = (float*)d_out; p.ws = (unsigned char*)d_ws;
    int lo = 0, hi = 12;
    void* args[] = {&p, &lo, &hi};
    hipError_t e = hipLaunchCooperativeKernel((const void*)fwd_mega, dim3(grid), dim3(512), args, LDS_BYTES, stream);
    if (e != hipSuccess) fprintf(stderr, "kernel_launch: cooperative launch failed: %s (grid %d)\n", hipGetErrorString(e), grid);
}
```

```cpp
#include <hip/hip_runtime.h>
#include <hip/hip_cooperative_groups.h>
#include <cstdio>
namespace cg = cooperative_groups;
namespace pg8 {
#define PG8_LAS __attribute__((address_space(3)))
typedef unsigned short bf16_t;
typedef short bf16x8 __attribute__((ext_vector_type(8)));
typedef float f32x4 __attribute__((ext_vector_type(4)));
typedef unsigned u32x4 __attribute__((ext_vector_type(4)));
constexpr int BM = 256, BK = 64, HALF = 128, HTB = HALF * BK * 2  , STAGE_BYTES = 8 * HTB, NXCD = 8, WGM = 8;

__host__ __device__ __forceinline__ int lds_byte(int r, int c) { const int st = (r >> 4) * 2 + (c >> 5), rr = r & 15, cc = c & 31, ob = rr * 64 + cc * 2; return st * 1024 + (ob ^ (((ob >> 9) & 1) << 5)); }
__host__ __device__ __forceinline__ void stage_rc(int b, int& R, int& C) { const int st = b / 1024, sb = b % 1024, swz = sb ^ (((sb >> 9) & 1) << 5); R = (st >> 1) * 16 + swz / 64; C = (st & 1) * 32 + (swz % 64) / 2; }
__host__ __device__ __forceinline__ int perm32(int rho) { const int n = rho >> 4, i = rho & 15; return 8 * (i >> 2) + 4 * n + (i & 3); }

struct Unit { int pm, pn; };
struct Gemm { const bf16_t* A; const bf16_t* Bt; int M, N, K; };

struct StaticOrder {
    int nM, nN, nwg, G, c;
    __host__ __device__ void init(int M, int N, int G_, int c_) { nM = M / BM; nN = N / BM; nwg = nM * nN; G = G_; c = c_; }
    __host__ __device__ bool next(int i, Unit& u) const {
        const long L = (long)i * G + c; if (L >= nwg) return false;
        int wgid = (int)L; { const int q = nwg / NXCD, r = nwg % NXCD, xcd = wgid % NXCD, off = wgid / NXCD; wgid = (xcd < r ? xcd * (q + 1) : r * (q + 1) + (xcd - r) * q) + off; }
        const int nig = WGM * nN, gid = wgid / nig, fm = gid * WGM, gsz = (nM - fm) < WGM ? (nM - fm) : WGM;
        u.pm = fm + ((wgid % nig) % gsz); u.pn = (wgid % nig) / gsz; return true;
    }
    __device__ __forceinline__ void a_ready(const Unit&) const {}
    __device__ __forceinline__ void done(const Unit&) const {}
};
__device__ __forceinline__ unsigned cvt_pk_bf16(float lo, float hi) { unsigned r; asm volatile("v_cvt_pk_bf16_f32 %0, %1, %2" : "=v"(r) : "v"(lo), "v"(hi)); return r; }
template <class Epi, class Sched, bool STAMP = false>
__device__ __forceinline__ void gemm_phase(PG8_LAS unsigned char* lds, const Gemm g, const Sched& S, const Epi& E, unsigned long long* stamps) {
    const int tid = threadIdx.x, wid = __builtin_amdgcn_readfirstlane(tid >> 6), lane = tid & 63, wr = wid >> 2, wc = wid & 3, fr = lane & 15, fq = lane >> 4;
    const int K = g.K, nt = K / BK;
    int ts_lo = 0, ts_hi = 0, nts = 0; const unsigned long long rt_entry = STAMP ? (unsigned long long)wall_clock64() : 0ull;
#define PG8_STAMP() do { if (STAMP && wid == 0 && nts < 64) { const unsigned long long _c = (unsigned long long)clock64(); \
        ts_lo = (lane == nts) ? (int)(unsigned)_c : ts_lo; ts_hi = (lane == nts) ? (int)(unsigned)(_c >> 32) : ts_hi; ++nts; } } while (0)
    PG8_STAMP();
    unsigned voffA[2], voffB[2];
#pragma unroll
    for (int i = 0; i < 2; ++i) { int R, C; stage_rc(tid * 16 + i * 8192, R, C); const int Rb = Epi::PERM ? ((R & ~31) + perm32(R & 31)) : R;
        voffA[i] = (unsigned)(R * K + C) * 2u; voffB[i] = (unsigned)(Rb * K + C) * 2u; }
    const size_t kstep = (size_t)(BK * 2);
    const size_t hstep = (size_t)HALF * K * 2;
    const size_t tstep = 2 * hstep;
    const unsigned ldsw = (unsigned)wid * 1024u;
    const int aoff = lds_byte(wr * 64 + fr, fq * 8), boff = lds_byte(wc * 32 + fr, fq * 8);
#define PG8_SA(b, h) (((b) * 2 + (h)) * HTB)
#define PG8_SB(b, h) ((4 + (b) * 2 + (h)) * HTB)
#define PG8_STAGE(bufoff, gbase, voff) do { _Pragma("unroll") for (int _i = 0; _i < 2; ++_i) \
        __builtin_amdgcn_global_load_lds((const unsigned*)((const char*)(gbase) + (voff)[_i]), (PG8_LAS unsigned*)(lds + (bufoff) + ldsw + _i * 8192), 16, 0, 0); } while (0)
#define PG8_LDA(dst, b, h) do { _Pragma("unroll") for (int m = 0; m < 4; ++m) _Pragma("unroll") for (int k = 0; k < 2; ++k) dst[m][k] = *(const PG8_LAS bf16x8*)(lds + PG8_SA(b, h) + aoff + m * 2048 + k * 1024); } while (0)
#define PG8_LDB(dst, b, h) do { _Pragma("unroll") for (int n = 0; n < 2; ++n) _Pragma("unroll") for (int k = 0; k < 2; ++k) dst[n][k] = *(const PG8_LAS bf16x8*)(lds + PG8_SB(b, h) + boff + n * 2048 + k * 1024); } while (0)
#define PG8_MMA(ai, bj, At, Bt) do { __builtin_amdgcn_s_setprio(1); _Pragma("unroll") for (int m = 0; m < 4; ++m) _Pragma("unroll") for (int n = 0; n < 2; ++n) _Pragma("unroll") for (int k = 0; k < 2; ++k) \
        acc[ai][bj][m][n] = __builtin_amdgcn_mfma_f32_16x16x32_bf16(Bt[n][k], At[m][k], acc[ai][bj][m][n], 0, 0, 0); __builtin_amdgcn_s_setprio(0); } while (0)
#define PG8_WAIT_V(n) asm volatile("s_waitcnt vmcnt(" #n ")" ::: "memory")
#define PG8_WAIT_L(n) asm volatile("s_waitcnt lgkmcnt(" #n ")" ::: "memory")
#define PG8_BAR __builtin_amdgcn_s_barrier()
#define PG8_SCHED __builtin_amdgcn_sched_barrier(0)
    Unit cur, nxt; int ui = 0;
    if (!S.next(0, cur)) return;
    f32x4 acc[2][2][4][2];
#pragma unroll
    for (int a = 0; a < 2; ++a)
#pragma unroll
        for (int b = 0; b < 2; ++b)
#pragma unroll
            for (int m = 0; m < 4; ++m)
#pragma unroll
                for (int n = 0; n < 2; ++n) acc[a][b][m][n] = (f32x4){0.f, 0.f, 0.f, 0.f};
    bf16x8 At[4][2], B0[2][2], B1[2][2];
    const char* cA = (const char*)g.A + (size_t)cur.pm * tstep; const char* cB = (const char*)g.Bt + (size_t)cur.pn * tstep;
    S.a_ready(cur);
    PG8_STAGE(PG8_SB(0, 0), cB, voffB); PG8_STAGE(PG8_SA(0, 0), cA, voffA); PG8_STAGE(PG8_SB(0, 1), cB + hstep, voffB); PG8_STAGE(PG8_SA(0, 1), cA + hstep, voffA);
    if (wr == 1) PG8_BAR;
    PG8_WAIT_V(4); PG8_BAR;
    PG8_STAGE(PG8_SB(1, 0), cB + kstep, voffB); PG8_STAGE(PG8_SA(1, 0), cA + kstep, voffA); PG8_STAGE(PG8_SB(1, 1), cB + hstep + kstep, voffB);
    PG8_WAIT_V(6); PG8_BAR;
    PG8_STAMP();
    for (;;) {
        const bool has_next = S.next(ui + 1, nxt);
        const char* nA = has_next ? (const char*)g.A + (size_t)nxt.pm * tstep : cA; const char* nB = has_next ? (const char*)g.Bt + (size_t)nxt.pn * tstep : cB;
        for (int t = 0; t < nt; t += 2) {
            const bool last = (t == nt - 2);
            const char* a1 = cA + (size_t)(t + 1) * kstep;
            const char* a2 = last ? nA : cA + (size_t)(t + 2) * kstep; const char* b2 = last ? nB : cB + (size_t)(t + 2) * kstep;
            const char* a3 = a2 + kstep; const char* b3 = b2 + kstep;
            if (last && has_next) S.a_ready(nxt);
            PG8_LDB(B0, 0, 0); PG8_SCHED; PG8_LDA(At, 0, 0); PG8_STAGE(PG8_SA(1, 1), a1 + hstep, voffA);
            PG8_WAIT_L(8); PG8_BAR; PG8_WAIT_L(0); PG8_MMA(0, 0, At, B0); PG8_BAR; PG8_SCHED;
            PG8_LDB(B1, 0, 1); PG8_STAGE(PG8_SB(0, 0), b2, voffB);
            PG8_BAR; PG8_WAIT_L(0); PG8_MMA(0, 1, At, B1); PG8_BAR;
            PG8_LDA(At, 0, 1); PG8_STAGE(PG8_SA(0, 0), a2, voffA);
            PG8_BAR; PG8_WAIT_L(0); PG8_MMA(1, 0, At, B0); PG8_BAR; PG8_SCHED;
            PG8_STAGE(PG8_SB(0, 1), b2 + hstep, voffB);
            PG8_WAIT_V(6); PG8_BAR; PG8_MMA(1, 1, At, B1); PG8_BAR;
            PG8_LDB(B0, 1, 0); PG8_SCHED; PG8_LDA(At, 1, 0); PG8_STAGE(PG8_SA(0, 1), a2 + hstep, voffA);
            PG8_WAIT_L(8); PG8_BAR; PG8_WAIT_L(0); PG8_MMA(0, 0, At, B0); PG8_BAR; PG8_SCHED;
            PG8_LDB(B1, 1, 1); PG8_STAGE(PG8_SB(1, 0), b3, voffB);
            PG8_BAR; PG8_WAIT_L(0); PG8_MMA(0, 1, At, B1); PG8_BAR;
            PG8_LDA(At, 1, 1); PG8_STAGE(PG8_SA(1, 0), a3, voffA);
            PG8_BAR; PG8_WAIT_L(0); PG8_MMA(1, 0, At, B0); PG8_BAR; PG8_SCHED;
            PG8_STAGE(PG8_SB(1, 1), b3 + hstep, voffB);
            PG8_WAIT_V(6); PG8_BAR; PG8_MMA(1, 1, At, B1); PG8_BAR;
        }
        PG8_STAMP();
        if constexpr (!Epi::AFTER_DRAIN) { E(acc, cur, wr, wc, fr, fq); S.done(cur); }
        PG8_STAMP();
        if (!has_next) break;
#pragma unroll
        for (int a = 0; a < 2; ++a)
#pragma unroll
            for (int b = 0; b < 2; ++b)
#pragma unroll
                for (int m = 0; m < 4; ++m)
#pragma unroll
                    for (int n = 0; n < 2; ++n) acc[a][b][m][n] = (f32x4){0.f, 0.f, 0.f, 0.f};
        cur = nxt; cA = nA; cB = nB; ++ui;
    }
    PG8_WAIT_V(0);
    if (wr == 0) PG8_BAR;
    PG8_BAR;
    if constexpr (Epi::AFTER_DRAIN) { E.fused(acc, cur, wr, wc, fr, fq, lds, wid, lane); S.done(cur); }
    PG8_STAMP();
    if (STAMP && wid == 0) { stamps[lane] = lane < nts ? (((unsigned long long)(unsigned)ts_hi << 32) | (unsigned)ts_lo) : 0ull;
        if (lane == 62) stamps[62] = rt_entry; if (lane == 63) stamps[63] = (unsigned long long)wall_clock64(); }
#undef PG8_STAMP
#undef PG8_SA
#undef PG8_SB
#undef PG8_STAGE
#undef PG8_LDA
#undef PG8_LDB
#undef PG8_MMA
#undef PG8_WAIT_V
#undef PG8_WAIT_L
#undef PG8_BAR
#undef PG8_SCHED
}
}


using pg8::bf16_t; using pg8::bf16x8; using pg8::f32x4; using pg8::u32x4;
typedef unsigned u32x2 __attribute__((ext_vector_type(2)));
typedef float f32x2v __attribute__((ext_vector_type(2)));
#define MFMA16(a, b, c) __builtin_amdgcn_mfma_f32_16x16x32_bf16((a), (b), (c), 0, 0, 0)

constexpr int MP = 65536, MS = 1024, MT = MP + MS, DM = 1024, DFF = 2816, NIN = 7424;
constexpr float EPS = 1e-6f;
constexpr size_t UB = (size_t)MT * 1024 * 2;
constexpr size_t WS_WIN = 0, WS_WBRA = WS_WIN + (size_t)NIN * 1024 * 2, WS_WBRB = WS_WBRA + 2097152, WS_WOUT = WS_WBRB + 2097152, WS_WPG = WS_WOUT + 2097152,
                 WS_WUP = WS_WPG + 2097152, WS_WDOWN = WS_WUP + (size_t)2 * DFF * 1024 * 2, WS_WPLE = WS_WDOWN + (size_t)1024 * DFF * 2, WS_KV = WS_WPLE + (size_t)1024 * 256 * 2,
                 WS_R0 = WS_KV + (size_t)MT * 256 * 2, WS_END = WS_R0 + 7 * UB;
constexpr size_t A_BYTES = (size_t)MT * DFF * 2;
constexpr size_t O_Y = 0, O_PWK = (size_t)MT * 1024, O_PWV = O_PWK + 524288, O_PST = O_PWV + 524288, O_PFC = O_PST + 4194304, O_SWK = O_PFC + 180224, O_SWV = O_SWK + 131072,
                 O_SST = O_SWV + 131072, O_SFC = O_SST + 4194304, O_END = O_SFC + 180224;
constexpr int LDS_BYTES = 147456;

struct Prm { const float* in[26]; float* out; unsigned char* ws; };
enum { I_XP = 0, I_XS, I_CK, I_CV, I_ST, I_CC, I_PP, I_PS, I_RB, I_LB, I_GPM, I_WIN, I_SINK, I_GH, I_WBRA, I_WBRB, I_WOUT, I_GPOST, I_GPF, I_WUP, I_WCONV, I_BCONV, I_WDOWN, I_GPFF, I_WPLE, I_WPG };

__device__ __forceinline__ unsigned pk2(float lo, float hi) { unsigned r; asm("v_cvt_pk_bf16_f32 %0, %1, %2" : "=v"(r) : "v"(lo), "v"(hi)); return r; }
__device__ __forceinline__ float bflo(unsigned w) { return __uint_as_float(w << 16); }
__device__ __forceinline__ float bfhi(unsigned w) { return __uint_as_float(w & 0xffff0000u); }
__device__ __forceinline__ float bf1(bf16_t b) { return __uint_as_float(((unsigned)b) << 16); }
__device__ __forceinline__ bf16_t f2bf(float f) { return (bf16_t)(pk2(f, 0.f) & 0xffffu); }
__device__ __forceinline__ float sigm(float x) { return __builtin_amdgcn_rcpf(1.0f + __expf(-x)); }
__device__ __forceinline__ float wsum(float v) { v += __shfl_xor(v, 32); v += __shfl_xor(v, 16); v += __shfl_xor(v, 8); v += __shfl_xor(v, 4); v += __shfl_xor(v, 2); v += __shfl_xor(v, 1); return v; }
__device__ __forceinline__ u32x4 pk8(f32x4 a, f32x4 b) { u32x4 w; w.x = pk2(a[0], a[1]); w.y = pk2(a[2], a[3]); w.z = pk2(b[0], b[1]); w.w = pk2(b[2], b[3]); return w; }
__device__ __forceinline__ u32x2 pk4(f32x4 a) { u32x2 w; w.x = pk2(a[0], a[1]); w.y = pk2(a[2], a[3]); return w; }
__device__ __forceinline__ void unpk8(u32x4 w, float (&f)[8]) { f[0] = bflo(w.x); f[1] = bfhi(w.x); f[2] = bflo(w.y); f[3] = bfhi(w.y); f[4] = bflo(w.z); f[5] = bfhi(w.z); f[6] = bflo(w.w); f[7] = bfhi(w.w); }

struct NoPre {};
template <class F> struct EpiT {
    static constexpr bool PERM = true, AFTER_DRAIN = false; F f;
    __device__ __forceinline__ void operator()(const f32x4 (&acc)[2][2][4][2], const pg8::Unit& u, int wr, int wc, int fr, int fq) const {
        const int row0 = u.pm * 256 + wr * 64 + fr, col0 = u.pn * 256 + wc * 32 + 8 * fq;
        constexpr int MB = F::MB;
#pragma unroll
        for (int a0 = 0; a0 < 8; a0 += MB) {
            typename F::Pre pre[MB][2];
#pragma unroll
            for (int mm = 0; mm < MB; ++mm)
#pragma unroll
                for (int bj = 0; bj < 2; ++bj) pre[mm][bj] = f.load(row0 + ((a0 + mm) >> 2) * 128 + ((a0 + mm) & 3) * 16, col0 + bj * 128);
#pragma unroll
            for (int mm = 0; mm < MB; ++mm)
#pragma unroll
                for (int bj = 0; bj < 2; ++bj) f(row0 + ((a0 + mm) >> 2) * 128 + ((a0 + mm) & 3) * 16, col0 + bj * 128, u.pn, acc[(a0 + mm) >> 2][bj][(a0 + mm) & 3][0], acc[(a0 + mm) >> 2][bj][(a0 + mm) & 3][1], pre[mm][bj]);
        }
    }
};
struct F1 {
    bf16_t* r0; bf16_t* kv; float* out; typedef NoPre Pre; static constexpr int MB = 1;
    __device__ __forceinline__ NoPre load(int, int) const { return NoPre(); }
    __device__ __forceinline__ void operator()(int row, int col, int pn, f32x4 v0, f32x4 v1, NoPre) const {
        const u32x4 w = pk8(v0, v1);
        if (pn < 4) { __builtin_nontemporal_store(w, (u32x4*)(r0 + (size_t)row * 1024 + col)); }
        else if (pn == 4) {
            const int c = col - 1024; *(u32x4*)(kv + (size_t)row * 256 + c) = w;
            float* o = nullptr;
            if (row >= MP) { o = out + (c < 128 ? O_SWK : O_SWV) + (size_t)(row - MP) * 128 + (c & 127); }
            else { const int t = row & 2047; if (t >= 1920) o = out + (c < 128 ? O_PWK : O_PWV) + (size_t)((row >> 11) * 128 + t - 1920) * 128 + (c & 127); }
            if (o) { *(f32x4*)o = v0; *(f32x4*)(o + 4) = v1; }
        } else { const int c2 = col - 1280, seg = c2 >> 10; __builtin_nontemporal_store(w, (u32x4*)(r0 + (size_t)(1 + seg) * (UB / 2) + (size_t)row * 1024 + (c2 & 1023))); }
    }
};
struct F2 {
    const bf16_t* g; bf16_t* o; typedef u32x4 Pre; static constexpr int MB = 8;
    __device__ __forceinline__ u32x4 load(int row, int col) const { return *(const u32x4*)(g + (size_t)row * 1024 + col); }
    __device__ __forceinline__ void operator()(int row, int col, int, f32x4 v0, f32x4 v1, u32x4 gw) const {
        const size_t i = (size_t)row * 1024 + col; float gf[8]; unpk8(gw, gf);
        f32x4 a, b;
#pragma unroll
        for (int j = 0; j < 4; ++j) { a[j] = v0[j] * sigm(gf[j]); b[j] = v1[j] * sigm(gf[4 + j]); }
        *(u32x4*)(o + i) = pk8(a, b);
    }
};
struct F3 {
    const bf16_t* g; const bf16_t* t; bf16_t* o; struct Pre { u32x4 g, t; }; static constexpr int MB = 4;
    __device__ __forceinline__ Pre load(int row, int col) const { const size_t i = (size_t)row * 1024 + col; Pre r; r.g = *(const u32x4*)(g + i); r.t = *(const u32x4*)(t + i); return r; }
    __device__ __forceinline__ void operator()(int row, int col, int, f32x4 v0, f32x4 v1, Pre pr) const {
        const size_t i = (size_t)row * 1024 + col; float gf[8], tf[8]; unpk8(pr.g, gf); unpk8(pr.t, tf);
        f32x4 a, b;
#pragma unroll
        for (int j = 0; j < 4; ++j) { a[j] = tf[j] + v0[j] * sigm(gf[j]); b[j] = tf[4 + j] + v1[j] * sigm(gf[4 + j]); }
        *(u32x4*)(o + i) = pk8(a, b);
    }
};
struct FF32 {
    float* o; typedef NoPre Pre; static constexpr int MB = 1;
    __device__ __forceinline__ NoPre load(int, int) const { return NoPre(); }
    __device__ __forceinline__ void operator()(int row, int col, int, f32x4 v0, f32x4 v1, NoPre) const { float* d = o + (size_t)row * 1024 + col; *(f32x4*)d = v0; *(f32x4*)(d + 4) = v1; }
};
struct FBF {
    bf16_t* o; typedef NoPre Pre; static constexpr int MB = 1;
    __device__ __forceinline__ NoPre load(int, int) const { return NoPre(); }
    __device__ __forceinline__ void operator()(int row, int col, int, f32x4 v0, f32x4 v1, NoPre) const { *(u32x4*)(o + (size_t)row * 1024 + col) = pk8(v0, v1); }
};
struct EpiUp {
    static constexpr bool PERM = true, AFTER_DRAIN = false;
    bf16_t* g; bf16_t* araw; float* out; const float* wcv; const float* bcv;
    __device__ __forceinline__ void operator()(const f32x4 (&acc)[2][2][4][2], const pg8::Unit& u, int wr, int wc, int fr, int fq) const {
        const int c0 = u.pn * 128 + wc * 32 + 8 * fq;
        float w0[8], w1[8], w2[8], bb[8];
        { const f32x4 t0 = *(const f32x4*)(wcv + c0), t1 = *(const f32x4*)(wcv + c0 + 4), t2 = *(const f32x4*)(wcv + DFF + c0), t3 = *(const f32x4*)(wcv + DFF + c0 + 4),
                      t4 = *(const f32x4*)(wcv + 2 * DFF + c0), t5 = *(const f32x4*)(wcv + 2 * DFF + c0 + 4), t6 = *(const f32x4*)(bcv + c0), t7 = *(const f32x4*)(bcv + c0 + 4);
#pragma unroll
          for (int j = 0; j < 4; ++j) { w0[j] = t0[j]; w0[4 + j] = t1[j]; w1[j] = t2[j]; w1[4 + j] = t3[j]; w2[j] = t4[j]; w2[4 + j] = t5[j]; bb[j] = t6[j]; bb[4 + j] = t7[j]; } }
#pragma unroll
        for (int ai = 0; ai < 2; ++ai) {
            float p1[8], p2[8];
#pragma unroll
            for (int j = 0; j < 8; ++j) { p1[j] = 0.f; p2[j] = 0.f; }
#pragma unroll
            for (int m = 0; m < 4; ++m) {
                const int row = u.pm * 256 + ai * 128 + wr * 64 + m * 16 + fr;
                float a[8], uu[8], r1[8], r2[8], gq[8];
#pragma unroll
                for (int j = 0; j < 4; ++j) { a[j] = acc[ai][0][m][0][j]; a[4 + j] = acc[ai][0][m][1][j]; uu[j] = acc[ai][1][m][0][j]; uu[4 + j] = acc[ai][1][m][1][j]; }
#pragma unroll
                for (int j = 0; j < 8; ++j) { r1[j] = __int_as_float(__builtin_amdgcn_mov_dpp(__float_as_int(a[j]), 0x121, 0xf, 0xf, false)); r2[j] = __int_as_float(__builtin_amdgcn_mov_dpp(__float_as_int(a[j]), 0x122, 0xf, 0xf, false)); }
                const bool sample = row >= MP;
                const bool boundary = (m == 0 && fr < 2) || (sample && ((m & 1) == 0) && fr < 2);
                const bool keep_a = boundary || (m == 3 && fr >= 14);
#pragma unroll
                for (int j = 0; j < 8; ++j) {
                    const float am1 = fr >= 1 ? r1[j] : p1[j], am2 = fr >= 2 ? r2[j] : p2[j];
                    const float ac = bb[j] + w0[j] * am2 + w1[j] * am1 + w2[j] * a[j];
                    const float y = 1.5957691216f * (ac + 0.044715f * ac * ac * ac);
                    gq[j] = boundary ? uu[j] : ac * sigm(y) * uu[j];
                    p1[j] = r1[j]; p2[j] = r2[j];
                }
                u32x4 wv; wv.x = pk2(gq[0], gq[1]); wv.y = pk2(gq[2], gq[3]); wv.z = pk2(gq[4], gq[5]); wv.w = pk2(gq[6], gq[7]);
                __builtin_nontemporal_store(wv, (u32x4*)(g + (size_t)row * DFF + c0));
                if (keep_a) { u32x4 av; av.x = pk2(a[0], a[1]); av.y = pk2(a[2], a[3]); av.z = pk2(a[4], a[5]); av.w = pk2(a[6], a[7]); *(u32x4*)(araw + (size_t)row * DFF + c0) = av; }
                float* o = nullptr;
                if (sample) { const int rs = row - MP, t = rs & 31; if (t >= 30) o = out + O_SFC + (size_t)((rs >> 5) * 2 + t - 30) * DFF + c0; }
                else { const int t = row & 2047; if (t >= 2046) o = out + O_PFC + (size_t)((row >> 11) * 2 + t - 2046) * DFF + c0; }
                if (o) { *(f32x4*)o = acc[ai][0][m][0]; *(f32x4*)(o + 4) = acc[ai][0][m][1]; }
            }
        }
    }
};
struct F9 {
    const bf16_t* pe; const bf16_t* xb; float* y; struct Pre { u32x4 p, x; }; static constexpr int MB = 4;
    __device__ __forceinline__ Pre load(int row, int col) const { const size_t i = (size_t)row * 1024 + col; Pre r; r.p = *(const u32x4*)(pe + i); r.x = *(const u32x4*)(xb + i); return r; }
    __device__ __forceinline__ void operator()(int row, int col, int, f32x4 v0, f32x4 v1, Pre pr) const {
        const size_t i = (size_t)row * 1024 + col; float pf[8], xf[8]; unpk8(pr.p, pf); unpk8(pr.x, xf);
        f32x4 a, b;
#pragma unroll
        for (int j = 0; j < 4; ++j) { a[j] = xf[j] + pf[j] * sigm(v0[j]); b[j] = xf[4 + j] + pf[4 + j] * sigm(v1[j]); }
        *(f32x4*)(y + i) = a; *(f32x4*)(y + i + 4) = b;
    }
};
template <class E> __device__ __forceinline__ void run_gemm_epi(unsigned char* lds, const bf16_t* A, const bf16_t* Bt, int N, int K, const E& e) {
    asm volatile("" : "+s"(K)); asm volatile("" : "+s"(N));
    pg8::Gemm g; g.A = A; g.Bt = Bt; g.M = MT; g.N = N; g.K = K;
    pg8::StaticOrder S; S.init(MT, N, (int)gridDim.x, (int)blockIdx.x);
    pg8::gemm_phase<E, pg8::StaticOrder, false>((PG8_LAS unsigned char*)lds, g, S, e, nullptr);
    __syncthreads();
}
template <class F> __device__ __forceinline__ void run_gemm(unsigned char* lds, const bf16_t* A, const bf16_t* Bt, int N, int K, const F& f) {
    asm volatile("" : "+s"(K)); asm volatile("" : "+s"(N));
    pg8::Gemm g; g.A = A; g.Bt = Bt; g.M = MT; g.N = N; g.K = K;
    pg8::StaticOrder S; S.init(MT, N, (int)gridDim.x, (int)blockIdx.x);
    EpiT<F> E; E.f = f;
    pg8::gemm_phase<EpiT<F>, pg8::StaticOrder, false>((PG8_LAS unsigned char*)lds, g, S, E, nullptr);
    __syncthreads();
}

template <bool ILV = false> __device__ __forceinline__ void transpose_w(const float* W, bf16_t* Bt, int K, int N, const float* gain, float* tile, int& toff) {
    const int nnt = N / 64, ntiles = (K / 64) * nnt, tid = threadIdx.x, G = gridDim.x;
    const int first = ((int)blockIdx.x - (toff % G) + G) % G;
    const int r0 = tid >> 6, c = tid & 63;
    float v[8];
#define TR_LOAD(t_) do { const int kt_ = (t_) / nnt, d0_ = ((t_) % nnt) * 64; \
        const int sc0_ = ILV ? (((d0_ & 255) < 128) ? (d0_ >> 8) * 128 + (d0_ & 127) : DFF + (d0_ >> 8) * 128 + (d0_ & 127)) : d0_; \
        _Pragma("unroll") for (int i = 0; i < 8; ++i) { const int r = r0 + 8 * i; float x = W[(size_t)(kt_ * 64 + r) * N + sc0_ + c]; if (gain) x *= gain[kt_ * 64 + r]; v[i] = x; } } while (0)
    if (first < ntiles) TR_LOAD(first);
    for (int t = first; t < ntiles; t += G) {
        const int kt = t / nnt, nt = t % nnt;
#pragma unroll
        for (int i = 0; i < 8; ++i) tile[(r0 + 8 * i) * 65 + c] = v[i];
        __syncthreads();
        if (t + G < ntiles) TR_LOAD(t + G);
        { const int n = tid >> 3, k8 = (tid & 7) * 8; u32x4 wv;
          wv.x = pk2(tile[(k8 + 0) * 65 + n], tile[(k8 + 1) * 65 + n]); wv.y = pk2(tile[(k8 + 2) * 65 + n], tile[(k8 + 3) * 65 + n]);
          wv.z = pk2(tile[(k8 + 4) * 65 + n], tile[(k8 + 5) * 65 + n]); wv.w = pk2(tile[(k8 + 6) * 65 + n], tile[(k8 + 7) * 65 + n]);
          *(u32x4*)(Bt + (size_t)(nt * 64 + n) * K + kt * 64 + k8) = wv; }
        __syncthreads();
    }
#undef TR_LOAD
    toff += ntiles;
}
__device__ __forceinline__ const float* xrow(const Prm& p, int row) { return row < MP ? p.in[I_XP] + (size_t)row * 1024 : p.in[I_XS] + (size_t)(row - MP) * 1024; }

__device__ __forceinline__ void phase0(const Prm& p, unsigned char* lds) {
    float* tile = (float*)lds; int toff = 0; unsigned char* ws = p.ws;
    transpose_w(p.in[I_WIN], (bf16_t*)(ws + WS_WIN), 1024, NIN, p.in[I_GPM], tile, toff);
    transpose_w<true>(p.in[I_WUP], (bf16_t*)(ws + WS_WUP), 1024, 2 * DFF, p.in[I_GPF], tile, toff);
    transpose_w(p.in[I_WDOWN], (bf16_t*)(ws + WS_WDOWN), DFF, 1024, nullptr, tile, toff);
    transpose_w(p.in[I_WBRA], (bf16_t*)(ws + WS_WBRA), 1024, 1024, nullptr, tile, toff);
    transpose_w(p.in[I_WBRB], (bf16_t*)(ws + WS_WBRB), 1024, 1024, nullptr, tile, toff);
    transpose_w(p.in[I_WOUT], (bf16_t*)(ws + WS_WOUT), 1024, 1024, nullptr, tile, toff);
    transpose_w(p.in[I_WPG], (bf16_t*)(ws + WS_WPG), 1024, 1024, nullptr, tile, toff);
    transpose_w(p.in[I_WPLE], (bf16_t*)(ws + WS_WPLE), 256, 1024, nullptr, tile, toff);
    bf16_t* xn = (bf16_t*)p.out;
    const int lane = threadIdx.x & 63, gw = blockIdx.x * 8 + (threadIdx.x >> 6), nw = gridDim.x * 8;
    for (int row = gw; row < MT; row += nw) {
        const float* xr = xrow(p, row); f32x4 v[4]; float ss = 0.f;
#pragma unroll
        for (int i = 0; i < 4; ++i) { v[i] = *(const f32x4*)(xr + i * 256 + lane * 4); ss += v[i][0] * v[i][0] + v[i][1] * v[i][1] + v[i][2] * v[i][2] + v[i][3] * v[i][3]; }
        ss = wsum(ss); const float rs = rsqrtf(ss * (1.0f / 1024.0f) + EPS);
#pragma unroll
        for (int i = 0; i < 4; ++i) *(u32x2*)(xn + (size_t)row * 1024 + i * 256 + lane * 4) = pk4(v[i] * rs);
    }
}

constexpr int AT_KS = 0, AT_VT = 27648, AT_BT = 53248;
__device__ __forceinline__ void attn_bias_table(const Prm& p, unsigned char* lds) {
    float* bT = (float*)(lds + AT_BT); const float* tab = p.in[I_RB];
    for (int i = threadIdx.x; i < 16 * 256; i += 512) {
        const int head = i >> 8, idx = i & 255, rel = idx - 191, n = rel < 0 ? -rel : rel;
        int bk = n < 8 ? n : min(15, 33 - __clz(n * n)); if (rel > 0) bk += 16;
        bT[i] = idx < 255 ? tab[bk * 16 + head] : 0.f;
    }
}
template <int NKT, int NQT, bool SAMPLE>
__device__ __forceinline__ void attn_item(const Prm& p, unsigned char* lds, int b, int c, int kvh, bf16_t* YA) {
    bf16_t* Ks = (bf16_t*)(lds + AT_KS); bf16_t* Vt = (bf16_t*)(lds + AT_VT); const float* bT = (const float*)(lds + AT_BT);
    const bf16_t* kv = (const bf16_t*)(p.ws + WS_KV); bf16_t* R0 = (bf16_t*)(p.ws + WS_R0);
    const int tid = threadIdx.x, lane = tid & 63, w = tid >> 6, lr = lane & 15, lq = lane >> 4;
    const int head = kvh * 8 + w; const int qrow0 = SAMPLE ? MP + b * 32 : b * 2048 + c * 64;
    const size_t qoff0 = (size_t)(qrow0 + lr) * 1024 + head * 64 + lq * 8;
    bf16x8 qn0 = *(const bf16x8*)(R0 + qoff0), qn1 = *(const bf16x8*)(R0 + qoff0 + 32);
    __syncthreads();
    if (!SAMPLE) {
        const int tok0 = b * 2048 + (c - 2) * 64;
        for (int id = tid; id < 192 * 8; id += 512) {
            const int key = id >> 3, dc = id & 7; u32x4 v = {0u, 0u, 0u, 0u};
            if (c * 64 - 128 + key >= 0) v = *(const u32x4*)(kv + (size_t)(tok0 + key) * 256 + kvh * 64 + dc * 8);
            *(u32x4*)(Ks + key * 72 + dc * 8) = v;
        }
        for (int id = tid; id < 192 * 8; id += 512) {
            const int key = id % 192, dc = id / 192; u32x4 v = {0u, 0u, 0u, 0u};
            if (c * 64 - 128 + key >= 0) v = *(const u32x4*)(kv + (size_t)(tok0 + key) * 256 + 128 + kvh * 64 + dc * 8);
            bf16_t* d = Vt + (dc * 8) * 200 + key;
            d[0] = (bf16_t)(v.x & 0xffffu); d[200] = (bf16_t)(v.x >> 16); d[400] = (bf16_t)(v.y & 0xffffu); d[600] = (bf16_t)(v.y >> 16);
            d[800] = (bf16_t)(v.z & 0xffffu); d[1000] = (bf16_t)(v.z >> 16); d[1200] = (bf16_t)(v.w & 0xffffu); d[1400] = (bf16_t)(v.w >> 16);
        }
    } else {
        const float* ck = p.in[I_CK]; const float* cvp = p.in[I_CV];
        for (int id = tid; id < 160 * 8; id += 512) {
            const int key = id >> 3, dc = id & 7; u32x4 v;
            if (key < 128) { const float* s = ck + (size_t)(b * 128 + key) * 128 + kvh * 64 + dc * 8; v = pk8(*(const f32x4*)s, *(const f32x4*)(s + 4)); }
            else v = *(const u32x4*)(kv + (size_t)(MP + b * 32 + key - 128) * 256 + kvh * 64 + dc * 8);
            *(u32x4*)(Ks + key * 72 + dc * 8) = v;
        }
        for (int id = tid; id < 160 * 8; id += 512) {
            const int key = id % 160, dc = id / 160; u32x4 v;
            if (key < 128) { const float* s = cvp + (size_t)(b * 128 + key) * 128 + kvh * 64 + dc * 8; v = pk8(*(const f32x4*)s, *(const f32x4*)(s + 4)); }
            else v = *(const u32x4*)(kv + (size_t)(MP + b * 32 + key - 128) * 256 + 128 + kvh * 64 + dc * 8);
            bf16_t* d = Vt + (dc * 8) * 200 + key;
            d[0] = (bf16_t)(v.x & 0xffffu); d[200] = (bf16_t)(v.x >> 16); d[400] = (bf16_t)(v.y & 0xffffu); d[600] = (bf16_t)(v.y >> 16);
            d[800] = (bf16_t)(v.z & 0xffffu); d[1000] = (bf16_t)(v.z >> 16); d[1200] = (bf16_t)(v.w & 0xffffu); d[1400] = (bf16_t)(v.w >> 16);
        }
    }
    __syncthreads();
    const float sink = p.in[I_SINK][head];
    const float* bTh = bT + head * 256;
#pragma unroll 1
    for (int qi = 0; qi < NQT; ++qi) {
        const int q = qi * 16 + lr;
        const bf16x8 qf0 = qn0, qf1 = qn1;
        if (qi + 1 < NQT) { qn0 = *(const bf16x8*)(R0 + qoff0 + (size_t)(qi + 1) * 16384); qn1 = *(const bf16x8*)(R0 + qoff0 + (size_t)(qi + 1) * 16384 + 32); }
        f32x4 s[NKT];
#pragma unroll
        for (int kt = 0; kt < NKT; ++kt) {
            const bf16_t* kp = Ks + (kt * 16 + lr) * 72 + lq * 8;
            const bf16x8 k0 = *(const bf16x8*)kp, k1 = *(const bf16x8*)(kp + 32);
            f32x4 a = {0.f, 0.f, 0.f, 0.f}; a = MFMA16(k0, qf0, a); a = MFMA16(k1, qf1, a); s[kt] = a;
        }
        float mx = sink;
#pragma unroll
        for (int kt = 0; kt < NKT; ++kt)
#pragma unroll
            for (int r = 0; r < 4; ++r) {
                const int key = kt * 16 + lq * 4 + r; float v = s[kt][r] * 0.125f + bTh[key - q + 63];
                if (!SAMPLE && (c * 64 - 128 + key < 0)) v = -1e30f;
                s[kt][r] = v; mx = fmaxf(mx, v);
            }
        mx = fmaxf(mx, __shfl_xor(mx, 16)); mx = fmaxf(mx, __shfl_xor(mx, 32));
        float sum = 0.f;
#pragma unroll
        for (int kt = 0; kt < NKT; ++kt)
#pragma unroll
            for (int r = 0; r < 4; ++r) { const float e = __expf(s[kt][r] - mx); s[kt][r] = e; sum += e; }
        sum += __shfl_xor(sum, 16); sum += __shfl_xor(sum, 32);
        const float inv = 1.0f / (sum + __expf(sink - mx));
        f32x4 o[4];
#pragma unroll
        for (int dt = 0; dt < 4; ++dt) o[dt] = (f32x4){0.f, 0.f, 0.f, 0.f};
#pragma unroll
        for (int ks = 0; ks < NKT / 2; ++ks) {
            const u32x4 pw = pk8(s[2 * ks], s[2 * ks + 1]); const bf16x8 pf = __builtin_bit_cast(bf16x8, pw);
#pragma unroll
            for (int dt = 0; dt < 4; ++dt) {
                const bf16_t* vp = Vt + (dt * 16 + lr) * 200 + ks * 32 + lq * 4;
                const u32x2 lo = *(const u32x2*)vp, hi = *(const u32x2*)(vp + 16);
                const u32x4 vw = {lo.x, lo.y, hi.x, hi.y};
                o[dt] = MFMA16(__builtin_bit_cast(bf16x8, vw), pf, o[dt]);
            }
        }
#pragma unroll
        for (int dt = 0; dt < 4; ++dt) *(u32x2*)(YA + (size_t)(qrow0 + q) * 1024 + head * 64 + dt * 16 + lq * 4) = pk4(o[dt] * inv);
    }
}

template <int L, bool SAMPLE>
__device__ __forceinline__ void hgrn_seq(const Prm& p, unsigned char* lds, int b, int h, bf16_t* YB) {
    constexpr int RPG = L / 8, NT = L / 16, NCH = SAMPLE ? 1 : 32, NP = 8 / NT;
    bf16_t* Qd = (bf16_t*)lds; bf16_t* Qm = Qd + 64 * 136; bf16_t* Km = Qm + 64 * 136; bf16_t* KlT = Km + 64 * 136; bf16_t* Vt = KlT + 128 * 72; bf16_t* St = Vt + 128 * 72; bf16_t* Al = St + 128 * 136;
    float* tot = (float*)(Al + 64 * 72); float* first = tot + 1024; float* decay = first + 1024; float* ssq = decay + 128;
    const bf16_t* R1 = (const bf16_t*)(p.ws + WS_R0 + UB); const bf16_t* R2 = (const bf16_t*)(p.ws + WS_R0 + 2 * UB); const bf16_t* R3 = (const bf16_t*)(p.ws + WS_R0 + 3 * UB); const bf16_t* R4 = (const bf16_t*)(p.ws + WS_R0 + 4 * UB);
    const int tid = threadIdx.x, lane = tid & 63, w = tid >> 6, lr = lane & 15, lq = lane >> 4, cp = lane, rg = w, c0 = 2 * cp;
    float lb[2];
#pragma unroll
    for (int c = 0; c < 2; ++c) { const float l0 = p.in[I_LB][h * 128 + c0 + c], l1 = p.in[I_LB][1024 + h * 128 + c0 + c]; lb[c] = 1.0f / (1.0f + __expf(l1 - l0)); }
    f32x4 S[8];
#pragma unroll
    for (int dvt = 0; dvt < 8; ++dvt) {
        if (SAMPLE) {
#pragma unroll
            for (int r = 0; r < 4; ++r) S[dvt][r] = p.in[I_ST][((size_t)(b * 8 + h) * 128 + 16 * w + 4 * lq + r) * 128 + 16 * dvt + lr];
        } else S[dvt] = (f32x4){0.f, 0.f, 0.f, 0.f};
    }
    const int tt = w % NT, dv0 = (w / NT) * NT;
    const int rowbase = SAMPLE ? MP + b * 32 : b * 2048;
    f32x4 ggv[NT];
#pragma unroll
    for (int i = 0; i < NT; ++i) ggv[i] = *(const f32x4*)(p.in[I_GH] + 16 * (dv0 + i) + 4 * lq);
    unsigned qw[RPG], fw[RPG], vw[RPG];
#pragma unroll
    for (int i = 0; i < RPG; ++i) { const size_t idx = (size_t)(rowbase + rg * RPG + i) * 1024 + h * 128 + c0; qw[i] = *(const unsigned*)(R1 + idx); fw[i] = *(const unsigned*)(R2 + idx); vw[i] = *(const unsigned*)(R3 + idx); }
#pragma unroll 1
    for (int ch = 0; ch < NCH; ++ch) {
        const int row0 = rowbase + ch * L;
        float qv[2][RPG], cv[2][RPG], kk[2][RPG]; unsigned vkeep[RPG]; float run[2] = {0.f, 0.f}, lf0[2] = {0.f, 0.f};
#pragma unroll
        for (int i = 0; i < RPG; ++i) {
            vkeep[i] = vw[i];
#pragma unroll
            for (int c = 0; c < 2; ++c) {
                const float q = c ? bfhi(qw[i]) : bflo(qw[i]), fl = c ? bfhi(fw[i]) : bflo(fw[i]);
                const float f = lb[c] + (1.0f - lb[c]) * sigm(fl), lf = __logf(f);
                run[c] += lf; cv[c][i] = run[c]; kk[c][i] = 1.0f - f; qv[c][i] = q * sigm(q); if (i == 0) lf0[c] = lf;
            }
        }
        *(f32x2v*)(tot + rg * 128 + c0) = (f32x2v){run[0], run[1]}; *(f32x2v*)(first + rg * 128 + c0) = (f32x2v){lf0[0], lf0[1]};
        if (ch + 1 < NCH) {
#pragma unroll
            for (int i = 0; i < RPG; ++i) { const size_t idx = (size_t)(row0 + L + rg * RPG + i) * 1024 + h * 128 + c0; qw[i] = *(const unsigned*)(R1 + idx); fw[i] = *(const unsigned*)(R2 + idx); vw[i] = *(const unsigned*)(R3 + idx); }
        }
        const size_t rbase = (size_t)(row0 + tt * 16 + lr) * 1024 + h * 128;
        u32x2 ogw[NT];
#pragma unroll
        for (int i = 0; i < NT; ++i) ogw[i] = *(const u32x2*)(R4 + rbase + 16 * (dv0 + i) + 4 * lq);
        __syncthreads();
        {
            float pre[2] = {0.f, 0.f}, bmid[2], blast[2], emid[2], elm[2];
#pragma unroll
            for (int c = 0; c < 2; ++c) {
                float acc = 0.f, half = 0.f;
#pragma unroll
                for (int j = 0; j < 8; ++j) { const float t = tot[j * 128 + c0 + c]; if (j < rg) pre[c] += t; if (j < 4) half += t; acc += t; }
                bmid[c] = half + first[4 * 128 + c0 + c]; blast[c] = acc; emid[c] = __expf(bmid[c]); elm[c] = __expf(blast[c] - bmid[c]);
            }
            float kl[2][RPG];
#pragma unroll
            for (int i = 0; i < RPG; ++i) {
                const int r = rg * RPG + i; float qd[2], qm[2], km[2];
#pragma unroll
                for (int c = 0; c < 2; ++c) {
                    const float E = __expf(pre[c] + cv[c][i] - bmid[c]), Ei = __builtin_amdgcn_rcpf(E);
                    qm[c] = qv[c][i] * E; qd[c] = qm[c] * emid[c]; km[c] = kk[c][i] * Ei; kl[c][i] = km[c] * elm[c];
                }
                *(unsigned*)(Qd + r * 136 + c0) = pk2(qd[0], qd[1]); *(unsigned*)(Qm + r * 136 + c0) = pk2(qm[0], qm[1]); *(unsigned*)(Km + r * 136 + c0) = pk2(km[0], km[1]);
            }
#pragma unroll
            for (int c = 0; c < 2; ++c) {
#pragma unroll
                for (int i = 0; i < RPG; i += 4) {
                    u32x2 a, v2; a.x = pk2(kl[c][i], kl[c][i + 1]); a.y = pk2(kl[c][i + 2], kl[c][i + 3]);
                    if (c == 0) { v2.x = (vkeep[i] & 0xffffu) | (vkeep[i + 1] << 16); v2.y = (vkeep[i + 2] & 0xffffu) | (vkeep[i + 3] << 16); }
                    else { v2.x = (vkeep[i] >> 16) | (vkeep[i + 1] & 0xffff0000u); v2.y = (vkeep[i + 2] >> 16) | (vkeep[i + 3] & 0xffff0000u); }
                    *(u32x2*)(KlT + (c0 + c) * 72 + rg * RPG + i) = a; *(u32x2*)(Vt + (c0 + c) * 72 + rg * RPG + i) = v2;
                }
            }
            if (rg == 0) *(f32x2v*)(decay + c0) = (f32x2v){__expf(blast[0]), __expf(blast[1])};
        }
#pragma unroll
        for (int dvt = 0; dvt < 8; ++dvt) *(u32x2*)(St + (16 * dvt + lr) * 136 + 16 * w + 4 * lq) = pk4(S[dvt]);
        __syncthreads();
        for (int id = w; id < NT * NT; id += 8) {
            const int st = id / NT, t2 = id % NT; f32x4 acc = {0.f, 0.f, 0.f, 0.f};
#pragma unroll
            for (int ks = 0; ks < 4; ++ks) acc = MFMA16(*(const bf16x8*)(Km + (st * 16 + lr) * 136 + ks * 32 + lq * 8), *(const bf16x8*)(Qm + (t2 * 16 + lr) * 136 + ks * 32 + lq * 8), acc);
            const int t = t2 * 16 + lr;
#pragma unroll
            for (int r = 0; r < 4; ++r) if (st * 16 + 4 * lq + r > t) acc[r] = 0.f;
            *(u32x2*)(Al + t * 72 + st * 16 + 4 * lq) = pk4(acc);
        }
        f32x4 o[NT];
#pragma unroll
        for (int i = 0; i < NT; ++i) {
            f32x4 acc = {0.f, 0.f, 0.f, 0.f};
#pragma unroll
            for (int ks = 0; ks < 4; ++ks) acc = MFMA16(*(const bf16x8*)(St + (16 * (dv0 + i) + lr) * 136 + ks * 32 + lq * 8), *(const bf16x8*)(Qd + (tt * 16 + lr) * 136 + ks * 32 + lq * 8), acc);
            o[i] = acc;
        }
        __syncthreads();
        float sq = 0.f;
#pragma unroll
        for (int i = 0; i < NT; ++i) {
#pragma unroll
            for (int ks = 0; ks < L / 32; ++ks) o[i] = MFMA16(*(const bf16x8*)(Vt + (16 * (dv0 + i) + lr) * 72 + ks * 32 + lq * 8), *(const bf16x8*)(Al + (tt * 16 + lr) * 72 + ks * 32 + lq * 8), o[i]);
            sq += o[i][0] * o[i][0] + o[i][1] * o[i][1] + o[i][2] * o[i][2] + o[i][3] * o[i][3];
        }
        sq += __shfl_xor(sq, 16); sq += __shfl_xor(sq, 32);
        if (lq == 0) ssq[(w / NT) * 64 + tt * 16 + lr] = sq;
        {
            const f32x4 dc = *(const f32x4*)(decay + 16 * w + 4 * lq);
#pragma unroll
            for (int dvt = 0; dvt < 8; ++dvt) {
                f32x4 acc = S[dvt] * dc;
#pragma unroll
                for (int ks = 0; ks < L / 32; ++ks) acc = MFMA16(*(const bf16x8*)(KlT + (16 * w + lr) * 72 + ks * 32 + lq * 8), *(const bf16x8*)(Vt + (16 * dvt + lr) * 72 + ks * 32 + lq * 8), acc);
                S[dvt] = acc;
            }
        }
        __syncthreads();
        {
            float tsq = 0.f;
#pragma unroll
            for (int j = 0; j < NP; ++j) tsq += ssq[j * 64 + tt * 16 + lr];
            const float rs = rsqrtf(tsq * (1.0f / 128.0f) + EPS);
#pragma unroll
            for (int i = 0; i < NT; ++i) {
                const int dvb = 16 * (dv0 + i) + 4 * lq;
                const f32x4 gg = ggv[i];
                const float og0 = bflo(ogw[i].x), og1 = bfhi(ogw[i].x), og2 = bflo(ogw[i].y), og3 = bfhi(ogw[i].y);
                f32x4 y; y[0] = o[i][0] * rs * gg[0] * og0 * sigm(og0); y[1] = o[i][1] * rs * gg[1] * og1 * sigm(og1); y[2] = o[i][2] * rs * gg[2] * og2 * sigm(og2); y[3] = o[i][3] * rs * gg[3] * og3 * sigm(og3);
                *(u32x2*)(YB + rbase + dvb) = pk4(y);
            }
        }
    }
    float* so = p.out + (SAMPLE ? O_SST : O_PST) + (size_t)(b * 8 + h) * 16384;
#pragma unroll
    for (int dvt = 0; dvt < 8; ++dvt)
#pragma unroll
        for (int r = 0; r < 4; ++r) so[(16 * w + 4 * lq + r) * 128 + 16 * dvt + lr] = S[dvt][r];
    __syncthreads();
}

__device__ __forceinline__ void phase_rp5(const Prm& p) {
    const bf16_t* O = (const bf16_t*)(p.ws + WS_R0 + 4 * UB); bf16_t* hf = (bf16_t*)(p.ws + WS_R0); const float* g = p.in[I_GPOST];
    const int lane = threadIdx.x & 63, gw = blockIdx.x * 8 + (threadIdx.x >> 6), nw = gridDim.x * 8;
    for (int row = gw; row < MT; row += nw) {
        const float* xr = xrow(p, row); const bf16_t* orow = O + (size_t)row * 1024; f32x4 v[4], x[4]; float ss = 0.f;
#pragma unroll
        for (int i = 0; i < 4; ++i) { { const u32x2 ow = *(const u32x2*)(orow + i * 256 + lane * 4); v[i] = (f32x4){bflo(ow.x), bfhi(ow.x), bflo(ow.y), bfhi(ow.y)}; } x[i] = *(const f32x4*)(xr + i * 256 + lane * 4); ss += v[i][0] * v[i][0] + v[i][1] * v[i][1] + v[i][2] * v[i][2] + v[i][3] * v[i][3]; }
        ss = wsum(ss); const float rs = rsqrtf(ss * (1.0f / 1024.0f) + EPS); float s2 = 0.f;
#pragma unroll
        for (int i = 0; i < 4; ++i) { const f32x4 gg = *(const f32x4*)(g + i * 256 + lane * 4); x[i] += v[i] * rs * gg; s2 += x[i][0] * x[i][0] + x[i][1] * x[i][1] + x[i][2] * x[i][2] + x[i][3] * x[i][3];
            *(u32x2*)((bf16_t*)p.out + (size_t)row * 1024 + i * 256 + lane * 4) = pk4(x[i]); }
        s2 = wsum(s2); const float r2 = rsqrtf(s2 * (1.0f / 1024.0f) + EPS);
#pragma unroll
        for (int i = 0; i < 4; ++i) *(u32x2*)(hf + (size_t)row * 1024 + i * 256 + lane * 4) = pk4(x[i] * r2);
    }
    bf16_t* pbf = (bf16_t*)(p.ws + WS_KV);
    for (int id = blockIdx.x * 512 + threadIdx.x; id < MT * 32; id += gridDim.x * 512) {
        const int row = id >> 5, c = (id & 31) * 8;
        const float* s = (row < MP ? p.in[I_PP] + (size_t)row * 256 : p.in[I_PS] + (size_t)(row - MP) * 256) + c;
        *(u32x4*)(pbf + (size_t)row * 256 + c) = pk8(*(const f32x4*)s, *(const f32x4*)(s + 4));
    }
}
__device__ __forceinline__ void phase_rp8(const Prm& p) {
    const bf16_t* O = (const bf16_t*)(p.ws + WS_R0 + UB); bf16_t* xb = (bf16_t*)(p.ws + WS_R0 + 3 * UB); const float* g = p.in[I_GPFF];
    const int lane = threadIdx.x & 63, gw = blockIdx.x * 8 + (threadIdx.x >> 6), nw = gridDim.x * 8;
    for (int row = gw; row < MT; row += nw) {
        const bf16_t* xr = (const bf16_t*)p.out + (size_t)row * 1024; const bf16_t* orow = O + (size_t)row * 1024; f32x4 v[4], x[4]; float ss = 0.f;
#pragma unroll
        for (int i = 0; i < 4; ++i) { { const u32x2 ow = *(const u32x2*)(orow + i * 256 + lane * 4); v[i] = (f32x4){bflo(ow.x), bfhi(ow.x), bflo(ow.y), bfhi(ow.y)}; } { const u32x2 xw = *(const u32x2*)(xr + i * 256 + lane * 4); x[i] = (f32x4){bflo(xw.x), bfhi(xw.x), bflo(xw.y), bfhi(xw.y)}; } ss += v[i][0] * v[i][0] + v[i][1] * v[i][1] + v[i][2] * v[i][2] + v[i][3] * v[i][3]; }
        ss = wsum(ss); const float rs = rsqrtf(ss * (1.0f / 1024.0f) + EPS);
#pragma unroll
        for (int i = 0; i < 4; ++i) { const f32x4 gg = *(const f32x4*)(g + i * 256 + lane * 4); x[i] += v[i] * rs * gg;
            *(u32x2*)(xb + (size_t)row * 1024 + i * 256 + lane * 4) = pk4(x[i]); }
    }
}
__device__ __forceinline__ void phase_conv(const Prm& p) {
    const bf16_t* A = (const bf16_t*)(p.ws + WS_R0 + UB); bf16_t* Ug = (bf16_t*)(p.ws + WS_R0 + UB + A_BYTES);
    const float* wc = p.in[I_WCONV]; const float* bc = p.in[I_BCONV]; const float* cc = p.in[I_CC];
    for (int id = blockIdx.x * 512 + threadIdx.x; id < 2112 * 352; id += gridDim.x * 512) {
        const int ri = id / 352, c0 = (id % 352) * 8;
        int row; if (ri < 2048) row = (ri >> 1) * 64 + (ri & 1); else { const int j = ri - 2048; row = MP + (j >> 1) * 32 + (j & 1); }
        float am2[8], am1[8], a[8], u[8], gq[8];
#pragma unroll
        for (int j = 0; j < 8; ++j) { am2[j] = 0.f; am1[j] = 0.f; }
        if (row < MP) {
            const int t = row & 2047;
            if (t >= 1) unpk8(*(const u32x4*)(A + (size_t)(row - 1) * DFF + c0), am1);
            if (t >= 2) unpk8(*(const u32x4*)(A + (size_t)(row - 2) * DFF + c0), am2);
        } else {
            const int rs = row - MP, b = rs >> 5, t = rs & 31;
            if (t == 0) {
#pragma unroll
                for (int j = 0; j < 8; ++j) { am2[j] = cc[(size_t)(b * 2) * DFF + c0 + j]; am1[j] = cc[(size_t)(b * 2 + 1) * DFF + c0 + j]; }
            } else {
#pragma unroll
                for (int j = 0; j < 8; ++j) am2[j] = cc[(size_t)(b * 2 + 1) * DFF + c0 + j];
                unpk8(*(const u32x4*)(A + (size_t)(row - 1) * DFF + c0), am1);
            }
        }
        const size_t off = (size_t)row * DFF + c0;
        unpk8(*(const u32x4*)(A + off), a); unpk8(*(const u32x4*)(Ug + off), u);
#pragma unroll
        for (int j = 0; j < 8; ++j) {
            const float ac = bc[c0 + j] + wc[c0 + j] * am2[j] + wc[DFF + c0 + j] * am1[j] + wc[2 * DFF + c0 + j] * a[j];
            const float y = 1.5957691216f * (ac + 0.044715f * ac * ac * ac);
            gq[j] = ac * sigm(y) * u[j];
        }
        u32x4 wv; wv.x = pk2(gq[0], gq[1]); wv.y = pk2(gq[2], gq[3]); wv.z = pk2(gq[4], gq[5]); wv.w = pk2(gq[6], gq[7]);
        *(u32x4*)(Ug + off) = wv;
    }
}

#ifndef PROBE_DUP
#define PROBE_DUP 0
#endif
#ifndef P2M
#define P2M 15
#endif
#ifndef PHM
#define PHM 0xfff
#endif

#define XB_TMO      128
#define XB_XCNT(j)  (256  + 64 * (j))
#define XB_XSUB(j)  (1280 + 64 * (j))
#define XB_XGEN(j)  (2304 + 64 * (j))
#define XB_TOP      3328
#define XB_TOPGEN   3392
#define XCD_BAR_WORDS 3456
#define XB_SPIN_CAP (1u << 18)
#define LAS __attribute__((address_space(3)))

__device__ __forceinline__ unsigned xb_ld(unsigned* p)              { return __hip_atomic_load(p, __ATOMIC_RELAXED, __HIP_MEMORY_SCOPE_AGENT); }
__device__ __forceinline__ unsigned xb_add(unsigned* p, unsigned v) { return __hip_atomic_fetch_add(p, v, __ATOMIC_RELAXED, __HIP_MEMORY_SCOPE_AGENT); }
__device__ __forceinline__ unsigned xb_xcc_id() { return (unsigned)__builtin_amdgcn_s_getreg((3 << 11) | 20) & 0xFu; }
#define XB_SPIN(cond, bar) do { unsigned _sp = 0; while (cond) { __builtin_amdgcn_s_sleep(1); \
    if ((++_sp & 255u) == 0u) { if (xb_ld(&(bar)[XB_TMO])) break; if (_sp > XB_SPIN_CAP) { atomicAdd(&(bar)[XB_TMO], 1u); break; } } } } while (0)
struct XcdBarrier {
    unsigned* bar; unsigned x;
    volatile LAS unsigned* st;
};

__device__ __forceinline__ XcdBarrier xcd_barrier_post(unsigned* bar, volatile LAS unsigned* st) {
    XcdBarrier b; b.bar = bar; b.x = xb_xcc_id(); b.st = st;
    if (threadIdx.x == 0) (void)xb_add(&bar[XB_XCNT(b.x)], 1u);
    return b;
}
__device__ __forceinline__ void xcd_barrier_complete(unsigned* bar, unsigned x, unsigned& nloc, unsigned& nx) {
    const unsigned G = gridDim.x * gridDim.y * gridDim.z;
    unsigned sum, cnt, mine, sp = 0u;
    for (;;) {
        sum = 0u; cnt = 0u; mine = 0u;
#pragma unroll
        for (unsigned j = 0; j < 16; ++j) { const unsigned c = xb_ld(&bar[XB_XCNT(j)]); sum += c; cnt += (c > 0u) ? 1u : 0u; mine = (j == x) ? c : mine; }
        if (sum == G) break;
        __builtin_amdgcn_s_sleep(1);
        if ((++sp & 255u) == 0u) { if (xb_ld(&bar[XB_TMO])) break; if (sp > XB_SPIN_CAP) { atomicAdd(&bar[XB_TMO], 1u); break; } }
    }
    nloc = mine > 0u ? mine : 1u; nx = cnt > 0u ? cnt : 1u;
}

__device__ __forceinline__ void xcd_barrier(const XcdBarrier& b) {
    asm volatile("s_waitcnt vmcnt(0)" ::: "memory");
    __syncthreads();
    if (threadIdx.x == 0) {
        unsigned* bar = b.bar;
        __builtin_amdgcn_s_waitcnt(0);
        unsigned nloc = b.st[0], nx = b.st[1];
        if (nloc == 0u) { xcd_barrier_complete(bar, b.x, nloc, nx); b.st[0] = nloc; b.st[1] = nx; }
        const unsigned old = xb_add(&bar[XB_XSUB(b.x)], 1u);
        const unsigned gen = old / nloc;
        if (old + 1u == (gen + 1u) * nloc) {
            __builtin_amdgcn_fence(__ATOMIC_RELEASE, "agent");
            asm volatile("s_waitcnt vmcnt(0)" ::: "memory");
            const unsigned og = xb_add(&bar[XB_TOP], 1u);
            const unsigned tg = og / nx;
            if (og + 1u == (tg + 1u) * nx) xb_add(&bar[XB_TOPGEN], 1u);
            else XB_SPIN(xb_ld(&bar[XB_TOPGEN]) == tg, bar);
            __builtin_amdgcn_fence(__ATOMIC_ACQUIRE, "agent");
            xb_add(&bar[XB_XGEN(b.x)], 1u);
            asm volatile("s_waitcnt vmcnt(0)" ::: "memory");
        } else {
            XB_SPIN(xb_ld(&bar[XB_XGEN(b.x)]) == gen, bar);
            __builtin_amdgcn_fence(__ATOMIC_ACQUIRE, "agent");
            asm volatile("s_waitcnt vmcnt(0)" ::: "memory");
        }
    }
    __syncthreads();
}

__global__ void __launch_bounds__(512, 2) fwd_mega(Prm p, int ph_lo, int ph_hi) {
    extern __shared__ __attribute__((aligned(16))) unsigned char lds[];
    cg::grid_group grid = cg::this_grid();
    unsigned char* ws = p.ws;
    bf16_t* R0 = (bf16_t*)(ws + WS_R0);
#define REG(i) ((bf16_t*)(ws + WS_R0 + (size_t)(i) * UB))
    unsigned* barw = (unsigned*)(ws + WS_END);
    if (blockIdx.x == 0) for (int i = threadIdx.x; i < XCD_BAR_WORDS; i += 512) barw[i] = 0u;
    volatile LAS unsigned* xst = (volatile LAS unsigned*)((PG8_LAS unsigned char*)lds + (LDS_BYTES - 16));
    if (threadIdx.x < 4) xst[threadIdx.x] = 0u;
    __syncthreads();
    XcdBarrier xb; xb.bar = barw; xb.x = 0u; xb.st = xst;
    unsigned bar_k = 0;
#define GRID_SEAM() do { if (bar_k == 0) { grid.sync(); xb = xcd_barrier_post(barw, xst); } else xcd_barrier(xb); ++bar_k; } while (0)
#define PH_BEGIN(n) if (ph_lo <= (n) && (n) < ph_hi) { if ((n) > ph_lo) GRID_SEAM();
#define PH_END }
#if (PHM >> 0) & 1
        PH_BEGIN(0) phase0(p, lds);
#if PROBE_DUP == 1
        grid.sync(); phase0(p, lds);
#endif
        PH_END
#else
#endif
#if (PHM >> 1) & 1
        PH_BEGIN(1) { F1 f; f.r0 = R0; f.kv = (bf16_t*)(ws + WS_KV); f.out = p.out; run_gemm(lds, (const bf16_t*)p.out, (const bf16_t*)(ws + WS_WIN), NIN, 1024, f);
#if PROBE_DUP == 3
            grid.sync(); run_gemm(lds, (const bf16_t*)p.out, (const bf16_t*)(ws + WS_WIN), NIN, 1024, f);
#endif
        } PH_END
#else
#endif
#if (PHM >> 2) & 1
        PH_BEGIN(2) {
#if PROBE_DUP == 2
            { bf16_t* YA = (bf16_t*)p.out; bf16_t* YB = (bf16_t*)p.out + UB / 2;
            const int G = gridDim.x;
#if P2M & 1
#pragma unroll 1
            for (int s = blockIdx.x; s < 256; s += G) hgrn_seq<64, false>(p, lds, s >> 3, s & 7, YB);
#endif
#if P2M & 2
#pragma unroll 1
            for (int s = blockIdx.x; s < 256; s += G) hgrn_seq<32, true>(p, lds, s >> 3, s & 7, YB);
#endif
            __syncthreads(); attn_bias_table(p, lds); __syncthreads();
#if P2M & 4
#pragma unroll 1
            for (int it = blockIdx.x; it < 2048; it += G) attn_item<12, 4, false>(p, lds, it >> 6, (it >> 1) & 31, it & 1, YA);
#endif
#if P2M & 8
#pragma unroll 1
            for (int it = blockIdx.x; it < 64; it += G) attn_item<10, 2, true>(p, lds, it >> 1, 0, it & 1, YA);
#endif
            __syncthreads(); }
#endif
            { bf16_t* YA = REG(0); bf16_t* YB = REG(1);
            const int G = gridDim.x;
#if P2M & 1
#pragma unroll 1
            for (int s = blockIdx.x; s < 256; s += G) hgrn_seq<64, false>(p, lds, s >> 3, s & 7, YB);
#endif
#if P2M & 2
#pragma unroll 1
            for (int s = blockIdx.x; s < 256; s += G) hgrn_seq<32, true>(p, lds, s >> 3, s & 7, YB);
#endif
            __syncthreads(); attn_bias_table(p, lds); __syncthreads();
#if P2M & 4
#pragma unroll 1
            for (int it = blockIdx.x; it < 2048; it += G) attn_item<12, 4, false>(p, lds, it >> 6, (it >> 1) & 31, it & 1, YA);
#endif
#if P2M & 8
#pragma unroll 1
            for (int it = blockIdx.x; it < 64; it += G) attn_item<10, 2, true>(p, lds, it >> 1, 0, it & 1, YA);
#endif
            }
        } PH_END
#else
#endif
#if (PHM >> 3) & 1
        PH_BEGIN(3) { F2 f; f.g = REG(5); f.o = REG(2); run_gemm(lds, REG(0), (const bf16_t*)(ws + WS_WBRA), 1024, 1024, f);
#if PROBE_DUP == 4
            grid.sync(); run_gemm(lds, REG(0), (const bf16_t*)(ws + WS_WBRA), 1024, 1024, f);
#endif
        } PH_END
#else
#endif
#if (PHM >> 4) & 1
        PH_BEGIN(4) { F3 f; f.g = REG(6); f.t = REG(2); f.o = REG(3); run_gemm(lds, REG(1), (const bf16_t*)(ws + WS_WBRB), 1024, 1024, f); } PH_END
#else
#endif
#if (PHM >> 5) & 1
        PH_BEGIN(5) { FBF f; f.o = REG(4); run_gemm(lds, REG(3), (const bf16_t*)(ws + WS_WOUT), 1024, 1024, f);
#if PROBE_DUP == 5
            grid.sync(); run_gemm(lds, REG(3), (const bf16_t*)(ws + WS_WOUT), 1024, 1024, f);
#endif
        } PH_END
#else
#endif
#if (PHM >> 6) & 1
        PH_BEGIN(6) phase_rp5(p); PH_END
#else
#endif
#if (PHM >> 7) & 1
        PH_BEGIN(7) { EpiUp e; e.g = (bf16_t*)(ws + WS_R0 + UB + A_BYTES); e.araw = REG(1); e.out = p.out; e.wcv = p.in[I_WCONV]; e.bcv = p.in[I_BCONV]; run_gemm_epi(lds, REG(0), (const bf16_t*)(ws + WS_WUP), 2 * DFF, 1024, e); } PH_END
#else
#endif
#if (PHM >> 8) & 1
        PH_BEGIN(8) phase_conv(p); PH_END
#else
#endif
        PH_BEGIN(9) { FBF f; f.o = REG(1); run_gemm(lds, (const bf16_t*)(ws + WS_R0 + UB + A_BYTES), (const bf16_t*)(ws + WS_WDOWN), 1024, DFF, f);
                  FBF f2; f2.o = REG(0); run_gemm(lds, (const bf16_t*)(ws + WS_KV), (const bf16_t*)(ws + WS_WPLE), 1024, 256, f2); } PH_END
#if (PHM >> 10) & 1
        PH_BEGIN(10) phase_rp8(p); PH_END
#else
#endif
#if (PHM >> 11) & 1
        PH_BEGIN(11) { F9 f; f.pe = REG(0); f.xb = REG(3); f.y = p.out; run_gemm(lds, REG(3), (const bf16_t*)(ws + WS_WPG), 1024, 1024, f); } PH_END
#else
#endif
#undef REG
}

extern "C" void kernel_launch(void* const* d_in, const int* in_sizes, int n_in, void* d_out, int out_size, void* d_ws, size_t ws_size, hipStream_t stream) {
    static int grid = 0;
    if (grid == 0) {
        if (n_in != 26 || (size_t)out_size != O_END || ws_size < WS_END) { fprintf(stderr, "kernel_launch: unexpected shapes n_in %d out %d ws %zu (need %zu)\n", n_in, out_size, ws_size, (size_t)WS_END); grid = -1; return; }
        int dev = 0, cus = 0, per_cu = 0;
        hipGetDevice(&dev); hipDeviceGetAttribute(&cus, hipDeviceAttributeMultiprocessorCount, dev);
        if (hipFuncSetAttribute((const void*)fwd_mega, hipFuncAttributeMaxDynamicSharedMemorySize, LDS_BYTES) != hipSuccess) { fprintf(stderr, "kernel_launch: hipFuncSetAttribute failed\n"); grid = -1; return; }
        if (hipOccupancyMaxActiveBlocksPerMultiprocessor(&per_cu, (const void*)fwd_mega, 512, LDS_BYTES) != hipSuccess || per_cu < 1) { fprintf(stderr, "kernel_launch: occupancy query says %d\n", per_cu); per_cu = 1; }
        (void)hipGetLastError();
        grid = cus;
    }
    if (grid < 0) return;
    Prm p{};
    for (int i = 0; i < 26; ++i) p.in[i] = (const float*)d_in[i];
    p.out = (float*)d_out; p.ws = (unsigned char*)d_ws;
    int lo = 0, hi = 12;
    void* args[] = {&p, &lo, &hi};
    hipError_t e = hipLaunchCooperativeKernel((const void*)fwd_mega, dim3(grid), dim3(512), args, LDS_BYTES, stream);
    if (e != hipSuccess) fprintf(stderr, "kernel_launch: cooperative launch failed: %s (grid %d)\n", hipGetErrorString(e), grid);
}
```

```cpp
#include <hip/hip_runtime.h>
#include <hip/hip_cooperative_groups.h>
#include <cstdio>
namespace cg = cooperative_groups;
namespace pg8 {
#define PG8_LAS __attribute__((address_space(3)))
typedef unsigned short bf16_t;
typedef short bf16x8 __attribute__((ext_vector_type(8)));
typedef float f32x4 __attribute__((ext_vector_type(4)));
typedef unsigned u32x4 __attribute__((ext_vector_type(4)));
constexpr int BM = 256, BK = 64, HALF = 128, HTB = HALF * BK * 2  , STAGE_BYTES = 8 * HTB, NXCD = 8, WGM = 8;

__host__ __device__ __forceinline__ int lds_byte(int r, int c) { const int st = (r >> 4) * 2 + (c >> 5), rr = r & 15, cc = c & 31, ob = rr * 64 + cc * 2; return st * 1024 + (ob ^ (((ob >> 9) & 1) << 5)); }
__host__ __device__ __forceinline__ void stage_rc(int b, int& R, int& C) { const int st = b / 1024, sb = b % 1024, swz = sb ^ (((sb >> 9) & 1) << 5); R = (st >> 1) * 16 + swz / 64; C = (st & 1) * 32 + (swz % 64) / 2; }
__host__ __device__ __forceinline__ int perm32(int rho) { const int n = rho >> 4, i = rho & 15; return 8 * (i >> 2) + 4 * n + (i & 3); }

struct Unit { int pm, pn; };
struct Gemm { const bf16_t* A; const bf16_t* Bt; int M, N, K; };

struct StaticOrder {
    int nM, nN, nwg, G, c;
    __host__ __device__ void init(int M, int N, int G_, int c_) { nM = M / BM; nN = N / BM; nwg = nM * nN; G = G_; c = c_; }
    __host__ __device__ bool next(int i, Unit& u) const {
        const long L = (long)i * G + c; if (L >= nwg) return false;
        int wgid = (int)L; { const int q = nwg / NXCD, r = nwg % NXCD, xcd = wgid % NXCD, off = wgid / NXCD; wgid = (xcd < r ? xcd * (q + 1) : r * (q + 1) + (xcd - r) * q) + off; }
        const int nig = WGM * nN, gid = wgid / nig, fm = gid * WGM, gsz = (nM - fm) < WGM ? (nM - fm) : WGM;
        u.pm = fm + ((wgid % nig) % gsz); u.pn = (wgid % nig) / gsz; return true;
    }
    __device__ __forceinline__ void a_ready(const Unit&) const {}
    __device__ __forceinline__ void done(const Unit&) const {}
};
__device__ __forceinline__ unsigned cvt_pk_bf16(float lo, float hi) { unsigned r; asm volatile("v_cvt_pk_bf16_f32 %0, %1, %2" : "=v"(r) : "v"(lo), "v"(hi)); return r; }
template <class Epi, class Sched, bool STAMP = false>
__device__ __forceinline__ void gemm_phase(PG8_LAS unsigned char* lds, const Gemm g, const Sched& S, const Epi& E, unsigned long long* stamps) {
    const int tid = threadIdx.x, wid = __builtin_amdgcn_readfirstlane(tid >> 6), lane = tid & 63, wr = wid >> 2, wc = wid & 3, fr = lane & 15, fq = lane >> 4;
    const int K = g.K, nt = K / BK;
    int ts_lo = 0, ts_hi = 0, nts = 0; const unsigned long long rt_entry = STAMP ? (unsigned long long)wall_clock64() : 0ull;
#define PG8_STAMP() do { if (STAMP && wid == 0 && nts < 64) { const unsigned long long _c = (unsigned long long)clock64(); \
        ts_lo = (lane == nts) ? (int)(unsigned)_c : ts_lo; ts_hi = (lane == nts) ? (int)(unsigned)(_c >> 32) : ts_hi; ++nts; } } while (0)
    PG8_STAMP();
    unsigned voffA[2], voffB[2];
#pragma unroll
    for (int i = 0; i < 2; ++i) { int R, C; stage_rc(tid * 16 + i * 8192, R, C); const int Rb = Epi::PERM ? ((R & ~31) + perm32(R & 31)) : R;
        voffA[i] = (unsigned)(R * K + C) * 2u; voffB[i] = (unsigned)(Rb * K + C) * 2u; }
    const size_t kstep = (size_t)(BK * 2);
    const size_t hstep = (size_t)HALF * K * 2;
    const size_t tstep = 2 * hstep;
    const unsigned ldsw = (unsigned)wid * 1024u;
    const int aoff = lds_byte(wr * 64 + fr, fq * 8), boff = lds_byte(wc * 32 + fr, fq * 8);
#define PG8_SA(b, h) (((b) * 2 + (h)) * HTB)
#define PG8_SB(b, h) ((4 + (b) * 2 + (h)) * HTB)
#define PG8_STAGE(bufoff, gbase, voff) do { _Pragma("unroll") for (int _i = 0; _i < 2; ++_i) \
        __builtin_amdgcn_global_load_lds((const unsigned*)((const char*)(gbase) + (voff)[_i]), (PG8_LAS unsigned*)(lds + (bufoff) + ldsw + _i * 8192), 16, 0, 0); } while (0)
#define PG8_LDA(dst, b, h) do { _Pragma("unroll") for (int m = 0; m < 4; ++m) _Pragma("unroll") for (int k = 0; k < 2; ++k) dst[m][k] = *(const PG8_LAS bf16x8*)(lds + PG8_SA(b, h) + aoff + m * 2048 + k * 1024); } while (0)
#define PG8_LDB(dst, b, h) do { _Pragma("unroll") for (int n = 0; n < 2; ++n) _Pragma("unroll") for (int k = 0; k < 2; ++k) dst[n][k] = *(const PG8_LAS bf16x8*)(lds + PG8_SB(b, h) + boff + n * 2048 + k * 1024); } while (0)
#define PG8_MMA(ai, bj, At, Bt) do { __builtin_amdgcn_s_setprio(1); _Pragma("unroll") for (int m = 0; m < 4; ++m) _Pragma("unroll") for (int n = 0; n < 2; ++n) _Pragma("unroll") for (int k = 0; k < 2; ++k) \
        acc[ai][bj][m][n] = __builtin_amdgcn_mfma_f32_16x16x32_bf16(Bt[n][k], At[m][k], acc[ai][bj][m][n], 0, 0, 0); __builtin_amdgcn_s_setprio(0); } while (0)
#define PG8_WAIT_V(n) asm volatile("s_waitcnt vmcnt(" #n ")" ::: "memory")
#define PG8_WAIT_L(n) asm volatile("s_waitcnt lgkmcnt(" #n ")" ::: "memory")
#define PG8_BAR __builtin_amdgcn_s_barrier()
#define PG8_SCHED __builtin_amdgcn_sched_barrier(0)
    Unit cur, nxt; int ui = 0;
    if (!S.next(0, cur)) return;
    f32x4 acc[2][2][4][2];
#pragma unroll
    for (int a = 0; a < 2; ++a)
#pragma unroll
        for (int b = 0; b < 2; ++b)
#pragma unroll
            for (int m = 0; m < 4; ++m)
#pragma unroll
                for (int n = 0; n < 2; ++n) acc[a][b][m][n] = (f32x4){0.f, 0.f, 0.f, 0.f};
    bf16x8 At[4][2], B0[2][2], B1[2][2];
    const char* cA = (const char*)g.A + (size_t)cur.pm * tstep; const char* cB = (const char*)g.Bt + (size_t)cur.pn * tstep;
    S.a_ready(cur);
    PG8_STAGE(PG8_SB(0, 0), cB, voffB); PG8_STAGE(PG8_SA(0, 0), cA, voffA); PG8_STAGE(PG8_SB(0, 1), cB + hstep, voffB); PG8_STAGE(PG8_SA(0, 1), cA + hstep, voffA);
    if (wr == 1) PG8_BAR;
    PG8_WAIT_V(4); PG8_BAR;
    PG8_STAGE(PG8_SB(1, 0), cB + kstep, voffB); PG8_STAGE(PG8_SA(1, 0), cA + kstep, voffA); PG8_STAGE(PG8_SB(1, 1), cB + hstep + kstep, voffB);
    PG8_WAIT_V(6); PG8_BAR;
    PG8_STAMP();
    for (;;) {
        const bool has_next = S.next(ui + 1, nxt);
        const char* nA = has_next ? (const char*)g.A + (size_t)nxt.pm * tstep : cA; const char* nB = has_next ? (const char*)g.Bt + (size_t)nxt.pn * tstep : cB;
        for (int t = 0; t < nt; t += 2) {
            const bool last = (t == nt - 2);
            const char* a1 = cA + (size_t)(t + 1) * kstep;
            const char* a2 = last ? nA : cA + (size_t)(t + 2) * kstep; const char* b2 = last ? nB : cB + (size_t)(t + 2) * kstep;
            const char* a3 = a2 + kstep; const char* b3 = b2 + kstep;
            if (last && has_next) S.a_ready(nxt);
            PG8_LDB(B0, 0, 0); PG8_SCHED; PG8_LDA(At, 0, 0); PG8_STAGE(PG8_SA(1, 1), a1 + hstep, voffA);
            PG8_WAIT_L(8); PG8_BAR; PG8_WAIT_L(0); PG8_MMA(0, 0, At, B0); PG8_BAR; PG8_SCHED;
            PG8_LDB(B1, 0, 1); PG8_STAGE(PG8_SB(0, 0), b2, voffB);
            PG8_BAR; PG8_WAIT_L(0); PG8_MMA(0, 1, At, B1); PG8_BAR;
            PG8_LDA(At, 0, 1); PG8_STAGE(PG8_SA(0, 0), a2, voffA);
            PG8_BAR; PG8_WAIT_L(0); PG8_MMA(1, 0, At, B0); PG8_BAR; PG8_SCHED;
            PG8_STAGE(PG8_SB(0, 1), b2 + hstep, voffB);
            PG8_WAIT_V(6); PG8_BAR; PG8_MMA(1, 1, At, B1); PG8_BAR;
            PG8_LDB(B0, 1, 0); PG8_SCHED; PG8_LDA(At, 1, 0); PG8_STAGE(PG8_SA(0, 1), a2 + hstep, voffA);
            PG8_WAIT_L(8); PG8_BAR; PG8_WAIT_L(0); PG8_MMA(0, 0, At, B0); PG8_BAR; PG8_SCHED;
            PG8_LDB(B1, 1, 1); PG8_STAGE(PG8_SB(1, 0), b3, voffB);
            PG8_BAR; PG8_WAIT_L(0); PG8_MMA(0, 1, At, B1); PG8_BAR;
            PG8_LDA(At, 1, 1); PG8_STAGE(PG8_SA(1, 0), a3, voffA);
            PG8_BAR; PG8_WAIT_L(0); PG8_MMA(1, 0, At, B0); PG8_BAR; PG8_SCHED;
            PG8_STAGE(PG8_SB(1, 1), b3 + hstep, voffB);
            PG8_WAIT_V(6); PG8_BAR; PG8_MMA(1, 1, At, B1); PG8_BAR;
        }
        PG8_STAMP();
        if constexpr (!Epi::AFTER_DRAIN) { E(acc, cur, wr, wc, fr, fq); S.done(cur); }
        PG8_STAMP();
        if (!has_next) break;
#pragma unroll
        for (int a = 0; a < 2; ++a)
#pragma unroll
            for (int b = 0; b < 2; ++b)
#pragma unroll
                for (int m = 0; m < 4; ++m)
#pragma unroll
                    for (int n = 0; n < 2; ++n) acc[a][b][m][n] = (f32x4){0.f, 0.f, 0.f, 0.f};
        cur = nxt; cA = nA; cB = nB; ++ui;
    }
    PG8_WAIT_V(0);
    if (wr == 0) PG8_BAR;
    PG8_BAR;
    if constexpr (Epi::AFTER_DRAIN) { E.fused(acc, cur, wr, wc, fr, fq, lds, wid, lane); S.done(cur); }
    PG8_STAMP();
    if (STAMP && wid == 0) { stamps[lane] = lane < nts ? (((unsigned long long)(unsigned)ts_hi << 32) | (unsigned)ts_lo) : 0ull;
        if (lane == 62) stamps[62] = rt_entry; if (lane == 63) stamps[63] = (unsigned long long)wall_clock64(); }
#undef PG8_STAMP
#undef PG8_SA
#undef PG8_SB
#undef PG8_STAGE
#undef PG8_LDA
#undef PG8_LDB
#undef PG8_MMA
#undef PG8_WAIT_V
#undef PG8_WAIT_L
#undef PG8_BAR
#undef PG8_SCHED
}
}


using pg8::bf16_t; using pg8::bf16x8; using pg8::f32x4; using pg8::u32x4;
typedef unsigned u32x2 __attribute__((ext_vector_type(2)));
typedef float f32x2v __attribute__((ext_vector_type(2)));
#define MFMA16(a, b, c) __builtin_amdgcn_mfma_f32_16x16x32_bf16((a), (b), (c), 0, 0, 0)

constexpr int MP = 65536, MS = 1024, MT = MP + MS, DM = 1024, DFF = 2816, NIN = 7424;
constexpr float EPS = 1e-6f;
constexpr size_t UB = (size_t)MT * 1024 * 2;
constexpr size_t WS_WIN = 0, WS_WBRA = WS_WIN + (size_t)NIN * 1024 * 2, WS_WBRB = WS_WBRA + 2097152, WS_WOUT = WS_WBRB + 2097152, WS_WPG = WS_WOUT + 2097152,
                 WS_WUP = WS_WPG + 2097152, WS_WDOWN = WS_WUP + (size_t)2 * DFF * 1024 * 2, WS_WPLE = WS_WDOWN + (size_t)1024 * DFF * 2, WS_KV = WS_WPLE + (size_t)1024 * 256 * 2,
                 WS_R0 = WS_KV + (size_t)MT * 256 * 2, WS_END = WS_R0 + 7 * UB;
constexpr size_t A_BYTES = (size_t)MT * DFF * 2;
constexpr size_t O_Y = 0, O_PWK = (size_t)MT * 1024, O_PWV = O_PWK + 524288, O_PST = O_PWV + 524288, O_PFC = O_PST + 4194304, O_SWK = O_PFC + 180224, O_SWV = O_SWK + 131072,
                 O_SST = O_SWV + 131072, O_SFC = O_SST + 4194304, O_END = O_SFC + 180224;
constexpr int LDS_BYTES = 147456;

struct Prm { const float* in[26]; float* out; unsigned char* ws; };
enum { I_XP = 0, I_XS, I_CK, I_CV, I_ST, I_CC, I_PP, I_PS, I_RB, I_LB, I_GPM, I_WIN, I_SINK, I_GH, I_WBRA, I_WBRB, I_WOUT, I_GPOST, I_GPF, I_WUP, I_WCONV, I_BCONV, I_WDOWN, I_GPFF, I_WPLE, I_WPG };

__device__ __forceinline__ unsigned pk2(float lo, float hi) { unsigned r; asm("v_cvt_pk_bf16_f32 %0, %1, %2" : "=v"(r) : "v"(lo), "v"(hi)); return r; }
__device__ __forceinline__ float bflo(unsigned w) { return __uint_as_float(w << 16); }
__device__ __forceinline__ float bfhi(unsigned w) { return __uint_as_float(w & 0xffff0000u); }
__device__ __forceinline__ float bf1(bf16_t b) { return __uint_as_float(((unsigned)b) << 16); }
__device__ __forceinline__ bf16_t f2bf(float f) { return (bf16_t)(pk2(f, 0.f) & 0xffffu); }
__device__ __forceinline__ float sigm(float x) { return __builtin_amdgcn_rcpf(1.0f + __expf(-x)); }
__device__ __forceinline__ float wsum(float v) { v += __shfl_xor(v, 32); v += __shfl_xor(v, 16); v += __shfl_xor(v, 8); v += __shfl_xor(v, 4); v += __shfl_xor(v, 2); v += __shfl_xor(v, 1); return v; }
__device__ __forceinline__ u32x4 pk8(f32x4 a, f32x4 b) { u32x4 w; w.x = pk2(a[0], a[1]); w.y = pk2(a[2], a[3]); w.z = pk2(b[0], b[1]); w.w = pk2(b[2], b[3]); return w; }
__device__ __forceinline__ u32x2 pk4(f32x4 a) { u32x2 w; w.x = pk2(a[0], a[1]); w.y = pk2(a[2], a[3]); return w; }
__device__ __forceinline__ void unpk8(u32x4 w, float (&f)[8]) { f[0] = bflo(w.x); f[1] = bfhi(w.x); f[2] = bflo(w.y); f[3] = bfhi(w.y); f[4] = bflo(w.z); f[5] = bfhi(w.z); f[6] = bflo(w.w); f[7] = bfhi(w.w); }

struct NoPre {};
template <class F> struct EpiT {
    static constexpr bool PERM = true, AFTER_DRAIN = false; F f;
    __device__ __forceinline__ void operator()(const f32x4 (&acc)[2][2][4][2], const pg8::Unit& u, int wr, int wc, int fr, int fq) const {
        const int row0 = u.pm * 256 + wr * 64 + fr, col0 = u.pn * 256 + wc * 32 + 8 * fq;
        constexpr int MB = F::MB;
#pragma unroll
        for (int a0 = 0; a0 < 8; a0 += MB) {
            typename F::Pre pre[MB][2];
#pragma unroll
            for (int mm = 0; mm < MB; ++mm)
#pragma unroll
                for (int bj = 0; bj < 2; ++bj) pre[mm][bj] = f.load(row0 + ((a0 + mm) >> 2) * 128 + ((a0 + mm) & 3) * 16, col0 + bj * 128);
#pragma unroll
            for (int mm = 0; mm < MB; ++mm)
#pragma unroll
                for (int bj = 0; bj < 2; ++bj) f(row0 + ((a0 + mm) >> 2) * 128 + ((a0 + mm) & 3) * 16, col0 + bj * 128, u.pn, acc[(a0 + mm) >> 2][bj][(a0 + mm) & 3][0], acc[(a0 + mm) >> 2][bj][(a0 + mm) & 3][1], pre[mm][bj]);
        }
    }
};
struct F1 {
    bf16_t* r0; bf16_t* kv; float* out; typedef NoPre Pre; static constexpr int MB = 1;
    __device__ __forceinline__ NoPre load(int, int) const { return NoPre(); }
    __device__ __forceinline__ void operator()(int row, int col, int pn, f32x4 v0, f32x4 v1, NoPre) const {
        const u32x4 w = pk8(v0, v1);
        if (pn < 4) { __builtin_nontemporal_store(w, (u32x4*)(r0 + (size_t)row * 1024 + col)); }
        else if (pn == 4) {
            const int c = col - 1024; *(u32x4*)(kv + (size_t)row * 256 + c) = w;
            float* o = nullptr;
            if (row >= MP) { o = out + (c < 128 ? O_SWK : O_SWV) + (size_t)(row - MP) * 128 + (c & 127); }
            else { const int t = row & 2047; if (t >= 1920) o = out + (c < 128 ? O_PWK : O_PWV) + (size_t)((row >> 11) * 128 + t - 1920) * 128 + (c & 127); }
            if (o) { *(f32x4*)o = v0; *(f32x4*)(o + 4) = v1; }
        } else { const int c2 = col - 1280, seg = c2 >> 10; __builtin_nontemporal_store(w, (u32x4*)(r0 + (size_t)(1 + seg) * (UB / 2) + (size_t)row * 1024 + (c2 & 1023))); }
    }
};
struct F2 {
    const bf16_t* g; bf16_t* o; typedef u32x4 Pre; static constexpr int MB = 8;
    __device__ __forceinline__ u32x4 load(int row, int col) const { return *(const u32x4*)(g + (size_t)row * 1024 + col); }
    __device__ __forceinline__ void operator()(int row, int col, int, f32x4 v0, f32x4 v1, u32x4 gw) const {
        const size_t i = (size_t)row * 1024 + col; float gf[8]; unpk8(gw, gf);
        f32x4 a, b;
#pragma unroll
        for (int j = 0; j < 4; ++j) { a[j] = v0[j] * sigm(gf[j]); b[j] = v1[j] * sigm(gf[4 + j]); }
        *(u32x4*)(o + i) = pk8(a, b);
    }
};
struct F3 {
    const bf16_t* g; const bf16_t* t; bf16_t* o; struct Pre { u32x4 g, t; }; static constexpr int MB = 4;
    __device__ __forceinline__ Pre load(int row, int col) const { const size_t i = (size_t)row * 1024 + col; Pre r; r.g = *(const u32x4*)(g + i); r.t = *(const u32x4*)(t + i); return r; }
    __device__ __forceinline__ void operator()(int row, int col, int, f32x4 v0, f32x4 v1, Pre pr) const {
        const size_t i = (size_t)row * 1024 + col; float gf[8], tf[8]; unpk8(pr.g, gf); unpk8(pr.t, tf);
        f32x4 a, b;
#pragma unroll
        for (int j = 0; j < 4; ++j) { a[j] = tf[j] + v0[j] * sigm(gf[j]); b[j] = tf[4 + j] + v1[j] * sigm(gf[4 + j]); }
        *(u32x4*)(o + i) = pk8(a, b);
    }
};
struct FF32 {
    float* o; typedef NoPre Pre; static constexpr int MB = 1;
    __device__ __forceinline__ NoPre load(int, int) const { return NoPre(); }
    __device__ __forceinline__ void operator()(int row, int col, int, f32x4 v0, f32x4 v1, NoPre) const { float* d = o + (size_t)row * 1024 + col; *(f32x4*)d = v0; *(f32x4*)(d + 4) = v1; }
};
struct FBF {
    bf16_t* o; typedef NoPre Pre; static constexpr int MB = 1;
    __device__ __forceinline__ NoPre load(int, int) const { return NoPre(); }
    __device__ __forceinline__ void operator()(int row, int col, int, f32x4 v0, f32x4 v1, NoPre) const { *(u32x4*)(o + (size_t)row * 1024 + col) = pk8(v0, v1); }
};
struct EpiUp {
    static constexpr bool PERM = true, AFTER_DRAIN = false;
    bf16_t* g; bf16_t* araw; float* out; const float* wcv; const float* bcv;
    __device__ __forceinline__ void operator()(const f32x4 (&acc)[2][2][4][2], const pg8::Unit& u, int wr, int wc, int fr, int fq) const {
        const int c0 = u.pn * 128 + wc * 32 + 8 * fq;
        float w0[8], w1[8], w2[8], bb[8];
        { const f32x4 t0 = *(const f32x4*)(wcv + c0), t1 = *(const f32x4*)(wcv + c0 + 4), t2 = *(const f32x4*)(wcv + DFF + c0), t3 = *(const f32x4*)(wcv + DFF + c0 + 4),
                      t4 = *(const f32x4*)(wcv + 2 * DFF + c0), t5 = *(const f32x4*)(wcv + 2 * DFF + c0 + 4), t6 = *(const f32x4*)(bcv + c0), t7 = *(const f32x4*)(bcv + c0 + 4);
#pragma unroll
          for (int j = 0; j < 4; ++j) { w0[j] = t0[j]; w0[4 + j] = t1[j]; w1[j] = t2[j]; w1[4 + j] = t3[j]; w2[j] = t4[j]; w2[4 + j] = t5[j]; bb[j] = t6[j]; bb[4 + j] = t7[j]; } }
#pragma unroll
        for (int ai = 0; ai < 2; ++ai) {
            float p1[8], p2[8];
#pragma unroll
            for (int j = 0; j < 8; ++j) { p1[j] = 0.f; p2[j] = 0.f; }
#pragma unroll
            for (int m = 0; m < 4; ++m) {
                const int row = u.pm * 256 + ai * 128 + wr * 64 + m * 16 + fr;
                float a[8], uu[8], r1[8], r2[8], gq[8];
#pragma unroll
                for (int j = 0; j < 4; ++j) { a[j] = acc[ai][0][m][0][j]; a[4 + j] = acc[ai][0][m][1][j]; uu[j] = acc[ai][1][m][0][j]; uu[4 + j] = acc[ai][1][m][1][j]; }
#pragma unroll
                for (int j = 0; j < 8; ++j) { r1[j] = __int_as_float(__builtin_amdgcn_mov_dpp(__float_as_int(a[j]), 0x121, 0xf, 0xf, false)); r2[j] = __int_as_float(__builtin_amdgcn_mov_dpp(__float_as_int(a[j]), 0x122, 0xf, 0xf, false)); }
                const bool sample = row >= MP;
                const bool boundary = (m == 0 && fr < 2) || (sample && ((m & 1) == 0) && fr < 2);
                const bool keep_a = boundary || (m == 3 && fr >= 14);
#pragma unroll
                for (int j = 0; j < 8; ++j) {
                    const float am1 = fr >= 1 ? r1[j] : p1[j], am2 = fr >= 2 ? r2[j] : p2[j];
                    const float ac = bb[j] + w0[j] * am2 + w1[j] * am1 + w2[j] * a[j];
                    const float y = 1.5957691216f * (ac + 0.044715f * ac * ac * ac);
                    gq[j] = boundary ? uu[j] : ac * sigm(y) * uu[j];
                    p1[j] = r1[j]; p2[j] = r2[j];
                }
                u32x4 wv; wv.x = pk2(gq[0], gq[1]); wv.y = pk2(gq[2], gq[3]); wv.z = pk2(gq[4], gq[5]); wv.w = pk2(gq[6], gq[7]);
                __builtin_nontemporal_store(wv, (u32x4*)(g + (size_t)row * DFF + c0));
                if (keep_a) { u32x4 av; av.x = pk2(a[0], a[1]); av.y = pk2(a[2], a[3]); av.z = pk2(a[4], a[5]); av.w = pk2(a[6], a[7]); *(u32x4*)(araw + (size_t)row * DFF + c0) = av; }
                float* o = nullptr;
                if (sample) { const int rs = row - MP, t = rs & 31; if (t >= 30) o = out + O_SFC + (size_t)((rs >> 5) * 2 + t - 30) * DFF + c0; }
                else { const int t = row & 2047; if (t >= 2046) o = out + O_PFC + (size_t)((row >> 11) * 2 + t - 2046) * DFF + c0; }
                if (o) { *(f32x4*)o = acc[ai][0][m][0]; *(f32x4*)(o + 4) = acc[ai][0][m][1]; }
            }
        }
    }
};
struct F9 {
    const bf16_t* pe; const bf16_t* xb; float* y; struct Pre { u32x4 p, x; }; static constexpr int MB = 4;
    __device__ __forceinline__ Pre load(int row, int col) const { const size_t i = (size_t)row * 1024 + col; Pre r; r.p = *(const u32x4*)(pe + i); r.x = *(const u32x4*)(xb + i); return r; }
    __device__ __forceinline__ void operator()(int row, int col, int, f32x4 v0, f32x4 v1, Pre pr) const {
        const size_t i = (size_t)row * 1024 + col; float pf[8], xf[8]; unpk8(pr.p, pf); unpk8(pr.x, xf);
        f32x4 a, b;
#pragma unroll
        for (int j = 0; j < 4; ++j) { a[j] = xf[j] + pf[j] * sigm(v0[j]); b[j] = xf[4 + j] + pf[4 + j] * sigm(v1[j]); }
        *(f32x4*)(y + i) = a; *(f32x4*)(y + i + 4) = b;
    }
};
template <class E> __device__ __forceinline__ void run_gemm_epi(unsigned char* lds, const bf16_t* A, const bf16_t* Bt, int N, int K, const E& e) {
    asm volatile("" : "+s"(K)); asm volatile("" : "+s"(N));
    pg8::Gemm g; g.A = A; g.Bt = Bt; g.M = MT; g.N = N; g.K = K;
    pg8::StaticOrder S; S.init(MT, N, (int)gridDim.x, (int)blockIdx.x);
    pg8::gemm_phase<E, pg8::StaticOrder, false>((PG8_LAS unsigned char*)lds, g, S, e, nullptr);
    __syncthreads();
}
template <class F> __device__ __forceinline__ void run_gemm(unsigned char* lds, const bf16_t* A, const bf16_t* Bt, int N, int K, const F& f) {
    asm volatile("" : "+s"(K)); asm volatile("" : "+s"(N));
    pg8::Gemm g; g.A = A; g.Bt = Bt; g.M = MT; g.N = N; g.K = K;
    pg8::StaticOrder S; S.init(MT, N, (int)gridDim.x, (int)blockIdx.x);
    EpiT<F> E; E.f = f;
    pg8::gemm_phase<EpiT<F>, pg8::StaticOrder, false>((PG8_LAS unsigned char*)lds, g, S, E, nullptr);
    __syncthreads();
}

template <bool ILV = false> __device__ __forceinline__ void transpose_w(const float* W, bf16_t* Bt, int K, int N, const float* gain, float* tile, int& toff, int cid, int G) {
    const int nnt = N / 64, ntiles = (K / 64) * nnt, tid = threadIdx.x;
    const int first = (cid - (toff % G) + G) % G;
    const int r0 = tid >> 6, c = tid & 63;
    float v[8];
#define TR_LOAD(t_) do { const int kt_ = (t_) / nnt, d0_ = ((t_) % nnt) * 64; \
        const int sc0_ = ILV ? (((d0_ & 255) < 128) ? (d0_ >> 8) * 128 + (d0_ & 127) : DFF + (d0_ >> 8) * 128 + (d0_ & 127)) : d0_; \
        _Pragma("unroll") for (int i = 0; i < 8; ++i) { const int r = r0 + 8 * i; float x = W[(size_t)(kt_ * 64 + r) * N + sc0_ + c]; if (gain) x *= gain[kt_ * 64 + r]; v[i] = x; } } while (0)
    if (first < ntiles) TR_LOAD(first);
    for (int t = first; t < ntiles; t += G) {
        const int kt = t / nnt, nt = t % nnt;
#pragma unroll
        for (int i = 0; i < 8; ++i) tile[(r0 + 8 * i) * 65 + c] = v[i];
        __syncthreads();
        if (t + G < ntiles) TR_LOAD(t + G);
        { const int n = tid >> 3, k8 = (tid & 7) * 8; u32x4 wv;
          wv.x = pk2(tile[(k8 + 0) * 65 + n], tile[(k8 + 1) * 65 + n]); wv.y = pk2(tile[(k8 + 2) * 65 + n], tile[(k8 + 3) * 65 + n]);
          wv.z = pk2(tile[(k8 + 4) * 65 + n], tile[(k8 + 5) * 65 + n]); wv.w = pk2(tile[(k8 + 6) * 65 + n], tile[(k8 + 7) * 65 + n]);
          *(u32x4*)(Bt + (size_t)(nt * 64 + n) * K + kt * 64 + k8) = wv; }
        __syncthreads();
    }
#undef TR_LOAD
    toff += ntiles;
}
__device__ __forceinline__ const float* xrow(const Prm& p, int row) { return row < MP ? p.in[I_XP] + (size_t)row * 1024 : p.in[I_XS] + (size_t)(row - MP) * 1024; }

__device__ __forceinline__ void late_weights(const Prm& p, unsigned char* lds) {
    if (blockIdx.x < 16) return;
    float* tile = (float*)lds; int toff = 0; unsigned char* ws = p.ws; const int cid = blockIdx.x - 16, G = gridDim.x - 16;
    transpose_w<true>(p.in[I_WUP], (bf16_t*)(ws + WS_WUP), 1024, 2 * DFF, p.in[I_GPF], tile, toff, cid, G);
    transpose_w(p.in[I_WDOWN], (bf16_t*)(ws + WS_WDOWN), DFF, 1024, nullptr, tile, toff, cid, G);
    transpose_w(p.in[I_WPG], (bf16_t*)(ws + WS_WPG), 1024, 1024, nullptr, tile, toff, cid, G);
    transpose_w(p.in[I_WPLE], (bf16_t*)(ws + WS_WPLE), 256, 1024, nullptr, tile, toff, cid, G);
}
__device__ __forceinline__ void phase0(const Prm& p, unsigned char* lds) {
    float* tile = (float*)lds; int toff = 0; unsigned char* ws = p.ws; const int cid = blockIdx.x, G = gridDim.x;
    transpose_w(p.in[I_WIN], (bf16_t*)(ws + WS_WIN), 1024, NIN, p.in[I_GPM], tile, toff, cid, G);
    transpose_w(p.in[I_WBRA], (bf16_t*)(ws + WS_WBRA), 1024, 1024, nullptr, tile, toff, cid, G);
    transpose_w(p.in[I_WBRB], (bf16_t*)(ws + WS_WBRB), 1024, 1024, nullptr, tile, toff, cid, G);
    transpose_w(p.in[I_WOUT], (bf16_t*)(ws + WS_WOUT), 1024, 1024, nullptr, tile, toff, cid, G);
    bf16_t* xn = (bf16_t*)p.out;
    const int lane = threadIdx.x & 63, gw = blockIdx.x * 8 + (threadIdx.x >> 6), nw = gridDim.x * 8;
    for (int row = gw; row < MT; row += nw) {
        const float* xr = xrow(p, row); f32x4 v[4]; float ss = 0.f;
#pragma unroll
        for (int i = 0; i < 4; ++i) { v[i] = *(const f32x4*)(xr + i * 256 + lane * 4); ss += v[i][0] * v[i][0] + v[i][1] * v[i][1] + v[i][2] * v[i][2] + v[i][3] * v[i][3]; }
        ss = wsum(ss); const float rs = rsqrtf(ss * (1.0f / 1024.0f) + EPS);
#pragma unroll
        for (int i = 0; i < 4; ++i) *(u32x2*)(xn + (size_t)row * 1024 + i * 256 + lane * 4) = pk4(v[i] * rs);
    }
}

constexpr int AT_KS = 0, AT_VT = 27648, AT_BT = 53248;
__device__ __forceinline__ void attn_bias_table(const Prm& p, unsigned char* lds) {
    float* bT = (float*)(lds + AT_BT); const float* tab = p.in[I_RB];
    for (int i = threadIdx.x; i < 16 * 256; i += 512) {
        const int head = i >> 8, idx = i & 255, rel = idx - 191, n = rel < 0 ? -rel : rel;
        int bk = n < 8 ? n : min(15, 33 - __clz(n * n)); if (rel > 0) bk += 16;
        bT[i] = idx < 255 ? tab[bk * 16 + head] : 0.f;
    }
}
template <int NKT, int NQT, bool SAMPLE>
__device__ __forceinline__ void attn_item(const Prm& p, unsigned char* lds, int b, int c, int kvh, bf16_t* YA) {
    bf16_t* Ks = (bf16_t*)(lds + AT_KS); bf16_t* Vt = (bf16_t*)(lds + AT_VT); const float* bT = (const float*)(lds + AT_BT);
    const bf16_t* kv = (const bf16_t*)(p.ws + WS_KV); bf16_t* R0 = (bf16_t*)(p.ws + WS_R0);
    const int tid = threadIdx.x, lane = tid & 63, w = tid >> 6, lr = lane & 15, lq = lane >> 4;
    const int head = kvh * 8 + w; const int qrow0 = SAMPLE ? MP + b * 32 : b * 2048 + c * 64;
    const size_t qoff0 = (size_t)(qrow0 + lr) * 1024 + head * 64 + lq * 8;
    bf16x8 qn0 = *(const bf16x8*)(R0 + qoff0), qn1 = *(const bf16x8*)(R0 + qoff0 + 32);
    __syncthreads();
    if (!SAMPLE) {
        const int tok0 = b * 2048 + (c - 2) * 64;
        for (int id = tid; id < 192 * 8; id += 512) {
            const int key = id >> 3, dc = id & 7; u32x4 v = {0u, 0u, 0u, 0u};
            if (c * 64 - 128 + key >= 0) v = *(const u32x4*)(kv + (size_t)(tok0 + key) * 256 + kvh * 64 + dc * 8);
            *(u32x4*)(Ks + key * 72 + dc * 8) = v;
        }
        for (int id = tid; id < 192 * 8; id += 512) {
            const int key = id % 192, dc = id / 192; u32x4 v = {0u, 0u, 0u, 0u};
            if (c * 64 - 128 + key >= 0) v = *(const u32x4*)(kv + (size_t)(tok0 + key) * 256 + 128 + kvh * 64 + dc * 8);
            bf16_t* d = Vt + (dc * 8) * 200 + key;
            d[0] = (bf16_t)(v.x & 0xffffu); d[200] = (bf16_t)(v.x >> 16); d[400] = (bf16_t)(v.y & 0xffffu); d[600] = (bf16_t)(v.y >> 16);
            d[800] = (bf16_t)(v.z & 0xffffu); d[1000] = (bf16_t)(v.z >> 16); d[1200] = (bf16_t)(v.w & 0xffffu); d[1400] = (bf16_t)(v.w >> 16);
        }
    } else {
        const float* ck = p.in[I_CK]; const float* cvp = p.in[I_CV];
        for (int id = tid; id < 160 * 8; id += 512) {
            const int key = id >> 3, dc = id & 7; u32x4 v;
            if (key < 128) { const float* s = ck + (size_t)(b * 128 + key) * 128 + kvh * 64 + dc * 8; v = pk8(*(const f32x4*)s, *(const f32x4*)(s + 4)); }
            else v = *(const u32x4*)(kv + (size_t)(MP + b * 32 + key - 128) * 256 + kvh * 64 + dc * 8);
            *(u32x4*)(Ks + key * 72 + dc * 8) = v;
        }
        for (int id = tid; id < 160 * 8; id += 512) {
            const int key = id % 160, dc = id / 160; u32x4 v;
            if (key < 128) { const float* s = cvp + (size_t)(b * 128 + key) * 128 + kvh * 64 + dc * 8; v = pk8(*(const f32x4*)s, *(const f32x4*)(s + 4)); }
            else v = *(const u32x4*)(kv + (size_t)(MP + b * 32 + key - 128) * 256 + 128 + kvh * 64 + dc * 8);
            bf16_t* d = Vt + (dc * 8) * 200 + key;
            d[0] = (bf16_t)(v.x & 0xffffu); d[200] = (bf16_t)(v.x >> 16); d[400] = (bf16_t)(v.y & 0xffffu); d[600] = (bf16_t)(v.y >> 16);
            d[800] = (bf16_t)(v.z & 0xffffu); d[1000] = (bf16_t)(v.z >> 16); d[1200] = (bf16_t)(v.w & 0xffffu); d[1400] = (bf16_t)(v.w >> 16);
        }
    }
    __syncthreads();
    const float sink = p.in[I_SINK][head];
    const float* bTh = bT + head * 256;
#pragma unroll 1
    for (int qi = 0; qi < NQT; ++qi) {
        const int q = qi * 16 + lr;
        const bf16x8 qf0 = qn0, qf1 = qn1;
        if (qi + 1 < NQT) { qn0 = *(const bf16x8*)(R0 + qoff0 + (size_t)(qi + 1) * 16384); qn1 = *(const bf16x8*)(R0 + qoff0 + (size_t)(qi + 1) * 16384 + 32); }
        f32x4 s[NKT];
#pragma unroll
        for (int kt = 0; kt < NKT; ++kt) {
            const bf16_t* kp = Ks + (kt * 16 + lr) * 72 + lq * 8;
            const bf16x8 k0 = *(const bf16x8*)kp, k1 = *(const bf16x8*)(kp + 32);
            f32x4 a = {0.f, 0.f, 0.f, 0.f}; a = MFMA16(k0, qf0, a); a = MFMA16(k1, qf1, a); s[kt] = a;
        }
        float mx = sink;
#pragma unroll
        for (int kt = 0; kt < NKT; ++kt)
#pragma unroll
            for (int r = 0; r < 4; ++r) {
                const int key = kt * 16 + lq * 4 + r; float v = s[kt][r] * 0.125f + bTh[key - q + 63];
                if (!SAMPLE && (c * 64 - 128 + key < 0)) v = -1e30f;
                s[kt][r] = v; mx = fmaxf(mx, v);
            }
        mx = fmaxf(mx, __shfl_xor(mx, 16)); mx = fmaxf(mx, __shfl_xor(mx, 32));
        float sum = 0.f;
#pragma unroll
        for (int kt = 0; kt < NKT; ++kt)
#pragma unroll
            for (int r = 0; r < 4; ++r) { const float e = __expf(s[kt][r] - mx); s[kt][r] = e; sum += e; }
        sum += __shfl_xor(sum, 16); sum += __shfl_xor(sum, 32);
        const float inv = 1.0f / (sum + __expf(sink - mx));
        f32x4 o[4];
#pragma unroll
        for (int dt = 0; dt < 4; ++dt) o[dt] = (f32x4){0.f, 0.f, 0.f, 0.f};
#pragma unroll
        for (int ks = 0; ks < NKT / 2; ++ks) {
            const u32x4 pw = pk8(s[2 * ks], s[2 * ks + 1]); const bf16x8 pf = __builtin_bit_cast(bf16x8, pw);
#pragma unroll
            for (int dt = 0; dt < 4; ++dt) {
                const bf16_t* vp = Vt + (dt * 16 + lr) * 200 + ks * 32 + lq * 4;
                const u32x2 lo = *(const u32x2*)vp, hi = *(const u32x2*)(vp + 16);
                const u32x4 vw = {lo.x, lo.y, hi.x, hi.y};
                o[dt] = MFMA16(__builtin_bit_cast(bf16x8, vw), pf, o[dt]);
            }
        }
#pragma unroll
        for (int dt = 0; dt < 4; ++dt) *(u32x2*)(YA + (size_t)(qrow0 + q) * 1024 + head * 64 + dt * 16 + lq * 4) = pk4(o[dt] * inv);
    }
}

template <int L, bool SAMPLE>
__device__ __forceinline__ void hgrn_seq(const Prm& p, unsigned char* lds, int b, int h, bf16_t* YB) {
    constexpr int RPG = L / 8, NT = L / 16, NCH = SAMPLE ? 1 : 32, NP = 8 / NT;
    bf16_t* Qd = (bf16_t*)lds; bf16_t* Qm = Qd + 64 * 136; bf16_t* Km = Qm + 64 * 136; bf16_t* KlT = Km + 64 * 136; bf16_t* Vt = KlT + 128 * 72; bf16_t* St = Vt + 128 * 72; bf16_t* Al = St + 128 * 136;
    float* tot = (float*)(Al + 64 * 72); float* first = tot + 1024; float* decay = first + 1024; float* ssq = decay + 128;
    const bf16_t* R1 = (const bf16_t*)(p.ws + WS_R0 + UB); const bf16_t* R2 = (const bf16_t*)(p.ws + WS_R0 + 2 * UB); const bf16_t* R3 = (const bf16_t*)(p.ws + WS_R0 + 3 * UB); const bf16_t* R4 = (const bf16_t*)(p.ws + WS_R0 + 4 * UB);
    const int tid = threadIdx.x, lane = tid & 63, w = tid >> 6, lr = lane & 15, lq = lane >> 4, cp = lane, rg = w, c0 = 2 * cp;
    float lb[2];
#pragma unroll
    for (int c = 0; c < 2; ++c) { const float l0 = p.in[I_LB][h * 128 + c0 + c], l1 = p.in[I_LB][1024 + h * 128 + c0 + c]; lb[c] = 1.0f / (1.0f + __expf(l1 - l0)); }
    f32x4 S[8];
#pragma unroll
    for (int dvt = 0; dvt < 8; ++dvt) {
        if (SAMPLE) {
#pragma unroll
            for (int r = 0; r < 4; ++r) S[dvt][r] = p.in[I_ST][((size_t)(b * 8 + h) * 128 + 16 * w + 4 * lq + r) * 128 + 16 * dvt + lr];
        } else S[dvt] = (f32x4){0.f, 0.f, 0.f, 0.f};
    }
    const int tt = w % NT, dv0 = (w / NT) * NT;
    const int rowbase = SAMPLE ? MP + b * 32 : b * 2048;
    f32x4 ggv[NT];
#pragma unroll
    for (int i = 0; i < NT; ++i) ggv[i] = *(const f32x4*)(p.in[I_GH] + 16 * (dv0 + i) + 4 * lq);
    unsigned qw[RPG], fw[RPG], vw[RPG];
#pragma unroll
    for (int i = 0; i < RPG; ++i) { const size_t idx = (size_t)(rowbase + rg * RPG + i) * 1024 + h * 128 + c0; qw[i] = *(const unsigned*)(R1 + idx); fw[i] = *(const unsigned*)(R2 + idx); vw[i] = *(const unsigned*)(R3 + idx); }
#pragma unroll 1
    for (int ch = 0; ch < NCH; ++ch) {
        const int row0 = rowbase + ch * L;
        float qv[2][RPG], cv[2][RPG], kk[2][RPG]; unsigned vkeep[RPG]; float run[2] = {1.f, 1.f}, lf0[2] = {0.f, 0.f};
#pragma unroll
        for (int i = 0; i < RPG; ++i) {
            vkeep[i] = vw[i];
#pragma unroll
            for (int c = 0; c < 2; ++c) {
                const float q = c ? bfhi(qw[i]) : bflo(qw[i]), fl = c ? bfhi(fw[i]) : bflo(fw[i]);
                const float f = lb[c] + (1.0f - lb[c]) * sigm(fl);
                run[c] *= f; cv[c][i] = run[c]; kk[c][i] = 1.0f - f; qv[c][i] = q * sigm(q); if (i == 0) lf0[c] = __logf(f);
            }
        }
        *(f32x2v*)(tot + rg * 128 + c0) = (f32x2v){__logf(run[0]), __logf(run[1])}; *(f32x2v*)(first + rg * 128 + c0) = (f32x2v){lf0[0], lf0[1]};
        if (ch + 1 < NCH) {
#pragma unroll
            for (int i = 0; i < RPG; ++i) { const size_t idx = (size_t)(row0 + L + rg * RPG + i) * 1024 + h * 128 + c0; qw[i] = *(const unsigned*)(R1 + idx); fw[i] = *(const unsigned*)(R2 + idx); vw[i] = *(const unsigned*)(R3 + idx); }
        }
        const size_t rbase = (size_t)(row0 + tt * 16 + lr) * 1024 + h * 128;
        u32x2 ogw[NT];
#pragma unroll
        for (int i = 0; i < NT; ++i) ogw[i] = *(const u32x2*)(R4 + rbase + 16 * (dv0 + i) + 4 * lq);
        __syncthreads();
        {
            float pre[2] = {0.f, 0.f}, bmid[2], blast[2], emid[2], elm[2], epre[2];
#pragma unroll
            for (int c = 0; c < 2; ++c) {
                float acc = 0.f, half = 0.f;
#pragma unroll
                for (int j = 0; j < 8; ++j) { const float t = tot[j * 128 + c0 + c]; if (j < rg) pre[c] += t; if (j < 4) half += t; acc += t; }
                bmid[c] = half + first[4 * 128 + c0 + c]; blast[c] = acc; emid[c] = __expf(bmid[c]); elm[c] = __expf(blast[c] - bmid[c]); epre[c] = __expf(pre[c] - bmid[c]);
            }
            float kl[2][RPG];
#pragma unroll
            for (int i = 0; i < RPG; ++i) {
                const int r = rg * RPG + i; float qd[2], qm[2], km[2];
#pragma unroll
                for (int c = 0; c < 2; ++c) {
                    const float E = epre[c] * cv[c][i], Ei = __builtin_amdgcn_rcpf(E);
                    qm[c] = qv[c][i] * E; qd[c] = qm[c] * emid[c]; km[c] = kk[c][i] * Ei; kl[c][i] = km[c] * elm[c];
                }
                *(unsigned*)(Qd + r * 136 + c0) = pk2(qd[0], qd[1]); *(unsigned*)(Qm + r * 136 + c0) = pk2(qm[0], qm[1]); *(unsigned*)(Km + r * 136 + c0) = pk2(km[0], km[1]);
            }
#pragma unroll
            for (int c = 0; c < 2; ++c) {
#pragma unroll
                for (int i = 0; i < RPG; i += 4) {
                    u32x2 a, v2; a.x = pk2(kl[c][i], kl[c][i + 1]); a.y = pk2(kl[c][i + 2], kl[c][i + 3]);
                    if (c == 0) { v2.x = (vkeep[i] & 0xffffu) | (vkeep[i + 1] << 16); v2.y = (vkeep[i + 2] & 0xffffu) | (vkeep[i + 3] << 16); }
                    else { v2.x = (vkeep[i] >> 16) | (vkeep[i + 1] & 0xffff0000u); v2.y = (vkeep[i + 2] >> 16) | (vkeep[i + 3] & 0xffff0000u); }
                    *(u32x2*)(KlT + (c0 + c) * 72 + rg * RPG + i) = a; *(u32x2*)(Vt + (c0 + c) * 72 + rg * RPG + i) = v2;
                }
            }
            if (rg == 0) *(f32x2v*)(decay + c0) = (f32x2v){__expf(blast[0]), __expf(blast[1])};
        }
#pragma unroll
        for (int dvt = 0; dvt < 8; ++dvt) *(u32x2*)(St + (16 * dvt + lr) * 136 + 16 * w + 4 * lq) = pk4(S[dvt]);
        __syncthreads();
        for (int id = w; id < NT * NT; id += 8) {
            const int st = id / NT, t2 = id % NT; f32x4 acc = {0.f, 0.f, 0.f, 0.f};
#pragma unroll
            for (int ks = 0; ks < 4; ++ks) acc = MFMA16(*(const bf16x8*)(Km + (st * 16 + lr) * 136 + ks * 32 + lq * 8), *(const bf16x8*)(Qm + (t2 * 16 + lr) * 136 + ks * 32 + lq * 8), acc);
            const int t = t2 * 16 + lr;
#pragma unroll
            for (int r = 0; r < 4; ++r) if (st * 16 + 4 * lq + r > t) acc[r] = 0.f;
            *(u32x2*)(Al + t * 72 + st * 16 + 4 * lq) = pk4(acc);
        }
        f32x4 o[NT];
#pragma unroll
        for (int i = 0; i < NT; ++i) {
            f32x4 acc = {0.f, 0.f, 0.f, 0.f};
#pragma unroll
            for (int ks = 0; ks < 4; ++ks) acc = MFMA16(*(const bf16x8*)(St + (16 * (dv0 + i) + lr) * 136 + ks * 32 + lq * 8), *(const bf16x8*)(Qd + (tt * 16 + lr) * 136 + ks * 32 + lq * 8), acc);
            o[i] = acc;
        }
        __syncthreads();
        float sq = 0.f;
#pragma unroll
        for (int i = 0; i < NT; ++i) {
#pragma unroll
            for (int ks = 0; ks < L / 32; ++ks) o[i] = MFMA16(*(const bf16x8*)(Vt + (16 * (dv0 + i) + lr) * 72 + ks * 32 + lq * 8), *(const bf16x8*)(Al + (tt * 16 + lr) * 72 + ks * 32 + lq * 8), o[i]);
            sq += o[i][0] * o[i][0] + o[i][1] * o[i][1] + o[i][2] * o[i][2] + o[i][3] * o[i][3];
        }
        sq += __shfl_xor(sq, 16); sq += __shfl_xor(sq, 32);
        if (lq == 0) ssq[(w / NT) * 64 + tt * 16 + lr] = sq;
        {
            const f32x4 dc = *(const f32x4*)(decay + 16 * w + 4 * lq);
#pragma unroll
            for (int dvt = 0; dvt < 8; ++dvt) {
                f32x4 acc = S[dvt] * dc;
#pragma unroll
                for (int ks = 0; ks < L / 32; ++ks) acc = MFMA16(*(const bf16x8*)(KlT + (16 * w + lr) * 72 + ks * 32 + lq * 8), *(const bf16x8*)(Vt + (16 * dvt + lr) * 72 + ks * 32 + lq * 8), acc);
                S[dvt] = acc;
            }
        }
        __syncthreads();
        {
            float tsq = 0.f;
#pragma unroll
            for (int j = 0; j < NP; ++j) tsq += ssq[j * 64 + tt * 16 + lr];
            const float rs = rsqrtf(tsq * (1.0f / 128.0f) + EPS);
#pragma unroll
            for (int i = 0; i < NT; ++i) {
                const int dvb = 16 * (dv0 + i) + 4 * lq;
                const f32x4 gg = ggv[i];
                const float og0 = bflo(ogw[i].x), og1 = bfhi(ogw[i].x), og2 = bflo(ogw[i].y), og3 = bfhi(ogw[i].y);
                f32x4 y; y[0] = o[i][0] * rs * gg[0] * og0 * sigm(og0); y[1] = o[i][1] * rs * gg[1] * og1 * sigm(og1); y[2] = o[i][2] * rs * gg[2] * og2 * sigm(og2); y[3] = o[i][3] * rs * gg[3] * og3 * sigm(og3);
                *(u32x2*)(YB + rbase + dvb) = pk4(y);
            }
        }
    }
    float* so = p.out + (SAMPLE ? O_SST : O_PST) + (size_t)(b * 8 + h) * 16384;
#pragma unroll
    for (int dvt = 0; dvt < 8; ++dvt)
#pragma unroll
        for (int r = 0; r < 4; ++r) so[(16 * w + 4 * lq + r) * 128 + 16 * dvt + lr] = S[dvt][r];
    __syncthreads();
}

__device__ __forceinline__ void phase_rp5(const Prm& p) {
    const bf16_t* O = (const bf16_t*)(p.ws + WS_R0 + 4 * UB); bf16_t* hf = (bf16_t*)(p.ws + WS_R0); const float* g = p.in[I_GPOST];
    const int lane = threadIdx.x & 63, gw = blockIdx.x * 8 + (threadIdx.x >> 6), nw = gridDim.x * 8;
    for (int row = gw; row < MT; row += nw) {
        const float* xr = xrow(p, row); const bf16_t* orow = O + (size_t)row * 1024; f32x4 v[4], x[4]; float ss = 0.f;
#pragma unroll
        for (int i = 0; i < 4; ++i) { { const u32x2 ow = *(const u32x2*)(orow + i * 256 + lane * 4); v[i] = (f32x4){bflo(ow.x), bfhi(ow.x), bflo(ow.y), bfhi(ow.y)}; } x[i] = *(const f32x4*)(xr + i * 256 + lane * 4); ss += v[i][0] * v[i][0] + v[i][1] * v[i][1] + v[i][2] * v[i][2] + v[i][3] * v[i][3]; }
        ss = wsum(ss); const float rs = rsqrtf(ss * (1.0f / 1024.0f) + EPS); float s2 = 0.f;
#pragma unroll
        for (int i = 0; i < 4; ++i) { const f32x4 gg = *(const f32x4*)(g + i * 256 + lane * 4); x[i] += v[i] * rs * gg; s2 += x[i][0] * x[i][0] + x[i][1] * x[i][1] + x[i][2] * x[i][2] + x[i][3] * x[i][3];
            *(u32x2*)((bf16_t*)p.out + (size_t)row * 1024 + i * 256 + lane * 4) = pk4(x[i]); }
        s2 = wsum(s2); const float r2 = rsqrtf(s2 * (1.0f / 1024.0f) + EPS);
#pragma unroll
        for (int i = 0; i < 4; ++i) *(u32x2*)(hf + (size_t)row * 1024 + i * 256 + lane * 4) = pk4(x[i] * r2);
    }
    bf16_t* pbf = (bf16_t*)(p.ws + WS_KV);
    for (int id = blockIdx.x * 512 + threadIdx.x; id < MT * 32; id += gridDim.x * 512) {
        const int row = id >> 5, c = (id & 31) * 8;
        const float* s = (row < MP ? p.in[I_PP] + (size_t)row * 256 : p.in[I_PS] + (size_t)(row - MP) * 256) + c;
        *(u32x4*)(pbf + (size_t)row * 256 + c) = pk8(*(const f32x4*)s, *(const f32x4*)(s + 4));
    }
}
__device__ __forceinline__ void phase_rp8(const Prm& p) {
    const bf16_t* O = (const bf16_t*)(p.ws + WS_R0 + UB); bf16_t* xb = (bf16_t*)(p.ws + WS_R0 + 3 * UB); const float* g = p.in[I_GPFF];
    const int lane = threadIdx.x & 63, gw = blockIdx.x * 8 + (threadIdx.x >> 6), nw = gridDim.x * 8;
    for (int row = gw; row < MT; row += nw) {
        const bf16_t* xr = (const bf16_t*)p.out + (size_t)row * 1024; const bf16_t* orow = O + (size_t)row * 1024; f32x4 v[4], x[4]; float ss = 0.f;
#pragma unroll
        for (int i = 0; i < 4; ++i) { { const u32x2 ow = *(const u32x2*)(orow + i * 256 + lane * 4); v[i] = (f32x4){bflo(ow.x), bfhi(ow.x), bflo(ow.y), bfhi(ow.y)}; } { const u32x2 xw = *(const u32x2*)(xr + i * 256 + lane * 4); x[i] = (f32x4){bflo(xw.x), bfhi(xw.x), bflo(xw.y), bfhi(xw.y)}; } ss += v[i][0] * v[i][0] + v[i][1] * v[i][1] + v[i][2] * v[i][2] + v[i][3] * v[i][3]; }
        ss = wsum(ss); const float rs = rsqrtf(ss * (1.0f / 1024.0f) + EPS);
#pragma unroll
        for (int i = 0; i < 4; ++i) { const f32x4 gg = *(const f32x4*)(g + i * 256 + lane * 4); x[i] += v[i] * rs * gg;
            *(u32x2*)(xb + (size_t)row * 1024 + i * 256 + lane * 4) = pk4(x[i]); }
    }
}
__device__ __forceinline__ void phase_conv(const Prm& p) {
    const bf16_t* A = (const bf16_t*)(p.ws + WS_R0 + UB); bf16_t* Ug = (bf16_t*)(p.ws + WS_R0 + UB + A_BYTES);
    const float* wc = p.in[I_WCONV]; const float* bc = p.in[I_BCONV]; const float* cc = p.in[I_CC];
    for (int id = blockIdx.x * 512 + threadIdx.x; id < 2112 * 352; id += gridDim.x * 512) {
        const int ri = id / 352, c0 = (id % 352) * 8;
        int row; if (ri < 2048) row = (ri >> 1) * 64 + (ri & 1); else { const int j = ri - 2048; row = MP + (j >> 1) * 32 + (j & 1); }
        float am2[8], am1[8], a[8], u[8], gq[8];
#pragma unroll
        for (int j = 0; j < 8; ++j) { am2[j] = 0.f; am1[j] = 0.f; }
        if (row < MP) {
            const int t = row & 2047;
            if (t >= 1) unpk8(*(const u32x4*)(A + (size_t)(row - 1) * DFF + c0), am1);
            if (t >= 2) unpk8(*(const u32x4*)(A + (size_t)(row - 2) * DFF + c0), am2);
        } else {
            const int rs = row - MP, b = rs >> 5, t = rs & 31;
            if (t == 0) {
#pragma unroll
                for (int j = 0; j < 8; ++j) { am2[j] = cc[(size_t)(b * 2) * DFF + c0 + j]; am1[j] = cc[(size_t)(b * 2 + 1) * DFF + c0 + j]; }
            } else {
#pragma unroll
                for (int j = 0; j < 8; ++j) am2[j] = cc[(size_t)(b * 2 + 1) * DFF + c0 + j];
                unpk8(*(const u32x4*)(A + (size_t)(row - 1) * DFF + c0), am1);
            }
        }
        const size_t off = (size_t)row * DFF + c0;
        unpk8(*(const u32x4*)(A + off), a); unpk8(*(const u32x4*)(Ug + off), u);
#pragma unroll
        for (int j = 0; j < 8; ++j) {
            const float ac = bc[c0 + j] + wc[c0 + j] * am2[j] + wc[DFF + c0 + j] * am1[j] + wc[2 * DFF + c0 + j] * a[j];
            const float y = 1.5957691216f * (ac + 0.044715f * ac * ac * ac);
            gq[j] = ac * sigm(y) * u[j];
        }
        u32x4 wv; wv.x = pk2(gq[0], gq[1]); wv.y = pk2(gq[2], gq[3]); wv.z = pk2(gq[4], gq[5]); wv.w = pk2(gq[6], gq[7]);
        *(u32x4*)(Ug + off) = wv;
    }
}

#ifndef PROBE_DUP
#define PROBE_DUP 0
#endif
#ifndef P2M
#define P2M 15
#endif
#ifndef PHM
#define PHM 0xfff
#endif

#define XB_TMO      128
#define XB_XCNT(j)  (256  + 64 * (j))
#define XB_XSUB(j)  (1280 + 64 * (j))
#define XB_XGEN(j)  (2304 + 64 * (j))
#define XB_TOP      3328
#define XB_TOPGEN   3392
#define XCD_BAR_WORDS 3456
#define XB_SPIN_CAP (1u << 18)
#define LAS __attribute__((address_space(3)))

__device__ __forceinline__ unsigned xb_ld(unsigned* p)              { return __hip_atomic_load(p, __ATOMIC_RELAXED, __HIP_MEMORY_SCOPE_AGENT); }
__device__ __forceinline__ unsigned xb_add(unsigned* p, unsigned v) { return __hip_atomic_fetch_add(p, v, __ATOMIC_RELAXED, __HIP_MEMORY_SCOPE_AGENT); }
__device__ __forceinline__ unsigned xb_xcc_id() { return (unsigned)__builtin_amdgcn_s_getreg((3 << 11) | 20) & 0xFu; }
#define XB_SPIN(cond, bar) do { unsigned _sp = 0; while (cond) { __builtin_amdgcn_s_sleep(1); \
    if ((++_sp & 255u) == 0u) { if (xb_ld(&(bar)[XB_TMO])) break; if (_sp > XB_SPIN_CAP) { atomicAdd(&(bar)[XB_TMO], 1u); break; } } } } while (0)
struct XcdBarrier {
    unsigned* bar; unsigned x;
    volatile LAS unsigned* st;
};

__device__ __forceinline__ XcdBarrier xcd_barrier_post(unsigned* bar, volatile LAS unsigned* st) {
    XcdBarrier b; b.bar = bar; b.x = xb_xcc_id(); b.st = st;
    if (threadIdx.x == 0) (void)xb_add(&bar[XB_XCNT(b.x)], 1u);
    return b;
}
__device__ __forceinline__ void xcd_barrier_complete(unsigned* bar, unsigned x, unsigned& nloc, unsigned& nx) {
    const unsigned G = gridDim.x * gridDim.y * gridDim.z;
    unsigned sum, cnt, mine, sp = 0u;
    for (;;) {
        sum = 0u; cnt = 0u; mine = 0u;
#pragma unroll
        for (unsigned j = 0; j < 16; ++j) { const unsigned c = xb_ld(&bar[XB_XCNT(j)]); sum += c; cnt += (c > 0u) ? 1u : 0u; mine = (j == x) ? c : mine; }
        if (sum == G) break;
        __builtin_amdgcn_s_sleep(1);
        if ((++sp & 255u) == 0u) { if (xb_ld(&bar[XB_TMO])) break; if (sp > XB_SPIN_CAP) { atomicAdd(&bar[XB_TMO], 1u); break; } }
    }
    nloc = mine > 0u ? mine : 1u; nx = cnt > 0u ? cnt : 1u;
}

__device__ __forceinline__ void xcd_barrier(const XcdBarrier& b) {
    asm volatile("s_waitcnt vmcnt(0)" ::: "memory");
    __syncthreads();
    if (threadIdx.x == 0) {
        unsigned* bar = b.bar;
        __builtin_amdgcn_s_waitcnt(0);
        unsigned nloc = b.st[0], nx = b.st[1];
        if (nloc == 0u) { xcd_barrier_complete(bar, b.x, nloc, nx); b.st[0] = nloc; b.st[1] = nx; }
        const unsigned old = xb_add(&bar[XB_XSUB(b.x)], 1u);
        const unsigned gen = old / nloc;
        if (old + 1u == (gen + 1u) * nloc) {
            __builtin_amdgcn_fence(__ATOMIC_RELEASE, "agent");
            asm volatile("s_waitcnt vmcnt(0)" ::: "memory");
            const unsigned og = xb_add(&bar[XB_TOP], 1u);
            const unsigned tg = og / nx;
            if (og + 1u == (tg + 1u) * nx) xb_add(&bar[XB_TOPGEN], 1u);
            else XB_SPIN(xb_ld(&bar[XB_TOPGEN]) == tg, bar);
            __builtin_amdgcn_fence(__ATOMIC_ACQUIRE, "agent");
            xb_add(&bar[XB_XGEN(b.x)], 1u);
            asm volatile("s_waitcnt vmcnt(0)" ::: "memory");
        } else {
            XB_SPIN(xb_ld(&bar[XB_XGEN(b.x)]) == gen, bar);
            __builtin_amdgcn_fence(__ATOMIC_ACQUIRE, "agent");
            asm volatile("s_waitcnt vmcnt(0)" ::: "memory");
        }
    }
    __syncthreads();
}

__global__ void __launch_bounds__(512, 2) fwd_mega(Prm p, int ph_lo, int ph_hi) {
    extern __shared__ __attribute__((aligned(16))) unsigned char lds[];
    cg::grid_group grid = cg::this_grid();
    unsigned char* ws = p.ws;
    bf16_t* R0 = (bf16_t*)(ws + WS_R0);
#define REG(i) ((bf16_t*)(ws + WS_R0 + (size_t)(i) * UB))
    unsigned* barw = (unsigned*)(ws + WS_END);
    if (blockIdx.x == 0) for (int i = threadIdx.x; i < XCD_BAR_WORDS; i += 512) barw[i] = 0u;
    volatile LAS unsigned* xst = (volatile LAS unsigned*)((PG8_LAS unsigned char*)lds + (LDS_BYTES - 16));
    if (threadIdx.x < 4) xst[threadIdx.x] = 0u;
    __syncthreads();
    XcdBarrier xb; xb.bar = barw; xb.x = 0u; xb.st = xst;
    unsigned bar_k = 0;
#define GRID_SEAM() do { if (bar_k == 0) { grid.sync(); xb = xcd_barrier_post(barw, xst); } else xcd_barrier(xb); ++bar_k; } while (0)
#define PH_BEGIN(n) if (ph_lo <= (n) && (n) < ph_hi) { if ((n) > ph_lo) GRID_SEAM();
#define PH_END }
#if (PHM >> 0) & 1
        PH_BEGIN(0) phase0(p, lds);
#if PROBE_DUP == 1
        grid.sync(); phase0(p, lds);
#endif
        PH_END
#else
#endif
#if (PHM >> 1) & 1
        PH_BEGIN(1) { F1 f; f.r0 = R0; f.kv = (bf16_t*)(ws + WS_KV); f.out = p.out; run_gemm(lds, (const bf16_t*)p.out, (const bf16_t*)(ws + WS_WIN), NIN, 1024, f);
#if PROBE_DUP == 3
            grid.sync(); run_gemm(lds, (const bf16_t*)p.out, (const bf16_t*)(ws + WS_WIN), NIN, 1024, f);
#endif
        } PH_END
#else
#endif
#if (PHM >> 2) & 1
        PH_BEGIN(2) {
#if PROBE_DUP == 2
            { bf16_t* YA = (bf16_t*)p.out; bf16_t* YB = (bf16_t*)p.out + UB / 2;
            const int G = gridDim.x;
#if P2M & 1
#pragma unroll 1
            for (int s = blockIdx.x; s < 256; s += G) hgrn_seq<64, false>(p, lds, s >> 3, s & 7, YB);
#endif
#if P2M & 2
#pragma unroll 1
            for (int s = blockIdx.x; s < 256; s += G) hgrn_seq<32, true>(p, lds, s >> 3, s & 7, YB);
#endif
            __syncthreads(); attn_bias_table(p, lds); __syncthreads();
#if P2M & 4
#pragma unroll 1
            for (int it = blockIdx.x; it < 2048; it += G) attn_item<12, 4, false>(p, lds, it >> 6, (it >> 1) & 31, it & 1, YA);
#endif
#if P2M & 8
#pragma unroll 1
            for (int it = blockIdx.x; it < 64; it += G) attn_item<10, 2, true>(p, lds, it >> 1, 0, it & 1, YA);
#endif
            __syncthreads(); }
#endif
            { bf16_t* YA = REG(0); bf16_t* YB = REG(1);
            const int G = gridDim.x;
#if P2M & 1
#pragma unroll 1
            for (int s = blockIdx.x; s < 256; s += G) hgrn_seq<64, false>(p, lds, s >> 3, s & 7, YB);
#endif
#if P2M & 2
#pragma unroll 1
            for (int s = blockIdx.x; s < 256; s += G) hgrn_seq<32, true>(p, lds, s >> 3, s & 7, YB);
#endif
            __syncthreads(); attn_bias_table(p, lds); __syncthreads();
#if P2M & 4
#pragma unroll 1
            for (int it = blockIdx.x; it < 2048; it += G) attn_item<12, 4, false>(p, lds, it >> 6, (it >> 1) & 31, it & 1, YA);
#endif
#if P2M & 8
#pragma unroll 1
            for (int it = blockIdx.x; it < 64; it += G) attn_item<10, 2, true>(p, lds, it >> 1, 0, it & 1, YA);
#endif
            }
        } PH_END
#else
#endif
#if (PHM >> 3) & 1
        PH_BEGIN(3) { F2 f; f.g = REG(5); f.o = REG(2); run_gemm(lds, REG(0), (const bf16_t*)(ws + WS_WBRA), 1024, 1024, f); late_weights(p, lds);
#if PROBE_DUP == 4
            grid.sync(); run_gemm(lds, REG(0), (const bf16_t*)(ws + WS_WBRA), 1024, 1024, f); late_weights(p, lds);
#endif
        } PH_END
#else
#endif
#if (PHM >> 4) & 1
        PH_BEGIN(4) { F3 f; f.g = REG(6); f.t = REG(2); f.o = REG(3); run_gemm(lds, REG(1), (const bf16_t*)(ws + WS_WBRB), 1024, 1024, f); } PH_END
#else
#endif
#if (PHM >> 5) & 1
        PH_BEGIN(5) { FBF f; f.o = REG(4); run_gemm(lds, REG(3), (const bf16_t*)(ws + WS_WOUT), 1024, 1024, f);
#if PROBE_DUP == 5
            grid.sync(); run_gemm(lds, REG(3), (const bf16_t*)(ws + WS_WOUT), 1024, 1024, f);
#endif
        } PH_END
#else
#endif
#if (PHM >> 6) & 1
        PH_BEGIN(6) phase_rp5(p); PH_END
#else
#endif
#if (PHM >> 7) & 1
        PH_BEGIN(7) { EpiUp e; e.g = (bf16_t*)(ws + WS_R0 + UB + A_BYTES); e.araw = REG(1); e.out = p.out; e.wcv = p.in[I_WCONV]; e.bcv = p.in[I_BCONV]; run_gemm_epi(lds, REG(0), (const bf16_t*)(ws + WS_WUP), 2 * DFF, 1024, e); } PH_END
#else
#endif
#if (PHM >> 8) & 1
        PH_BEGIN(8) phase_conv(p); PH_END
#else
#endif
        PH_BEGIN(9) { FBF f; f.o = REG(1); run_gemm(lds, (const bf16_t*)(ws + WS_R0 + UB + A_BYTES), (const bf16_t*)(ws + WS_WDOWN), 1024, DFF, f);
                  FBF f2; f2.o = REG(0); run_gemm(lds, (const bf16_t*)(ws + WS_KV), (const bf16_t*)(ws + WS_WPLE), 1024, 256, f2); } PH_END
#if (PHM >> 10) & 1
        PH_BEGIN(10) phase_rp8(p); PH_END
#else
#endif
#if (PHM >> 11) & 1
        PH_BEGIN(11) { F9 f; f.pe = REG(0); f.xb = REG(3); f.y = p.out; run_gemm(lds, REG(3), (const bf16_t*)(ws + WS_WPG), 1024, 1024, f); } PH_END
#else
#endif
#undef REG
}

extern "C" void kernel_launch(void* const* d_in, const int* in_sizes, int n_in, void* d_out, int out_size, void* d_ws, size_t ws_size, hipStream_t stream) {
    static int grid = 0;
    if (grid == 0) {
        if (n_in != 26 || (size_t)out_size != O_END || ws_size < WS_END) { fprintf(stderr, "kernel_launch: unexpected shapes n_in %d out %d ws %zu (need %zu)\n", n_in, out_size, ws_size, (size_t)WS_END); grid = -1; return; }
        int dev = 0, cus = 0, per_cu = 0;
        hipGetDevice(&dev); hipDeviceGetAttribute(&cus, hipDeviceAttributeMultiprocessorCount, dev);
        if (hipFuncSetAttribute((const void*)fwd_mega, hipFuncAttributeMaxDynamicSharedMemorySize, LDS_BYTES) != hipSuccess) { fprintf(stderr, "kernel_launch: hipFuncSetAttribute failed\n"); grid = -1; return; }
        if (hipOccupancyMaxActiveBlocksPerMultiprocessor(&per_cu, (const void*)fwd_mega, 512, LDS_BYTES) != hipSuccess || per_cu < 1) { fprintf(stderr, "kernel_launch: occupancy query says %d\n", per_cu); per_cu = 1; }
        (void)hipGetLastError();
        grid = cus;
    }
    if (grid < 0) return;
    Prm p{};
    for (int i = 0; i < 26; ++i) p.in[i] = (const float*)d_in[i];
    p.out = (float*)d_out; p.ws = (unsigned char*)d_ws;
    int lo = 0, hi = 12;
    void* args[] = {&p, &lo, &hi};
    hipError_t e = hipLaunchCooperativeKernel((const void*)fwd_mega, dim3(grid), dim3(512), args, LDS_BYTES, stream);
    if (e != hipSuccess) fprintf(stderr, "kernel_launch: cooperative launch failed: %s (grid %d)\n", hipGetErrorString(e), grid);
}
```

```cpp
#include <hip/hip_runtime.h>
#include <hip/hip_cooperative_groups.h>
#include <cstdio>
namespace cg = cooperative_groups;
namespace pg8 {
#define PG8_LAS __attribute__((address_space(3)))
typedef unsigned short bf16_t;
typedef short bf16x8 __attribute__((ext_vector_type(8)));
typedef float f32x4 __attribute__((ext_vector_type(4)));
typedef unsigned u32x4 __attribute__((ext_vector_type(4)));
constexpr int BM = 256, BK = 64, HALF = 128, HTB = HALF * BK * 2  , STAGE_BYTES = 8 * HTB, NXCD = 8, WGM = 8;

__host__ __device__ __forceinline__ int lds_byte(int r, int c) { const int st = (r >> 4) * 2 + (c >> 5), rr = r & 15, cc = c & 31, ob = rr * 64 + cc * 2; return st * 1024 + (ob ^ (((ob >> 9) & 1) << 5)); }
__host__ __device__ __forceinline__ void stage_rc(int b, int& R, int& C) { const int st = b / 1024, sb = b % 1024, swz = sb ^ (((sb >> 9) & 1) << 5); R = (st >> 1) * 16 + swz / 64; C = (st & 1) * 32 + (swz % 64) / 2; }
__host__ __device__ __forceinline__ int perm32(int rho) { const int n = rho >> 4, i = rho & 15; return 8 * (i >> 2) + 4 * n + (i & 3); }

struct Unit { int pm, pn; };
struct Gemm { const bf16_t* A; const bf16_t* Bt; int M, N, K; };

struct StaticOrder {
    int nM, nN, nwg, G, c;
    __host__ __device__ void init(int M, int N, int G_, int c_) { nM = M / BM; nN = N / BM; nwg = nM * nN; G = G_; c = c_; }
    __host__ __device__ bool next(int i, Unit& u) const {
        const long L = (long)i * G + c; if (L >= nwg) return false;
        int wgid = (int)L; { const int q = nwg / NXCD, r = nwg % NXCD, xcd = wgid % NXCD, off = wgid / NXCD; wgid = (xcd < r ? xcd * (q + 1) : r * (q + 1) + (xcd - r) * q) + off; }
        const int nig = WGM * nN, gid = wgid / nig, fm = gid * WGM, gsz = (nM - fm) < WGM ? (nM - fm) : WGM;
        u.pm = fm + ((wgid % nig) % gsz); u.pn = (wgid % nig) / gsz; return true;
    }
    __device__ __forceinline__ void a_ready(const Unit&) const {}
    __device__ __forceinline__ void done(const Unit&) const {}
};
__device__ __forceinline__ unsigned cvt_pk_bf16(float lo, float hi) { unsigned r; asm volatile("v_cvt_pk_bf16_f32 %0, %1, %2" : "=v"(r) : "v"(lo), "v"(hi)); return r; }
template <class Epi, class Sched, bool STAMP = false>
__device__ __forceinline__ void gemm_phase(PG8_LAS unsigned char* lds, const Gemm g, const Sched& S, const Epi& E, unsigned long long* stamps) {
    const int tid = threadIdx.x, wid = __builtin_amdgcn_readfirstlane(tid >> 6), lane = tid & 63, wr = wid >> 2, wc = wid & 3, fr = lane & 15, fq = lane >> 4;
    const int K = g.K, nt = K / BK;
    int ts_lo = 0, ts_hi = 0, nts = 0; const unsigned long long rt_entry = STAMP ? (unsigned long long)wall_clock64() : 0ull;
#define PG8_STAMP() do { if (STAMP && wid == 0 && nts < 64) { const unsigned long long _c = (unsigned long long)clock64(); \
        ts_lo = (lane == nts) ? (int)(unsigned)_c : ts_lo; ts_hi = (lane == nts) ? (int)(unsigned)(_c >> 32) : ts_hi; ++nts; } } while (0)
    PG8_STAMP();
    unsigned voffA[2], voffB[2];
#pragma unroll
    for (int i = 0; i < 2; ++i) { int R, C; stage_rc(tid * 16 + i * 8192, R, C); const int Rb = Epi::PERM ? ((R & ~31) + perm32(R & 31)) : R;
        voffA[i] = (unsigned)(R * K + C) * 2u; voffB[i] = (unsigned)(Rb * K + C) * 2u; }
    const size_t kstep = (size_t)(BK * 2);
    const size_t hstep = (size_t)HALF * K * 2;
    const size_t tstep = 2 * hstep;
    const unsigned ldsw = (unsigned)wid * 1024u;
    const int aoff = lds_byte(wr * 64 + fr, fq * 8), boff = lds_byte(wc * 32 + fr, fq * 8);
#define PG8_SA(b, h) (((b) * 2 + (h)) * HTB)
#define PG8_SB(b, h) ((4 + (b) * 2 + (h)) * HTB)
#define PG8_STAGE(bufoff, gbase, voff) do { _Pragma("unroll") for (int _i = 0; _i < 2; ++_i) \
        __builtin_amdgcn_global_load_lds((const unsigned*)((const char*)(gbase) + (voff)[_i]), (PG8_LAS unsigned*)(lds + (bufoff) + ldsw + _i * 8192), 16, 0, 0); } while (0)
#define PG8_LDA(dst, b, h) do { _Pragma("unroll") for (int m = 0; m < 4; ++m) _Pragma("unroll") for (int k = 0; k < 2; ++k) dst[m][k] = *(const PG8_LAS bf16x8*)(lds + PG8_SA(b, h) + aoff + m * 2048 + k * 1024); } while (0)
#define PG8_LDB(dst, b, h) do { _Pragma("unroll") for (int n = 0; n < 2; ++n) _Pragma("unroll") for (int k = 0; k < 2; ++k) dst[n][k] = *(const PG8_LAS bf16x8*)(lds + PG8_SB(b, h) + boff + n * 2048 + k * 1024); } while (0)
#define PG8_MMA(ai, bj, At, Bt) do { __builtin_amdgcn_s_setprio(1); _Pragma("unroll") for (int m = 0; m < 4; ++m) _Pragma("unroll") for (int n = 0; n < 2; ++n) _Pragma("unroll") for (int k = 0; k < 2; ++k) \
        acc[ai][bj][m][n] = __builtin_amdgcn_mfma_f32_16x16x32_bf16(Bt[n][k], At[m][k], acc[ai][bj][m][n], 0, 0, 0); __builtin_amdgcn_s_setprio(0); } while (0)
#define PG8_WAIT_V(n) asm volatile("s_waitcnt vmcnt(" #n ")" ::: "memory")
#define PG8_WAIT_L(n) asm volatile("s_waitcnt lgkmcnt(" #n ")" ::: "memory")
#define PG8_BAR __builtin_amdgcn_s_barrier()
#define PG8_SCHED __builtin_amdgcn_sched_barrier(0)
    Unit cur, nxt; int ui = 0;
    if (!S.next(0, cur)) return;
    f32x4 acc[2][2][4][2];
#pragma unroll
    for (int a = 0; a < 2; ++a)
#pragma unroll
        for (int b = 0; b < 2; ++b)
#pragma unroll
            for (int m = 0; m < 4; ++m)
#pragma unroll
                for (int n = 0; n < 2; ++n) acc[a][b][m][n] = (f32x4){0.f, 0.f, 0.f, 0.f};
    bf16x8 At[4][2], B0[2][2], B1[2][2];
    const char* cA = (const char*)g.A + (size_t)cur.pm * tstep; const char* cB = (const char*)g.Bt + (size_t)cur.pn * tstep;
    S.a_ready(cur);
    PG8_STAGE(PG8_SB(0, 0), cB, voffB); PG8_STAGE(PG8_SA(0, 0), cA, voffA); PG8_STAGE(PG8_SB(0, 1), cB + hstep, voffB); PG8_STAGE(PG8_SA(0, 1), cA + hstep, voffA);
    if (wr == 1) PG8_BAR;
    PG8_WAIT_V(4); PG8_BAR;
    PG8_STAGE(PG8_SB(1, 0), cB + kstep, voffB); PG8_STAGE(PG8_SA(1, 0), cA + kstep, voffA); PG8_STAGE(PG8_SB(1, 1), cB + hstep + kstep, voffB);
    PG8_WAIT_V(6); PG8_BAR;
    PG8_STAMP();
    for (;;) {
        const bool has_next = S.next(ui + 1, nxt);
        const char* nA = has_next ? (const char*)g.A + (size_t)nxt.pm * tstep : cA; const char* nB = has_next ? (const char*)g.Bt + (size_t)nxt.pn * tstep : cB;
        for (int t = 0; t < nt; t += 2) {
            const bool last = (t == nt - 2);
            const char* a1 = cA + (size_t)(t + 1) * kstep;
            const char* a2 = last ? nA : cA + (size_t)(t + 2) * kstep; const char* b2 = last ? nB : cB + (size_t)(t + 2) * kstep;
            const char* a3 = a2 + kstep; const char* b3 = b2 + kstep;
            if (last && has_next) S.a_ready(nxt);
            PG8_LDB(B0, 0, 0); PG8_SCHED; PG8_LDA(At, 0, 0); PG8_STAGE(PG8_SA(1, 1), a1 + hstep, voffA);
            PG8_WAIT_L(8); PG8_BAR; PG8_WAIT_L(0); PG8_MMA(0, 0, At, B0); PG8_BAR; PG8_SCHED;
            PG8_LDB(B1, 0, 1); PG8_STAGE(PG8_SB(0, 0), b2, voffB);
            PG8_BAR; PG8_WAIT_L(0); PG8_MMA(0, 1, At, B1); PG8_BAR;
            PG8_LDA(At, 0, 1); PG8_STAGE(PG8_SA(0, 0), a2, voffA);
            PG8_BAR; PG8_WAIT_L(0); PG8_MMA(1, 0, At, B0); PG8_BAR; PG8_SCHED;
            PG8_STAGE(PG8_SB(0, 1), b2 + hstep, voffB);
            PG8_WAIT_V(6); PG8_BAR; PG8_MMA(1, 1, At, B1); PG8_BAR;
            PG8_LDB(B0, 1, 0); PG8_SCHED; PG8_LDA(At, 1, 0); PG8_STAGE(PG8_SA(0, 1), a2 + hstep, voffA);
            PG8_WAIT_L(8); PG8_BAR; PG8_WAIT_L(0); PG8_MMA(0, 0, At, B0); PG8_BAR; PG8_SCHED;
            PG8_LDB(B1, 1, 1); PG8_STAGE(PG8_SB(1, 0), b3, voffB);
            PG8_BAR; PG8_WAIT_L(0); PG8_MMA(0, 1, At, B1); PG8_BAR;
            PG8_LDA(At, 1, 1); PG8_STAGE(PG8_SA(1, 0), a3, voffA);
            PG8_BAR; PG8_WAIT_L(0); PG8_MMA(1, 0, At, B0); PG8_BAR; PG8_SCHED;
            PG8_STAGE(PG8_SB(1, 1), b3 + hstep, voffB);
            PG8_WAIT_V(6); PG8_BAR; PG8_MMA(1, 1, At, B1); PG8_BAR;
        }
        PG8_STAMP();
        if constexpr (!Epi::AFTER_DRAIN) { E(acc, cur, wr, wc, fr, fq); S.done(cur); }
        PG8_STAMP();
        if (!has_next) break;
#pragma unroll
        for (int a = 0; a < 2; ++a)
#pragma unroll
            for (int b = 0; b < 2; ++b)
#pragma unroll
                for (int m = 0; m < 4; ++m)
#pragma unroll
                    for (int n = 0; n < 2; ++n) acc[a][b][m][n] = (f32x4){0.f, 0.f, 0.f, 0.f};
        cur = nxt; cA = nA; cB = nB; ++ui;
    }
    PG8_WAIT_V(0);
    if (wr == 0) PG8_BAR;
    PG8_BAR;
    if constexpr (Epi::AFTER_DRAIN) { E.fused(acc, cur, wr, wc, fr, fq, lds, wid, lane); S.done(cur); }
    PG8_STAMP();
    if (STAMP && wid == 0) { stamps[lane] = lane < nts ? (((unsigned long long)(unsigned)ts_hi << 32) | (unsigned)ts_lo) : 0ull;
        if (lane == 62) stamps[62] = rt_entry; if (lane == 63) stamps[63] = (unsigned long long)wall_clock64(); }
#undef PG8_STAMP
#undef PG8_SA
#undef PG8_SB
#undef PG8_STAGE
#undef PG8_LDA
#undef PG8_LDB
#undef PG8_MMA
#undef PG8_WAIT_V
#undef PG8_WAIT_L
#undef PG8_BAR
#undef PG8_SCHED
}
}


using pg8::bf16_t; using pg8::bf16x8; using pg8::f32x4; using pg8::u32x4;
typedef unsigned u32x2 __attribute__((ext_vector_type(2)));
typedef float f32x2v __attribute__((ext_vector_type(2)));
#define MFMA16(a, b, c) __builtin_amdgcn_mfma_f32_16x16x32_bf16((a), (b), (c), 0, 0, 0)

constexpr int MP = 65536, MS = 1024, MT = MP + MS, DM = 1024, DFF = 2816, NIN = 7424;
constexpr float EPS = 1e-6f;
constexpr size_t UB = (size_t)MT * 1024 * 2;
constexpr size_t WS_WIN = 0, WS_WBRA = WS_WIN + (size_t)NIN * 1024 * 2, WS_WBRB = WS_WBRA + 2097152, WS_WOUT = WS_WBRB + 2097152, WS_WPG = WS_WOUT + 2097152,
                 WS_WUP = WS_WPG + 2097152, WS_WDOWN = WS_WUP + (size_t)2 * DFF * 1024 * 2, WS_WPLE = WS_WDOWN + (size_t)1024 * DFF * 2, WS_KV = WS_WPLE + (size_t)1024 * 256 * 2,
                 WS_R0 = WS_KV + (size_t)MT * 256 * 2, WS_END = WS_R0 + 7 * UB;
constexpr size_t A_BYTES = (size_t)MT * DFF * 2;
constexpr size_t O_Y = 0, O_PWK = (size_t)MT * 1024, O_PWV = O_PWK + 524288, O_PST = O_PWV + 524288, O_PFC = O_PST + 4194304, O_SWK = O_PFC + 180224, O_SWV = O_SWK + 131072,
                 O_SST = O_SWV + 131072, O_SFC = O_SST + 4194304, O_END = O_SFC + 180224;
constexpr int LDS_BYTES = 147456;

struct Prm { const float* in[26]; float* out; unsigned char* ws; };
enum { I_XP = 0, I_XS, I_CK, I_CV, I_ST, I_CC, I_PP, I_PS, I_RB, I_LB, I_GPM, I_WIN, I_SINK, I_GH, I_WBRA, I_WBRB, I_WOUT, I_GPOST, I_GPF, I_WUP, I_WCONV, I_BCONV, I_WDOWN, I_GPFF, I_WPLE, I_WPG };

__device__ __forceinline__ unsigned pk2(float lo, float hi) { unsigned r; asm("v_cvt_pk_bf16_f32 %0, %1, %2" : "=v"(r) : "v"(lo), "v"(hi)); return r; }
__device__ __forceinline__ float bflo(unsigned w) { return __uint_as_float(w << 16); }
__device__ __forceinline__ float bfhi(unsigned w) { return __uint_as_float(w & 0xffff0000u); }
__device__ __forceinline__ float bf1(bf16_t b) { return __uint_as_float(((unsigned)b) << 16); }
__device__ __forceinline__ bf16_t f2bf(float f) { return (bf16_t)(pk2(f, 0.f) & 0xffffu); }
__device__ __forceinline__ float sigm(float x) { return __builtin_amdgcn_rcpf(1.0f + __expf(-x)); }
__device__ __forceinline__ float wsum(float v) { v += __shfl_xor(v, 32); v += __shfl_xor(v, 16); v += __shfl_xor(v, 8); v += __shfl_xor(v, 4); v += __shfl_xor(v, 2); v += __shfl_xor(v, 1); return v; }
__device__ __forceinline__ u32x4 pk8(f32x4 a, f32x4 b) { u32x4 w; w.x = pk2(a[0], a[1]); w.y = pk2(a[2], a[3]); w.z = pk2(b[0], b[1]); w.w = pk2(b[2], b[3]); return w; }
__device__ __forceinline__ u32x2 pk4(f32x4 a) { u32x2 w; w.x = pk2(a[0], a[1]); w.y = pk2(a[2], a[3]); return w; }
__device__ __forceinline__ void unpk8(u32x4 w, float (&f)[8]) { f[0] = bflo(w.x); f[1] = bfhi(w.x); f[2] = bflo(w.y); f[3] = bfhi(w.y); f[4] = bflo(w.z); f[5] = bfhi(w.z); f[6] = bflo(w.w); f[7] = bfhi(w.w); }

struct NoPre {};
template <class F> struct EpiT {
    static constexpr bool PERM = true, AFTER_DRAIN = false; F f;
    __device__ __forceinline__ void operator()(const f32x4 (&acc)[2][2][4][2], const pg8::Unit& u, int wr, int wc, int fr, int fq) const {
        const int row0 = u.pm * 256 + wr * 64 + fr, col0 = u.pn * 256 + wc * 32 + 8 * fq;
        constexpr int MB = F::MB;
#pragma unroll
        for (int a0 = 0; a0 < 8; a0 += MB) {
            typename F::Pre pre[MB][2];
#pragma unroll
            for (int mm = 0; mm < MB; ++mm)
#pragma unroll
                for (int bj = 0; bj < 2; ++bj) pre[mm][bj] = f.load(row0 + ((a0 + mm) >> 2) * 128 + ((a0 + mm) & 3) * 16, col0 + bj * 128);
#pragma unroll
            for (int mm = 0; mm < MB; ++mm)
#pragma unroll
                for (int bj = 0; bj < 2; ++bj) f(row0 + ((a0 + mm) >> 2) * 128 + ((a0 + mm) & 3) * 16, col0 + bj * 128, u.pn, acc[(a0 + mm) >> 2][bj][(a0 + mm) & 3][0], acc[(a0 + mm) >> 2][bj][(a0 + mm) & 3][1], pre[mm][bj]);
        }
    }
};
struct F1 {
    bf16_t* r0; bf16_t* kv; float* out; typedef NoPre Pre; static constexpr int MB = 1;
    __device__ __forceinline__ NoPre load(int, int) const { return NoPre(); }
    __device__ __forceinline__ void operator()(int row, int col, int pn, f32x4 v0, f32x4 v1, NoPre) const {
        const u32x4 w = pk8(v0, v1);
        if (pn < 4) { __builtin_nontemporal_store(w, (u32x4*)(r0 + (size_t)row * 1024 + col)); }
        else if (pn == 4) {
            const int c = col - 1024; *(u32x4*)(kv + (size_t)row * 256 + c) = w;
            float* o = nullptr;
            if (row >= MP) { o = out + (c < 128 ? O_SWK : O_SWV) + (size_t)(row - MP) * 128 + (c & 127); }
            else { const int t = row & 2047; if (t >= 1920) o = out + (c < 128 ? O_PWK : O_PWV) + (size_t)((row >> 11) * 128 + t - 1920) * 128 + (c & 127); }
            if (o) { *(f32x4*)o = v0; *(f32x4*)(o + 4) = v1; }
        } else { const int c2 = col - 1280, seg = c2 >> 10; __builtin_nontemporal_store(w, (u32x4*)(r0 + (size_t)(1 + seg) * (UB / 2) + (size_t)row * 1024 + (c2 & 1023))); }
    }
};
struct F2 {
    const bf16_t* g; bf16_t* o; typedef u32x4 Pre; static constexpr int MB = 8;
    __device__ __forceinline__ u32x4 load(int row, int col) const { return *(const u32x4*)(g + (size_t)row * 1024 + col); }
    __device__ __forceinline__ void operator()(int row, int col, int, f32x4 v0, f32x4 v1, u32x4 gw) const {
        const size_t i = (size_t)row * 1024 + col; float gf[8]; unpk8(gw, gf);
        f32x4 a, b;
#pragma unroll
        for (int j = 0; j < 4; ++j) { a[j] = v0[j] * sigm(gf[j]); b[j] = v1[j] * sigm(gf[4 + j]); }
        *(u32x4*)(o + i) = pk8(a, b);
    }
};
struct F3 {
    const bf16_t* g; const bf16_t* t; bf16_t* o; struct Pre { u32x4 g, t; }; static constexpr int MB = 4;
    __device__ __forceinline__ Pre load(int row, int col) const { const size_t i = (size_t)row * 1024 + col; Pre r; r.g = *(const u32x4*)(g + i); r.t = *(const u32x4*)(t + i); return r; }
    __device__ __forceinline__ void operator()(int row, int col, int, f32x4 v0, f32x4 v1, Pre pr) const {
        const size_t i = (size_t)row * 1024 + col; float gf[8], tf[8]; unpk8(pr.g, gf); unpk8(pr.t, tf);
        f32x4 a, b;
#pragma unroll
        for (int j = 0; j < 4; ++j) { a[j] = tf[j] + v0[j] * sigm(gf[j]); b[j] = tf[4 + j] + v1[j] * sigm(gf[4 + j]); }
        *(u32x4*)(o + i) = pk8(a, b);
    }
};
struct FF32 {
    float* o; typedef NoPre Pre; static constexpr int MB = 1;
    __device__ __forceinline__ NoPre load(int, int) const { return NoPre(); }
    __device__ __forceinline__ void operator()(int row, int col, int, f32x4 v0, f32x4 v1, NoPre) const { float* d = o + (size_t)row * 1024 + col; *(f32x4*)d = v0; *(f32x4*)(d + 4) = v1; }
};
struct FBF {
    bf16_t* o; typedef NoPre Pre; static constexpr int MB = 1;
    __device__ __forceinline__ NoPre load(int, int) const { return NoPre(); }
    __device__ __forceinline__ void operator()(int row, int col, int, f32x4 v0, f32x4 v1, NoPre) const { *(u32x4*)(o + (size_t)row * 1024 + col) = pk8(v0, v1); }
};
struct EpiUp {
    static constexpr bool PERM = true, AFTER_DRAIN = false;
    bf16_t* g; bf16_t* araw; float* out; const float* wcv; const float* bcv;
    __device__ __forceinline__ void operator()(const f32x4 (&acc)[2][2][4][2], const pg8::Unit& u, int wr, int wc, int fr, int fq) const {
        const int c0 = u.pn * 128 + wc * 32 + 8 * fq;
        float w0[8], w1[8], w2[8], bb[8];
        { const f32x4 t0 = *(const f32x4*)(wcv + c0), t1 = *(const f32x4*)(wcv + c0 + 4), t2 = *(const f32x4*)(wcv + DFF + c0), t3 = *(const f32x4*)(wcv + DFF + c0 + 4),
                      t4 = *(const f32x4*)(wcv + 2 * DFF + c0), t5 = *(const f32x4*)(wcv + 2 * DFF + c0 + 4), t6 = *(const f32x4*)(bcv + c0), t7 = *(const f32x4*)(bcv + c0 + 4);
#pragma unroll
          for (int j = 0; j < 4; ++j) { w0[j] = t0[j]; w0[4 + j] = t1[j]; w1[j] = t2[j]; w1[4 + j] = t3[j]; w2[j] = t4[j]; w2[4 + j] = t5[j]; bb[j] = t6[j]; bb[4 + j] = t7[j]; } }
#pragma unroll
        for (int ai = 0; ai < 2; ++ai) {
            float p1[8], p2[8];
#pragma unroll
            for (int j = 0; j < 8; ++j) { p1[j] = 0.f; p2[j] = 0.f; }
#pragma unroll
            for (int m = 0; m < 4; ++m) {
                const int row = u.pm * 256 + ai * 128 + wr * 64 + m * 16 + fr;
                float a[8], uu[8], r1[8], r2[8], gq[8];
#pragma unroll
                for (int j = 0; j < 4; ++j) { a[j] = acc[ai][0][m][0][j]; a[4 + j] = acc[ai][0][m][1][j]; uu[j] = acc[ai][1][m][0][j]; uu[4 + j] = acc[ai][1][m][1][j]; }
#pragma unroll
                for (int j = 0; j < 8; ++j) { r1[j] = __int_as_float(__builtin_amdgcn_mov_dpp(__float_as_int(a[j]), 0x121, 0xf, 0xf, false)); r2[j] = __int_as_float(__builtin_amdgcn_mov_dpp(__float_as_int(a[j]), 0x122, 0xf, 0xf, false)); }
                const bool sample = row >= MP;
                const bool boundary = (m == 0 && fr < 2) || (sample && ((m & 1) == 0) && fr < 2);
                const bool keep_a = boundary || (m == 3 && fr >= 14);
#pragma unroll
                for (int j = 0; j < 8; ++j) {
                    const float am1 = fr >= 1 ? r1[j] : p1[j], am2 = fr >= 2 ? r2[j] : p2[j];
                    const float ac = bb[j] + w0[j] * am2 + w1[j] * am1 + w2[j] * a[j];
                    const float y = 1.5957691216f * (ac + 0.044715f * ac * ac * ac);
                    gq[j] = boundary ? uu[j] : ac * sigm(y) * uu[j];
                    p1[j] = r1[j]; p2[j] = r2[j];
                }
                u32x4 wv; wv.x = pk2(gq[0], gq[1]); wv.y = pk2(gq[2], gq[3]); wv.z = pk2(gq[4], gq[5]); wv.w = pk2(gq[6], gq[7]);
                __builtin_nontemporal_store(wv, (u32x4*)(g + (size_t)row * DFF + c0));
                if (keep_a) { u32x4 av; av.x = pk2(a[0], a[1]); av.y = pk2(a[2], a[3]); av.z = pk2(a[4], a[5]); av.w = pk2(a[6], a[7]); *(u32x4*)(araw + (size_t)row * DFF + c0) = av; }
                float* o = nullptr;
                if (sample) { const int rs = row - MP, t = rs & 31; if (t >= 30) o = out + O_SFC + (size_t)((rs >> 5) * 2 + t - 30) * DFF + c0; }
                else { const int t = row & 2047; if (t >= 2046) o = out + O_PFC + (size_t)((row >> 11) * 2 + t - 2046) * DFF + c0; }
                if (o) { *(f32x4*)o = acc[ai][0][m][0]; *(f32x4*)(o + 4) = acc[ai][0][m][1]; }
            }
        }
    }
};
struct F9 {
    const bf16_t* pe; const bf16_t* xb; float* y; struct Pre { u32x4 p, x; }; static constexpr int MB = 4;
    __device__ __forceinline__ Pre load(int row, int col) const { const size_t i = (size_t)row * 1024 + col; Pre r; r.p = *(const u32x4*)(pe + i); r.x = *(const u32x4*)(xb + i); return r; }
    __device__ __forceinline__ void operator()(int row, int col, int, f32x4 v0, f32x4 v1, Pre pr) const {
        const size_t i = (size_t)row * 1024 + col; float pf[8], xf[8]; unpk8(pr.p, pf); unpk8(pr.x, xf);
        f32x4 a, b;
#pragma unroll
        for (int j = 0; j < 4; ++j) { a[j] = xf[j] + pf[j] * sigm(v0[j]); b[j] = xf[4 + j] + pf[4 + j] * sigm(v1[j]); }
        *(f32x4*)(y + i) = a; *(f32x4*)(y + i + 4) = b;
    }
};
template <class E> __device__ __forceinline__ void run_gemm_epi(unsigned char* lds, const bf16_t* A, const bf16_t* Bt, int N, int K, const E& e) {
    asm volatile("" : "+s"(K)); asm volatile("" : "+s"(N));
    pg8::Gemm g; g.A = A; g.Bt = Bt; g.M = MT; g.N = N; g.K = K;
    pg8::StaticOrder S; S.init(MT, N, (int)gridDim.x, (int)blockIdx.x);
    pg8::gemm_phase<E, pg8::StaticOrder, false>((PG8_LAS unsigned char*)lds, g, S, e, nullptr);
    __syncthreads();
}
template <class F> __device__ __forceinline__ void run_gemm(unsigned char* lds, const bf16_t* A, const bf16_t* Bt, int N, int K, const F& f, int skip = 0) {
    asm volatile("" : "+s"(K)); asm volatile("" : "+s"(N));
    pg8::Gemm g; g.A = A; g.Bt = Bt; g.M = MT; g.N = N; g.K = K;
    pg8::StaticOrder S; S.init(MT, N, (int)gridDim.x - skip, (int)blockIdx.x - skip);
    EpiT<F> E; E.f = f;
    pg8::gemm_phase<EpiT<F>, pg8::StaticOrder, false>((PG8_LAS unsigned char*)lds, g, S, E, nullptr);
    __syncthreads();
}

template <bool ILV = false> __device__ __forceinline__ void transpose_w(const float* W, bf16_t* Bt, int K, int N, const float* gain, float* tile, int& toff, int cid, int G) {
    const int nnt = N / 64, ntiles = (K / 64) * nnt, tid = threadIdx.x;
    const int first = (cid - (toff % G) + G) % G;
    const int r0 = tid >> 6, c = tid & 63;
    float v[8];
#define TR_LOAD(t_) do { const int kt_ = (t_) / nnt, d0_ = ((t_) % nnt) * 64; \
        const int sc0_ = ILV ? (((d0_ & 255) < 128) ? (d0_ >> 8) * 128 + (d0_ & 127) : DFF + (d0_ >> 8) * 128 + (d0_ & 127)) : d0_; \
        _Pragma("unroll") for (int i = 0; i < 8; ++i) { const int r = r0 + 8 * i; float x = W[(size_t)(kt_ * 64 + r) * N + sc0_ + c]; if (gain) x *= gain[kt_ * 64 + r]; v[i] = x; } } while (0)
    if (first < ntiles) TR_LOAD(first);
    for (int t = first; t < ntiles; t += G) {
        const int kt = t / nnt, nt = t % nnt;
#pragma unroll
        for (int i = 0; i < 8; ++i) tile[(r0 + 8 * i) * 65 + c] = v[i];
        __syncthreads();
        if (t + G < ntiles) TR_LOAD(t + G);
        { const int n = tid >> 3, k8 = (tid & 7) * 8; u32x4 wv;
          wv.x = pk2(tile[(k8 + 0) * 65 + n], tile[(k8 + 1) * 65 + n]); wv.y = pk2(tile[(k8 + 2) * 65 + n], tile[(k8 + 3) * 65 + n]);
          wv.z = pk2(tile[(k8 + 4) * 65 + n], tile[(k8 + 5) * 65 + n]); wv.w = pk2(tile[(k8 + 6) * 65 + n], tile[(k8 + 7) * 65 + n]);
          *(u32x4*)(Bt + (size_t)(nt * 64 + n) * K + kt * 64 + k8) = wv; }
        __syncthreads();
    }
#undef TR_LOAD
    toff += ntiles;
}
__device__ __forceinline__ const float* xrow(const Prm& p, int row) { return row < MP ? p.in[I_XP] + (size_t)row * 1024 : p.in[I_XS] + (size_t)(row - MP) * 1024; }

__device__ __forceinline__ void late_weights(const Prm& p, unsigned char* lds) {
    if (blockIdx.x < 16) return;
    float* tile = (float*)lds; int toff = 0; unsigned char* ws = p.ws; const int cid = blockIdx.x - 16, G = gridDim.x - 16;
    transpose_w<true>(p.in[I_WUP], (bf16_t*)(ws + WS_WUP), 1024, 2 * DFF, p.in[I_GPF], tile, toff, cid, G);
    transpose_w(p.in[I_WDOWN], (bf16_t*)(ws + WS_WDOWN), DFF, 1024, nullptr, tile, toff, cid, G);
    transpose_w(p.in[I_WPG], (bf16_t*)(ws + WS_WPG), 1024, 1024, nullptr, tile, toff, cid, G);
    transpose_w(p.in[I_WPLE], (bf16_t*)(ws + WS_WPLE), 256, 1024, nullptr, tile, toff, cid, G);
}
__device__ __forceinline__ void phase0(const Prm& p, unsigned char* lds) {
    float* tile = (float*)lds; int toff = 0; unsigned char* ws = p.ws; const int cid = blockIdx.x, G = gridDim.x;
    transpose_w(p.in[I_WIN], (bf16_t*)(ws + WS_WIN), 1024, NIN, p.in[I_GPM], tile, toff, cid, G);
    transpose_w(p.in[I_WBRA], (bf16_t*)(ws + WS_WBRA), 1024, 1024, nullptr, tile, toff, cid, G);
    transpose_w(p.in[I_WBRB], (bf16_t*)(ws + WS_WBRB), 1024, 1024, nullptr, tile, toff, cid, G);
    transpose_w(p.in[I_WOUT], (bf16_t*)(ws + WS_WOUT), 1024, 1024, nullptr, tile, toff, cid, G);
    bf16_t* xn = (bf16_t*)p.out;
    const int lane = threadIdx.x & 63, gw = blockIdx.x * 8 + (threadIdx.x >> 6), nw = gridDim.x * 8;
    for (int row = gw; row < MT; row += nw) {
        const float* xr = xrow(p, row); f32x4 v[4]; float ss = 0.f;
#pragma unroll
        for (int i = 0; i < 4; ++i) { v[i] = *(const f32x4*)(xr + i * 256 + lane * 4); ss += v[i][0] * v[i][0] + v[i][1] * v[i][1] + v[i][2] * v[i][2] + v[i][3] * v[i][3]; }
        ss = wsum(ss); const float rs = rsqrtf(ss * (1.0f / 1024.0f) + EPS);
#pragma unroll
        for (int i = 0; i < 4; ++i) *(u32x2*)(xn + (size_t)row * 1024 + i * 256 + lane * 4) = pk4(v[i] * rs);
    }
}

constexpr int AT_KS = 0, AT_VT = 27648, AT_BT = 53248;
__device__ __forceinline__ void attn_bias_table(const Prm& p, unsigned char* lds) {
    float* bT = (float*)(lds + AT_BT); const float* tab = p.in[I_RB];
    for (int i = threadIdx.x; i < 16 * 256; i += 512) {
        const int head = i >> 8, idx = i & 255, rel = idx - 191, n = rel < 0 ? -rel : rel;
        int bk = n < 8 ? n : min(15, 33 - __clz(n * n)); if (rel > 0) bk += 16;
        bT[i] = idx < 255 ? tab[bk * 16 + head] : 0.f;
    }
}
template <int NKT, int NQT, bool SAMPLE>
__device__ __forceinline__ void attn_item(const Prm& p, unsigned char* lds, int b, int c, int kvh, bf16_t* YA) {
    bf16_t* Ks = (bf16_t*)(lds + AT_KS); bf16_t* Vt = (bf16_t*)(lds + AT_VT); const float* bT = (const float*)(lds + AT_BT);
    const bf16_t* kv = (const bf16_t*)(p.ws + WS_KV); bf16_t* R0 = (bf16_t*)(p.ws + WS_R0);
    const int tid = threadIdx.x, lane = tid & 63, w = tid >> 6, lr = lane & 15, lq = lane >> 4;
    const int head = kvh * 8 + w; const int qrow0 = SAMPLE ? MP + b * 32 : b * 2048 + c * 64;
    const size_t qoff0 = (size_t)(qrow0 + lr) * 1024 + head * 64 + lq * 8;
    bf16x8 qn0 = *(const bf16x8*)(R0 + qoff0), qn1 = *(const bf16x8*)(R0 + qoff0 + 32);
    __syncthreads();
    if (!SAMPLE) {
        const int tok0 = b * 2048 + (c - 2) * 64;
        for (int id = tid; id < 192 * 8; id += 512) {
            const int key = id >> 3, dc = id & 7; u32x4 v = {0u, 0u, 0u, 0u};
            if (c * 64 - 128 + key >= 0) v = *(const u32x4*)(kv + (size_t)(tok0 + key) * 256 + kvh * 64 + dc * 8);
            *(u32x4*)(Ks + key * 72 + dc * 8) = v;
        }
        for (int id = tid; id < 192 * 8; id += 512) {
            const int key = id % 192, dc = id / 192; u32x4 v = {0u, 0u, 0u, 0u};
            if (c * 64 - 128 + key >= 0) v = *(const u32x4*)(kv + (size_t)(tok0 + key) * 256 + 128 + kvh * 64 + dc * 8);
            bf16_t* d = Vt + (dc * 8) * 200 + key;
            d[0] = (bf16_t)(v.x & 0xffffu); d[200] = (bf16_t)(v.x >> 16); d[400] = (bf16_t)(v.y & 0xffffu); d[600] = (bf16_t)(v.y >> 16);
            d[800] = (bf16_t)(v.z & 0xffffu); d[1000] = (bf16_t)(v.z >> 16); d[1200] = (bf16_t)(v.w & 0xffffu); d[1400] = (bf16_t)(v.w >> 16);
        }
    } else {
        const float* ck = p.in[I_CK]; const float* cvp = p.in[I_CV];
        for (int id = tid; id < 160 * 8; id += 512) {
            const int key = id >> 3, dc = id & 7; u32x4 v;
            if (key < 128) { const float* s = ck + (size_t)(b * 128 + key) * 128 + kvh * 64 + dc * 8; v = pk8(*(const f32x4*)s, *(const f32x4*)(s + 4)); }
            else v = *(const u32x4*)(kv + (size_t)(MP + b * 32 + key - 128) * 256 + kvh * 64 + dc * 8);
            *(u32x4*)(Ks + key * 72 + dc * 8) = v;
        }
        for (int id = tid; id < 160 * 8; id += 512) {
            const int key = id % 160, dc = id / 160; u32x4 v;
            if (key < 128) { const float* s = cvp + (size_t)(b * 128 + key) * 128 + kvh * 64 + dc * 8; v = pk8(*(const f32x4*)s, *(const f32x4*)(s + 4)); }
            else v = *(const u32x4*)(kv + (size_t)(MP + b * 32 + key - 128) * 256 + 128 + kvh * 64 + dc * 8);
            bf16_t* d = Vt + (dc * 8) * 200 + key;
            d[0] = (bf16_t)(v.x & 0xffffu); d[200] = (bf16_t)(v.x >> 16); d[400] = (bf16_t)(v.y & 0xffffu); d[600] = (bf16_t)(v.y >> 16);
            d[800] = (bf16_t)(v.z & 0xffffu); d[1000] = (bf16_t)(v.z >> 16); d[1200] = (bf16_t)(v.w & 0xffffu); d[1400] = (bf16_t)(v.w >> 16);
        }
    }
    __syncthreads();
    const float sink = p.in[I_SINK][head];
    const float* bTh = bT + head * 256;
#pragma unroll 1
    for (int qi = 0; qi < NQT; ++qi) {
        const int q = qi * 16 + lr;
        const bf16x8 qf0 = qn0, qf1 = qn1;
        if (qi + 1 < NQT) { qn0 = *(const bf16x8*)(R0 + qoff0 + (size_t)(qi + 1) * 16384); qn1 = *(const bf16x8*)(R0 + qoff0 + (size_t)(qi + 1) * 16384 + 32); }
        f32x4 s[NKT];
#pragma unroll
        for (int kt = 0; kt < NKT; ++kt) {
            const bf16_t* kp = Ks + (kt * 16 + lr) * 72 + lq * 8;
            const bf16x8 k0 = *(const bf16x8*)kp, k1 = *(const bf16x8*)(kp + 32);
            f32x4 a = {0.f, 0.f, 0.f, 0.f}; a = MFMA16(k0, qf0, a); a = MFMA16(k1, qf1, a); s[kt] = a;
        }
        float mx = sink;
#pragma unroll
        for (int kt = 0; kt < NKT; ++kt)
#pragma unroll
            for (int r = 0; r < 4; ++r) {
                const int key = kt * 16 + lq * 4 + r; float v = s[kt][r] * 0.125f + bTh[key - q + 63];
                if (!SAMPLE && (c * 64 - 128 + key < 0)) v = -1e30f;
                s[kt][r] = v; mx = fmaxf(mx, v);
            }
        mx = fmaxf(mx, __shfl_xor(mx, 16)); mx = fmaxf(mx, __shfl_xor(mx, 32));
        float sum = 0.f;
#pragma unroll
        for (int kt = 0; kt < NKT; ++kt)
#pragma unroll
            for (int r = 0; r < 4; ++r) { const float e = __expf(s[kt][r] - mx); s[kt][r] = e; sum += e; }
        sum += __shfl_xor(sum, 16); sum += __shfl_xor(sum, 32);
        const float inv = 1.0f / (sum + __expf(sink - mx));
        f32x4 o[4];
#pragma unroll
        for (int dt = 0; dt < 4; ++dt) o[dt] = (f32x4){0.f, 0.f, 0.f, 0.f};
#pragma unroll
        for (int ks = 0; ks < NKT / 2; ++ks) {
            const u32x4 pw = pk8(s[2 * ks], s[2 * ks + 1]); const bf16x8 pf = __builtin_bit_cast(bf16x8, pw);
#pragma unroll
            for (int dt = 0; dt < 4; ++dt) {
                const bf16_t* vp = Vt + (dt * 16 + lr) * 200 + ks * 32 + lq * 4;
                const u32x2 lo = *(const u32x2*)vp, hi = *(const u32x2*)(vp + 16);
                const u32x4 vw = {lo.x, lo.y, hi.x, hi.y};
                o[dt] = MFMA16(__builtin_bit_cast(bf16x8, vw), pf, o[dt]);
            }
        }
#pragma unroll
        for (int dt = 0; dt < 4; ++dt) *(u32x2*)(YA + (size_t)(qrow0 + q) * 1024 + head * 64 + dt * 16 + lq * 4) = pk4(o[dt] * inv);
    }
}

template <int L, bool SAMPLE>
__device__ __forceinline__ void hgrn_seq(const Prm& p, unsigned char* lds, int b, int h, bf16_t* YB) {
    constexpr int RPG = L / 8, NT = L / 16, NCH = SAMPLE ? 1 : 32, NP = 8 / NT;
    bf16_t* Qd = (bf16_t*)lds; bf16_t* Qm = Qd + 64 * 136; bf16_t* Km = Qm + 64 * 136; bf16_t* KlT = Km + 64 * 136; bf16_t* Vt = KlT + 128 * 72; bf16_t* St = Vt + 128 * 72; bf16_t* Al = St + 128 * 136;
    float* tot = (float*)(Al + 64 * 72); float* first = tot + 1024; float* decay = first + 1024; float* ssq = decay + 128;
    const bf16_t* R1 = (const bf16_t*)(p.ws + WS_R0 + UB); const bf16_t* R2 = (const bf16_t*)(p.ws + WS_R0 + 2 * UB); const bf16_t* R3 = (const bf16_t*)(p.ws + WS_R0 + 3 * UB); const bf16_t* R4 = (const bf16_t*)(p.ws + WS_R0 + 4 * UB);
    const int tid = threadIdx.x, lane = tid & 63, w = tid >> 6, lr = lane & 15, lq = lane >> 4, cp = lane, rg = w, c0 = 2 * cp;
    float lb[2];
#pragma unroll
    for (int c = 0; c < 2; ++c) { const float l0 = p.in[I_LB][h * 128 + c0 + c], l1 = p.in[I_LB][1024 + h * 128 + c0 + c]; lb[c] = 1.0f / (1.0f + __expf(l1 - l0)); }
    f32x4 S[8];
#pragma unroll
    for (int dvt = 0; dvt < 8; ++dvt) {
        if (SAMPLE) {
#pragma unroll
            for (int r = 0; r < 4; ++r) S[dvt][r] = p.in[I_ST][((size_t)(b * 8 + h) * 128 + 16 * w + 4 * lq + r) * 128 + 16 * dvt + lr];
        } else S[dvt] = (f32x4){0.f, 0.f, 0.f, 0.f};
    }
    const int tt = w % NT, dv0 = (w / NT) * NT;
    const int rowbase = SAMPLE ? MP + b * 32 : b * 2048;
    f32x4 ggv[NT];
#pragma unroll
    for (int i = 0; i < NT; ++i) ggv[i] = *(const f32x4*)(p.in[I_GH] + 16 * (dv0 + i) + 4 * lq);
    unsigned qw[RPG], fw[RPG], vw[RPG];
#pragma unroll
    for (int i = 0; i < RPG; ++i) { const size_t idx = (size_t)(rowbase + rg * RPG + i) * 1024 + h * 128 + c0; qw[i] = *(const unsigned*)(R1 + idx); fw[i] = *(const unsigned*)(R2 + idx); vw[i] = *(const unsigned*)(R3 + idx); }
#pragma unroll 1
    for (int ch = 0; ch < NCH; ++ch) {
        const int row0 = rowbase + ch * L;
        float qv[2][RPG], cv[2][RPG], kk[2][RPG]; unsigned vkeep[RPG]; float run[2] = {1.f, 1.f}, lf0[2] = {0.f, 0.f};
#pragma unroll
        for (int i = 0; i < RPG; ++i) {
            vkeep[i] = vw[i];
#pragma unroll
            for (int c = 0; c < 2; ++c) {
                const float q = c ? bfhi(qw[i]) : bflo(qw[i]), fl = c ? bfhi(fw[i]) : bflo(fw[i]);
                const float f = lb[c] + (1.0f - lb[c]) * sigm(fl);
                run[c] *= f; cv[c][i] = run[c]; kk[c][i] = 1.0f - f; qv[c][i] = q * sigm(q); if (i == 0) lf0[c] = __logf(f);
            }
        }
        *(f32x2v*)(tot + rg * 128 + c0) = (f32x2v){__logf(run[0]), __logf(run[1])}; *(f32x2v*)(first + rg * 128 + c0) = (f32x2v){lf0[0], lf0[1]};
        if (ch + 1 < NCH) {
#pragma unroll
            for (int i = 0; i < RPG; ++i) { const size_t idx = (size_t)(row0 + L + rg * RPG + i) * 1024 + h * 128 + c0; qw[i] = *(const unsigned*)(R1 + idx); fw[i] = *(const unsigned*)(R2 + idx); vw[i] = *(const unsigned*)(R3 + idx); }
        }
        const size_t rbase = (size_t)(row0 + tt * 16 + lr) * 1024 + h * 128;
        u32x2 ogw[NT];
#pragma unroll
        for (int i = 0; i < NT; ++i) ogw[i] = *(const u32x2*)(R4 + rbase + 16 * (dv0 + i) + 4 * lq);
        __syncthreads();
        {
            float pre[2] = {0.f, 0.f}, bmid[2], blast[2], emid[2], elm[2], epre[2];
#pragma unroll
            for (int c = 0; c < 2; ++c) {
                float acc = 0.f, half = 0.f;
#pragma unroll
                for (int j = 0; j < 8; ++j) { const float t = tot[j * 128 + c0 + c]; if (j < rg) pre[c] += t; if (j < 4) half += t; acc += t; }
                bmid[c] = half + first[4 * 128 + c0 + c]; blast[c] = acc; emid[c] = __expf(bmid[c]); elm[c] = __expf(blast[c] - bmid[c]); epre[c] = __expf(pre[c] - bmid[c]);
            }
            float kl[2][RPG];
#pragma unroll
            for (int i = 0; i < RPG; ++i) {
                const int r = rg * RPG + i; float qd[2], qm[2], km[2];
#pragma unroll
                for (int c = 0; c < 2; ++c) {
                    const float E = epre[c] * cv[c][i], Ei = __builtin_amdgcn_rcpf(E);
                    qm[c] = qv[c][i] * E; qd[c] = qm[c] * emid[c]; km[c] = kk[c][i] * Ei; kl[c][i] = km[c] * elm[c];
                }
                *(unsigned*)(Qd + r * 136 + c0) = pk2(qd[0], qd[1]); *(unsigned*)(Qm + r * 136 + c0) = pk2(qm[0], qm[1]); *(unsigned*)(Km + r * 136 + c0) = pk2(km[0], km[1]);
            }
#pragma unroll
            for (int c = 0; c < 2; ++c) {
#pragma unroll
                for (int i = 0; i < RPG; i += 4) {
                    u32x2 a, v2; a.x = pk2(kl[c][i], kl[c][i + 1]); a.y = pk2(kl[c][i + 2], kl[c][i + 3]);
                    if (c == 0) { v2.x = (vkeep[i] & 0xffffu) | (vkeep[i + 1] << 16); v2.y = (vkeep[i + 2] & 0xffffu) | (vkeep[i + 3] << 16); }
                    else { v2.x = (vkeep[i] >> 16) | (vkeep[i + 1] & 0xffff0000u); v2.y = (vkeep[i + 2] >> 16) | (vkeep[i + 3] & 0xffff0000u); }
                    *(u32x2*)(KlT + (c0 + c) * 72 + rg * RPG + i) = a; *(u32x2*)(Vt + (c0 + c) * 72 + rg * RPG + i) = v2;
                }
            }
            if (rg == 0) *(f32x2v*)(decay + c0) = (f32x2v){__expf(blast[0]), __expf(blast[1])};
        }
#pragma unroll
        for (int dvt = 0; dvt < 8; ++dvt) *(u32x2*)(St + (16 * dvt + lr) * 136 + 16 * w + 4 * lq) = pk4(S[dvt]);
        __syncthreads();
        for (int id = w; id < NT * NT; id += 8) {
            const int st = id / NT, t2 = id % NT; f32x4 acc = {0.f, 0.f, 0.f, 0.f};
#pragma unroll
            for (int ks = 0; ks < 4; ++ks) acc = MFMA16(*(const bf16x8*)(Km + (st * 16 + lr) * 136 + ks * 32 + lq * 8), *(const bf16x8*)(Qm + (t2 * 16 + lr) * 136 + ks * 32 + lq * 8), acc);
            const int t = t2 * 16 + lr;
#pragma unroll
            for (int r = 0; r < 4; ++r) if (st * 16 + 4 * lq + r > t) acc[r] = 0.f;
            *(u32x2*)(Al + t * 72 + st * 16 + 4 * lq) = pk4(acc);
        }
        f32x4 o[NT];
#pragma unroll
        for (int i = 0; i < NT; ++i) {
            f32x4 acc = {0.f, 0.f, 0.f, 0.f};
#pragma unroll
            for (int ks = 0; ks < 4; ++ks) acc = MFMA16(*(const bf16x8*)(St + (16 * (dv0 + i) + lr) * 136 + ks * 32 + lq * 8), *(const bf16x8*)(Qd + (tt * 16 + lr) * 136 + ks * 32 + lq * 8), acc);
            o[i] = acc;
        }
        __syncthreads();
        float sq = 0.f;
#pragma unroll
        for (int i = 0; i < NT; ++i) {
#pragma unroll
            for (int ks = 0; ks < L / 32; ++ks) o[i] = MFMA16(*(const bf16x8*)(Vt + (16 * (dv0 + i) + lr) * 72 + ks * 32 + lq * 8), *(const bf16x8*)(Al + (tt * 16 + lr) * 72 + ks * 32 + lq * 8), o[i]);
            sq += o[i][0] * o[i][0] + o[i][1] * o[i][1] + o[i][2] * o[i][2] + o[i][3] * o[i][3];
        }
        sq += __shfl_xor(sq, 16); sq += __shfl_xor(sq, 32);
        if (lq == 0) ssq[(w / NT) * 64 + tt * 16 + lr] = sq;
        {
            const f32x4 dc = *(const f32x4*)(decay + 16 * w + 4 * lq);
#pragma unroll
            for (int dvt = 0; dvt < 8; ++dvt) {
                f32x4 acc = S[dvt] * dc;
#pragma unroll
                for (int ks = 0; ks < L / 32; ++ks) acc = MFMA16(*(const bf16x8*)(KlT + (16 * w + lr) * 72 + ks * 32 + lq * 8), *(const bf16x8*)(Vt + (16 * dvt + lr) * 72 + ks * 32 + lq * 8), acc);
                S[dvt] = acc;
            }
        }
        __syncthreads();
        {
            float tsq = 0.f;
#pragma unroll
            for (int j = 0; j < NP; ++j) tsq += ssq[j * 64 + tt * 16 + lr];
            const float rs = rsqrtf(tsq * (1.0f / 128.0f) + EPS);
#pragma unroll
            for (int i = 0; i < NT; ++i) {
                const int dvb = 16 * (dv0 + i) + 4 * lq;
                const f32x4 gg = ggv[i];
                const float og0 = bflo(ogw[i].x), og1 = bfhi(ogw[i].x), og2 = bflo(ogw[i].y), og3 = bfhi(ogw[i].y);
                f32x4 y; y[0] = o[i][0] * rs * gg[0] * og0 * sigm(og0); y[1] = o[i][1] * rs * gg[1] * og1 * sigm(og1); y[2] = o[i][2] * rs * gg[2] * og2 * sigm(og2); y[3] = o[i][3] * rs * gg[3] * og3 * sigm(og3);
                *(u32x2*)(YB + rbase + dvb) = pk4(y);
            }
        }
    }
    float* so = p.out + (SAMPLE ? O_SST : O_PST) + (size_t)(b * 8 + h) * 16384;
#pragma unroll
    for (int dvt = 0; dvt < 8; ++dvt)
#pragma unroll
        for (int r = 0; r < 4; ++r) so[(16 * w + 4 * lq + r) * 128 + 16 * dvt + lr] = S[dvt][r];
    __syncthreads();
}

__device__ __forceinline__ void conv_p(const Prm& p) {
    if (blockIdx.x < 16) return;
    bf16_t* pbf = (bf16_t*)(p.ws + WS_KV);
    for (int id = (blockIdx.x - 16) * 512 + threadIdx.x; id < MT * 32; id += (gridDim.x - 16) * 512) {
        const int row = id >> 5, c = (id & 31) * 8;
        const float* s = (row < MP ? p.in[I_PP] + (size_t)row * 256 : p.in[I_PS] + (size_t)(row - MP) * 256) + c;
        *(u32x4*)(pbf + (size_t)row * 256 + c) = pk8(*(const f32x4*)s, *(const f32x4*)(s + 4));
    }
}
__device__ __forceinline__ void phase_rp5(const Prm& p) {
    const bf16_t* O = (const bf16_t*)(p.ws + WS_R0 + 4 * UB); bf16_t* hf = (bf16_t*)(p.ws + WS_R0); const float* g = p.in[I_GPOST];
    const int lane = threadIdx.x & 63, gw = blockIdx.x * 8 + (threadIdx.x >> 6), nw = gridDim.x * 8;
    for (int row = gw; row < MT; row += nw) {
        const float* xr = xrow(p, row); const bf16_t* orow = O + (size_t)row * 1024; f32x4 v[4], x[4]; float ss = 0.f;
#pragma unroll
        for (int i = 0; i < 4; ++i) { { const u32x2 ow = *(const u32x2*)(orow + i * 256 + lane * 4); v[i] = (f32x4){bflo(ow.x), bfhi(ow.x), bflo(ow.y), bfhi(ow.y)}; } x[i] = *(const f32x4*)(xr + i * 256 + lane * 4); ss += v[i][0] * v[i][0] + v[i][1] * v[i][1] + v[i][2] * v[i][2] + v[i][3] * v[i][3]; }
        ss = wsum(ss); const float rs = rsqrtf(ss * (1.0f / 1024.0f) + EPS); float s2 = 0.f;
#pragma unroll
        for (int i = 0; i < 4; ++i) { const f32x4 gg = *(const f32x4*)(g + i * 256 + lane * 4); x[i] += v[i] * rs * gg; s2 += x[i][0] * x[i][0] + x[i][1] * x[i][1] + x[i][2] * x[i][2] + x[i][3] * x[i][3];
            *(u32x2*)((bf16_t*)p.out + (size_t)row * 1024 + i * 256 + lane * 4) = pk4(x[i]); }
        s2 = wsum(s2); const float r2 = rsqrtf(s2 * (1.0f / 1024.0f) + EPS);
#pragma unroll
        for (int i = 0; i < 4; ++i) *(u32x2*)(hf + (size_t)row * 1024 + i * 256 + lane * 4) = pk4(x[i] * r2);
    }
}
__device__ __forceinline__ void phase_rp8(const Prm& p) {
    const bf16_t* O = (const bf16_t*)(p.ws + WS_R0 + UB); bf16_t* xb = (bf16_t*)(p.ws + WS_R0 + 3 * UB); const float* g = p.in[I_GPFF];
    const int lane = threadIdx.x & 63, gw = blockIdx.x * 8 + (threadIdx.x >> 6), nw = gridDim.x * 8;
    for (int row = gw; row < MT; row += nw) {
        const bf16_t* xr = (const bf16_t*)p.out + (size_t)row * 1024; const bf16_t* orow = O + (size_t)row * 1024; f32x4 v[4], x[4]; float ss = 0.f;
#pragma unroll
        for (int i = 0; i < 4; ++i) { { const u32x2 ow = *(const u32x2*)(orow + i * 256 + lane * 4); v[i] = (f32x4){bflo(ow.x), bfhi(ow.x), bflo(ow.y), bfhi(ow.y)}; } { const u32x2 xw = *(const u32x2*)(xr + i * 256 + lane * 4); x[i] = (f32x4){bflo(xw.x), bfhi(xw.x), bflo(xw.y), bfhi(xw.y)}; } ss += v[i][0] * v[i][0] + v[i][1] * v[i][1] + v[i][2] * v[i][2] + v[i][3] * v[i][3]; }
        ss = wsum(ss); const float rs = rsqrtf(ss * (1.0f / 1024.0f) + EPS);
#pragma unroll
        for (int i = 0; i < 4; ++i) { const f32x4 gg = *(const f32x4*)(g + i * 256 + lane * 4); x[i] += v[i] * rs * gg;
            *(u32x2*)(xb + (size_t)row * 1024 + i * 256 + lane * 4) = pk4(x[i]); }
    }
}
__device__ __forceinline__ void phase_conv(const Prm& p) {
    const bf16_t* A = (const bf16_t*)(p.ws + WS_R0 + UB); bf16_t* Ug = (bf16_t*)(p.ws + WS_R0 + UB + A_BYTES);
    const float* wc = p.in[I_WCONV]; const float* bc = p.in[I_BCONV]; const float* cc = p.in[I_CC];
    for (int id = blockIdx.x * 512 + threadIdx.x; id < 2112 * 352; id += gridDim.x * 512) {
        const int ri = id / 352, c0 = (id % 352) * 8;
        int row; if (ri < 2048) row = (ri >> 1) * 64 + (ri & 1); else { const int j = ri - 2048; row = MP + (j >> 1) * 32 + (j & 1); }
        float am2[8], am1[8], a[8], u[8], gq[8];
#pragma unroll
        for (int j = 0; j < 8; ++j) { am2[j] = 0.f; am1[j] = 0.f; }
        if (row < MP) {
            const int t = row & 2047;
            if (t >= 1) unpk8(*(const u32x4*)(A + (size_t)(row - 1) * DFF + c0), am1);
            if (t >= 2) unpk8(*(const u32x4*)(A + (size_t)(row - 2) * DFF + c0), am2);
        } else {
            const int rs = row - MP, b = rs >> 5, t = rs & 31;
            if (t == 0) {
#pragma unroll
                for (int j = 0; j < 8; ++j) { am2[j] = cc[(size_t)(b * 2) * DFF + c0 + j]; am1[j] = cc[(size_t)(b * 2 + 1) * DFF + c0 + j]; }
            } else {
#pragma unroll
                for (int j = 0; j < 8; ++j) am2[j] = cc[(size_t)(b * 2 + 1) * DFF + c0 + j];
                unpk8(*(const u32x4*)(A + (size_t)(row - 1) * DFF + c0), am1);
            }
        }
        const size_t off = (size_t)row * DFF + c0;
        unpk8(*(const u32x4*)(A + off), a); unpk8(*(const u32x4*)(Ug + off), u);
#pragma unroll
        for (int j = 0; j < 8; ++j) {
            const float ac = bc[c0 + j] + wc[c0 + j] * am2[j] + wc[DFF + c0 + j] * am1[j] + wc[2 * DFF + c0 + j] * a[j];
            const float y = 1.5957691216f * (ac + 0.044715f * ac * ac * ac);
            gq[j] = ac * sigm(y) * u[j];
        }
        u32x4 wv; wv.x = pk2(gq[0], gq[1]); wv.y = pk2(gq[2], gq[3]); wv.z = pk2(gq[4], gq[5]); wv.w = pk2(gq[6], gq[7]);
        *(u32x4*)(Ug + off) = wv;
    }
}

#ifndef PROBE_DUP
#define PROBE_DUP 0
#endif
#ifndef P2M
#define P2M 15
#endif
#ifndef PHM
#define PHM 0xfff
#endif

#define XB_TMO      128
#define XB_XCNT(j)  (256  + 64 * (j))
#define XB_XSUB(j)  (1280 + 64 * (j))
#define XB_XGEN(j)  (2304 + 64 * (j))
#define XB_TOP      3328
#define XB_TOPGEN   3392
#define XCD_BAR_WORDS 3456
#define XB_SPIN_CAP (1u << 18)
#define LAS __attribute__((address_space(3)))

__device__ __forceinline__ unsigned xb_ld(unsigned* p)              { return __hip_atomic_load(p, __ATOMIC_RELAXED, __HIP_MEMORY_SCOPE_AGENT); }
__device__ __forceinline__ unsigned xb_add(unsigned* p, unsigned v) { return __hip_atomic_fetch_add(p, v, __ATOMIC_RELAXED, __HIP_MEMORY_SCOPE_AGENT); }
__device__ __forceinline__ unsigned xb_xcc_id() { return (unsigned)__builtin_amdgcn_s_getreg((3 << 11) | 20) & 0xFu; }
#define XB_SPIN(cond, bar) do { unsigned _sp = 0; while (cond) { __builtin_amdgcn_s_sleep(1); \
    if ((++_sp & 255u) == 0u) { if (xb_ld(&(bar)[XB_TMO])) break; if (_sp > XB_SPIN_CAP) { atomicAdd(&(bar)[XB_TMO], 1u); break; } } } } while (0)
struct XcdBarrier {
    unsigned* bar; unsigned x;
    volatile LAS unsigned* st;
};

__device__ __forceinline__ XcdBarrier xcd_barrier_post(unsigned* bar, volatile LAS unsigned* st) {
    XcdBarrier b; b.bar = bar; b.x = xb_xcc_id(); b.st = st;
    if (threadIdx.x == 0) (void)xb_add(&bar[XB_XCNT(b.x)], 1u);
    return b;
}
__device__ __forceinline__ void xcd_barrier_complete(unsigned* bar, unsigned x, unsigned& nloc, unsigned& nx) {
    const unsigned G = gridDim.x * gridDim.y * gridDim.z;
    unsigned sum, cnt, mine, sp = 0u;
    for (;;) {
        sum = 0u; cnt = 0u; mine = 0u;
#pragma unroll
        for (unsigned j = 0; j < 16; ++j) { const unsigned c = xb_ld(&bar[XB_XCNT(j)]); sum += c; cnt += (c > 0u) ? 1u : 0u; mine = (j == x) ? c : mine; }
        if (sum == G) break;
        __builtin_amdgcn_s_sleep(1);
        if ((++sp & 255u) == 0u) { if (xb_ld(&bar[XB_TMO])) break; if (sp > XB_SPIN_CAP) { atomicAdd(&bar[XB_TMO], 1u); break; } }
    }
    nloc = mine > 0u ? mine : 1u; nx = cnt > 0u ? cnt : 1u;
}

__device__ __forceinline__ void xcd_barrier(const XcdBarrier& b) {
    asm volatile("s_waitcnt vmcnt(0)" ::: "memory");
    __syncthreads();
    if (threadIdx.x == 0) {
        unsigned* bar = b.bar;
        __builtin_amdgcn_s_waitcnt(0);
        unsigned nloc = b.st[0], nx = b.st[1];
        if (nloc == 0u) { xcd_barrier_complete(bar, b.x, nloc, nx); b.st[0] = nloc; b.st[1] = nx; }
        const unsigned old = xb_add(&bar[XB_XSUB(b.x)], 1u);
        const unsigned gen = old / nloc;
        if (old + 1u == (gen + 1u) * nloc) {
            __builtin_amdgcn_fence(__ATOMIC_RELEASE, "agent");
            asm volatile("s_waitcnt vmcnt(0)" ::: "memory");
            const unsigned og = xb_add(&bar[XB_TOP], 1u);
            const unsigned tg = og / nx;
            if (og + 1u == (tg + 1u) * nx) xb_add(&bar[XB_TOPGEN], 1u);
            else XB_SPIN(xb_ld(&bar[XB_TOPGEN]) == tg, bar);
            __builtin_amdgcn_fence(__ATOMIC_ACQUIRE, "agent");
            xb_add(&bar[XB_XGEN(b.x)], 1u);
            asm volatile("s_waitcnt vmcnt(0)" ::: "memory");
        } else {
            XB_SPIN(xb_ld(&bar[XB_XGEN(b.x)]) == gen, bar);
            __builtin_amdgcn_fence(__ATOMIC_ACQUIRE, "agent");
            asm volatile("s_waitcnt vmcnt(0)" ::: "memory");
        }
    }
    __syncthreads();
}

__global__ void __launch_bounds__(512, 2) fwd_mega(Prm p, int ph_lo, int ph_hi) {
    extern __shared__ __attribute__((aligned(16))) unsigned char lds[];
    cg::grid_group grid = cg::this_grid();
    unsigned char* ws = p.ws;
    bf16_t* R0 = (bf16_t*)(ws + WS_R0);
#define REG(i) ((bf16_t*)(ws + WS_R0 + (size_t)(i) * UB))
    unsigned* barw = (unsigned*)(ws + WS_END);
    if (blockIdx.x == 0) for (int i = threadIdx.x; i < XCD_BAR_WORDS; i += 512) barw[i] = 0u;
    volatile LAS unsigned* xst = (volatile LAS unsigned*)((PG8_LAS unsigned char*)lds + (LDS_BYTES - 16));
    if (threadIdx.x < 4) xst[threadIdx.x] = 0u;
    __syncthreads();
    XcdBarrier xb; xb.bar = barw; xb.x = 0u; xb.st = xst;
    unsigned bar_k = 0;
#define GRID_SEAM() do { if (bar_k == 0) { grid.sync(); xb = xcd_barrier_post(barw, xst); } else xcd_barrier(xb); ++bar_k; } while (0)
#define PH_BEGIN(n) if (ph_lo <= (n) && (n) < ph_hi) { if ((n) > ph_lo) GRID_SEAM();
#define PH_END }
#if (PHM >> 0) & 1
        PH_BEGIN(0) phase0(p, lds);
#if PROBE_DUP == 1
        grid.sync(); phase0(p, lds);
#endif
        PH_END
#else
#endif
#if (PHM >> 1) & 1
        PH_BEGIN(1) { F1 f; f.r0 = R0; f.kv = (bf16_t*)(ws + WS_KV); f.out = p.out; run_gemm(lds, (const bf16_t*)p.out, (const bf16_t*)(ws + WS_WIN), NIN, 1024, f);
#if PROBE_DUP == 3
            grid.sync(); run_gemm(lds, (const bf16_t*)p.out, (const bf16_t*)(ws + WS_WIN), NIN, 1024, f);
#endif
        } PH_END
#else
#endif
#if (PHM >> 2) & 1
        PH_BEGIN(2) {
#if PROBE_DUP == 2
            { bf16_t* YA = (bf16_t*)p.out; bf16_t* YB = (bf16_t*)p.out + UB / 2;
            const int G = gridDim.x;
#if P2M & 1
#pragma unroll 1
            for (int s = blockIdx.x; s < 256; s += G) hgrn_seq<64, false>(p, lds, s >> 3, s & 7, YB);
#endif
#if P2M & 2
#pragma unroll 1
            for (int s = blockIdx.x; s < 256; s += G) hgrn_seq<32, true>(p, lds, s >> 3, s & 7, YB);
#endif
            __syncthreads(); attn_bias_table(p, lds); __syncthreads();
#if P2M & 4
#pragma unroll 1
            for (int it = blockIdx.x; it < 2048; it += G) attn_item<12, 4, false>(p, lds, it >> 6, (it >> 1) & 31, it & 1, YA);
#endif
#if P2M & 8
#pragma unroll 1
            for (int it = blockIdx.x; it < 64; it += G) attn_item<10, 2, true>(p, lds, it >> 1, 0, it & 1, YA);
#endif
            __syncthreads(); }
#endif
            { bf16_t* YA = REG(0); bf16_t* YB = REG(1);
            const int G = gridDim.x;
#if P2M & 1
#pragma unroll 1
            for (int s = blockIdx.x; s < 256; s += G) hgrn_seq<64, false>(p, lds, s >> 3, s & 7, YB);
#endif
#if P2M & 2
#pragma unroll 1
            for (int s = blockIdx.x; s < 256; s += G) hgrn_seq<32, true>(p, lds, s >> 3, s & 7, YB);
#endif
            __syncthreads(); attn_bias_table(p, lds); __syncthreads();
#if P2M & 4
#pragma unroll 1
            for (int it = blockIdx.x; it < 2048; it += G) attn_item<12, 4, false>(p, lds, it >> 6, (it >> 1) & 31, it & 1, YA);
#endif
#if P2M & 8
#pragma unroll 1
            for (int it = blockIdx.x; it < 64; it += G) attn_item<10, 2, true>(p, lds, it >> 1, 0, it & 1, YA);
#endif
            }
        } PH_END
#else
#endif
#if (PHM >> 3) & 1
        PH_BEGIN(3) { F2 f; f.g = REG(5); f.o = REG(2); run_gemm(lds, REG(0), (const bf16_t*)(ws + WS_WBRA), 1024, 1024, f); late_weights(p, lds);
#if PROBE_DUP == 4
            grid.sync(); run_gemm(lds, REG(0), (const bf16_t*)(ws + WS_WBRA), 1024, 1024, f); late_weights(p, lds);
#endif
        } PH_END
#else
#endif
#if (PHM >> 4) & 1
        PH_BEGIN(4) { F3 f; f.g = REG(6); f.t = REG(2); f.o = REG(3); run_gemm(lds, REG(1), (const bf16_t*)(ws + WS_WBRB), 1024, 1024, f); conv_p(p); } PH_END
#else
#endif
#if (PHM >> 5) & 1
        PH_BEGIN(5) { FBF f; f.o = REG(4); run_gemm(lds, REG(3), (const bf16_t*)(ws + WS_WOUT), 1024, 1024, f);
#if PROBE_DUP == 5
            grid.sync(); run_gemm(lds, REG(3), (const bf16_t*)(ws + WS_WOUT), 1024, 1024, f);
#endif
        } PH_END
#else
#endif
#if (PHM >> 6) & 1
        PH_BEGIN(6) phase_rp5(p); PH_END
#else
#endif
#if (PHM >> 7) & 1
        PH_BEGIN(7) { EpiUp e; e.g = (bf16_t*)(ws + WS_R0 + UB + A_BYTES); e.araw = REG(1); e.out = p.out; e.wcv = p.in[I_WCONV]; e.bcv = p.in[I_BCONV]; run_gemm_epi(lds, REG(0), (const bf16_t*)(ws + WS_WUP), 2 * DFF, 1024, e); } PH_END
#else
#endif
#if (PHM >> 8) & 1
        PH_BEGIN(8) phase_conv(p); PH_END
#else
#endif
        PH_BEGIN(9) { FBF f; f.o = REG(1); run_gemm(lds, (const bf16_t*)(ws + WS_R0 + UB + A_BYTES), (const bf16_t*)(ws + WS_WDOWN), 1024, DFF, f);
                  FBF f2; f2.o = REG(0); if (blockIdx.x >= 16) run_gemm(lds, (const bf16_t*)(ws + WS_KV), (const bf16_t*)(ws + WS_WPLE), 1024, 256, f2, 16); } PH_END
#if (PHM >> 10) & 1
        PH_BEGIN(10) phase_rp8(p); PH_END
#else
#endif
#if (PHM >> 11) & 1
        PH_BEGIN(11) { F9 f; f.pe = REG(0); f.xb = REG(3); f.y = p.out; run_gemm(lds, REG(3), (const bf16_t*)(ws + WS_WPG), 1024, 1024, f); } PH_END
#else
#endif
#undef REG
}

extern "C" void kernel_launch(void* const* d_in, const int* in_sizes, int n_in, void* d_out, int out_size, void* d_ws, size_t ws_size, hipStream_t stream) {
    static int grid = 0;
    if (grid == 0) {
        if (n_in != 26 || (size_t)out_size != O_END || ws_size < WS_END) { fprintf(stderr, "kernel_launch: unexpected shapes n_in %d out %d ws %zu (need %zu)\n", n_in, out_size, ws_size, (size_t)WS_END); grid = -1; return; }
        int dev = 0, cus = 0, per_cu = 0;
        hipGetDevice(&dev); hipDeviceGetAttribute(&cus, hipDeviceAttributeMultiprocessorCount, dev);
        if (hipFuncSetAttribute((const void*)fwd_mega, hipFuncAttributeMaxDynamicSharedMemorySize, LDS_BYTES) != hipSuccess) { fprintf(stderr, "kernel_launch: hipFuncSetAttribute failed\n"); grid = -1; return; }
        if (hipOccupancyMaxActiveBlocksPerMultiprocessor(&per_cu, (const void*)fwd_mega, 512, LDS_BYTES) != hipSuccess || per_cu < 1) { fprintf(stderr, "kernel_launch: occupancy query says %d\n", per_cu); per_cu = 1; }
        (void)hipGetLastError();
        grid = cus;
    }
    if (grid < 0) return;
    Prm p{};
    for (int i = 0; i < 26; ++i) p.in[i] = (const float*)d_in[i];
    p.out = (float*)d_out; p.ws = (unsigned char*)d_ws;
    int lo = 0, hi = 12;
    void* args[] = {&p, &lo, &hi};
    hipError_t e = hipLaunchCooperativeKernel((const void*)fwd_mega, dim3(grid), dim3(512), args, LDS_BYTES, stream);
    if (e != hipSuccess) fprintf(stderr, "kernel_launch: cooperative launch failed: %s (grid %d)\n", hipGetErrorString(e), grid);
}
```

```cpp
#include <hip/hip_runtime.h>
#include <hip/hip_cooperative_groups.h>
#include <cstdio>
namespace cg = cooperative_groups;
namespace pg8 {
#define PG8_LAS __attribute__((address_space(3)))
typedef unsigned short bf16_t;
typedef short bf16x8 __attribute__((ext_vector_type(8)));
typedef float f32x4 __attribute__((ext_vector_type(4)));
typedef unsigned u32x4 __attribute__((ext_vector_type(4)));
constexpr int BM = 256, BK = 64, HALF = 128, HTB = HALF * BK * 2  , STAGE_BYTES = 8 * HTB, NXCD = 8, WGM = 8;

__host__ __device__ __forceinline__ int lds_byte(int r, int c) { const int st = (r >> 4) * 2 + (c >> 5), rr = r & 15, cc = c & 31, ob = rr * 64 + cc * 2; return st * 1024 + (ob ^ (((ob >> 9) & 1) << 5)); }
__host__ __device__ __forceinline__ void stage_rc(int b, int& R, int& C) { const int st = b / 1024, sb = b % 1024, swz = sb ^ (((sb >> 9) & 1) << 5); R = (st >> 1) * 16 + swz / 64; C = (st & 1) * 32 + (swz % 64) / 2; }
__host__ __device__ __forceinline__ int perm32(int rho) { const int n = rho >> 4, i = rho & 15; return 8 * (i >> 2) + 4 * n + (i & 3); }

struct Unit { int pm, pn; };
struct Gemm { const bf16_t* A; const bf16_t* Bt; int M, N, K; };

struct StaticOrder {
    int nM, nN, nwg, G, c;
    __host__ __device__ void init(int M, int N, int G_, int c_) { nM = M / BM; nN = N / BM; nwg = nM * nN; G = G_; c = c_; }
    __host__ __device__ bool next(int i, Unit& u) const {
        const long L = (long)i * G + c; if (L >= nwg) return false;
        int wgid = (int)L; { const int q = nwg / NXCD, r = nwg % NXCD, xcd = wgid % NXCD, off = wgid / NXCD; wgid = (xcd < r ? xcd * (q + 1) : r * (q + 1) + (xcd - r) * q) + off; }
        const int nig = WGM * nN, gid = wgid / nig, fm = gid * WGM, gsz = (nM - fm) < WGM ? (nM - fm) : WGM;
        u.pm = fm + ((wgid % nig) % gsz); u.pn = (wgid % nig) / gsz; return true;
    }
    __device__ __forceinline__ void a_ready(const Unit&) const {}
    __device__ __forceinline__ void done(const Unit&) const {}
};
__device__ __forceinline__ unsigned cvt_pk_bf16(float lo, float hi) { unsigned r; asm volatile("v_cvt_pk_bf16_f32 %0, %1, %2" : "=v"(r) : "v"(lo), "v"(hi)); return r; }
template <class Epi, class Sched, bool STAMP = false>
__device__ __forceinline__ void gemm_phase(PG8_LAS unsigned char* lds, const Gemm g, const Sched& S, const Epi& E, unsigned long long* stamps) {
    const int tid = threadIdx.x, wid = __builtin_amdgcn_readfirstlane(tid >> 6), lane = tid & 63, wr = wid >> 2, wc = wid & 3, fr = lane & 15, fq = lane >> 4;
    const int K = g.K, nt = K / BK;
    int ts_lo = 0, ts_hi = 0, nts = 0; const unsigned long long rt_entry = STAMP ? (unsigned long long)wall_clock64() : 0ull;
#define PG8_STAMP() do { if (STAMP && wid == 0 && nts < 64) { const unsigned long long _c = (unsigned long long)clock64(); \
        ts_lo = (lane == nts) ? (int)(unsigned)_c : ts_lo; ts_hi = (lane == nts) ? (int)(unsigned)(_c >> 32) : ts_hi; ++nts; } } while (0)
    PG8_STAMP();
    unsigned voffA[2], voffB[2];
#pragma unroll
    for (int i = 0; i < 2; ++i) { int R, C; stage_rc(tid * 16 + i * 8192, R, C); const int Rb = Epi::PERM ? ((R & ~31) + perm32(R & 31)) : R;
        voffA[i] = (unsigned)(R * K + C) * 2u; voffB[i] = (unsigned)(Rb * K + C) * 2u; }
    const size_t kstep = (size_t)(BK * 2);
    const size_t hstep = (size_t)HALF * K * 2;
    const size_t tstep = 2 * hstep;
    const unsigned ldsw = (unsigned)wid * 1024u;
    const int aoff = lds_byte(wr * 64 + fr, fq * 8), boff = lds_byte(wc * 32 + fr, fq * 8);
#define PG8_SA(b, h) (((b) * 2 + (h)) * HTB)
#define PG8_SB(b, h) ((4 + (b) * 2 + (h)) * HTB)
#define PG8_STAGE(bufoff, gbase, voff) do { _Pragma("unroll") for (int _i = 0; _i < 2; ++_i) \
        __builtin_amdgcn_global_load_lds((const unsigned*)((const char*)(gbase) + (voff)[_i]), (PG8_LAS unsigned*)(lds + (bufoff) + ldsw + _i * 8192), 16, 0, 0); } while (0)
#define PG8_LDA(dst, b, h) do { _Pragma("unroll") for (int m = 0; m < 4; ++m) _Pragma("unroll") for (int k = 0; k < 2; ++k) dst[m][k] = *(const PG8_LAS bf16x8*)(lds + PG8_SA(b, h) + aoff + m * 2048 + k * 1024); } while (0)
#define PG8_LDB(dst, b, h) do { _Pragma("unroll") for (int n = 0; n < 2; ++n) _Pragma("unroll") for (int k = 0; k < 2; ++k) dst[n][k] = *(const PG8_LAS bf16x8*)(lds + PG8_SB(b, h) + boff + n * 2048 + k * 1024); } while (0)
#define PG8_MMA(ai, bj, At, Bt) do { __builtin_amdgcn_s_setprio(1); _Pragma("unroll") for (int m = 0; m < 4; ++m) _Pragma("unroll") for (int n = 0; n < 2; ++n) _Pragma("unroll") for (int k = 0; k < 2; ++k) \
        acc[ai][bj][m][n] = __builtin_amdgcn_mfma_f32_16x16x32_bf16(Bt[n][k], At[m][k], acc[ai][bj][m][n], 0, 0, 0); __builtin_amdgcn_s_setprio(0); } while (0)
#define PG8_WAIT_V(n) asm volatile("s_waitcnt vmcnt(" #n ")" ::: "memory")
#define PG8_WAIT_L(n) asm volatile("s_waitcnt lgkmcnt(" #n ")" ::: "memory")
#define PG8_BAR __builtin_amdgcn_s_barrier()
#define PG8_SCHED __builtin_amdgcn_sched_barrier(0)
    Unit cur, nxt; int ui = 0;
    if (!S.next(0, cur)) return;
    f32x4 acc[2][2][4][2];
#pragma unroll
    for (int a = 0; a < 2; ++a)
#pragma unroll
        for (int b = 0; b < 2; ++b)
#pragma unroll
            for (int m = 0; m < 4; ++m)
#pragma unroll
                for (int n = 0; n < 2; ++n) acc[a][b][m][n] = (f32x4){0.f, 0.f, 0.f, 0.f};
    bf16x8 At[4][2], B0[2][2], B1[2][2];
    const char* cA = (const char*)g.A + (size_t)cur.pm * tstep; const char* cB = (const char*)g.Bt + (size_t)cur.pn * tstep;
    S.a_ready(cur);
    PG8_STAGE(PG8_SB(0, 0), cB, voffB); PG8_STAGE(PG8_SA(0, 0), cA, voffA); PG8_STAGE(PG8_SB(0, 1), cB + hstep, voffB); PG8_STAGE(PG8_SA(0, 1), cA + hstep, voffA);
    if (wr == 1) PG8_BAR;
    PG8_WAIT_V(4); PG8_BAR;
    PG8_STAGE(PG8_SB(1, 0), cB + kstep, voffB); PG8_STAGE(PG8_SA(1, 0), cA + kstep, voffA); PG8_STAGE(PG8_SB(1, 1), cB + hstep + kstep, voffB);
    PG8_WAIT_V(6); PG8_BAR;
    PG8_STAMP();
    for (;;) {
        const bool has_next = S.next(ui + 1, nxt);
        const char* nA = has_next ? (const char*)g.A + (size_t)nxt.pm * tstep : cA; const char* nB = has_next ? (const char*)g.Bt + (size_t)nxt.pn * tstep : cB;
        for (int t = 0; t < nt; t += 2) {
            const bool last = (t == nt - 2);
            const char* a1 = cA + (size_t)(t + 1) * kstep;
            const char* a2 = last ? nA : cA + (size_t)(t + 2) * kstep; const char* b2 = last ? nB : cB + (size_t)(t + 2) * kstep;
            const char* a3 = a2 + kstep; const char* b3 = b2 + kstep;
            if (last && has_next) S.a_ready(nxt);
            PG8_LDB(B0, 0, 0); PG8_SCHED; PG8_LDA(At, 0, 0); PG8_STAGE(PG8_SA(1, 1), a1 + hstep, voffA);
            PG8_WAIT_L(8); PG8_BAR; PG8_WAIT_L(0); PG8_MMA(0, 0, At, B0); PG8_BAR; PG8_SCHED;
            PG8_LDB(B1, 0, 1); PG8_STAGE(PG8_SB(0, 0), b2, voffB);
            PG8_BAR; PG8_WAIT_L(0); PG8_MMA(0, 1, At, B1); PG8_BAR;
            PG8_LDA(At, 0, 1); PG8_STAGE(PG8_SA(0, 0), a2, voffA);
            PG8_BAR; PG8_WAIT_L(0); PG8_MMA(1, 0, At, B0); PG8_BAR; PG8_SCHED;
            PG8_STAGE(PG8_SB(0, 1), b2 + hstep, voffB);
            PG8_WAIT_V(6); PG8_BAR; PG8_MMA(1, 1, At, B1); PG8_BAR;
            PG8_LDB(B0, 1, 0); PG8_SCHED; PG8_LDA(At, 1, 0); PG8_STAGE(PG8_SA(0, 1), a2 + hstep, voffA);
            PG8_WAIT_L(8); PG8_BAR; PG8_WAIT_L(0); PG8_MMA(0, 0, At, B0); PG8_BAR; PG8_SCHED;
            PG8_LDB(B1, 1, 1); PG8_STAGE(PG8_SB(1, 0), b3, voffB);
            PG8_BAR; PG8_WAIT_L(0); PG8_MMA(0, 1, At, B1); PG8_BAR;
            PG8_LDA(At, 1, 1); PG8_STAGE(PG8_SA(1, 0), a3, voffA);
            PG8_BAR; PG8_WAIT_L(0); PG8_MMA(1, 0, At, B0); PG8_BAR; PG8_SCHED;
            PG8_STAGE(PG8_SB(1, 1), b3 + hstep, voffB);
            PG8_WAIT_V(6); PG8_BAR; PG8_MMA(1, 1, At, B1); PG8_BAR;
        }
        PG8_STAMP();
        if constexpr (!Epi::AFTER_DRAIN) { E(acc, cur, wr, wc, fr, fq); S.done(cur); }
        PG8_STAMP();
        if (!has_next) break;
#pragma unroll
        for (int a = 0; a < 2; ++a)
#pragma unroll
            for (int b = 0; b < 2; ++b)
#pragma unroll
                for (int m = 0; m < 4; ++m)
#pragma unroll
                    for (int n = 0; n < 2; ++n) acc[a][b][m][n] = (f32x4){0.f, 0.f, 0.f, 0.f};
        cur = nxt; cA = nA; cB = nB; ++ui;
    }
    PG8_WAIT_V(0);
    if (wr == 0) PG8_BAR;
    PG8_BAR;
    if constexpr (Epi::AFTER_DRAIN) { E.fused(acc, cur, wr, wc, fr, fq, lds, wid, lane); S.done(cur); }
    PG8_STAMP();
    if (STAMP && wid == 0) { stamps[lane] = lane < nts ? (((unsigned long long)(unsigned)ts_hi << 32) | (unsigned)ts_lo) : 0ull;
        if (lane == 62) stamps[62] = rt_entry; if (lane == 63) stamps[63] = (unsigned long long)wall_clock64(); }
#undef PG8_STAMP
#undef PG8_SA
#undef PG8_SB
#undef PG8_STAGE
#undef PG8_LDA
#undef PG8_LDB
#undef PG8_MMA
#undef PG8_WAIT_V
#undef PG8_WAIT_L
#undef PG8_BAR
#undef PG8_SCHED
}
}


using pg8::bf16_t; using pg8::bf16x8; using pg8::f32x4; using pg8::u32x4;
typedef unsigned u32x2 __attribute__((ext_vector_type(2)));
typedef float f32x2v __attribute__((ext_vector_type(2)));
#define MFMA16(a, b, c) __builtin_amdgcn_mfma_f32_16x16x32_bf16((a), (b), (c), 0, 0, 0)

constexpr int MP = 65536, MS = 1024, MT = MP + MS, DM = 1024, DFF = 2816, NIN = 7424;
constexpr float EPS = 1e-6f;
constexpr size_t UB = (size_t)MT * 1024 * 2;
constexpr size_t WS_WIN = 0, WS_WBRA = WS_WIN + (size_t)NIN * 1024 * 2, WS_WBRB = WS_WBRA + 2097152, WS_WOUT = WS_WBRB + 2097152, WS_WPG = WS_WOUT + 2097152,
                 WS_WUP = WS_WPG + 2097152, WS_WDOWN = WS_WUP + (size_t)2 * DFF * 1024 * 2, WS_WPLE = WS_WDOWN + (size_t)1024 * DFF * 2, WS_KV = WS_WPLE + (size_t)1024 * 256 * 2,
                 WS_R0 = WS_KV + (size_t)MT * 256 * 2, WS_END = WS_R0 + 7 * UB;
constexpr size_t A_BYTES = (size_t)MT * DFF * 2;
constexpr size_t O_Y = 0, O_PWK = (size_t)MT * 1024, O_PWV = O_PWK + 524288, O_PST = O_PWV + 524288, O_PFC = O_PST + 4194304, O_SWK = O_PFC + 180224, O_SWV = O_SWK + 131072,
                 O_SST = O_SWV + 131072, O_SFC = O_SST + 4194304, O_END = O_SFC + 180224;
constexpr size_t WS_RS0 = WS_END + 65536;
constexpr int LDS_BYTES = 147456;

struct Prm { const float* in[26]; float* out; unsigned char* ws; };
enum { I_XP = 0, I_XS, I_CK, I_CV, I_ST, I_CC, I_PP, I_PS, I_RB, I_LB, I_GPM, I_WIN, I_SINK, I_GH, I_WBRA, I_WBRB, I_WOUT, I_GPOST, I_GPF, I_WUP, I_WCONV, I_BCONV, I_WDOWN, I_GPFF, I_WPLE, I_WPG };

__device__ __forceinline__ unsigned pk2(float lo, float hi) { unsigned r; asm("v_cvt_pk_bf16_f32 %0, %1, %2" : "=v"(r) : "v"(lo), "v"(hi)); return r; }
__device__ __forceinline__ float bflo(unsigned w) { return __uint_as_float(w << 16); }
__device__ __forceinline__ float bfhi(unsigned w) { return __uint_as_float(w & 0xffff0000u); }
__device__ __forceinline__ float bf1(bf16_t b) { return __uint_as_float(((unsigned)b) << 16); }
__device__ __forceinline__ bf16_t f2bf(float f) { return (bf16_t)(pk2(f, 0.f) & 0xffffu); }
__device__ __forceinline__ float sigm(float x) { return __builtin_amdgcn_rcpf(1.0f + __expf(-x)); }
__device__ __forceinline__ float wsum(float v) { v += __shfl_xor(v, 32); v += __shfl_xor(v, 16); v += __shfl_xor(v, 8); v += __shfl_xor(v, 4); v += __shfl_xor(v, 2); v += __shfl_xor(v, 1); return v; }
__device__ __forceinline__ u32x4 pk8(f32x4 a, f32x4 b) { u32x4 w; w.x = pk2(a[0], a[1]); w.y = pk2(a[2], a[3]); w.z = pk2(b[0], b[1]); w.w = pk2(b[2], b[3]); return w; }
__device__ __forceinline__ u32x2 pk4(f32x4 a) { u32x2 w; w.x = pk2(a[0], a[1]); w.y = pk2(a[2], a[3]); return w; }
__device__ __forceinline__ void unpk8(u32x4 w, float (&f)[8]) { f[0] = bflo(w.x); f[1] = bfhi(w.x); f[2] = bflo(w.y); f[3] = bfhi(w.y); f[4] = bflo(w.z); f[5] = bfhi(w.z); f[6] = bflo(w.w); f[7] = bfhi(w.w); }

struct NoPre {};
template <class F> struct EpiT {
    static constexpr bool PERM = true, AFTER_DRAIN = false; F f;
    __device__ __forceinline__ void operator()(const f32x4 (&acc)[2][2][4][2], const pg8::Unit& u, int wr, int wc, int fr, int fq) const {
        const int row0 = u.pm * 256 + wr * 64 + fr, col0 = u.pn * 256 + wc * 32 + 8 * fq;
        constexpr int MB = F::MB;
#pragma unroll
        for (int a0 = 0; a0 < 8; a0 += MB) {
            typename F::Pre pre[MB][2];
#pragma unroll
            for (int mm = 0; mm < MB; ++mm)
#pragma unroll
                for (int bj = 0; bj < 2; ++bj) pre[mm][bj] = f.load(row0 + ((a0 + mm) >> 2) * 128 + ((a0 + mm) & 3) * 16, col0 + bj * 128);
#pragma unroll
            for (int mm = 0; mm < MB; ++mm)
#pragma unroll
                for (int bj = 0; bj < 2; ++bj) f(row0 + ((a0 + mm) >> 2) * 128 + ((a0 + mm) & 3) * 16, col0 + bj * 128, u.pn, acc[(a0 + mm) >> 2][bj][(a0 + mm) & 3][0], acc[(a0 + mm) >> 2][bj][(a0 + mm) & 3][1], pre[mm][bj]);
        }
    }
};
struct F1 {
    bf16_t* r0; bf16_t* kv; float* out; typedef NoPre Pre; static constexpr int MB = 1;
    __device__ __forceinline__ NoPre load(int, int) const { return NoPre(); }
    __device__ __forceinline__ void operator()(int row, int col, int pn, f32x4 v0, f32x4 v1, NoPre) const {
        const u32x4 w = pk8(v0, v1);
        if (pn < 4) { __builtin_nontemporal_store(w, (u32x4*)(r0 + (size_t)row * 1024 + col)); }
        else if (pn == 4) {
            const int c = col - 1024; *(u32x4*)(kv + (size_t)row * 256 + c) = w;
            float* o = nullptr;
            if (row >= MP) { o = out + (c < 128 ? O_SWK : O_SWV) + (size_t)(row - MP) * 128 + (c & 127); }
            else { const int t = row & 2047; if (t >= 1920) o = out + (c < 128 ? O_PWK : O_PWV) + (size_t)((row >> 11) * 128 + t - 1920) * 128 + (c & 127); }
            if (o) { *(f32x4*)o = v0; *(f32x4*)(o + 4) = v1; }
        } else { const int c2 = col - 1280, seg = c2 >> 10; __builtin_nontemporal_store(w, (u32x4*)(r0 + (size_t)(1 + seg) * (UB / 2) + (size_t)row * 1024 + (c2 & 1023))); }
    }
};
struct F2 {
    const bf16_t* g; bf16_t* o; typedef u32x4 Pre; static constexpr int MB = 8;
    __device__ __forceinline__ u32x4 load(int row, int col) const { return *(const u32x4*)(g + (size_t)row * 1024 + col); }
    __device__ __forceinline__ void operator()(int row, int col, int, f32x4 v0, f32x4 v1, u32x4 gw) const {
        const size_t i = (size_t)row * 1024 + col; float gf[8]; unpk8(gw, gf);
        f32x4 a, b;
#pragma unroll
        for (int j = 0; j < 4; ++j) { a[j] = v0[j] * sigm(gf[j]); b[j] = v1[j] * sigm(gf[4 + j]); }
        *(u32x4*)(o + i) = pk8(a, b);
    }
};
struct F3 {
    const bf16_t* g; const bf16_t* t; bf16_t* o; struct Pre { u32x4 g, t; }; static constexpr int MB = 4;
    __device__ __forceinline__ Pre load(int row, int col) const { const size_t i = (size_t)row * 1024 + col; Pre r; r.g = *(const u32x4*)(g + i); r.t = *(const u32x4*)(t + i); return r; }
    __device__ __forceinline__ void operator()(int row, int col, int, f32x4 v0, f32x4 v1, Pre pr) const {
        const size_t i = (size_t)row * 1024 + col; float gf[8], tf[8]; unpk8(pr.g, gf); unpk8(pr.t, tf);
        f32x4 a, b;
#pragma unroll
        for (int j = 0; j < 4; ++j) { a[j] = tf[j] + v0[j] * sigm(gf[j]); b[j] = tf[4 + j] + v1[j] * sigm(gf[4 + j]); }
        *(u32x4*)(o + i) = pk8(a, b);
    }
};
struct FF32 {
    float* o; typedef NoPre Pre; static constexpr int MB = 1;
    __device__ __forceinline__ NoPre load(int, int) const { return NoPre(); }
    __device__ __forceinline__ void operator()(int row, int col, int, f32x4 v0, f32x4 v1, NoPre) const { float* d = o + (size_t)row * 1024 + col; *(f32x4*)d = v0; *(f32x4*)(d + 4) = v1; }
};
struct FBF {
    bf16_t* o; typedef NoPre Pre; static constexpr int MB = 1;
    __device__ __forceinline__ NoPre load(int, int) const { return NoPre(); }
    __device__ __forceinline__ void operator()(int row, int col, int, f32x4 v0, f32x4 v1, NoPre) const { *(u32x4*)(o + (size_t)row * 1024 + col) = pk8(v0, v1); }
};
struct EpiUp {
    static constexpr bool PERM = true, AFTER_DRAIN = false;
    bf16_t* g; bf16_t* araw; float* out; const float* wcv; const float* bcv;
    __device__ __forceinline__ void operator()(const f32x4 (&acc)[2][2][4][2], const pg8::Unit& u, int wr, int wc, int fr, int fq) const {
        const int c0 = u.pn * 128 + wc * 32 + 8 * fq;
        float w0[8], w1[8], w2[8], bb[8];
        { const f32x4 t0 = *(const f32x4*)(wcv + c0), t1 = *(const f32x4*)(wcv + c0 + 4), t2 = *(const f32x4*)(wcv + DFF + c0), t3 = *(const f32x4*)(wcv + DFF + c0 + 4),
                      t4 = *(const f32x4*)(wcv + 2 * DFF + c0), t5 = *(const f32x4*)(wcv + 2 * DFF + c0 + 4), t6 = *(const f32x4*)(bcv + c0), t7 = *(const f32x4*)(bcv + c0 + 4);
#pragma unroll
          for (int j = 0; j < 4; ++j) { w0[j] = t0[j]; w0[4 + j] = t1[j]; w1[j] = t2[j]; w1[4 + j] = t3[j]; w2[j] = t4[j]; w2[4 + j] = t5[j]; bb[j] = t6[j]; bb[4 + j] = t7[j]; } }
#pragma unroll
        for (int ai = 0; ai < 2; ++ai) {
            float p1[8], p2[8];
#pragma unroll
            for (int j = 0; j < 8; ++j) { p1[j] = 0.f; p2[j] = 0.f; }
#pragma unroll
            for (int m = 0; m < 4; ++m) {
                const int row = u.pm * 256 + ai * 128 + wr * 64 + m * 16 + fr;
                float a[8], uu[8], r1[8], r2[8], gq[8];
#pragma unroll
                for (int j = 0; j < 4; ++j) { a[j] = acc[ai][0][m][0][j]; a[4 + j] = acc[ai][0][m][1][j]; uu[j] = acc[ai][1][m][0][j]; uu[4 + j] = acc[ai][1][m][1][j]; }
#pragma unroll
                for (int j = 0; j < 8; ++j) { r1[j] = __int_as_float(__builtin_amdgcn_mov_dpp(__float_as_int(a[j]), 0x121, 0xf, 0xf, false)); r2[j] = __int_as_float(__builtin_amdgcn_mov_dpp(__float_as_int(a[j]), 0x122, 0xf, 0xf, false)); }
                const bool sample = row >= MP;
                const bool boundary = (m == 0 && fr < 2) || (sample && ((m & 1) == 0) && fr < 2);
                const bool keep_a = boundary || (m == 3 && fr >= 14);
#pragma unroll
                for (int j = 0; j < 8; ++j) {
                    const float am1 = fr >= 1 ? r1[j] : p1[j], am2 = fr >= 2 ? r2[j] : p2[j];
                    const float ac = bb[j] + w0[j] * am2 + w1[j] * am1 + w2[j] * a[j];
                    const float y = 1.5957691216f * (ac + 0.044715f * ac * ac * ac);
                    gq[j] = boundary ? uu[j] : ac * sigm(y) * uu[j];
                    p1[j] = r1[j]; p2[j] = r2[j];
                }
                u32x4 wv; wv.x = pk2(gq[0], gq[1]); wv.y = pk2(gq[2], gq[3]); wv.z = pk2(gq[4], gq[5]); wv.w = pk2(gq[6], gq[7]);
                __builtin_nontemporal_store(wv, (u32x4*)(g + (size_t)row * DFF + c0));
                if (keep_a) { u32x4 av; av.x = pk2(a[0], a[1]); av.y = pk2(a[2], a[3]); av.z = pk2(a[4], a[5]); av.w = pk2(a[6], a[7]); *(u32x4*)(araw + (size_t)row * DFF + c0) = av; }
                float* o = nullptr;
                if (sample) { const int rs = row - MP, t = rs & 31; if (t >= 30) o = out + O_SFC + (size_t)((rs >> 5) * 2 + t - 30) * DFF + c0; }
                else { const int t = row & 2047; if (t >= 2046) o = out + O_PFC + (size_t)((row >> 11) * 2 + t - 2046) * DFF + c0; }
                if (o) { *(f32x4*)o = acc[ai][0][m][0]; *(f32x4*)(o + 4) = acc[ai][0][m][1]; }
            }
        }
    }
};
struct F9 {
    const bf16_t* pe; const bf16_t* xb; float* y; struct Pre { u32x4 p, x; }; static constexpr int MB = 4;
    __device__ __forceinline__ Pre load(int row, int col) const { const size_t i = (size_t)row * 1024 + col; Pre r; r.p = *(const u32x4*)(pe + i); r.x = *(const u32x4*)(xb + i); return r; }
    __device__ __forceinline__ void operator()(int row, int col, int, f32x4 v0, f32x4 v1, Pre pr) const {
        const size_t i = (size_t)row * 1024 + col; float pf[8], xf[8]; unpk8(pr.p, pf); unpk8(pr.x, xf);
        f32x4 a, b;
#pragma unroll
        for (int j = 0; j < 4; ++j) { a[j] = xf[j] + pf[j] * sigm(v0[j]); b[j] = xf[4 + j] + pf[4 + j] * sigm(v1[j]); }
        *(f32x4*)(y + i) = a; *(f32x4*)(y + i + 4) = b;
    }
};
template <class E> __device__ __forceinline__ void run_gemm_epi(unsigned char* lds, const bf16_t* A, const bf16_t* Bt, int N, int K, const E& e) {
    asm volatile("" : "+s"(K)); asm volatile("" : "+s"(N));
    pg8::Gemm g; g.A = A; g.Bt = Bt; g.M = MT; g.N = N; g.K = K;
    pg8::StaticOrder S; S.init(MT, N, (int)gridDim.x, (int)blockIdx.x);
    pg8::gemm_phase<E, pg8::StaticOrder, false>((PG8_LAS unsigned char*)lds, g, S, e, nullptr);
    __syncthreads();
}
template <class F> __device__ __forceinline__ void run_gemm(unsigned char* lds, const bf16_t* A, const bf16_t* Bt, int N, int K, const F& f, int skip = 0) {
    asm volatile("" : "+s"(K)); asm volatile("" : "+s"(N));
    pg8::Gemm g; g.A = A; g.Bt = Bt; g.M = MT; g.N = N; g.K = K;
    pg8::StaticOrder S; S.init(MT, N, (int)gridDim.x - skip, (int)blockIdx.x - skip);
    EpiT<F> E; E.f = f;
    pg8::gemm_phase<EpiT<F>, pg8::StaticOrder, false>((PG8_LAS unsigned char*)lds, g, S, E, nullptr);
    __syncthreads();
}

template <bool ILV = false> __device__ __forceinline__ void transpose_w(const float* W, bf16_t* Bt, int K, int N, const float* gain, float* tile, int& toff, int cid, int G) {
    const int nnt = N / 64, ntiles = (K / 64) * nnt, tid = threadIdx.x;
    const int first = (cid - (toff % G) + G) % G;
    const int r0 = tid >> 6, c = tid & 63;
    float v[8];
#define TR_LOAD(t_) do { const int kt_ = (t_) / nnt, d0_ = ((t_) % nnt) * 64; \
        const int sc0_ = ILV ? (((d0_ & 255) < 128) ? (d0_ >> 8) * 128 + (d0_ & 127) : DFF + (d0_ >> 8) * 128 + (d0_ & 127)) : d0_; \
        _Pragma("unroll") for (int i = 0; i < 8; ++i) { const int r = r0 + 8 * i; float x = W[(size_t)(kt_ * 64 + r) * N + sc0_ + c]; if (gain) x *= gain[kt_ * 64 + r]; v[i] = x; } } while (0)
    if (first < ntiles) TR_LOAD(first);
    for (int t = first; t < ntiles; t += G) {
        const int kt = t / nnt, nt = t % nnt;
#pragma unroll
        for (int i = 0; i < 8; ++i) tile[(r0 + 8 * i) * 65 + c] = v[i];
        __syncthreads();
        if (t + G < ntiles) TR_LOAD(t + G);
        { const int n = tid >> 3, k8 = (tid & 7) * 8; u32x4 wv;
          wv.x = pk2(tile[(k8 + 0) * 65 + n], tile[(k8 + 1) * 65 + n]); wv.y = pk2(tile[(k8 + 2) * 65 + n], tile[(k8 + 3) * 65 + n]);
          wv.z = pk2(tile[(k8 + 4) * 65 + n], tile[(k8 + 5) * 65 + n]); wv.w = pk2(tile[(k8 + 6) * 65 + n], tile[(k8 + 7) * 65 + n]);
          *(u32x4*)(Bt + (size_t)(nt * 64 + n) * K + kt * 64 + k8) = wv; }
        __syncthreads();
    }
#undef TR_LOAD
    toff += ntiles;
}
__device__ __forceinline__ const float* xrow(const Prm& p, int row) { return row < MP ? p.in[I_XP] + (size_t)row * 1024 : p.in[I_XS] + (size_t)(row - MP) * 1024; }

__device__ __forceinline__ void late_weights(const Prm& p, unsigned char* lds) {
    if (blockIdx.x < 16) return;
    float* tile = (float*)lds; int toff = 0; unsigned char* ws = p.ws; const int cid = blockIdx.x - 16, G = gridDim.x - 16;
    transpose_w<true>(p.in[I_WUP], (bf16_t*)(ws + WS_WUP), 1024, 2 * DFF, p.in[I_GPF], tile, toff, cid, G);
    transpose_w(p.in[I_WDOWN], (bf16_t*)(ws + WS_WDOWN), DFF, 1024, nullptr, tile, toff, cid, G);
    transpose_w(p.in[I_WPG], (bf16_t*)(ws + WS_WPG), 1024, 1024, nullptr, tile, toff, cid, G);
    transpose_w(p.in[I_WPLE], (bf16_t*)(ws + WS_WPLE), 256, 1024, nullptr, tile, toff, cid, G);
}
__device__ __forceinline__ void phase0(const Prm& p, unsigned char* lds) {
    float* tile = (float*)lds; int toff = 0; unsigned char* ws = p.ws; const int cid = blockIdx.x, G = gridDim.x;
    transpose_w(p.in[I_WIN], (bf16_t*)(ws + WS_WIN), 1024, NIN, p.in[I_GPM], tile, toff, cid, G);
    transpose_w(p.in[I_WBRA], (bf16_t*)(ws + WS_WBRA), 1024, 1024, nullptr, tile, toff, cid, G);
    transpose_w(p.in[I_WBRB], (bf16_t*)(ws + WS_WBRB), 1024, 1024, nullptr, tile, toff, cid, G);
    transpose_w(p.in[I_WOUT], (bf16_t*)(ws + WS_WOUT), 1024, 1024, nullptr, tile, toff, cid, G);
    bf16_t* xn = (bf16_t*)p.out;
    const int lane = threadIdx.x & 63, gw = blockIdx.x * 8 + (threadIdx.x >> 6), nw = gridDim.x * 8;
    for (int row = gw; row < MT; row += nw) {
        const float* xr = xrow(p, row); f32x4 v[4]; float ss = 0.f;
#pragma unroll
        for (int i = 0; i < 4; ++i) { v[i] = *(const f32x4*)(xr + i * 256 + lane * 4); ss += v[i][0] * v[i][0] + v[i][1] * v[i][1] + v[i][2] * v[i][2] + v[i][3] * v[i][3]; }
        ss = wsum(ss); const float ms = ss * (1.0f / 1024.0f) + EPS, rs = rsqrtf(ms);
        if (lane == 0) ((float*)(p.ws + WS_RS0))[row] = ms * rs;
#pragma unroll
        for (int i = 0; i < 4; ++i) *(u32x2*)(xn + (size_t)row * 1024 + i * 256 + lane * 4) = pk4(v[i] * rs);
    }
}

constexpr int AT_KS = 0, AT_VT = 27648, AT_BT = 53248;
__device__ __forceinline__ void attn_bias_table(const Prm& p, unsigned char* lds) {
    float* bT = (float*)(lds + AT_BT); const float* tab = p.in[I_RB];
    for (int i = threadIdx.x; i < 16 * 256; i += 512) {
        const int head = i >> 8, idx = i & 255, rel = idx - 191, n = rel < 0 ? -rel : rel;
        int bk = n < 8 ? n : min(15, 33 - __clz(n * n)); if (rel > 0) bk += 16;
        bT[i] = idx < 255 ? tab[bk * 16 + head] : 0.f;
    }
}
template <int NKT, int NQT, bool SAMPLE>
__device__ __forceinline__ void attn_item(const Prm& p, unsigned char* lds, int b, int c, int kvh, bf16_t* YA) {
    bf16_t* Ks = (bf16_t*)(lds + AT_KS); bf16_t* Vt = (bf16_t*)(lds + AT_VT); const float* bT = (const float*)(lds + AT_BT);
    const bf16_t* kv = (const bf16_t*)(p.ws + WS_KV); bf16_t* R0 = (bf16_t*)(p.ws + WS_R0);
    const int tid = threadIdx.x, lane = tid & 63, w = tid >> 6, lr = lane & 15, lq = lane >> 4;
    const int head = kvh * 8 + w; const int qrow0 = SAMPLE ? MP + b * 32 : b * 2048 + c * 64;
    const size_t qoff0 = (size_t)(qrow0 + lr) * 1024 + head * 64 + lq * 8;
    bf16x8 qn0 = *(const bf16x8*)(R0 + qoff0), qn1 = *(const bf16x8*)(R0 + qoff0 + 32);
    __syncthreads();
    if (!SAMPLE) {
        const int tok0 = b * 2048 + (c - 2) * 64;
        for (int id = tid; id < 192 * 8; id += 512) {
            const int key = id >> 3, dc = id & 7; u32x4 v = {0u, 0u, 0u, 0u};
            if (c * 64 - 128 + key >= 0) v = *(const u32x4*)(kv + (size_t)(tok0 + key) * 256 + kvh * 64 + dc * 8);
            *(u32x4*)(Ks + key * 72 + dc * 8) = v;
        }
        for (int id = tid; id < 192 * 8; id += 512) {
            const int key = id % 192, dc = id / 192; u32x4 v = {0u, 0u, 0u, 0u};
            if (c * 64 - 128 + key >= 0) v = *(const u32x4*)(kv + (size_t)(tok0 + key) * 256 + 128 + kvh * 64 + dc * 8);
            bf16_t* d = Vt + (dc * 8) * 200 + key;
            d[0] = (bf16_t)(v.x & 0xffffu); d[200] = (bf16_t)(v.x >> 16); d[400] = (bf16_t)(v.y & 0xffffu); d[600] = (bf16_t)(v.y >> 16);
            d[800] = (bf16_t)(v.z & 0xffffu); d[1000] = (bf16_t)(v.z >> 16); d[1200] = (bf16_t)(v.w & 0xffffu); d[1400] = (bf16_t)(v.w >> 16);
        }
    } else {
        const float* ck = p.in[I_CK]; const float* cvp = p.in[I_CV];
        for (int id = tid; id < 160 * 8; id += 512) {
            const int key = id >> 3, dc = id & 7; u32x4 v;
            if (key < 128) { const float* s = ck + (size_t)(b * 128 + key) * 128 + kvh * 64 + dc * 8; v = pk8(*(const f32x4*)s, *(const f32x4*)(s + 4)); }
            else v = *(const u32x4*)(kv + (size_t)(MP + b * 32 + key - 128) * 256 + kvh * 64 + dc * 8);
            *(u32x4*)(Ks + key * 72 + dc * 8) = v;
        }
        for (int id = tid; id < 160 * 8; id += 512) {
            const int key = id % 160, dc = id / 160; u32x4 v;
            if (key < 128) { const float* s = cvp + (size_t)(b * 128 + key) * 128 + kvh * 64 + dc * 8; v = pk8(*(const f32x4*)s, *(const f32x4*)(s + 4)); }
            else v = *(const u32x4*)(kv + (size_t)(MP + b * 32 + key - 128) * 256 + 128 + kvh * 64 + dc * 8);
            bf16_t* d = Vt + (dc * 8) * 200 + key;
            d[0] = (bf16_t)(v.x & 0xffffu); d[200] = (bf16_t)(v.x >> 16); d[400] = (bf16_t)(v.y & 0xffffu); d[600] = (bf16_t)(v.y >> 16);
            d[800] = (bf16_t)(v.z & 0xffffu); d[1000] = (bf16_t)(v.z >> 16); d[1200] = (bf16_t)(v.w & 0xffffu); d[1400] = (bf16_t)(v.w >> 16);
        }
    }
    __syncthreads();
    const float sink = p.in[I_SINK][head];
    const float* bTh = bT + head * 256;
#pragma unroll 1
    for (int qi = 0; qi < NQT; ++qi) {
        const int q = qi * 16 + lr;
        const bf16x8 qf0 = qn0, qf1 = qn1;
        if (qi + 1 < NQT) { qn0 = *(const bf16x8*)(R0 + qoff0 + (size_t)(qi + 1) * 16384); qn1 = *(const bf16x8*)(R0 + qoff0 + (size_t)(qi + 1) * 16384 + 32); }
        f32x4 s[NKT];
#pragma unroll
        for (int kt = 0; kt < NKT; ++kt) {
            const bf16_t* kp = Ks + (kt * 16 + lr) * 72 + lq * 8;
            const bf16x8 k0 = *(const bf16x8*)kp, k1 = *(const bf16x8*)(kp + 32);
            f32x4 a = {0.f, 0.f, 0.f, 0.f}; a = MFMA16(k0, qf0, a); a = MFMA16(k1, qf1, a); s[kt] = a;
        }
        float mx = sink;
#pragma unroll
        for (int kt = 0; kt < NKT; ++kt)
#pragma unroll
            for (int r = 0; r < 4; ++r) {
                const int key = kt * 16 + lq * 4 + r; float v = s[kt][r] * 0.125f + bTh[key - q + 63];
                if (!SAMPLE && (c * 64 - 128 + key < 0)) v = -1e30f;
                s[kt][r] = v; mx = fmaxf(mx, v);
            }
        mx = fmaxf(mx, __shfl_xor(mx, 16)); mx = fmaxf(mx, __shfl_xor(mx, 32));
        float sum = 0.f;
#pragma unroll
        for (int kt = 0; kt < NKT; ++kt)
#pragma unroll
            for (int r = 0; r < 4; ++r) { const float e = __expf(s[kt][r] - mx); s[kt][r] = e; sum += e; }
        sum += __shfl_xor(sum, 16); sum += __shfl_xor(sum, 32);
        const float inv = 1.0f / (sum + __expf(sink - mx));
        f32x4 o[4];
#pragma unroll
        for (int dt = 0; dt < 4; ++dt) o[dt] = (f32x4){0.f, 0.f, 0.f, 0.f};
#pragma unroll
        for (int ks = 0; ks < NKT / 2; ++ks) {
            const u32x4 pw = pk8(s[2 * ks], s[2 * ks + 1]); const bf16x8 pf = __builtin_bit_cast(bf16x8, pw);
#pragma unroll
            for (int dt = 0; dt < 4; ++dt) {
                const bf16_t* vp = Vt + (dt * 16 + lr) * 200 + ks * 32 + lq * 4;
                const u32x2 lo = *(const u32x2*)vp, hi = *(const u32x2*)(vp + 16);
                const u32x4 vw = {lo.x, lo.y, hi.x, hi.y};
                o[dt] = MFMA16(__builtin_bit_cast(bf16x8, vw), pf, o[dt]);
            }
        }
#pragma unroll
        for (int dt = 0; dt < 4; ++dt) *(u32x2*)(YA + (size_t)(qrow0 + q) * 1024 + head * 64 + dt * 16 + lq * 4) = pk4(o[dt] * inv);
    }
}

template <int L, bool SAMPLE>
__device__ __forceinline__ void hgrn_seq(const Prm& p, unsigned char* lds, int b, int h, bf16_t* YB) {
    constexpr int RPG = L / 8, NT = L / 16, NCH = SAMPLE ? 1 : 32, NP = 8 / NT;
    bf16_t* Qd = (bf16_t*)lds; bf16_t* Qm = Qd + 64 * 136; bf16_t* Km = Qm + 64 * 136; bf16_t* KlT = Km + 64 * 136; bf16_t* Vt = KlT + 128 * 72; bf16_t* St = Vt + 128 * 72; bf16_t* Al = St + 128 * 136;
    float* tot = (float*)(Al + 64 * 72); float* first = tot + 1024; float* decay = first + 1024; float* ssq = decay + 128;
    const bf16_t* R1 = (const bf16_t*)(p.ws + WS_R0 + UB); const bf16_t* R2 = (const bf16_t*)(p.ws + WS_R0 + 2 * UB); const bf16_t* R3 = (const bf16_t*)(p.ws + WS_R0 + 3 * UB); const bf16_t* R4 = (const bf16_t*)(p.ws + WS_R0 + 4 * UB);
    const int tid = threadIdx.x, lane = tid & 63, w = tid >> 6, lr = lane & 15, lq = lane >> 4, cp = lane, rg = w, c0 = 2 * cp;
    float lb[2];
#pragma unroll
    for (int c = 0; c < 2; ++c) { const float l0 = p.in[I_LB][h * 128 + c0 + c], l1 = p.in[I_LB][1024 + h * 128 + c0 + c]; lb[c] = 1.0f / (1.0f + __expf(l1 - l0)); }
    f32x4 S[8];
#pragma unroll
    for (int dvt = 0; dvt < 8; ++dvt) {
        if (SAMPLE) {
#pragma unroll
            for (int r = 0; r < 4; ++r) S[dvt][r] = p.in[I_ST][((size_t)(b * 8 + h) * 128 + 16 * w + 4 * lq + r) * 128 + 16 * dvt + lr];
        } else S[dvt] = (f32x4){0.f, 0.f, 0.f, 0.f};
    }
    const int tt = w % NT, dv0 = (w / NT) * NT;
    const int rowbase = SAMPLE ? MP + b * 32 : b * 2048;
    f32x4 ggv[NT];
#pragma unroll
    for (int i = 0; i < NT; ++i) ggv[i] = *(const f32x4*)(p.in[I_GH] + 16 * (dv0 + i) + 4 * lq);
    unsigned qw[RPG], fw[RPG], vw[RPG];
#pragma unroll
    for (int i = 0; i < RPG; ++i) { const size_t idx = (size_t)(rowbase + rg * RPG + i) * 1024 + h * 128 + c0; qw[i] = *(const unsigned*)(R1 + idx); fw[i] = *(const unsigned*)(R2 + idx); vw[i] = *(const unsigned*)(R3 + idx); }
#pragma unroll 1
    for (int ch = 0; ch < NCH; ++ch) {
        const int row0 = rowbase + ch * L;
        float qv[2][RPG], cv[2][RPG], kk[2][RPG]; unsigned vkeep[RPG]; float run[2] = {1.f, 1.f}, lf0[2] = {0.f, 0.f};
#pragma unroll
        for (int i = 0; i < RPG; ++i) {
            vkeep[i] = vw[i];
#pragma unroll
            for (int c = 0; c < 2; ++c) {
                const float q = c ? bfhi(qw[i]) : bflo(qw[i]), fl = c ? bfhi(fw[i]) : bflo(fw[i]);
                const float f = lb[c] + (1.0f - lb[c]) * sigm(fl);
                run[c] *= f; cv[c][i] = run[c]; kk[c][i] = 1.0f - f; qv[c][i] = q * sigm(q); if (i == 0) lf0[c] = __logf(f);
            }
        }
        *(f32x2v*)(tot + rg * 128 + c0) = (f32x2v){__logf(run[0]), __logf(run[1])}; *(f32x2v*)(first + rg * 128 + c0) = (f32x2v){lf0[0], lf0[1]};
        if (ch + 1 < NCH) {
#pragma unroll
            for (int i = 0; i < RPG; ++i) { const size_t idx = (size_t)(row0 + L + rg * RPG + i) * 1024 + h * 128 + c0; qw[i] = *(const unsigned*)(R1 + idx); fw[i] = *(const unsigned*)(R2 + idx); vw[i] = *(const unsigned*)(R3 + idx); }
        }
        const size_t rbase = (size_t)(row0 + tt * 16 + lr) * 1024 + h * 128;
        u32x2 ogw[NT];
#pragma unroll
        for (int i = 0; i < NT; ++i) ogw[i] = *(const u32x2*)(R4 + rbase + 16 * (dv0 + i) + 4 * lq);
        __syncthreads();
        {
            float pre[2] = {0.f, 0.f}, bmid[2], blast[2], emid[2], elm[2], epre[2];
#pragma unroll
            for (int c = 0; c < 2; ++c) {
                float acc = 0.f, half = 0.f;
#pragma unroll
                for (int j = 0; j < 8; ++j) { const float t = tot[j * 128 + c0 + c]; if (j < rg) pre[c] += t; if (j < 4) half += t; acc += t; }
                bmid[c] = half + first[4 * 128 + c0 + c]; blast[c] = acc; emid[c] = __expf(bmid[c]); elm[c] = __expf(blast[c] - bmid[c]); epre[c] = __expf(pre[c] - bmid[c]);
            }
            float kl[2][RPG];
#pragma unroll
            for (int i = 0; i < RPG; ++i) {
                const int r = rg * RPG + i; float qd[2], qm[2], km[2];
#pragma unroll
                for (int c = 0; c < 2; ++c) {
                    const float E = epre[c] * cv[c][i], Ei = __builtin_amdgcn_rcpf(E);
                    qm[c] = qv[c][i] * E; qd[c] = qm[c] * emid[c]; km[c] = kk[c][i] * Ei; kl[c][i] = km[c] * elm[c];
                }
                *(unsigned*)(Qd + r * 136 + c0) = pk2(qd[0], qd[1]); *(unsigned*)(Qm + r * 136 + c0) = pk2(qm[0], qm[1]); *(unsigned*)(Km + r * 136 + c0) = pk2(km[0], km[1]);
            }
#pragma unroll
            for (int c = 0; c < 2; ++c) {
#pragma unroll
                for (int i = 0; i < RPG; i += 4) {
                    u32x2 a, v2; a.x = pk2(kl[c][i], kl[c][i + 1]); a.y = pk2(kl[c][i + 2], kl[c][i + 3]);
                    if (c == 0) { v2.x = (vkeep[i] & 0xffffu) | (vkeep[i + 1] << 16); v2.y = (vkeep[i + 2] & 0xffffu) | (vkeep[i + 3] << 16); }
                    else { v2.x = (vkeep[i] >> 16) | (vkeep[i + 1] & 0xffff0000u); v2.y = (vkeep[i + 2] >> 16) | (vkeep[i + 3] & 0xffff0000u); }
                    *(u32x2*)(KlT + (c0 + c) * 72 + rg * RPG + i) = a; *(u32x2*)(Vt + (c0 + c) * 72 + rg * RPG + i) = v2;
                }
            }
            if (rg == 0) *(f32x2v*)(decay + c0) = (f32x2v){__expf(blast[0]), __expf(blast[1])};
        }
#pragma unroll
        for (int dvt = 0; dvt < 8; ++dvt) *(u32x2*)(St + (16 * dvt + lr) * 136 + 16 * w + 4 * lq) = pk4(S[dvt]);
        __syncthreads();
        for (int id = w; id < NT * NT; id += 8) {
            const int st = id / NT, t2 = id % NT; f32x4 acc = {0.f, 0.f, 0.f, 0.f};
#pragma unroll
            for (int ks = 0; ks < 4; ++ks) acc = MFMA16(*(const bf16x8*)(Km + (st * 16 + lr) * 136 + ks * 32 + lq * 8), *(const bf16x8*)(Qm + (t2 * 16 + lr) * 136 + ks * 32 + lq * 8), acc);
            const int t = t2 * 16 + lr;
#pragma unroll
            for (int r = 0; r < 4; ++r) if (st * 16 + 4 * lq + r > t) acc[r] = 0.f;
            *(u32x2*)(Al + t * 72 + st * 16 + 4 * lq) = pk4(acc);
        }
        f32x4 o[NT];
#pragma unroll
        for (int i = 0; i < NT; ++i) {
            f32x4 acc = {0.f, 0.f, 0.f, 0.f};
#pragma unroll
            for (int ks = 0; ks < 4; ++ks) acc = MFMA16(*(const bf16x8*)(St + (16 * (dv0 + i) + lr) * 136 + ks * 32 + lq * 8), *(const bf16x8*)(Qd + (tt * 16 + lr) * 136 + ks * 32 + lq * 8), acc);
            o[i] = acc;
        }
        __syncthreads();
        float sq = 0.f;
#pragma unroll
        for (int i = 0; i < NT; ++i) {
#pragma unroll
            for (int ks = 0; ks < L / 32; ++ks) o[i] = MFMA16(*(const bf16x8*)(Vt + (16 * (dv0 + i) + lr) * 72 + ks * 32 + lq * 8), *(const bf16x8*)(Al + (tt * 16 + lr) * 72 + ks * 32 + lq * 8), o[i]);
            sq += o[i][0] * o[i][0] + o[i][1] * o[i][1] + o[i][2] * o[i][2] + o[i][3] * o[i][3];
        }
        sq += __shfl_xor(sq, 16); sq += __shfl_xor(sq, 32);
        if (lq == 0) ssq[(w / NT) * 64 + tt * 16 + lr] = sq;
        {
            const f32x4 dc = *(const f32x4*)(decay + 16 * w + 4 * lq);
#pragma unroll
            for (int dvt = 0; dvt < 8; ++dvt) {
                f32x4 acc = S[dvt] * dc;
#pragma unroll
                for (int ks = 0; ks < L / 32; ++ks) acc = MFMA16(*(const bf16x8*)(KlT + (16 * w + lr) * 72 + ks * 32 + lq * 8), *(const bf16x8*)(Vt + (16 * dvt + lr) * 72 + ks * 32 + lq * 8), acc);
                S[dvt] = acc;
            }
        }
        __syncthreads();
        {
            float tsq = 0.f;
#pragma unroll
            for (int j = 0; j < NP; ++j) tsq += ssq[j * 64 + tt * 16 + lr];
            const float rs = rsqrtf(tsq * (1.0f / 128.0f) + EPS);
#pragma unroll
            for (int i = 0; i < NT; ++i) {
                const int dvb = 16 * (dv0 + i) + 4 * lq;
                const f32x4 gg = ggv[i];
                const float og0 = bflo(ogw[i].x), og1 = bfhi(ogw[i].x), og2 = bflo(ogw[i].y), og3 = bfhi(ogw[i].y);
                f32x4 y; y[0] = o[i][0] * rs * gg[0] * og0 * sigm(og0); y[1] = o[i][1] * rs * gg[1] * og1 * sigm(og1); y[2] = o[i][2] * rs * gg[2] * og2 * sigm(og2); y[3] = o[i][3] * rs * gg[3] * og3 * sigm(og3);
                *(u32x2*)(YB + rbase + dvb) = pk4(y);
            }
        }
    }
    float* so = p.out + (SAMPLE ? O_SST : O_PST) + (size_t)(b * 8 + h) * 16384;
#pragma unroll
    for (int dvt = 0; dvt < 8; ++dvt)
#pragma unroll
        for (int r = 0; r < 4; ++r) so[(16 * w + 4 * lq + r) * 128 + 16 * dvt + lr] = S[dvt][r];
    __syncthreads();
}

__device__ __forceinline__ void conv_p(const Prm& p) {
    if (blockIdx.x < 16) return;
    bf16_t* pbf = (bf16_t*)(p.ws + WS_KV);
    for (int id = (blockIdx.x - 16) * 512 + threadIdx.x; id < MT * 32; id += (gridDim.x - 16) * 512) {
        const int row = id >> 5, c = (id & 31) * 8;
        const float* s = (row < MP ? p.in[I_PP] + (size_t)row * 256 : p.in[I_PS] + (size_t)(row - MP) * 256) + c;
        *(u32x4*)(pbf + (size_t)row * 256 + c) = pk8(*(const f32x4*)s, *(const f32x4*)(s + 4));
    }
}
__device__ __forceinline__ void phase_rp5(const Prm& p) {
    const bf16_t* O = (const bf16_t*)(p.ws + WS_R0 + 4 * UB); bf16_t* hf = (bf16_t*)(p.ws + WS_R0); const float* g = p.in[I_GPOST];
    const int lane = threadIdx.x & 63, gw = blockIdx.x * 8 + (threadIdx.x >> 6), nw = gridDim.x * 8;
    for (int row = gw; row < MT; row += nw) {
        const bf16_t* xr = (const bf16_t*)p.out + (size_t)row * 1024; const float xs = ((const float*)(p.ws + WS_RS0))[row]; const bf16_t* orow = O + (size_t)row * 1024; f32x4 v[4], x[4]; float ss = 0.f;
#pragma unroll
        for (int i = 0; i < 4; ++i) { { const u32x2 ow = *(const u32x2*)(orow + i * 256 + lane * 4); v[i] = (f32x4){bflo(ow.x), bfhi(ow.x), bflo(ow.y), bfhi(ow.y)}; } { const u32x2 xw = *(const u32x2*)(xr + i * 256 + lane * 4); x[i] = (f32x4){bflo(xw.x), bfhi(xw.x), bflo(xw.y), bfhi(xw.y)} * xs; } ss += v[i][0] * v[i][0] + v[i][1] * v[i][1] + v[i][2] * v[i][2] + v[i][3] * v[i][3]; }
        ss = wsum(ss); const float rs = rsqrtf(ss * (1.0f / 1024.0f) + EPS); float s2 = 0.f;
#pragma unroll
        for (int i = 0; i < 4; ++i) { const f32x4 gg = *(const f32x4*)(g + i * 256 + lane * 4); x[i] += v[i] * rs * gg; s2 += x[i][0] * x[i][0] + x[i][1] * x[i][1] + x[i][2] * x[i][2] + x[i][3] * x[i][3];
            *(u32x2*)((bf16_t*)p.out + (size_t)row * 1024 + i * 256 + lane * 4) = pk4(x[i]); }
        s2 = wsum(s2); const float r2 = rsqrtf(s2 * (1.0f / 1024.0f) + EPS);
#pragma unroll
        for (int i = 0; i < 4; ++i) *(u32x2*)(hf + (size_t)row * 1024 + i * 256 + lane * 4) = pk4(x[i] * r2);
    }
}
__device__ __forceinline__ void phase_rp8(const Prm& p) {
    const bf16_t* O = (const bf16_t*)(p.ws + WS_R0 + UB); bf16_t* xb = (bf16_t*)(p.ws + WS_R0 + 3 * UB); const float* g = p.in[I_GPFF];
    const int lane = threadIdx.x & 63, gw = blockIdx.x * 8 + (threadIdx.x >> 6), nw = gridDim.x * 8;
    for (int row = gw; row < MT; row += nw) {
        const bf16_t* xr = (const bf16_t*)p.out + (size_t)row * 1024; const bf16_t* orow = O + (size_t)row * 1024; f32x4 v[4], x[4]; float ss = 0.f;
#pragma unroll
        for (int i = 0; i < 4; ++i) { { const u32x2 ow = *(const u32x2*)(orow + i * 256 + lane * 4); v[i] = (f32x4){bflo(ow.x), bfhi(ow.x), bflo(ow.y), bfhi(ow.y)}; } { const u32x2 xw = *(const u32x2*)(xr + i * 256 + lane * 4); x[i] = (f32x4){bflo(xw.x), bfhi(xw.x), bflo(xw.y), bfhi(xw.y)}; } ss += v[i][0] * v[i][0] + v[i][1] * v[i][1] + v[i][2] * v[i][2] + v[i][3] * v[i][3]; }
        ss = wsum(ss); const float rs = rsqrtf(ss * (1.0f / 1024.0f) + EPS);
#pragma unroll
        for (int i = 0; i < 4; ++i) { const f32x4 gg = *(const f32x4*)(g + i * 256 + lane * 4); x[i] += v[i] * rs * gg;
            *(u32x2*)(xb + (size_t)row * 1024 + i * 256 + lane * 4) = pk4(x[i]); }
    }
}
__device__ __forceinline__ void phase_conv(const Prm& p) {
    const bf16_t* A = (const bf16_t*)(p.ws + WS_R0 + UB); bf16_t* Ug = (bf16_t*)(p.ws + WS_R0 + UB + A_BYTES);
    const float* wc = p.in[I_WCONV]; const float* bc = p.in[I_BCONV]; const float* cc = p.in[I_CC];
    for (int id = blockIdx.x * 512 + threadIdx.x; id < 2112 * 352; id += gridDim.x * 512) {
        const int ri = id / 352, c0 = (id % 352) * 8;
        int row; if (ri < 2048) row = (ri >> 1) * 64 + (ri & 1); else { const int j = ri - 2048; row = MP + (j >> 1) * 32 + (j & 1); }
        float am2[8], am1[8], a[8], u[8], gq[8];
#pragma unroll
        for (int j = 0; j < 8; ++j) { am2[j] = 0.f; am1[j] = 0.f; }
        if (row < MP) {
            const int t = row & 2047;
            if (t >= 1) unpk8(*(const u32x4*)(A + (size_t)(row - 1) * DFF + c0), am1);
            if (t >= 2) unpk8(*(const u32x4*)(A + (size_t)(row - 2) * DFF + c0), am2);
        } else {
            const int rs = row - MP, b = rs >> 5, t = rs & 31;
            if (t == 0) {
#pragma unroll
                for (int j = 0; j < 8; ++j) { am2[j] = cc[(size_t)(b * 2) * DFF + c0 + j]; am1[j] = cc[(size_t)(b * 2 + 1) * DFF + c0 + j]; }
            } else {
#pragma unroll
                for (int j = 0; j < 8; ++j) am2[j] = cc[(size_t)(b * 2 + 1) * DFF + c0 + j];
                unpk8(*(const u32x4*)(A + (size_t)(row - 1) * DFF + c0), am1);
            }
        }
        const size_t off = (size_t)row * DFF + c0;
        unpk8(*(const u32x4*)(A + off), a); unpk8(*(const u32x4*)(Ug + off), u);
#pragma unroll
        for (int j = 0; j < 8; ++j) {
            const float ac = bc[c0 + j] + wc[c0 + j] * am2[j] + wc[DFF + c0 + j] * am1[j] + wc[2 * DFF + c0 + j] * a[j];
            const float y = 1.5957691216f * (ac + 0.044715f * ac * ac * ac);
            gq[j] = ac * sigm(y) * u[j];
        }
        u32x4 wv; wv.x = pk2(gq[0], gq[1]); wv.y = pk2(gq[2], gq[3]); wv.z = pk2(gq[4], gq[5]); wv.w = pk2(gq[6], gq[7]);
        *(u32x4*)(Ug + off) = wv;
    }
}

#ifndef PROBE_DUP
#define PROBE_DUP 0
#endif
#ifndef P2M
#define P2M 15
#endif
#ifndef PHM
#define PHM 0xfff
#endif

#define XB_TMO      128
#define XB_XCNT(j)  (256  + 64 * (j))
#define XB_XSUB(j)  (1280 + 64 * (j))
#define XB_XGEN(j)  (2304 + 64 * (j))
#define XB_TOP      3328
#define XB_TOPGEN   3392
#define XCD_BAR_WORDS 3456
#define XB_SPIN_CAP (1u << 18)
#define LAS __attribute__((address_space(3)))

__device__ __forceinline__ unsigned xb_ld(unsigned* p)              { return __hip_atomic_load(p, __ATOMIC_RELAXED, __HIP_MEMORY_SCOPE_AGENT); }
__device__ __forceinline__ unsigned xb_add(unsigned* p, unsigned v) { return __hip_atomic_fetch_add(p, v, __ATOMIC_RELAXED, __HIP_MEMORY_SCOPE_AGENT); }
__device__ __forceinline__ unsigned xb_xcc_id() { return (unsigned)__builtin_amdgcn_s_getreg((3 << 11) | 20) & 0xFu; }
#define XB_SPIN(cond, bar) do { unsigned _sp = 0; while (cond) { __builtin_amdgcn_s_sleep(1); \
    if ((++_sp & 255u) == 0u) { if (xb_ld(&(bar)[XB_TMO])) break; if (_sp > XB_SPIN_CAP) { atomicAdd(&(bar)[XB_TMO], 1u); break; } } } } while (0)
struct XcdBarrier {
    unsigned* bar; unsigned x;
    volatile LAS unsigned* st;
};

__device__ __forceinline__ XcdBarrier xcd_barrier_post(unsigned* bar, volatile LAS unsigned* st) {
    XcdBarrier b; b.bar = bar; b.x = xb_xcc_id(); b.st = st;
    if (threadIdx.x == 0) (void)xb_add(&bar[XB_XCNT(b.x)], 1u);
    return b;
}
__device__ __forceinline__ void xcd_barrier_complete(unsigned* bar, unsigned x, unsigned& nloc, unsigned& nx) {
    const unsigned G = gridDim.x * gridDim.y * gridDim.z;
    unsigned sum, cnt, mine, sp = 0u;
    for (;;) {
        sum = 0u; cnt = 0u; mine = 0u;
#pragma unroll
        for (unsigned j = 0; j < 16; ++j) { const unsigned c = xb_ld(&bar[XB_XCNT(j)]); sum += c; cnt += (c > 0u) ? 1u : 0u; mine = (j == x) ? c : mine; }
        if (sum == G) break;
        __builtin_amdgcn_s_sleep(1);
        if ((++sp & 255u) == 0u) { if (xb_ld(&bar[XB_TMO])) break; if (sp > XB_SPIN_CAP) { atomicAdd(&bar[XB_TMO], 1u); break; } }
    }
    nloc = mine > 0u ? mine : 1u; nx = cnt > 0u ? cnt : 1u;
}

__device__ __forceinline__ void xcd_barrier(const XcdBarrier& b) {
    asm volatile("s_waitcnt vmcnt(0)" ::: "memory");
    __syncthreads();
    if (threadIdx.x == 0) {
        unsigned* bar = b.bar;
        __builtin_amdgcn_s_waitcnt(0);
        unsigned nloc = b.st[0], nx = b.st[1];
        if (nloc == 0u) { xcd_barrier_complete(bar, b.x, nloc, nx); b.st[0] = nloc; b.st[1] = nx; }
        const unsigned old = xb_add(&bar[XB_XSUB(b.x)], 1u);
        const unsigned gen = old / nloc;
        if (old + 1u == (gen + 1u) * nloc) {
            __builtin_amdgcn_fence(__ATOMIC_RELEASE, "agent");
            asm volatile("s_waitcnt vmcnt(0)" ::: "memory");
            const unsigned og = xb_add(&bar[XB_TOP], 1u);
            const unsigned tg = og / nx;
            if (og + 1u == (tg + 1u) * nx) xb_add(&bar[XB_TOPGEN], 1u);
            else XB_SPIN(xb_ld(&bar[XB_TOPGEN]) == tg, bar);
            __builtin_amdgcn_fence(__ATOMIC_ACQUIRE, "agent");
            xb_add(&bar[XB_XGEN(b.x)], 1u);
            asm volatile("s_waitcnt vmcnt(0)" ::: "memory");
        } else {
            XB_SPIN(xb_ld(&bar[XB_XGEN(b.x)]) == gen, bar);
            __builtin_amdgcn_fence(__ATOMIC_ACQUIRE, "agent");
            asm volatile("s_waitcnt vmcnt(0)" ::: "memory");
        }
    }
    __syncthreads();
}

__global__ void __launch_bounds__(512, 2) fwd_mega(Prm p, int ph_lo, int ph_hi) {
    extern __shared__ __attribute__((aligned(16))) unsigned char lds[];
    cg::grid_group grid = cg::this_grid();
    unsigned char* ws = p.ws;
    bf16_t* R0 = (bf16_t*)(ws + WS_R0);
#define REG(i) ((bf16_t*)(ws + WS_R0 + (size_t)(i) * UB))
    unsigned* barw = (unsigned*)(ws + WS_END);
    if (blockIdx.x == 0) for (int i = threadIdx.x; i < XCD_BAR_WORDS; i += 512) barw[i] = 0u;
    volatile LAS unsigned* xst = (volatile LAS unsigned*)((PG8_LAS unsigned char*)lds + (LDS_BYTES - 16));
    if (threadIdx.x < 4) xst[threadIdx.x] = 0u;
    __syncthreads();
    XcdBarrier xb; xb.bar = barw; xb.x = 0u; xb.st = xst;
    unsigned bar_k = 0;
#define GRID_SEAM() do { if (bar_k == 0) { grid.sync(); xb = xcd_barrier_post(barw, xst); } else xcd_barrier(xb); ++bar_k; } while (0)
#define PH_BEGIN(n) if (ph_lo <= (n) && (n) < ph_hi) { if ((n) > ph_lo) GRID_SEAM();
#define PH_END }
#if (PHM >> 0) & 1
        PH_BEGIN(0) phase0(p, lds);
#if PROBE_DUP == 1
        grid.sync(); phase0(p, lds);
#endif
        PH_END
#else
#endif
#if (PHM >> 1) & 1
        PH_BEGIN(1) { F1 f; f.r0 = R0; f.kv = (bf16_t*)(ws + WS_KV); f.out = p.out; run_gemm(lds, (const bf16_t*)p.out, (const bf16_t*)(ws + WS_WIN), NIN, 1024, f);
#if PROBE_DUP == 3
            grid.sync(); run_gemm(lds, (const bf16_t*)p.out, (const bf16_t*)(ws + WS_WIN), NIN, 1024, f);
#endif
        } PH_END
#else
#endif
#if (PHM >> 2) & 1
        PH_BEGIN(2) {
#if PROBE_DUP == 2
            { bf16_t* YA = (bf16_t*)p.out; bf16_t* YB = (bf16_t*)p.out + UB / 2;
            const int G = gridDim.x;
#if P2M & 1
#pragma unroll 1
            for (int s = blockIdx.x; s < 256; s += G) hgrn_seq<64, false>(p, lds, s >> 3, s & 7, YB);
#endif
#if P2M & 2
#pragma unroll 1
            for (int s = blockIdx.x; s < 256; s += G) hgrn_seq<32, true>(p, lds, s >> 3, s & 7, YB);
#endif
            __syncthreads(); attn_bias_table(p, lds); __syncthreads();
#if P2M & 4
#pragma unroll 1
            for (int it = blockIdx.x; it < 2048; it += G) attn_item<12, 4, false>(p, lds, it >> 6, (it >> 1) & 31, it & 1, YA);
#endif
#if P2M & 8
#pragma unroll 1
            for (int it = blockIdx.x; it < 64; it += G) attn_item<10, 2, true>(p, lds, it >> 1, 0, it & 1, YA);
#endif
            __syncthreads(); }
#endif
            { bf16_t* YA = REG(0); bf16_t* YB = REG(1);
            const int G = gridDim.x;
#if P2M & 1
#pragma unroll 1
            for (int s = blockIdx.x; s < 256; s += G) hgrn_seq<64, false>(p, lds, s >> 3, s & 7, YB);
#endif
#if P2M & 2
#pragma unroll 1
            for (int s = blockIdx.x; s < 256; s += G) hgrn_seq<32, true>(p, lds, s >> 3, s & 7, YB);
#endif
            __syncthreads(); attn_bias_table(p, lds); __syncthreads();
#if P2M & 4
#pragma unroll 1
            for (int it = blockIdx.x; it < 2048; it += G) attn_item<12, 4, false>(p, lds, it >> 6, (it >> 1) & 31, it & 1, YA);
#endif
#if P2M & 8
#pragma unroll 1
            for (int it = blockIdx.x; it < 64; it += G) attn_item<10, 2, true>(p, lds, it >> 1, 0, it & 1, YA);
#endif
            }
        } PH_END
#else
#endif
#if (PHM >> 3) & 1
        PH_BEGIN(3) { F2 f; f.g = REG(5); f.o = REG(2); run_gemm(lds, REG(0), (const bf16_t*)(ws + WS_WBRA), 1024, 1024, f); late_weights(p, lds);
#if PROBE_DUP == 4
            grid.sync(); run_gemm(lds, REG(0), (const bf16_t*)(ws + WS_WBRA), 1024, 1024, f); late_weights(p, lds);
#endif
        } PH_END
#else
#endif
#if (PHM >> 4) & 1
        PH_BEGIN(4) { F3 f; f.g = REG(6); f.t = REG(2); f.o = REG(3); run_gemm(lds, REG(1), (const bf16_t*)(ws + WS_WBRB), 1024, 1024, f); conv_p(p); } PH_END
#else
#endif
#if (PHM >> 5) & 1
        PH_BEGIN(5) { FBF f; f.o = REG(4); run_gemm(lds, REG(3), (const bf16_t*)(ws + WS_WOUT), 1024, 1024, f);
#if PROBE_DUP == 5
            grid.sync(); run_gemm(lds, REG(3), (const bf16_t*)(ws + WS_WOUT), 1024, 1024, f);
#endif
        } PH_END
#else
#endif
#if (PHM >> 6) & 1
        PH_BEGIN(6) phase_rp5(p); PH_END
#else
#endif
#if (PHM >> 7) & 1
        PH_BEGIN(7) { EpiUp e; e.g = (bf16_t*)(ws + WS_R0 + UB + A_BYTES); e.araw = REG(1); e.out = p.out; e.wcv = p.in[I_WCONV]; e.bcv = p.in[I_BCONV]; run_gemm_epi(lds, REG(0), (const bf16_t*)(ws + WS_WUP), 2 * DFF, 1024, e); } PH_END
#else
#endif
#if (PHM >> 8) & 1
        PH_BEGIN(8) phase_conv(p); PH_END
#else
#endif
        PH_BEGIN(9) { FBF f; f.o = REG(1); run_gemm(lds, (const bf16_t*)(ws + WS_R0 + UB + A_BYTES), (const bf16_t*)(ws + WS_WDOWN), 1024, DFF, f);
                  FBF f2; f2.o = REG(0); if (blockIdx.x >= 16) run_gemm(lds, (const bf16_t*)(ws + WS_KV), (const bf16_t*)(ws + WS_WPLE), 1024, 256, f2, 16); } PH_END
#if (PHM >> 10) & 1
        PH_BEGIN(10) phase_rp8(p); PH_END
#else
#endif
#if (PHM >> 11) & 1
        PH_BEGIN(11) { F9 f; f.pe = REG(0); f.xb = REG(3); f.y = p.out; run_gemm(lds, REG(3), (const bf16_t*)(ws + WS_WPG), 1024, 1024, f); } PH_END
#else
#endif
#undef REG
}

extern "C" void kernel_launch(void* const* d_in, const int* in_sizes, int n_in, void* d_out, int out_size, void* d_ws, size_t ws_size, hipStream_t stream) {
    static int grid = 0;
    if (grid == 0) {
        if (n_in != 26 || (size_t)out_size != O_END || ws_size < WS_END) { fprintf(stderr, "kernel_launch: unexpected shapes n_in %d out %d ws %zu (need %zu)\n", n_in, out_size, ws_size, (size_t)WS_END); grid = -1; return; }
        int dev = 0, cus = 0, per_cu = 0;
        hipGetDevice(&dev); hipDeviceGetAttribute(&cus, hipDeviceAttributeMultiprocessorCount, dev);
        if (hipFuncSetAttribute((const void*)fwd_mega, hipFuncAttributeMaxDynamicSharedMemorySize, LDS_BYTES) != hipSuccess) { fprintf(stderr, "kernel_launch: hipFuncSetAttribute failed\n"); grid = -1; return; }
        if (hipOccupancyMaxActiveBlocksPerMultiprocessor(&per_cu, (const void*)fwd_mega, 512, LDS_BYTES) != hipSuccess || per_cu < 1) { fprintf(stderr, "kernel_launch: occupancy query says %d\n", per_cu); per_cu = 1; }
        (void)hipGetLastError();
        grid = cus;
    }
    if (grid < 0) return;
    Prm p{};
    for (int i = 0; i < 26; ++i) p.in[i] = (const float*)d_in[i];
    p.out = (float*)d_out; p.ws = (unsigned char*)d_ws;
    int lo = 0, hi = 12;
    void* args[] = {&p, &lo, &hi};
    hipError_t e = hipLaunchCooperativeKernel((const void*)fwd_mega, dim3(grid), dim3(512), args, LDS_BYTES, stream);
    if (e != hipSuccess) fprintf(stderr, "kernel_launch: cooperative launch failed: %s (grid %d)\n", hipGetErrorString(e), grid);
}
```

```cpp
#include <hip/hip_runtime.h>
#include <hip/hip_cooperative_groups.h>
#include <cstdio>
namespace cg = cooperative_groups;
namespace pg8 {
#define PG8_LAS __attribute__((address_space(3)))
typedef unsigned short bf16_t;
typedef short bf16x8 __attribute__((ext_vector_type(8)));
typedef float f32x4 __attribute__((ext_vector_type(4)));
typedef unsigned u32x4 __attribute__((ext_vector_type(4)));
constexpr int BM = 256, BK = 64, HALF = 128, HTB = HALF * BK * 2  , STAGE_BYTES = 8 * HTB, NXCD = 8, WGM = 8;

__host__ __device__ __forceinline__ int lds_byte(int r, int c) { const int st = (r >> 4) * 2 + (c >> 5), rr = r & 15, cc = c & 31, ob = rr * 64 + cc * 2; return st * 1024 + (ob ^ (((ob >> 9) & 1) << 5)); }
__host__ __device__ __forceinline__ void stage_rc(int b, int& R, int& C) { const int st = b / 1024, sb = b % 1024, swz = sb ^ (((sb >> 9) & 1) << 5); R = (st >> 1) * 16 + swz / 64; C = (st & 1) * 32 + (swz % 64) / 2; }
__host__ __device__ __forceinline__ int perm32(int rho) { const int n = rho >> 4, i = rho & 15; return 8 * (i >> 2) + 4 * n + (i & 3); }

struct Unit { int pm, pn, which; size_t aoff, boff; };
struct Gemm { const bf16_t* A; const bf16_t* Bt; int M, N, K; };

struct StaticOrder {
    int nM, nN, nwg, G, c;
    __host__ __device__ void init(int M, int N, int G_, int c_) { nM = M / BM; nN = N / BM; nwg = nM * nN; G = G_; c = c_; }
    __host__ __device__ bool next(int i, Unit& u) const {
        const long L = (long)i * G + c; if (L >= nwg) return false;
        int wgid = (int)L; { const int q = nwg / NXCD, r = nwg % NXCD, xcd = wgid % NXCD, off = wgid / NXCD; wgid = (xcd < r ? xcd * (q + 1) : r * (q + 1) + (xcd - r) * q) + off; }
        const int nig = WGM * nN, gid = wgid / nig, fm = gid * WGM, gsz = (nM - fm) < WGM ? (nM - fm) : WGM;
        u.pm = fm + ((wgid % nig) % gsz); u.pn = (wgid % nig) / gsz; u.which = 0; u.aoff = 0; u.boff = 0; return true;
    }
    __device__ __forceinline__ void a_ready(const Unit&) const {}
    __device__ __forceinline__ void done(const Unit&) const {}
};
__device__ __forceinline__ unsigned cvt_pk_bf16(float lo, float hi) { unsigned r; asm volatile("v_cvt_pk_bf16_f32 %0, %1, %2" : "=v"(r) : "v"(lo), "v"(hi)); return r; }
template <class Epi, class Sched, bool STAMP = false>
__device__ __forceinline__ void gemm_phase(PG8_LAS unsigned char* lds, const Gemm g, const Sched& S, const Epi& E, unsigned long long* stamps) {
    const int tid = threadIdx.x, wid = __builtin_amdgcn_readfirstlane(tid >> 6), lane = tid & 63, wr = wid >> 2, wc = wid & 3, fr = lane & 15, fq = lane >> 4;
    const int K = g.K, nt = K / BK;
    int ts_lo = 0, ts_hi = 0, nts = 0; const unsigned long long rt_entry = STAMP ? (unsigned long long)wall_clock64() : 0ull;
#define PG8_STAMP() do { if (STAMP && wid == 0 && nts < 64) { const unsigned long long _c = (unsigned long long)clock64(); \
        ts_lo = (lane == nts) ? (int)(unsigned)_c : ts_lo; ts_hi = (lane == nts) ? (int)(unsigned)(_c >> 32) : ts_hi; ++nts; } } while (0)
    PG8_STAMP();
    unsigned voffA[2], voffB[2];
#pragma unroll
    for (int i = 0; i < 2; ++i) { int R, C; stage_rc(tid * 16 + i * 8192, R, C); const int Rb = Epi::PERM ? ((R & ~31) + perm32(R & 31)) : R;
        voffA[i] = (unsigned)(R * K + C) * 2u; voffB[i] = (unsigned)(Rb * K + C) * 2u; }
    const size_t kstep = (size_t)(BK * 2);
    const size_t hstep = (size_t)HALF * K * 2;
    const size_t tstep = 2 * hstep;
    const unsigned ldsw = (unsigned)wid * 1024u;
    const int aoff = lds_byte(wr * 64 + fr, fq * 8), boff = lds_byte(wc * 32 + fr, fq * 8);
#define PG8_SA(b, h) (((b) * 2 + (h)) * HTB)
#define PG8_SB(b, h) ((4 + (b) * 2 + (h)) * HTB)
#define PG8_STAGE(bufoff, gbase, voff) do { _Pragma("unroll") for (int _i = 0; _i < 2; ++_i) \
        __builtin_amdgcn_global_load_lds((const unsigned*)((const char*)(gbase) + (voff)[_i]), (PG8_LAS unsigned*)(lds + (bufoff) + ldsw + _i * 8192), 16, 0, 0); } while (0)
#define PG8_LDA(dst, b, h) do { _Pragma("unroll") for (int m = 0; m < 4; ++m) _Pragma("unroll") for (int k = 0; k < 2; ++k) dst[m][k] = *(const PG8_LAS bf16x8*)(lds + PG8_SA(b, h) + aoff + m * 2048 + k * 1024); } while (0)
#define PG8_LDB(dst, b, h) do { _Pragma("unroll") for (int n = 0; n < 2; ++n) _Pragma("unroll") for (int k = 0; k < 2; ++k) dst[n][k] = *(const PG8_LAS bf16x8*)(lds + PG8_SB(b, h) + boff + n * 2048 + k * 1024); } while (0)
#define PG8_MMA(ai, bj, At, Bt) do { __builtin_amdgcn_s_setprio(1); _Pragma("unroll") for (int m = 0; m < 4; ++m) _Pragma("unroll") for (int n = 0; n < 2; ++n) _Pragma("unroll") for (int k = 0; k < 2; ++k) \
        acc[ai][bj][m][n] = __builtin_amdgcn_mfma_f32_16x16x32_bf16(Bt[n][k], At[m][k], acc[ai][bj][m][n], 0, 0, 0); __builtin_amdgcn_s_setprio(0); } while (0)
#define PG8_WAIT_V(n) asm volatile("s_waitcnt vmcnt(" #n ")" ::: "memory")
#define PG8_WAIT_L(n) asm volatile("s_waitcnt lgkmcnt(" #n ")" ::: "memory")
#define PG8_BAR __builtin_amdgcn_s_barrier()
#define PG8_SCHED __builtin_amdgcn_sched_barrier(0)
    Unit cur, nxt; int ui = 0;
    if (!S.next(0, cur)) return;
    f32x4 acc[2][2][4][2];
#pragma unroll
    for (int a = 0; a < 2; ++a)
#pragma unroll
        for (int b = 0; b < 2; ++b)
#pragma unroll
            for (int m = 0; m < 4; ++m)
#pragma unroll
                for (int n = 0; n < 2; ++n) acc[a][b][m][n] = (f32x4){0.f, 0.f, 0.f, 0.f};
    bf16x8 At[4][2], B0[2][2], B1[2][2];
    const char* cA = (const char*)g.A + (size_t)cur.pm * tstep + cur.aoff; const char* cB = (const char*)g.Bt + (size_t)cur.pn * tstep + cur.boff;
    S.a_ready(cur);
    PG8_STAGE(PG8_SB(0, 0), cB, voffB); PG8_STAGE(PG8_SA(0, 0), cA, voffA); PG8_STAGE(PG8_SB(0, 1), cB + hstep, voffB); PG8_STAGE(PG8_SA(0, 1), cA + hstep, voffA);
    if (wr == 1) PG8_BAR;
    PG8_WAIT_V(4); PG8_BAR;
    PG8_STAGE(PG8_SB(1, 0), cB + kstep, voffB); PG8_STAGE(PG8_SA(1, 0), cA + kstep, voffA); PG8_STAGE(PG8_SB(1, 1), cB + hstep + kstep, voffB);
    PG8_WAIT_V(6); PG8_BAR;
    PG8_STAMP();
    for (;;) {
        const bool has_next = S.next(ui + 1, nxt);
        const char* nA = has_next ? (const char*)g.A + (size_t)nxt.pm * tstep + nxt.aoff : cA; const char* nB = has_next ? (const char*)g.Bt + (size_t)nxt.pn * tstep + nxt.boff : cB;
        for (int t = 0; t < nt; t += 2) {
            const bool last = (t == nt - 2);
            const char* a1 = cA + (size_t)(t + 1) * kstep;
            const char* a2 = last ? nA : cA + (size_t)(t + 2) * kstep; const char* b2 = last ? nB : cB + (size_t)(t + 2) * kstep;
            const char* a3 = a2 + kstep; const char* b3 = b2 + kstep;
            if (last && has_next) S.a_ready(nxt);
            PG8_LDB(B0, 0, 0); PG8_SCHED; PG8_LDA(At, 0, 0); PG8_STAGE(PG8_SA(1, 1), a1 + hstep, voffA);
            PG8_WAIT_L(8); PG8_BAR; PG8_WAIT_L(0); PG8_MMA(0, 0, At, B0); PG8_BAR; PG8_SCHED;
            PG8_LDB(B1, 0, 1); PG8_STAGE(PG8_SB(0, 0), b2, voffB);
            PG8_BAR; PG8_WAIT_L(0); PG8_MMA(0, 1, At, B1); PG8_BAR;
            PG8_LDA(At, 0, 1); PG8_STAGE(PG8_SA(0, 0), a2, voffA);
            PG8_BAR; PG8_WAIT_L(0); PG8_MMA(1, 0, At, B0); PG8_BAR; PG8_SCHED;
            PG8_STAGE(PG8_SB(0, 1), b2 + hstep, voffB);
            PG8_WAIT_V(6); PG8_BAR; PG8_MMA(1, 1, At, B1); PG8_BAR;
            PG8_LDB(B0, 1, 0); PG8_SCHED; PG8_LDA(At, 1, 0); PG8_STAGE(PG8_SA(0, 1), a2 + hstep, voffA);
            PG8_WAIT_L(8); PG8_BAR; PG8_WAIT_L(0); PG8_MMA(0, 0, At, B0); PG8_BAR; PG8_SCHED;
            PG8_LDB(B1, 1, 1); PG8_STAGE(PG8_SB(1, 0), b3, voffB);
            PG8_BAR; PG8_WAIT_L(0); PG8_MMA(0, 1, At, B1); PG8_BAR;
            PG8_LDA(At, 1, 1); PG8_STAGE(PG8_SA(1, 0), a3, voffA);
            PG8_BAR; PG8_WAIT_L(0); PG8_MMA(1, 0, At, B0); PG8_BAR; PG8_SCHED;
            PG8_STAGE(PG8_SB(1, 1), b3 + hstep, voffB);
            PG8_WAIT_V(6); PG8_BAR; PG8_MMA(1, 1, At, B1); PG8_BAR;
        }
        PG8_STAMP();
        if constexpr (!Epi::AFTER_DRAIN) { E(acc, cur, wr, wc, fr, fq); S.done(cur); }
        PG8_STAMP();
        if (!has_next) break;
#pragma unroll
        for (int a = 0; a < 2; ++a)
#pragma unroll
            for (int b = 0; b < 2; ++b)
#pragma unroll
                for (int m = 0; m < 4; ++m)
#pragma unroll
                    for (int n = 0; n < 2; ++n) acc[a][b][m][n] = (f32x4){0.f, 0.f, 0.f, 0.f};
        cur = nxt; cA = nA; cB = nB; ++ui;
    }
    PG8_WAIT_V(0);
    if (wr == 0) PG8_BAR;
    PG8_BAR;
    if constexpr (Epi::AFTER_DRAIN) { E.fused(acc, cur, wr, wc, fr, fq, lds, wid, lane); S.done(cur); }
    PG8_STAMP();
    if (STAMP && wid == 0) { stamps[lane] = lane < nts ? (((unsigned long long)(unsigned)ts_hi << 32) | (unsigned)ts_lo) : 0ull;
        if (lane == 62) stamps[62] = rt_entry; if (lane == 63) stamps[63] = (unsigned long long)wall_clock64(); }
#undef PG8_STAMP
#undef PG8_SA
#undef PG8_SB
#undef PG8_STAGE
#undef PG8_LDA
#undef PG8_LDB
#undef PG8_MMA
#undef PG8_WAIT_V
#undef PG8_WAIT_L
#undef PG8_BAR
#undef PG8_SCHED
}
}


using pg8::bf16_t; using pg8::bf16x8; using pg8::f32x4; using pg8::u32x4;
typedef unsigned u32x2 __attribute__((ext_vector_type(2)));
typedef float f32x2v __attribute__((ext_vector_type(2)));
#define MFMA16(a, b, c) __builtin_amdgcn_mfma_f32_16x16x32_bf16((a), (b), (c), 0, 0, 0)

constexpr int MP = 65536, MS = 1024, MT = MP + MS, DM = 1024, DFF = 2816, NIN = 7424;
constexpr float EPS = 1e-6f;
constexpr size_t UB = (size_t)MT * 1024 * 2;
constexpr size_t WS_WIN = 0, WS_WBRA = WS_WIN + (size_t)NIN * 1024 * 2, WS_WBRB = WS_WBRA + 2097152, WS_WOUT = WS_WBRB + 2097152, WS_WPG = WS_WOUT + 2097152,
                 WS_WUP = WS_WPG + 2097152, WS_WDOWN = WS_WUP + (size_t)2 * DFF * 1024 * 2, WS_WPLE = WS_WDOWN + (size_t)1024 * DFF * 2, WS_KV = WS_WPLE + (size_t)1024 * 256 * 2,
                 WS_R0 = WS_KV + (size_t)MT * 256 * 2, WS_END = WS_R0 + 7 * UB;
constexpr size_t A_BYTES = (size_t)MT * DFF * 2;
constexpr size_t O_Y = 0, O_PWK = (size_t)MT * 1024, O_PWV = O_PWK + 524288, O_PST = O_PWV + 524288, O_PFC = O_PST + 4194304, O_SWK = O_PFC + 180224, O_SWV = O_SWK + 131072,
                 O_SST = O_SWV + 131072, O_SFC = O_SST + 4194304, O_END = O_SFC + 180224;
constexpr size_t WS_RS0 = WS_END + 65536;
constexpr int LDS_BYTES = 147456;

struct Prm { const float* in[26]; float* out; unsigned char* ws; };
enum { I_XP = 0, I_XS, I_CK, I_CV, I_ST, I_CC, I_PP, I_PS, I_RB, I_LB, I_GPM, I_WIN, I_SINK, I_GH, I_WBRA, I_WBRB, I_WOUT, I_GPOST, I_GPF, I_WUP, I_WCONV, I_BCONV, I_WDOWN, I_GPFF, I_WPLE, I_WPG };

__device__ __forceinline__ unsigned pk2(float lo, float hi) { unsigned r; asm("v_cvt_pk_bf16_f32 %0, %1, %2" : "=v"(r) : "v"(lo), "v"(hi)); return r; }
__device__ __forceinline__ float bflo(unsigned w) { return __uint_as_float(w << 16); }
__device__ __forceinline__ float bfhi(unsigned w) { return __uint_as_float(w & 0xffff0000u); }
__device__ __forceinline__ float bf1(bf16_t b) { return __uint_as_float(((unsigned)b) << 16); }
__device__ __forceinline__ bf16_t f2bf(float f) { return (bf16_t)(pk2(f, 0.f) & 0xffffu); }
__device__ __forceinline__ float sigm(float x) { return __builtin_amdgcn_rcpf(1.0f + __expf(-x)); }
__device__ __forceinline__ float wsum(float v) { v += __shfl_xor(v, 32); v += __shfl_xor(v, 16); v += __shfl_xor(v, 8); v += __shfl_xor(v, 4); v += __shfl_xor(v, 2); v += __shfl_xor(v, 1); return v; }
__device__ __forceinline__ u32x4 pk8(f32x4 a, f32x4 b) { u32x4 w; w.x = pk2(a[0], a[1]); w.y = pk2(a[2], a[3]); w.z = pk2(b[0], b[1]); w.w = pk2(b[2], b[3]); return w; }
__device__ __forceinline__ u32x2 pk4(f32x4 a) { u32x2 w; w.x = pk2(a[0], a[1]); w.y = pk2(a[2], a[3]); return w; }
__device__ __forceinline__ void unpk8(u32x4 w, float (&f)[8]) { f[0] = bflo(w.x); f[1] = bfhi(w.x); f[2] = bflo(w.y); f[3] = bfhi(w.y); f[4] = bflo(w.z); f[5] = bfhi(w.z); f[6] = bflo(w.w); f[7] = bfhi(w.w); }

struct NoPre {};
template <class F> struct EpiT {
    static constexpr bool PERM = true, AFTER_DRAIN = false; F f;
    __device__ __forceinline__ void operator()(const f32x4 (&acc)[2][2][4][2], const pg8::Unit& u, int wr, int wc, int fr, int fq) const {
        const int row0 = u.pm * 256 + wr * 64 + fr, col0 = u.pn * 256 + wc * 32 + 8 * fq;
        constexpr int MB = F::MB;
#pragma unroll
        for (int a0 = 0; a0 < 8; a0 += MB) {
            typename F::Pre pre[MB][2];
#pragma unroll
            for (int mm = 0; mm < MB; ++mm)
#pragma unroll
                for (int bj = 0; bj < 2; ++bj) pre[mm][bj] = f.load(row0 + ((a0 + mm) >> 2) * 128 + ((a0 + mm) & 3) * 16, col0 + bj * 128);
#pragma unroll
            for (int mm = 0; mm < MB; ++mm)
#pragma unroll
                for (int bj = 0; bj < 2; ++bj) f(row0 + ((a0 + mm) >> 2) * 128 + ((a0 + mm) & 3) * 16, col0 + bj * 128, u.pn, acc[(a0 + mm) >> 2][bj][(a0 + mm) & 3][0], acc[(a0 + mm) >> 2][bj][(a0 + mm) & 3][1], pre[mm][bj]);
        }
    }
};
struct F1 {
    bf16_t* r0; bf16_t* kv; float* out; typedef NoPre Pre; static constexpr int MB = 1;
    __device__ __forceinline__ NoPre load(int, int) const { return NoPre(); }
    __device__ __forceinline__ void operator()(int row, int col, int pn, f32x4 v0, f32x4 v1, NoPre) const {
        const u32x4 w = pk8(v0, v1);
        if (pn < 4) { __builtin_nontemporal_store(w, (u32x4*)(r0 + (size_t)row * 1024 + col)); }
        else if (pn == 4) {
            const int c = col - 1024; *(u32x4*)(kv + (size_t)row * 256 + c) = w;
            float* o = nullptr;
            if (row >= MP) { o = out + (c < 128 ? O_SWK : O_SWV) + (size_t)(row - MP) * 128 + (c & 127); }
            else { const int t = row & 2047; if (t >= 1920) o = out + (c < 128 ? O_PWK : O_PWV) + (size_t)((row >> 11) * 128 + t - 1920) * 128 + (c & 127); }
            if (o) { *(f32x4*)o = v0; *(f32x4*)(o + 4) = v1; }
        } else { const int c2 = col - 1280, seg = c2 >> 10; __builtin_nontemporal_store(w, (u32x4*)(r0 + (size_t)(1 + seg) * (UB / 2) + (size_t)row * 1024 + (c2 & 1023))); }
    }
};
struct F2 {
    const bf16_t* g; bf16_t* o; typedef u32x4 Pre; static constexpr int MB = 8;
    __device__ __forceinline__ u32x4 load(int row, int col) const { return *(const u32x4*)(g + (size_t)row * 1024 + col); }
    __device__ __forceinline__ void operator()(int row, int col, int, f32x4 v0, f32x4 v1, u32x4 gw) const {
        const size_t i = (size_t)row * 1024 + col; float gf[8]; unpk8(gw, gf);
        f32x4 a, b;
#pragma unroll
        for (int j = 0; j < 4; ++j) { a[j] = v0[j] * sigm(gf[j]); b[j] = v1[j] * sigm(gf[4 + j]); }
        *(u32x4*)(o + i) = pk8(a, b);
    }
};
struct F3 {
    const bf16_t* g; const bf16_t* t; bf16_t* o; struct Pre { u32x4 g, t; }; static constexpr int MB = 4;
    __device__ __forceinline__ Pre load(int row, int col) const { const size_t i = (size_t)row * 1024 + col; Pre r; r.g = *(const u32x4*)(g + i); r.t = *(const u32x4*)(t + i); return r; }
    __device__ __forceinline__ void operator()(int row, int col, int, f32x4 v0, f32x4 v1, Pre pr) const {
        const size_t i = (size_t)row * 1024 + col; float gf[8], tf[8]; unpk8(pr.g, gf); unpk8(pr.t, tf);
        f32x4 a, b;
#pragma unroll
        for (int j = 0; j < 4; ++j) { a[j] = tf[j] + v0[j] * sigm(gf[j]); b[j] = tf[4 + j] + v1[j] * sigm(gf[4 + j]); }
        *(u32x4*)(o + i) = pk8(a, b);
    }
};
struct FF32 {
    float* o; typedef NoPre Pre; static constexpr int MB = 1;
    __device__ __forceinline__ NoPre load(int, int) const { return NoPre(); }
    __device__ __forceinline__ void operator()(int row, int col, int, f32x4 v0, f32x4 v1, NoPre) const { float* d = o + (size_t)row * 1024 + col; *(f32x4*)d = v0; *(f32x4*)(d + 4) = v1; }
};
struct FBF {
    bf16_t* o; typedef NoPre Pre; static constexpr int MB = 1;
    __device__ __forceinline__ NoPre load(int, int) const { return NoPre(); }
    __device__ __forceinline__ void operator()(int row, int col, int, f32x4 v0, f32x4 v1, NoPre) const { *(u32x4*)(o + (size_t)row * 1024 + col) = pk8(v0, v1); }
};
struct EpiUp {
    static constexpr bool PERM = true, AFTER_DRAIN = false;
    bf16_t* g; bf16_t* araw; float* out; const float* wcv; const float* bcv;
    __device__ __forceinline__ void operator()(const f32x4 (&acc)[2][2][4][2], const pg8::Unit& u, int wr, int wc, int fr, int fq) const {
        const int c0 = u.pn * 128 + wc * 32 + 8 * fq;
        float w0[8], w1[8], w2[8], bb[8];
        { const f32x4 t0 = *(const f32x4*)(wcv + c0), t1 = *(const f32x4*)(wcv + c0 + 4), t2 = *(const f32x4*)(wcv + DFF + c0), t3 = *(const f32x4*)(wcv + DFF + c0 + 4),
                      t4 = *(const f32x4*)(wcv + 2 * DFF + c0), t5 = *(const f32x4*)(wcv + 2 * DFF + c0 + 4), t6 = *(const f32x4*)(bcv + c0), t7 = *(const f32x4*)(bcv + c0 + 4);
#pragma unroll
          for (int j = 0; j < 4; ++j) { w0[j] = t0[j]; w0[4 + j] = t1[j]; w1[j] = t2[j]; w1[4 + j] = t3[j]; w2[j] = t4[j]; w2[4 + j] = t5[j]; bb[j] = t6[j]; bb[4 + j] = t7[j]; } }
#pragma unroll
        for (int ai = 0; ai < 2; ++ai) {
            float p1[8], p2[8];
#pragma unroll
            for (int j = 0; j < 8; ++j) { p1[j] = 0.f; p2[j] = 0.f; }
#pragma unroll
            for (int m = 0; m < 4; ++m) {
                const int row = u.pm * 256 + ai * 128 + wr * 64 + m * 16 + fr;
                float a[8], uu[8], r1[8], r2[8], gq[8];
#pragma unroll
                for (int j = 0; j < 4; ++j) { a[j] = acc[ai][0][m][0][j]; a[4 + j] = acc[ai][0][m][1][j]; uu[j] = acc[ai][1][m][0][j]; uu[4 + j] = acc[ai][1][m][1][j]; }
#pragma unroll
                for (int j = 0; j < 8; ++j) { r1[j] = __int_as_float(__builtin_amdgcn_mov_dpp(__float_as_int(a[j]), 0x121, 0xf, 0xf, false)); r2[j] = __int_as_float(__builtin_amdgcn_mov_dpp(__float_as_int(a[j]), 0x122, 0xf, 0xf, false)); }
                const bool sample = row >= MP;
                const bool boundary = (m == 0 && fr < 2) || (sample && ((m & 1) == 0) && fr < 2);
                const bool keep_a = boundary || (m == 3 && fr >= 14);
#pragma unroll
                for (int j = 0; j < 8; ++j) {
                    const float am1 = fr >= 1 ? r1[j] : p1[j], am2 = fr >= 2 ? r2[j] : p2[j];
                    const float ac = bb[j] + w0[j] * am2 + w1[j] * am1 + w2[j] * a[j];
                    const float y = 1.5957691216f * (ac + 0.044715f * ac * ac * ac);
                    gq[j] = boundary ? uu[j] : ac * sigm(y) * uu[j];
                    p1[j] = r1[j]; p2[j] = r2[j];
                }
                u32x4 wv; wv.x = pk2(gq[0], gq[1]); wv.y = pk2(gq[2], gq[3]); wv.z = pk2(gq[4], gq[5]); wv.w = pk2(gq[6], gq[7]);
                __builtin_nontemporal_store(wv, (u32x4*)(g + (size_t)row * DFF + c0));
                if (keep_a) { u32x4 av; av.x = pk2(a[0], a[1]); av.y = pk2(a[2], a[3]); av.z = pk2(a[4], a[5]); av.w = pk2(a[6], a[7]); *(u32x4*)(araw + (size_t)row * DFF + c0) = av; }
                float* o = nullptr;
                if (sample) { const int rs = row - MP, t = rs & 31; if (t >= 30) o = out + O_SFC + (size_t)((rs >> 5) * 2 + t - 30) * DFF + c0; }
                else { const int t = row & 2047; if (t >= 2046) o = out + O_PFC + (size_t)((row >> 11) * 2 + t - 2046) * DFF + c0; }
                if (o) { *(f32x4*)o = acc[ai][0][m][0]; *(f32x4*)(o + 4) = acc[ai][0][m][1]; }
            }
        }
    }
};
struct F9 {
    const bf16_t* pe; const bf16_t* xb; float* y; struct Pre { u32x4 p, x; }; static constexpr int MB = 4;
    __device__ __forceinline__ Pre load(int row, int col) const { const size_t i = (size_t)row * 1024 + col; Pre r; r.p = *(const u32x4*)(pe + i); r.x = *(const u32x4*)(xb + i); return r; }
    __device__ __forceinline__ void operator()(int row, int col, int, f32x4 v0, f32x4 v1, Pre pr) const {
        const size_t i = (size_t)row * 1024 + col; float pf[8], xf[8]; unpk8(pr.p, pf); unpk8(pr.x, xf);
        f32x4 a, b;
#pragma unroll
        for (int j = 0; j < 4; ++j) { a[j] = xf[j] + pf[j] * sigm(v0[j]); b[j] = xf[4 + j] + pf[4 + j] * sigm(v1[j]); }
        *(f32x4*)(y + i) = a; *(f32x4*)(y + i + 4) = b;
    }
};
template <class E> __device__ __forceinline__ void run_gemm_epi(unsigned char* lds, const bf16_t* A, const bf16_t* Bt, int N, int K, const E& e) {
    asm volatile("" : "+s"(K)); asm volatile("" : "+s"(N));
    pg8::Gemm g; g.A = A; g.Bt = Bt; g.M = MT; g.N = N; g.K = K;
    pg8::StaticOrder S; S.init(MT, N, (int)gridDim.x, (int)blockIdx.x);
    pg8::gemm_phase<E, pg8::StaticOrder, false>((PG8_LAS unsigned char*)lds, g, S, e, nullptr);
    __syncthreads();
}
struct PairOrder {
    pg8::StaticOrder S; size_t astep, bstep;
    __device__ __forceinline__ bool next(int i, pg8::Unit& u) const { if (!S.next(i >> 1, u)) return false; const int w = i & 1; u.which = w; u.aoff = w ? astep : 0; u.boff = w ? bstep : 0; return true; }
    __device__ __forceinline__ void a_ready(const pg8::Unit&) const {}
    __device__ __forceinline__ void done(const pg8::Unit&) const {}
};
struct Epi34 {
    static constexpr bool PERM = true, AFTER_DRAIN = false; EpiT<F2> e2; EpiT<F3> e3;
    __device__ __forceinline__ void operator()(const f32x4 (&acc)[2][2][4][2], const pg8::Unit& u, int wr, int wc, int fr, int fq) const { if (u.which == 0) e2(acc, u, wr, wc, fr, fq); else e3(acc, u, wr, wc, fr, fq); }
};
template <class F> __device__ __forceinline__ void run_gemm(unsigned char* lds, const bf16_t* A, const bf16_t* Bt, int N, int K, const F& f, int skip = 0) {
    asm volatile("" : "+s"(K)); asm volatile("" : "+s"(N));
    pg8::Gemm g; g.A = A; g.Bt = Bt; g.M = MT; g.N = N; g.K = K;
    pg8::StaticOrder S; S.init(MT, N, (int)gridDim.x - skip, (int)blockIdx.x - skip);
    EpiT<F> E; E.f = f;
    pg8::gemm_phase<EpiT<F>, pg8::StaticOrder, false>((PG8_LAS unsigned char*)lds, g, S, E, nullptr);
    __syncthreads();
}

template <bool ILV = false> __device__ __forceinline__ void transpose_w(const float* W, bf16_t* Bt, int K, int N, const float* gain, float* tile, int& toff, int cid, int G) {
    const int nnt = N / 64, ntiles = (K / 64) * nnt, tid = threadIdx.x;
    const int first = (cid - (toff % G) + G) % G;
    const int r0 = tid >> 6, c = tid & 63;
    float v[8];
#define TR_LOAD(t_) do { const int kt_ = (t_) / nnt, d0_ = ((t_) % nnt) * 64; \
        const int sc0_ = ILV ? (((d0_ & 255) < 128) ? (d0_ >> 8) * 128 + (d0_ & 127) : DFF + (d0_ >> 8) * 128 + (d0_ & 127)) : d0_; \
        _Pragma("unroll") for (int i = 0; i < 8; ++i) { const int r = r0 + 8 * i; float x = W[(size_t)(kt_ * 64 + r) * N + sc0_ + c]; if (gain) x *= gain[kt_ * 64 + r]; v[i] = x; } } while (0)
    if (first < ntiles) TR_LOAD(first);
    for (int t = first; t < ntiles; t += G) {
        const int kt = t / nnt, nt = t % nnt;
#pragma unroll
        for (int i = 0; i < 8; ++i) tile[(r0 + 8 * i) * 65 + c] = v[i];
        __syncthreads();
        if (t + G < ntiles) TR_LOAD(t + G);
        { const int n = tid >> 3, k8 = (tid & 7) * 8; u32x4 wv;
          wv.x = pk2(tile[(k8 + 0) * 65 + n], tile[(k8 + 1) * 65 + n]); wv.y = pk2(tile[(k8 + 2) * 65 + n], tile[(k8 + 3) * 65 + n]);
          wv.z = pk2(tile[(k8 + 4) * 65 + n], tile[(k8 + 5) * 65 + n]); wv.w = pk2(tile[(k8 + 6) * 65 + n], tile[(k8 + 7) * 65 + n]);
          *(u32x4*)(Bt + (size_t)(nt * 64 + n) * K + kt * 64 + k8) = wv; }
        __syncthreads();
    }
#undef TR_LOAD
    toff += ntiles;
}
__device__ __forceinline__ const float* xrow(const Prm& p, int row) { return row < MP ? p.in[I_XP] + (size_t)row * 1024 : p.in[I_XS] + (size_t)(row - MP) * 1024; }

__device__ __forceinline__ void late_weights(const Prm& p, unsigned char* lds) {
    if (blockIdx.x < 16) return;
    float* tile = (float*)lds; int toff = 0; unsigned char* ws = p.ws; const int cid = blockIdx.x - 16, G = gridDim.x - 16;
    transpose_w<true>(p.in[I_WUP], (bf16_t*)(ws + WS_WUP), 1024, 2 * DFF, p.in[I_GPF], tile, toff, cid, G);
    transpose_w(p.in[I_WDOWN], (bf16_t*)(ws + WS_WDOWN), DFF, 1024, nullptr, tile, toff, cid, G);
    transpose_w(p.in[I_WPG], (bf16_t*)(ws + WS_WPG), 1024, 1024, nullptr, tile, toff, cid, G);
    transpose_w(p.in[I_WPLE], (bf16_t*)(ws + WS_WPLE), 256, 1024, nullptr, tile, toff, cid, G);
}
__device__ __forceinline__ void phase0(const Prm& p, unsigned char* lds) {
    float* tile = (float*)lds; int toff = 0; unsigned char* ws = p.ws; const int cid = blockIdx.x, G = gridDim.x;
    transpose_w(p.in[I_WIN], (bf16_t*)(ws + WS_WIN), 1024, NIN, p.in[I_GPM], tile, toff, cid, G);
    transpose_w(p.in[I_WBRA], (bf16_t*)(ws + WS_WBRA), 1024, 1024, nullptr, tile, toff, cid, G);
    transpose_w(p.in[I_WBRB], (bf16_t*)(ws + WS_WBRB), 1024, 1024, nullptr, tile, toff, cid, G);
    transpose_w(p.in[I_WOUT], (bf16_t*)(ws + WS_WOUT), 1024, 1024, nullptr, tile, toff, cid, G);
    bf16_t* xn = (bf16_t*)p.out;
    const int lane = threadIdx.x & 63, gw = blockIdx.x * 8 + (threadIdx.x >> 6), nw = gridDim.x * 8;
    for (int row = gw; row < MT; row += nw) {
        const float* xr = xrow(p, row); f32x4 v[4]; float ss = 0.f;
#pragma unroll
        for (int i = 0; i < 4; ++i) { v[i] = *(const f32x4*)(xr + i * 256 + lane * 4); ss += v[i][0] * v[i][0] + v[i][1] * v[i][1] + v[i][2] * v[i][2] + v[i][3] * v[i][3]; }
        ss = wsum(ss); const float ms = ss * (1.0f / 1024.0f) + EPS, rs = rsqrtf(ms);
        if (lane == 0) ((float*)(p.ws + WS_RS0))[row] = ms * rs;
#pragma unroll
        for (int i = 0; i < 4; ++i) *(u32x2*)(xn + (size_t)row * 1024 + i * 256 + lane * 4) = pk4(v[i] * rs);
    }
}

constexpr int AT_KS = 0, AT_VT = 27648, AT_BT = 53248;
__device__ __forceinline__ void attn_bias_table(const Prm& p, unsigned char* lds) {
    float* bT = (float*)(lds + AT_BT); const float* tab = p.in[I_RB];
    for (int i = threadIdx.x; i < 16 * 256; i += 512) {
        const int head = i >> 8, idx = i & 255, rel = idx - 191, n = rel < 0 ? -rel : rel;
        int bk = n < 8 ? n : min(15, 33 - __clz(n * n)); if (rel > 0) bk += 16;
        bT[i] = idx < 255 ? tab[bk * 16 + head] : 0.f;
    }
}
template <int NKT, int NQT, bool SAMPLE>
__device__ __forceinline__ void attn_item(const Prm& p, unsigned char* lds, int b, int c, int kvh, bf16_t* YA) {
    bf16_t* Ks = (bf16_t*)(lds + AT_KS); bf16_t* Vt = (bf16_t*)(lds + AT_VT); const float* bT = (const float*)(lds + AT_BT);
    const bf16_t* kv = (const bf16_t*)(p.ws + WS_KV); bf16_t* R0 = (bf16_t*)(p.ws + WS_R0);
    const int tid = threadIdx.x, lane = tid & 63, w = tid >> 6, lr = lane & 15, lq = lane >> 4;
    const int head = kvh * 8 + w; const int qrow0 = SAMPLE ? MP + b * 32 : b * 2048 + c * 64;
    const size_t qoff0 = (size_t)(qrow0 + lr) * 1024 + head * 64 + lq * 8;
    bf16x8 qn0 = *(const bf16x8*)(R0 + qoff0), qn1 = *(const bf16x8*)(R0 + qoff0 + 32);
    __syncthreads();
    if (!SAMPLE) {
        const int tok0 = b * 2048 + (c - 2) * 64;
        for (int id = tid; id < 192 * 8; id += 512) {
            const int key = id >> 3, dc = id & 7; u32x4 v = {0u, 0u, 0u, 0u};
            if (c * 64 - 128 + key >= 0) v = *(const u32x4*)(kv + (size_t)(tok0 + key) * 256 + kvh * 64 + dc * 8);
            *(u32x4*)(Ks + key * 72 + dc * 8) = v;
        }
        for (int id = tid; id < 192 * 8; id += 512) {
            const int key = id % 192, dc = id / 192; u32x4 v = {0u, 0u, 0u, 0u};
            if (c * 64 - 128 + key >= 0) v = *(const u32x4*)(kv + (size_t)(tok0 + key) * 256 + 128 + kvh * 64 + dc * 8);
            bf16_t* d = Vt + (dc * 8) * 200 + key;
            d[0] = (bf16_t)(v.x & 0xffffu); d[200] = (bf16_t)(v.x >> 16); d[400] = (bf16_t)(v.y & 0xffffu); d[600] = (bf16_t)(v.y >> 16);
            d[800] = (bf16_t)(v.z & 0xffffu); d[1000] = (bf16_t)(v.z >> 16); d[1200] = (bf16_t)(v.w & 0xffffu); d[1400] = (bf16_t)(v.w >> 16);
        }
    } else {
        const float* ck = p.in[I_CK]; const float* cvp = p.in[I_CV];
        for (int id = tid; id < 160 * 8; id += 512) {
            const int key = id >> 3, dc = id & 7; u32x4 v;
            if (key < 128) { const float* s = ck + (size_t)(b * 128 + key) * 128 + kvh * 64 + dc * 8; v = pk8(*(const f32x4*)s, *(const f32x4*)(s + 4)); }
            else v = *(const u32x4*)(kv + (size_t)(MP + b * 32 + key - 128) * 256 + kvh * 64 + dc * 8);
            *(u32x4*)(Ks + key * 72 + dc * 8) = v;
        }
        for (int id = tid; id < 160 * 8; id += 512) {
            const int key = id % 160, dc = id / 160; u32x4 v;
            if (key < 128) { const float* s = cvp + (size_t)(b * 128 + key) * 128 + kvh * 64 + dc * 8; v = pk8(*(const f32x4*)s, *(const f32x4*)(s + 4)); }
            else v = *(const u32x4*)(kv + (size_t)(MP + b * 32 + key - 128) * 256 + 128 + kvh * 64 + dc * 8);
            bf16_t* d = Vt + (dc * 8) * 200 + key;
            d[0] = (bf16_t)(v.x & 0xffffu); d[200] = (bf16_t)(v.x >> 16); d[400] = (bf16_t)(v.y & 0xffffu); d[600] = (bf16_t)(v.y >> 16);
            d[800] = (bf16_t)(v.z & 0xffffu); d[1000] = (bf16_t)(v.z >> 16); d[1200] = (bf16_t)(v.w & 0xffffu); d[1400] = (bf16_t)(v.w >> 16);
        }
    }
    __syncthreads();
    const float sink = p.in[I_SINK][head];
    const float* bTh = bT + head * 256;
#pragma unroll 1
    for (int qi = 0; qi < NQT; ++qi) {
        const int q = qi * 16 + lr;
        const bf16x8 qf0 = qn0, qf1 = qn1;
        if (qi + 1 < NQT) { qn0 = *(const bf16x8*)(R0 + qoff0 + (size_t)(qi + 1) * 16384); qn1 = *(const bf16x8*)(R0 + qoff0 + (size_t)(qi + 1) * 16384 + 32); }
        f32x4 s[NKT];
#pragma unroll
        for (int kt = 0; kt < NKT; ++kt) {
            const bf16_t* kp = Ks + (kt * 16 + lr) * 72 + lq * 8;
            const bf16x8 k0 = *(const bf16x8*)kp, k1 = *(const bf16x8*)(kp + 32);
            f32x4 a = {0.f, 0.f, 0.f, 0.f}; a = MFMA16(k0, qf0, a); a = MFMA16(k1, qf1, a); s[kt] = a;
        }
        float mx = sink;
#pragma unroll
        for (int kt = 0; kt < NKT; ++kt)
#pragma unroll
            for (int r = 0; r < 4; ++r) {
                const int key = kt * 16 + lq * 4 + r; float v = s[kt][r] * 0.125f + bTh[key - q + 63];
                if (!SAMPLE && (c * 64 - 128 + key < 0)) v = -1e30f;
                s[kt][r] = v; mx = fmaxf(mx, v);
            }
        mx = fmaxf(mx, __shfl_xor(mx, 16)); mx = fmaxf(mx, __shfl_xor(mx, 32));
        float sum = 0.f;
#pragma unroll
        for (int kt = 0; kt < NKT; ++kt)
#pragma unroll
            for (int r = 0; r < 4; ++r) { const float e = __expf(s[kt][r] - mx); s[kt][r] = e; sum += e; }
        sum += __shfl_xor(sum, 16); sum += __shfl_xor(sum, 32);
        const float inv = 1.0f / (sum + __expf(sink - mx));
        f32x4 o[4];
#pragma unroll
        for (int dt = 0; dt < 4; ++dt) o[dt] = (f32x4){0.f, 0.f, 0.f, 0.f};
#pragma unroll
        for (int ks = 0; ks < NKT / 2; ++ks) {
            const u32x4 pw = pk8(s[2 * ks], s[2 * ks + 1]); const bf16x8 pf = __builtin_bit_cast(bf16x8, pw);
#pragma unroll
            for (int dt = 0; dt < 4; ++dt) {
                const bf16_t* vp = Vt + (dt * 16 + lr) * 200 + ks * 32 + lq * 4;
                const u32x2 lo = *(const u32x2*)vp, hi = *(const u32x2*)(vp + 16);
                const u32x4 vw = {lo.x, lo.y, hi.x, hi.y};
                o[dt] = MFMA16(__builtin_bit_cast(bf16x8, vw), pf, o[dt]);
            }
        }
#pragma unroll
        for (int dt = 0; dt < 4; ++dt) *(u32x2*)(YA + (size_t)(qrow0 + q) * 1024 + head * 64 + dt * 16 + lq * 4) = pk4(o[dt] * inv);
    }
}

template <int L, bool SAMPLE>
__device__ __forceinline__ void hgrn_seq(const Prm& p, unsigned char* lds, int b, int h, bf16_t* YB) {
    constexpr int RPG = L / 8, NT = L / 16, NCH = SAMPLE ? 1 : 32, NP = 8 / NT;
    bf16_t* Qd = (bf16_t*)lds; bf16_t* Qm = Qd + 64 * 136; bf16_t* Km = Qm + 64 * 136; bf16_t* KlT = Km + 64 * 136; bf16_t* Vt = KlT + 128 * 72; bf16_t* St = Vt + 128 * 72; bf16_t* Al = St + 128 * 136;
    float* tot = (float*)(Al + 64 * 72); float* first = tot + 1024; float* decay = first + 1024; float* ssq = decay + 128;
    const bf16_t* R1 = (const bf16_t*)(p.ws + WS_R0 + UB); const bf16_t* R2 = (const bf16_t*)(p.ws + WS_R0 + 2 * UB); const bf16_t* R3 = (const bf16_t*)(p.ws + WS_R0 + 3 * UB); const bf16_t* R4 = (const bf16_t*)(p.ws + WS_R0 + 4 * UB);
    const int tid = threadIdx.x, lane = tid & 63, w = tid >> 6, lr = lane & 15, lq = lane >> 4, cp = lane, rg = w, c0 = 2 * cp;
    float lb[2];
#pragma unroll
    for (int c = 0; c < 2; ++c) { const float l0 = p.in[I_LB][h * 128 + c0 + c], l1 = p.in[I_LB][1024 + h * 128 + c0 + c]; lb[c] = 1.0f / (1.0f + __expf(l1 - l0)); }
    f32x4 S[8];
#pragma unroll
    for (int dvt = 0; dvt < 8; ++dvt) {
        if (SAMPLE) {
#pragma unroll
            for (int r = 0; r < 4; ++r) S[dvt][r] = p.in[I_ST][((size_t)(b * 8 + h) * 128 + 16 * w + 4 * lq + r) * 128 + 16 * dvt + lr];
        } else S[dvt] = (f32x4){0.f, 0.f, 0.f, 0.f};
    }
    const int tt = w % NT, dv0 = (w / NT) * NT;
    const int rowbase = SAMPLE ? MP + b * 32 : b * 2048;
    f32x4 ggv[NT];
#pragma unroll
    for (int i = 0; i < NT; ++i) ggv[i] = *(const f32x4*)(p.in[I_GH] + 16 * (dv0 + i) + 4 * lq);
    unsigned qw[RPG], fw[RPG], vw[RPG];
#pragma unroll
    for (int i = 0; i < RPG; ++i) { const size_t idx = (size_t)(rowbase + rg * RPG + i) * 1024 + h * 128 + c0; qw[i] = *(const unsigned*)(R1 + idx); fw[i] = *(const unsigned*)(R2 + idx); vw[i] = *(const unsigned*)(R3 + idx); }
#pragma unroll 1
    for (int ch = 0; ch < NCH; ++ch) {
        const int row0 = rowbase + ch * L;
        float qv[2][RPG], cv[2][RPG], kk[2][RPG]; unsigned vkeep[RPG]; float run[2] = {1.f, 1.f}, lf0[2] = {0.f, 0.f};
#pragma unroll
        for (int i = 0; i < RPG; ++i) {
            vkeep[i] = vw[i];
#pragma unroll
            for (int c = 0; c < 2; ++c) {
                const float q = c ? bfhi(qw[i]) : bflo(qw[i]), fl = c ? bfhi(fw[i]) : bflo(fw[i]);
                const float f = lb[c] + (1.0f - lb[c]) * sigm(fl);
                run[c] *= f; cv[c][i] = run[c]; kk[c][i] = 1.0f - f; qv[c][i] = q * sigm(q); if (i == 0) lf0[c] = __logf(f);
            }
        }
        *(f32x2v*)(tot + rg * 128 + c0) = (f32x2v){__logf(run[0]), __logf(run[1])}; *(f32x2v*)(first + rg * 128 + c0) = (f32x2v){lf0[0], lf0[1]};
        if (ch + 1 < NCH) {
#pragma unroll
            for (int i = 0; i < RPG; ++i) { const size_t idx = (size_t)(row0 + L + rg * RPG + i) * 1024 + h * 128 + c0; qw[i] = *(const unsigned*)(R1 + idx); fw[i] = *(const unsigned*)(R2 + idx); vw[i] = *(const unsigned*)(R3 + idx); }
        }
        const size_t rbase = (size_t)(row0 + tt * 16 + lr) * 1024 + h * 128;
        u32x2 ogw[NT];
#pragma unroll
        for (int i = 0; i < NT; ++i) ogw[i] = *(const u32x2*)(R4 + rbase + 16 * (dv0 + i) + 4 * lq);
        __syncthreads();
        {
            float pre[2] = {0.f, 0.f}, bmid[2], blast[2], emid[2], elm[2], epre[2];
#pragma unroll
            for (int c = 0; c < 2; ++c) {
                float acc = 0.f, half = 0.f;
#pragma unroll
                for (int j = 0; j < 8; ++j) { const float t = tot[j * 128 + c0 + c]; if (j < rg) pre[c] += t; if (j < 4) half += t; acc += t; }
                bmid[c] = half + first[4 * 128 + c0 + c]; blast[c] = acc; emid[c] = __expf(bmid[c]); elm[c] = __expf(blast[c] - bmid[c]); epre[c] = __expf(pre[c] - bmid[c]);
            }
            float kl[2][RPG];
#pragma unroll
            for (int i = 0; i < RPG; ++i) {
                const int r = rg * RPG + i; float qd[2], qm[2], km[2];
#pragma unroll
                for (int c = 0; c < 2; ++c) {
                    const float E = epre[c] * cv[c][i], Ei = __builtin_amdgcn_rcpf(E);
                    qm[c] = qv[c][i] * E; qd[c] = qm[c] * emid[c]; km[c] = kk[c][i] * Ei; kl[c][i] = km[c] * elm[c];
                }
                *(unsigned*)(Qd + r * 136 + c0) = pk2(qd[0], qd[1]); *(unsigned*)(Qm + r * 136 + c0) = pk2(qm[0], qm[1]); *(unsigned*)(Km + r * 136 + c0) = pk2(km[0], km[1]);
            }
#pragma unroll
            for (int c = 0; c < 2; ++c) {
#pragma unroll
                for (int i = 0; i < RPG; i += 4) {
                    u32x2 a, v2; a.x = pk2(kl[c][i], kl[c][i + 1]); a.y = pk2(kl[c][i + 2], kl[c][i + 3]);
                    if (c == 0) { v2.x = (vkeep[i] & 0xffffu) | (vkeep[i + 1] << 16); v2.y = (vkeep[i + 2] & 0xffffu) | (vkeep[i + 3] << 16); }
                    else { v2.x = (vkeep[i] >> 16) | (vkeep[i + 1] & 0xffff0000u); v2.y = (vkeep[i + 2] >> 16) | (vkeep[i + 3] & 0xffff0000u); }
                    *(u32x2*)(KlT + (c0 + c) * 72 + rg * RPG + i) = a; *(u32x2*)(Vt + (c0 + c) * 72 + rg * RPG + i) = v2;
                }
            }
            if (rg == 0) *(f32x2v*)(decay + c0) = (f32x2v){__expf(blast[0]), __expf(blast[1])};
        }
#pragma unroll
        for (int dvt = 0; dvt < 8; ++dvt) *(u32x2*)(St + (16 * dvt + lr) * 136 + 16 * w + 4 * lq) = pk4(S[dvt]);
        __syncthreads();
        for (int id = w; id < NT * NT; id += 8) {
            const int st = id / NT, t2 = id % NT; f32x4 acc = {0.f, 0.f, 0.f, 0.f};
#pragma unroll
            for (int ks = 0; ks < 4; ++ks) acc = MFMA16(*(const bf16x8*)(Km + (st * 16 + lr) * 136 + ks * 32 + lq * 8), *(const bf16x8*)(Qm + (t2 * 16 + lr) * 136 + ks * 32 + lq * 8), acc);
            const int t = t2 * 16 + lr;
#pragma unroll
            for (int r = 0; r < 4; ++r) if (st * 16 + 4 * lq + r > t) acc[r] = 0.f;
            *(u32x2*)(Al + t * 72 + st * 16 + 4 * lq) = pk4(acc);
        }
        f32x4 o[NT];
#pragma unroll
        for (int i = 0; i < NT; ++i) {
            f32x4 acc = {0.f, 0.f, 0.f, 0.f};
#pragma unroll
            for (int ks = 0; ks < 4; ++ks) acc = MFMA16(*(const bf16x8*)(St + (16 * (dv0 + i) + lr) * 136 + ks * 32 + lq * 8), *(const bf16x8*)(Qd + (tt * 16 + lr) * 136 + ks * 32 + lq * 8), acc);
            o[i] = acc;
        }
        __syncthreads();
        float sq = 0.f;
#pragma unroll
        for (int i = 0; i < NT; ++i) {
#pragma unroll
            for (int ks = 0; ks < L / 32; ++ks) o[i] = MFMA16(*(const bf16x8*)(Vt + (16 * (dv0 + i) + lr) * 72 + ks * 32 + lq * 8), *(const bf16x8*)(Al + (tt * 16 + lr) * 72 + ks * 32 + lq * 8), o[i]);
            sq += o[i][0] * o[i][0] + o[i][1] * o[i][1] + o[i][2] * o[i][2] + o[i][3] * o[i][3];
        }
        sq += __shfl_xor(sq, 16); sq += __shfl_xor(sq, 32);
        if (lq == 0) ssq[(w / NT) * 64 + tt * 16 + lr] = sq;
        {
            const f32x4 dc = *(const f32x4*)(decay + 16 * w + 4 * lq);
#pragma unroll
            for (int dvt = 0; dvt < 8; ++dvt) {
                f32x4 acc = S[dvt] * dc;
#pragma unroll
                for (int ks = 0; ks < L / 32; ++ks) acc = MFMA16(*(const bf16x8*)(KlT + (16 * w + lr) * 72 + ks * 32 + lq * 8), *(const bf16x8*)(Vt + (16 * dvt + lr) * 72 + ks * 32 + lq * 8), acc);
                S[dvt] = acc;
            }
        }
        __syncthreads();
        {
            float tsq = 0.f;
#pragma unroll
            for (int j = 0; j < NP; ++j) tsq += ssq[j * 64 + tt * 16 + lr];
            const float rs = rsqrtf(tsq * (1.0f / 128.0f) + EPS);
#pragma unroll
            for (int i = 0; i < NT; ++i) {
                const int dvb = 16 * (dv0 + i) + 4 * lq;
                const f32x4 gg = ggv[i];
                const float og0 = bflo(ogw[i].x), og1 = bfhi(ogw[i].x), og2 = bflo(ogw[i].y), og3 = bfhi(ogw[i].y);
                f32x4 y; y[0] = o[i][0] * rs * gg[0] * og0 * sigm(og0); y[1] = o[i][1] * rs * gg[1] * og1 * sigm(og1); y[2] = o[i][2] * rs * gg[2] * og2 * sigm(og2); y[3] = o[i][3] * rs * gg[3] * og3 * sigm(og3);
                *(u32x2*)(YB + rbase + dvb) = pk4(y);
            }
        }
    }
    float* so = p.out + (SAMPLE ? O_SST : O_PST) + (size_t)(b * 8 + h) * 16384;
#pragma unroll
    for (int dvt = 0; dvt < 8; ++dvt)
#pragma unroll
        for (int r = 0; r < 4; ++r) so[(16 * w + 4 * lq + r) * 128 + 16 * dvt + lr] = S[dvt][r];
    __syncthreads();
}

__device__ __forceinline__ void conv_p(const Prm& p) {
    if (blockIdx.x < 16) return;
    bf16_t* pbf = (bf16_t*)(p.ws + WS_KV);
    for (int id = (blockIdx.x - 16) * 512 + threadIdx.x; id < MT * 32; id += (gridDim.x - 16) * 512) {
        const int row = id >> 5, c = (id & 31) * 8;
        const float* s = (row < MP ? p.in[I_PP] + (size_t)row * 256 : p.in[I_PS] + (size_t)(row - MP) * 256) + c;
        *(u32x4*)(pbf + (size_t)row * 256 + c) = pk8(*(const f32x4*)s, *(const f32x4*)(s + 4));
    }
}
__device__ __forceinline__ void phase_rp5(const Prm& p) {
    const bf16_t* O = (const bf16_t*)(p.ws + WS_R0 + 4 * UB); bf16_t* hf = (bf16_t*)(p.ws + WS_R0); const float* g = p.in[I_GPOST];
    const int lane = threadIdx.x & 63, gw = blockIdx.x * 8 + (threadIdx.x >> 6), nw = gridDim.x * 8;
    for (int row = gw; row < MT; row += nw) {
        const bf16_t* xr = (const bf16_t*)p.out + (size_t)row * 1024; const float xs = ((const float*)(p.ws + WS_RS0))[row]; const bf16_t* orow = O + (size_t)row * 1024; f32x4 v[4], x[4]; float ss = 0.f;
#pragma unroll
        for (int i = 0; i < 4; ++i) { { const u32x2 ow = *(const u32x2*)(orow + i * 256 + lane * 4); v[i] = (f32x4){bflo(ow.x), bfhi(ow.x), bflo(ow.y), bfhi(ow.y)}; } { const u32x2 xw = *(const u32x2*)(xr + i * 256 + lane * 4); x[i] = (f32x4){bflo(xw.x), bfhi(xw.x), bflo(xw.y), bfhi(xw.y)} * xs; } ss += v[i][0] * v[i][0] + v[i][1] * v[i][1] + v[i][2] * v[i][2] + v[i][3] * v[i][3]; }
        ss = wsum(ss); const float rs = rsqrtf(ss * (1.0f / 1024.0f) + EPS); float s2 = 0.f;
#pragma unroll
        for (int i = 0; i < 4; ++i) { const f32x4 gg = *(const f32x4*)(g + i * 256 + lane * 4); x[i] += v[i] * rs * gg; s2 += x[i][0] * x[i][0] + x[i][1] * x[i][1] + x[i][2] * x[i][2] + x[i][3] * x[i][3];
            *(u32x2*)((bf16_t*)p.out + (size_t)row * 1024 + i * 256 + lane * 4) = pk4(x[i]); }
        s2 = wsum(s2); const float r2 = rsqrtf(s2 * (1.0f / 1024.0f) + EPS);
#pragma unroll
        for (int i = 0; i < 4; ++i) *(u32x2*)(hf + (size_t)row * 1024 + i * 256 + lane * 4) = pk4(x[i] * r2);
    }
}
__device__ __forceinline__ void phase_rp8(const Prm& p) {
    const bf16_t* O = (const bf16_t*)(p.ws + WS_R0 + UB); bf16_t* xb = (bf16_t*)(p.ws + WS_R0 + 3 * UB); const float* g = p.in[I_GPFF];
    const int lane = threadIdx.x & 63, gw = blockIdx.x * 8 + (threadIdx.x >> 6), nw = gridDim.x * 8;
    for (int row = gw; row < MT; row += nw) {
        const bf16_t* xr = (const bf16_t*)p.out + (size_t)row * 1024; const bf16_t* orow = O + (size_t)row * 1024; f32x4 v[4], x[4]; float ss = 0.f;
#pragma unroll
        for (int i = 0; i < 4; ++i) { { const u32x2 ow = *(const u32x2*)(orow + i * 256 + lane * 4); v[i] = (f32x4){bflo(ow.x), bfhi(ow.x), bflo(ow.y), bfhi(ow.y)}; } { const u32x2 xw = *(const u32x2*)(xr + i * 256 + lane * 4); x[i] = (f32x4){bflo(xw.x), bfhi(xw.x), bflo(xw.y), bfhi(xw.y)}; } ss += v[i][0] * v[i][0] + v[i][1] * v[i][1] + v[i][2] * v[i][2] + v[i][3] * v[i][3]; }
        ss = wsum(ss); const float rs = rsqrtf(ss * (1.0f / 1024.0f) + EPS);
#pragma unroll
        for (int i = 0; i < 4; ++i) { const f32x4 gg = *(const f32x4*)(g + i * 256 + lane * 4); x[i] += v[i] * rs * gg;
            *(u32x2*)(xb + (size_t)row * 1024 + i * 256 + lane * 4) = pk4(x[i]); }
    }
}
__device__ __forceinline__ void phase_conv(const Prm& p) {
    const bf16_t* A = (const bf16_t*)(p.ws + WS_R0 + UB); bf16_t* Ug = (bf16_t*)(p.ws + WS_R0 + UB + A_BYTES);
    const float* wc = p.in[I_WCONV]; const float* bc = p.in[I_BCONV]; const float* cc = p.in[I_CC];
    for (int id = blockIdx.x * 512 + threadIdx.x; id < 2112 * 352; id += gridDim.x * 512) {
        const int ri = id / 352, c0 = (id % 352) * 8;
        int row; if (ri < 2048) row = (ri >> 1) * 64 + (ri & 1); else { const int j = ri - 2048; row = MP + (j >> 1) * 32 + (j & 1); }
        float am2[8], am1[8], a[8], u[8], gq[8];
#pragma unroll
        for (int j = 0; j < 8; ++j) { am2[j] = 0.f; am1[j] = 0.f; }
        if (row < MP) {
            const int t = row & 2047;
            if (t >= 1) unpk8(*(const u32x4*)(A + (size_t)(row - 1) * DFF + c0), am1);
            if (t >= 2) unpk8(*(const u32x4*)(A + (size_t)(row - 2) * DFF + c0), am2);
        } else {
            const int rs = row - MP, b = rs >> 5, t = rs & 31;
            if (t == 0) {
#pragma unroll
                for (int j = 0; j < 8; ++j) { am2[j] = cc[(size_t)(b * 2) * DFF + c0 + j]; am1[j] = cc[(size_t)(b * 2 + 1) * DFF + c0 + j]; }
            } else {
#pragma unroll
                for (int j = 0; j < 8; ++j) am2[j] = cc[(size_t)(b * 2 + 1) * DFF + c0 + j];
                unpk8(*(const u32x4*)(A + (size_t)(row - 1) * DFF + c0), am1);
            }
        }
        const size_t off = (size_t)row * DFF + c0;
        unpk8(*(const u32x4*)(A + off), a); unpk8(*(const u32x4*)(Ug + off), u);
#pragma unroll
        for (int j = 0; j < 8; ++j) {
            const float ac = bc[c0 + j] + wc[c0 + j] * am2[j] + wc[DFF + c0 + j] * am1[j] + wc[2 * DFF + c0 + j] * a[j];
            const float y = 1.5957691216f * (ac + 0.044715f * ac * ac * ac);
            gq[j] = ac * sigm(y) * u[j];
        }
        u32x4 wv; wv.x = pk2(gq[0], gq[1]); wv.y = pk2(gq[2], gq[3]); wv.z = pk2(gq[4], gq[5]); wv.w = pk2(gq[6], gq[7]);
        *(u32x4*)(Ug + off) = wv;
    }
}

#ifndef PROBE_DUP
#define PROBE_DUP 0
#endif
#ifndef P2M
#define P2M 15
#endif
#ifndef PHM
#define PHM 0xfff
#endif

#define XB_TMO      128
#define XB_XCNT(j)  (256  + 64 * (j))
#define XB_XSUB(j)  (1280 + 64 * (j))
#define XB_XGEN(j)  (2304 + 64 * (j))
#define XB_TOP      3328
#define XB_TOPGEN   3392
#define XCD_BAR_WORDS 3456
#define XB_SPIN_CAP (1u << 18)
#define LAS __attribute__((address_space(3)))

__device__ __forceinline__ unsigned xb_ld(unsigned* p)              { return __hip_atomic_load(p, __ATOMIC_RELAXED, __HIP_MEMORY_SCOPE_AGENT); }
__device__ __forceinline__ unsigned xb_add(unsigned* p, unsigned v) { return __hip_atomic_fetch_add(p, v, __ATOMIC_RELAXED, __HIP_MEMORY_SCOPE_AGENT); }
__device__ __forceinline__ unsigned xb_xcc_id() { return (unsigned)__builtin_amdgcn_s_getreg((3 << 11) | 20) & 0xFu; }
#define XB_SPIN(cond, bar) do { unsigned _sp = 0; while (cond) { __builtin_amdgcn_s_sleep(1); \
    if ((++_sp & 255u) == 0u) { if (xb_ld(&(bar)[XB_TMO])) break; if (_sp > XB_SPIN_CAP) { atomicAdd(&(bar)[XB_TMO], 1u); break; } } } } while (0)
struct XcdBarrier {
    unsigned* bar; unsigned x;
    volatile LAS unsigned* st;
};

__device__ __forceinline__ XcdBarrier xcd_barrier_post(unsigned* bar, volatile LAS unsigned* st) {
    XcdBarrier b; b.bar = bar; b.x = xb_xcc_id(); b.st = st;
    if (threadIdx.x == 0) (void)xb_add(&bar[XB_XCNT(b.x)], 1u);
    return b;
}
__device__ __forceinline__ void xcd_barrier_complete(unsigned* bar, unsigned x, unsigned& nloc, unsigned& nx) {
    const unsigned G = gridDim.x * gridDim.y * gridDim.z;
    unsigned sum, cnt, mine, sp = 0u;
    for (;;) {
        sum = 0u; cnt = 0u; mine = 0u;
#pragma unroll
        for (unsigned j = 0; j < 16; ++j) { const unsigned c = xb_ld(&bar[XB_XCNT(j)]); sum += c; cnt += (c > 0u) ? 1u : 0u; mine = (j == x) ? c : mine; }
        if (sum == G) break;
        __builtin_amdgcn_s_sleep(1);
        if ((++sp & 255u) == 0u) { if (xb_ld(&bar[XB_TMO])) break; if (sp > XB_SPIN_CAP) { atomicAdd(&bar[XB_TMO], 1u); break; } }
    }
    nloc = mine > 0u ? mine : 1u; nx = cnt > 0u ? cnt : 1u;
}

__device__ __forceinline__ void xcd_barrier(const XcdBarrier& b) {
    asm volatile("s_waitcnt vmcnt(0)" ::: "memory");
    __syncthreads();
    if (threadIdx.x == 0) {
        unsigned* bar = b.bar;
        __builtin_amdgcn_s_waitcnt(0);
        unsigned nloc = b.st[0], nx = b.st[1];
        if (nloc == 0u) { xcd_barrier_complete(bar, b.x, nloc, nx); b.st[0] = nloc; b.st[1] = nx; }
        const unsigned old = xb_add(&bar[XB_XSUB(b.x)], 1u);
        const unsigned gen = old / nloc;
        if (old + 1u == (gen + 1u) * nloc) {
            __builtin_amdgcn_fence(__ATOMIC_RELEASE, "agent");
            asm volatile("s_waitcnt vmcnt(0)" ::: "memory");
            const unsigned og = xb_add(&bar[XB_TOP], 1u);
            const unsigned tg = og / nx;
            if (og + 1u == (tg + 1u) * nx) xb_add(&bar[XB_TOPGEN], 1u);
            else XB_SPIN(xb_ld(&bar[XB_TOPGEN]) == tg, bar);
            __builtin_amdgcn_fence(__ATOMIC_ACQUIRE, "agent");
            xb_add(&bar[XB_XGEN(b.x)], 1u);
            asm volatile("s_waitcnt vmcnt(0)" ::: "memory");
        } else {
            XB_SPIN(xb_ld(&bar[XB_XGEN(b.x)]) == gen, bar);
            __builtin_amdgcn_fence(__ATOMIC_ACQUIRE, "agent");
            asm volatile("s_waitcnt vmcnt(0)" ::: "memory");
        }
    }
    __syncthreads();
}

__global__ void __launch_bounds__(512, 2) fwd_mega(Prm p, int ph_lo, int ph_hi) {
    extern __shared__ __attribute__((aligned(16))) unsigned char lds[];
    cg::grid_group grid = cg::this_grid();
    unsigned char* ws = p.ws;
    bf16_t* R0 = (bf16_t*)(ws + WS_R0);
#define REG(i) ((bf16_t*)(ws + WS_R0 + (size_t)(i) * UB))
    unsigned* barw = (unsigned*)(ws + WS_END);
    if (blockIdx.x == 0) for (int i = threadIdx.x; i < XCD_BAR_WORDS; i += 512) barw[i] = 0u;
    volatile LAS unsigned* xst = (volatile LAS unsigned*)((PG8_LAS unsigned char*)lds + (LDS_BYTES - 16));
    if (threadIdx.x < 4) xst[threadIdx.x] = 0u;
    __syncthreads();
    XcdBarrier xb; xb.bar = barw; xb.x = 0u; xb.st = xst;
    unsigned bar_k = 0;
#define GRID_SEAM() do { if (bar_k == 0) { grid.sync(); xb = xcd_barrier_post(barw, xst); } else xcd_barrier(xb); ++bar_k; } while (0)
#define PH_BEGIN(n) if (ph_lo <= (n) && (n) < ph_hi) { if ((n) > ph_lo) GRID_SEAM();
#define PH_END }
#if (PHM >> 0) & 1
        PH_BEGIN(0) phase0(p, lds);
#if PROBE_DUP == 1
        grid.sync(); phase0(p, lds);
#endif
        PH_END
#else
#endif
#if (PHM >> 1) & 1
        PH_BEGIN(1) { F1 f; f.r0 = R0; f.kv = (bf16_t*)(ws + WS_KV); f.out = p.out; run_gemm(lds, (const bf16_t*)p.out, (const bf16_t*)(ws + WS_WIN), NIN, 1024, f);
#if PROBE_DUP == 3
            grid.sync(); run_gemm(lds, (const bf16_t*)p.out, (const bf16_t*)(ws + WS_WIN), NIN, 1024, f);
#endif
        } PH_END
#else
#endif
#if (PHM >> 2) & 1
        PH_BEGIN(2) {
#if PROBE_DUP == 2
            { bf16_t* YA = (bf16_t*)p.out; bf16_t* YB = (bf16_t*)p.out + UB / 2;
            const int G = gridDim.x;
#if P2M & 1
#pragma unroll 1
            for (int s = blockIdx.x; s < 256; s += G) hgrn_seq<64, false>(p, lds, s >> 3, s & 7, YB);
#endif
#if P2M & 2
#pragma unroll 1
            for (int s = blockIdx.x; s < 256; s += G) hgrn_seq<32, true>(p, lds, s >> 3, s & 7, YB);
#endif
            __syncthreads(); attn_bias_table(p, lds); __syncthreads();
#if P2M & 4
#pragma unroll 1
            for (int it = blockIdx.x; it < 2048; it += G) attn_item<12, 4, false>(p, lds, it >> 6, (it >> 1) & 31, it & 1, YA);
#endif
#if P2M & 8
#pragma unroll 1
            for (int it = blockIdx.x; it < 64; it += G) attn_item<10, 2, true>(p, lds, it >> 1, 0, it & 1, YA);
#endif
            __syncthreads(); }
#endif
            { bf16_t* YA = REG(0); bf16_t* YB = REG(1);
            const int G = gridDim.x;
#if P2M & 1
#pragma unroll 1
            for (int s = blockIdx.x; s < 256; s += G) hgrn_seq<64, false>(p, lds, s >> 3, s & 7, YB);
#endif
#if P2M & 2
#pragma unroll 1
            for (int s = blockIdx.x; s < 256; s += G) hgrn_seq<32, true>(p, lds, s >> 3, s & 7, YB);
#endif
            __syncthreads(); attn_bias_table(p, lds); __syncthreads();
#if P2M & 4
#pragma unroll 1
            for (int it = blockIdx.x; it < 2048; it += G) attn_item<12, 4, false>(p, lds, it >> 6, (it >> 1) & 31, it & 1, YA);
#endif
#if P2M & 8
#pragma unroll 1
            for (int it = blockIdx.x; it < 64; it += G) attn_item<10, 2, true>(p, lds, it >> 1, 0, it & 1, YA);
#endif
            }
        } PH_END
#else
#endif
#if (PHM >> 3) & 1
        PH_BEGIN(3) {
            Epi34 E; E.e2.f.g = REG(5); E.e2.f.o = REG(2); E.e3.f.g = REG(6); E.e3.f.t = REG(2); E.e3.f.o = REG(3);
            int K34 = 1024, N34 = 1024; asm volatile("" : "+s"(K34)); asm volatile("" : "+s"(N34));
            pg8::Gemm g; g.A = REG(0); g.Bt = (const bf16_t*)(ws + WS_WBRA); g.M = MT; g.N = N34; g.K = K34;
            PairOrder S; S.S.init(MT, N34, (int)gridDim.x, (int)blockIdx.x); S.astep = UB; S.bstep = WS_WBRB - WS_WBRA;
            pg8::gemm_phase<Epi34, PairOrder, false>((PG8_LAS unsigned char*)lds, g, S, E, nullptr);
            __syncthreads();
            late_weights(p, lds); conv_p(p);
        } PH_END
#endif
#if (PHM >> 5) & 1
        PH_BEGIN(5) { FBF f; f.o = REG(4); run_gemm(lds, REG(3), (const bf16_t*)(ws + WS_WOUT), 1024, 1024, f);
#if PROBE_DUP == 5
            grid.sync(); run_gemm(lds, REG(3), (const bf16_t*)(ws + WS_WOUT), 1024, 1024, f);
#endif
        } PH_END
#else
#endif
#if (PHM >> 6) & 1
        PH_BEGIN(6) phase_rp5(p); PH_END
#else
#endif
#if (PHM >> 7) & 1
        PH_BEGIN(7) { EpiUp e; e.g = (bf16_t*)(ws + WS_R0 + UB + A_BYTES); e.araw = REG(1); e.out = p.out; e.wcv = p.in[I_WCONV]; e.bcv = p.in[I_BCONV]; run_gemm_epi(lds, REG(0), (const bf16_t*)(ws + WS_WUP), 2 * DFF, 1024, e); } PH_END
#else
#endif
#if (PHM >> 8) & 1
        PH_BEGIN(8) phase_conv(p); PH_END
#else
#endif
        PH_BEGIN(9) { FBF f; f.o = REG(1); run_gemm(lds, (const bf16_t*)(ws + WS_R0 + UB + A_BYTES), (const bf16_t*)(ws + WS_WDOWN), 1024, DFF, f);
                  FBF f2; f2.o = REG(0); if (blockIdx.x >= 16) run_gemm(lds, (const bf16_t*)(ws + WS_KV), (const bf16_t*)(ws + WS_WPLE), 1024, 256, f2, 16); } PH_END
#if (PHM >> 10) & 1
        PH_BEGIN(10) phase_rp8(p); PH_END
#else
#endif
#if (PHM >> 11) & 1
        PH_BEGIN(11) { F9 f; f.pe = REG(0); f.xb = REG(3); f.y = p.out; run_gemm(lds, REG(3), (const bf16_t*)(ws + WS_WPG), 1024, 1024, f); } PH_END
#else
#endif
#undef REG
}

extern "C" void kernel_launch(void* const* d_in, const int* in_sizes, int n_in, void* d_out, int out_size, void* d_ws, size_t ws_size, hipStream_t stream) {
    static int grid = 0;
    if (grid == 0) {
        if (n_in != 26 || (size_t)out_size != O_END || ws_size < WS_END) { fprintf(stderr, "kernel_launch: unexpected shapes n_in %d out %d ws %zu (need %zu)\n", n_in, out_size, ws_size, (size_t)WS_END); grid = -1; return; }
        int dev = 0, cus = 0, per_cu = 0;
        hipGetDevice(&dev); hipDeviceGetAttribute(&cus, hipDeviceAttributeMultiprocessorCount, dev);
        if (hipFuncSetAttribute((const void*)fwd_mega, hipFuncAttributeMaxDynamicSharedMemorySize, LDS_BYTES) != hipSuccess) { fprintf(stderr, "kernel_launch: hipFuncSetAttribute failed\n"); grid = -1; return; }
        if (hipOccupancyMaxActiveBlocksPerMultiprocessor(&per_cu, (const void*)fwd_mega, 512, LDS_BYTES) != hipSuccess || per_cu < 1) { fprintf(stderr, "kernel_launch: occupancy query says %d\n", per_cu); per_cu = 1; }
        (void)hipGetLastError();
        grid = cus;
    }
    if (grid < 0) return;
    Prm p{};
    for (int i = 0; i < 26; ++i) p.in[i] = (const float*)d_in[i];
    p.out = (float*)d_out; p.ws = (unsigned char*)d_ws;
    int lo = 0, hi = 12;
    void* args[] = {&p, &lo, &hi};
    hipError_t e = hipLaunchCooperativeKernel((const void*)fwd_mega, dim3(grid), dim3(512), args, LDS_BYTES, stream);
    if (e != hipSuccess) fprintf(stderr, "kernel_launch: cooperative launch failed: %s (grid %d)\n", hipGetErrorString(e), grid);
}
```

```cpp
#include <hip/hip_runtime.h>
#include <hip/hip_cooperative_groups.h>
#include <cstdio>
namespace cg = cooperative_groups;
namespace pg8 {
#define PG8_LAS __attribute__((address_space(3)))
typedef unsigned short bf16_t;
typedef short bf16x8 __attribute__((ext_vector_type(8)));
typedef float f32x4 __attribute__((ext_vector_type(4)));
typedef unsigned u32x4 __attribute__((ext_vector_type(4)));
constexpr int BM = 256, BK = 64, HALF = 128, HTB = HALF * BK * 2  , STAGE_BYTES = 8 * HTB, NXCD = 8, WGM = 8;

__host__ __device__ __forceinline__ int lds_byte(int r, int c) { const int st = (r >> 4) * 2 + (c >> 5), rr = r & 15, cc = c & 31, ob = rr * 64 + cc * 2; return st * 1024 + (ob ^ (((ob >> 9) & 1) << 5)); }
__host__ __device__ __forceinline__ void stage_rc(int b, int& R, int& C) { const int st = b / 1024, sb = b % 1024, swz = sb ^ (((sb >> 9) & 1) << 5); R = (st >> 1) * 16 + swz / 64; C = (st & 1) * 32 + (swz % 64) / 2; }
__host__ __device__ __forceinline__ int perm32(int rho) { const int n = rho >> 4, i = rho & 15; return 8 * (i >> 2) + 4 * n + (i & 3); }

struct Unit { int pm, pn, which; size_t aoff, boff; };
struct Gemm { const bf16_t* A; const bf16_t* Bt; int M, N, K; };

struct StaticOrder {
    int nM, nN, nwg, G, c;
    __host__ __device__ void init(int M, int N, int G_, int c_) { nM = M / BM; nN = N / BM; nwg = nM * nN; G = G_; c = c_; }
    __host__ __device__ bool next(int i, Unit& u) const {
        const long L = (long)i * G + c; if (L >= nwg) return false;
        int wgid = (int)L; { const int q = nwg / NXCD, r = nwg % NXCD, xcd = wgid % NXCD, off = wgid / NXCD; wgid = (xcd < r ? xcd * (q + 1) : r * (q + 1) + (xcd - r) * q) + off; }
        const int nig = WGM * nN, gid = wgid / nig, fm = gid * WGM, gsz = (nM - fm) < WGM ? (nM - fm) : WGM;
        u.pm = fm + ((wgid % nig) % gsz); u.pn = (wgid % nig) / gsz; u.which = 0; u.aoff = 0; u.boff = 0; return true;
    }
    __device__ __forceinline__ void a_ready(const Unit&) const {}
    __device__ __forceinline__ void done(const Unit&) const {}
};
__device__ __forceinline__ unsigned cvt_pk_bf16(float lo, float hi) { unsigned r; asm volatile("v_cvt_pk_bf16_f32 %0, %1, %2" : "=v"(r) : "v"(lo), "v"(hi)); return r; }
template <class Epi, class Sched, bool STAMP = false, bool ALIGN_EPI = true, bool SP2 = true>
__device__ __forceinline__ void gemm_phase(PG8_LAS unsigned char* lds, const Gemm g, const Sched& S, const Epi& E, unsigned long long* stamps) {
    const int tid = threadIdx.x, wid = __builtin_amdgcn_readfirstlane(tid >> 6), lane = tid & 63, wr = wid >> 2, wc = wid & 3, fr = lane & 15, fq = lane >> 4;
    const int K = g.K, nt = K / BK;
    int ts_lo = 0, ts_hi = 0, nts = 0; const unsigned long long rt_entry = STAMP ? (unsigned long long)wall_clock64() : 0ull;
#define PG8_STAMP() do { if (STAMP && wid == 0 && nts < 64) { const unsigned long long _c = (unsigned long long)clock64(); \
        ts_lo = (lane == nts) ? (int)(unsigned)_c : ts_lo; ts_hi = (lane == nts) ? (int)(unsigned)(_c >> 32) : ts_hi; ++nts; } } while (0)
    PG8_STAMP();
    unsigned voffA[2], voffB[2];
#pragma unroll
    for (int i = 0; i < 2; ++i) { int R, C; stage_rc(tid * 16 + i * 8192, R, C); const int Rb = Epi::PERM ? ((R & ~31) + perm32(R & 31)) : R;
        voffA[i] = (unsigned)(R * K + C) * 2u; voffB[i] = (unsigned)(Rb * K + C) * 2u; }
    const size_t kstep = (size_t)(BK * 2);
    const size_t hstep = (size_t)HALF * K * 2;
    const size_t tstep = 2 * hstep;
    const unsigned ldsw = (unsigned)wid * 1024u;
    const int aoff = lds_byte(wr * 64 + fr, fq * 8), boff = lds_byte(wc * 32 + fr, fq * 8);
#define PG8_SA(b, h) (((b) * 2 + (h)) * HTB)
#define PG8_SB(b, h) ((4 + (b) * 2 + (h)) * HTB)
#define PG8_STAGE(bufoff, gbase, voff) do { _Pragma("unroll") for (int _i = 0; _i < 2; ++_i) \
        __builtin_amdgcn_global_load_lds((const unsigned*)((const char*)(gbase) + (voff)[_i]), (PG8_LAS unsigned*)(lds + (bufoff) + ldsw + _i * 8192), 16, 0, 0); } while (0)
#define PG8_LDA(dst, b, h) do { _Pragma("unroll") for (int m = 0; m < 4; ++m) _Pragma("unroll") for (int k = 0; k < 2; ++k) dst[m][k] = *(const PG8_LAS bf16x8*)(lds + PG8_SA(b, h) + aoff + m * 2048 + k * 1024); } while (0)
#define PG8_LDB(dst, b, h) do { _Pragma("unroll") for (int n = 0; n < 2; ++n) _Pragma("unroll") for (int k = 0; k < 2; ++k) dst[n][k] = *(const PG8_LAS bf16x8*)(lds + PG8_SB(b, h) + boff + n * 2048 + k * 1024); } while (0)
#define PG8_MMA(ai, bj, At, Bt) do { __builtin_amdgcn_s_setprio(1); _Pragma("unroll") for (int m = 0; m < 4; ++m) _Pragma("unroll") for (int n = 0; n < 2; ++n) _Pragma("unroll") for (int k = 0; k < 2; ++k) \
        acc[ai][bj][m][n] = __builtin_amdgcn_mfma_f32_16x16x32_bf16(Bt[n][k], At[m][k], acc[ai][bj][m][n], 0, 0, 0); __builtin_amdgcn_s_setprio(0); } while (0)
#define PG8_WAIT_V(n) asm volatile("s_waitcnt vmcnt(" #n ")" ::: "memory")
#define PG8_WAIT_L(n) asm volatile("s_waitcnt lgkmcnt(" #n ")" ::: "memory")
#define PG8_BAR __builtin_amdgcn_s_barrier()
#define PG8_SCHED __builtin_amdgcn_sched_barrier(0)
    Unit cur, nxt; int ui = 0;
    if (!S.next(0, cur)) return;
    f32x4 acc[2][2][4][2];
#pragma unroll
    for (int a = 0; a < 2; ++a)
#pragma unroll
        for (int b = 0; b < 2; ++b)
#pragma unroll
            for (int m = 0; m < 4; ++m)
#pragma unroll
                for (int n = 0; n < 2; ++n) acc[a][b][m][n] = (f32x4){0.f, 0.f, 0.f, 0.f};
    bf16x8 At[4][2], B0[2][2], B1[2][2];
    const char* cA = (const char*)g.A + (size_t)cur.pm * tstep + cur.aoff; const char* cB = (const char*)g.Bt + (size_t)cur.pn * tstep + cur.boff;
    S.a_ready(cur);
    if constexpr (SP2) {
        PG8_STAGE(PG8_SB(0, 0), cB, voffB); PG8_STAGE(PG8_SB(0, 1), cB + hstep, voffB); PG8_STAGE(PG8_SA(0, 0), cA, voffA); PG8_STAGE(PG8_SA(0, 1), cA + hstep, voffA);
        if (wr == 1) PG8_BAR;
        PG8_WAIT_V(2); PG8_BAR;
        PG8_STAGE(PG8_SB(1, 0), cB + kstep, voffB); PG8_STAGE(PG8_SA(1, 0), cA + kstep, voffA); PG8_STAGE(PG8_SB(1, 1), cB + hstep + kstep, voffB);
        PG8_WAIT_V(6); PG8_BAR;
    } else {
        PG8_STAGE(PG8_SB(0, 0), cB, voffB); PG8_STAGE(PG8_SA(0, 0), cA, voffA); PG8_STAGE(PG8_SB(0, 1), cB + hstep, voffB); PG8_STAGE(PG8_SA(0, 1), cA + hstep, voffA);
        if (wr == 1) PG8_BAR;
        PG8_WAIT_V(4); PG8_BAR;
        PG8_STAGE(PG8_SB(1, 0), cB + kstep, voffB); PG8_STAGE(PG8_SA(1, 0), cA + kstep, voffA); PG8_STAGE(PG8_SB(1, 1), cB + hstep + kstep, voffB);
        PG8_WAIT_V(6); PG8_BAR;
    }
    PG8_STAMP();
    for (;;) {
        const bool has_next = S.next(ui + 1, nxt);
        const char* nA = has_next ? (const char*)g.A + (size_t)nxt.pm * tstep + nxt.aoff : cA; const char* nB = has_next ? (const char*)g.Bt + (size_t)nxt.pn * tstep + nxt.boff : cB;
        for (int t = 0; t < nt; t += 2) {
            const bool last = (t == nt - 2);
            const char* a1 = cA + (size_t)(t + 1) * kstep;
            const char* a2 = last ? nA : cA + (size_t)(t + 2) * kstep; const char* b2 = last ? nB : cB + (size_t)(t + 2) * kstep;
            const char* a3 = a2 + kstep; const char* b3 = b2 + kstep;
            if (last && has_next) S.a_ready(nxt);
            if constexpr (SP2) {
            PG8_LDB(B0, 0, 0); PG8_LDB(B1, 0, 1); PG8_SCHED; PG8_LDA(At, 0, 0); PG8_STAGE(PG8_SA(1, 1), a1 + hstep, voffA);
            PG8_WAIT_V(8); PG8_WAIT_L(0); PG8_BAR; PG8_MMA(0, 0, At, B0); PG8_MMA(0, 1, At, B1); PG8_BAR; PG8_SCHED;
            PG8_LDA(At, 0, 1); PG8_STAGE(PG8_SB(0, 0), b2, voffB); PG8_STAGE(PG8_SB(0, 1), b2 + hstep, voffB); PG8_STAGE(PG8_SA(0, 0), a2, voffA);
            PG8_WAIT_V(8); PG8_WAIT_L(0); PG8_BAR; PG8_MMA(1, 0, At, B0); PG8_MMA(1, 1, At, B1); PG8_BAR; PG8_SCHED;
            PG8_LDB(B0, 1, 0); PG8_LDB(B1, 1, 1); PG8_SCHED; PG8_LDA(At, 1, 0); PG8_STAGE(PG8_SA(0, 1), a2 + hstep, voffA);
            PG8_WAIT_V(8); PG8_WAIT_L(0); PG8_BAR; PG8_MMA(0, 0, At, B0); PG8_MMA(0, 1, At, B1); PG8_BAR; PG8_SCHED;
            PG8_LDA(At, 1, 1); PG8_STAGE(PG8_SB(1, 0), b3, voffB); PG8_STAGE(PG8_SB(1, 1), b3 + hstep, voffB); PG8_STAGE(PG8_SA(1, 0), a3, voffA);
            PG8_WAIT_V(8); PG8_WAIT_L(0); PG8_BAR; PG8_MMA(1, 0, At, B0); PG8_MMA(1, 1, At, B1); PG8_BAR; PG8_SCHED;
            } else {
            PG8_LDB(B0, 0, 0); PG8_SCHED; PG8_LDA(At, 0, 0); PG8_STAGE(PG8_SA(1, 1), a1 + hstep, voffA);
            PG8_WAIT_L(8); PG8_BAR; PG8_WAIT_L(0); PG8_MMA(0, 0, At, B0); PG8_BAR; PG8_SCHED;
            PG8_LDB(B1, 0, 1); PG8_STAGE(PG8_SB(0, 0), b2, voffB);
            PG8_BAR; PG8_WAIT_L(0); PG8_MMA(0, 1, At, B1); PG8_BAR;
            PG8_LDA(At, 0, 1); PG8_STAGE(PG8_SA(0, 0), a2, voffA);
            PG8_BAR; PG8_WAIT_L(0); PG8_MMA(1, 0, At, B0); PG8_BAR; PG8_SCHED;
            PG8_STAGE(PG8_SB(0, 1), b2 + hstep, voffB);
            PG8_WAIT_V(6); PG8_BAR; PG8_MMA(1, 1, At, B1); PG8_BAR;
            PG8_LDB(B0, 1, 0); PG8_SCHED; PG8_LDA(At, 1, 0); PG8_STAGE(PG8_SA(0, 1), a2 + hstep, voffA);
            PG8_WAIT_L(8); PG8_BAR; PG8_WAIT_L(0); PG8_MMA(0, 0, At, B0); PG8_BAR; PG8_SCHED;
            PG8_LDB(B1, 1, 1); PG8_STAGE(PG8_SB(1, 0), b3, voffB);
            PG8_BAR; PG8_WAIT_L(0); PG8_MMA(0, 1, At, B1); PG8_BAR;
            PG8_LDA(At, 1, 1); PG8_STAGE(PG8_SA(1, 0), a3, voffA);
            PG8_BAR; PG8_WAIT_L(0); PG8_MMA(1, 0, At, B0); PG8_BAR; PG8_SCHED;
            PG8_STAGE(PG8_SB(1, 1), b3 + hstep, voffB);
            PG8_WAIT_V(6); PG8_BAR; PG8_MMA(1, 1, At, B1); PG8_BAR;
            }
        }
        PG8_STAMP();
        if constexpr (ALIGN_EPI) { if (wr == 0) PG8_BAR; }
        if constexpr (!Epi::AFTER_DRAIN) { E(acc, cur, wr, wc, fr, fq); S.done(cur); }
        PG8_STAMP();
        if (!has_next) break;
#pragma unroll
        for (int a = 0; a < 2; ++a)
#pragma unroll
            for (int b = 0; b < 2; ++b)
#pragma unroll
                for (int m = 0; m < 4; ++m)
#pragma unroll
                    for (int n = 0; n < 2; ++n) acc[a][b][m][n] = (f32x4){0.f, 0.f, 0.f, 0.f};
        cur = nxt; cA = nA; cB = nB; ++ui;
        if constexpr (ALIGN_EPI) { if (wr == 1) PG8_BAR; }
    }
    PG8_WAIT_V(0);
    if constexpr (!ALIGN_EPI) { if (wr == 0) PG8_BAR; }
    PG8_BAR;
    if constexpr (Epi::AFTER_DRAIN) { E.fused(acc, cur, wr, wc, fr, fq, lds, wid, lane); S.done(cur); }
    PG8_STAMP();
    if (STAMP && wid == 0) { stamps[lane] = lane < nts ? (((unsigned long long)(unsigned)ts_hi << 32) | (unsigned)ts_lo) : 0ull;
        if (lane == 62) stamps[62] = rt_entry; if (lane == 63) stamps[63] = (unsigned long long)wall_clock64(); }
#undef PG8_STAMP
#undef PG8_SA
#undef PG8_SB
#undef PG8_STAGE
#undef PG8_LDA
#undef PG8_LDB
#undef PG8_MMA
#undef PG8_WAIT_V
#undef PG8_WAIT_L
#undef PG8_BAR
#undef PG8_SCHED
}
}


using pg8::bf16_t; using pg8::bf16x8; using pg8::f32x4; using pg8::u32x4;
typedef unsigned u32x2 __attribute__((ext_vector_type(2)));
typedef float f32x2v __attribute__((ext_vector_type(2)));
#define MFMA16(a, b, c) __builtin_amdgcn_mfma_f32_16x16x32_bf16((a), (b), (c), 0, 0, 0)

constexpr int MP = 65536, MS = 1024, MT = MP + MS, DM = 1024, DFF = 2816, NIN = 7424;
constexpr float EPS = 1e-6f;
constexpr size_t UB = (size_t)MT * 1024 * 2;
constexpr size_t WS_WIN = 0, WS_WBRA = WS_WIN + (size_t)NIN * 1024 * 2, WS_WBRB = WS_WBRA + 2097152, WS_WOUT = WS_WBRB + 2097152, WS_WPG = WS_WOUT + 2097152,
                 WS_WUP = WS_WPG + 2097152, WS_WDOWN = WS_WUP + (size_t)2 * DFF * 1024 * 2, WS_WPLE = WS_WDOWN + (size_t)1024 * DFF * 2, WS_KV = WS_WPLE + (size_t)1024 * 256 * 2,
                 WS_R0 = WS_KV + (size_t)MT * 256 * 2, WS_END = WS_R0 + 7 * UB;
constexpr size_t A_BYTES = (size_t)MT * DFF * 2;
constexpr size_t O_Y = 0, O_PWK = (size_t)MT * 1024, O_PWV = O_PWK + 524288, O_PST = O_PWV + 524288, O_PFC = O_PST + 4194304, O_SWK = O_PFC + 180224, O_SWV = O_SWK + 131072,
                 O_SST = O_SWV + 131072, O_SFC = O_SST + 4194304, O_END = O_SFC + 180224;
constexpr size_t WS_RS0 = WS_END + 65536;
constexpr int LDS_BYTES = 147456;

struct Prm { const float* in[26]; float* out; unsigned char* ws; };
enum { I_XP = 0, I_XS, I_CK, I_CV, I_ST, I_CC, I_PP, I_PS, I_RB, I_LB, I_GPM, I_WIN, I_SINK, I_GH, I_WBRA, I_WBRB, I_WOUT, I_GPOST, I_GPF, I_WUP, I_WCONV, I_BCONV, I_WDOWN, I_GPFF, I_WPLE, I_WPG };

__device__ __forceinline__ unsigned pk2(float lo, float hi) { unsigned r; asm("v_cvt_pk_bf16_f32 %0, %1, %2" : "=v"(r) : "v"(lo), "v"(hi)); return r; }
__device__ __forceinline__ float bflo(unsigned w) { return __uint_as_float(w << 16); }
__device__ __forceinline__ float bfhi(unsigned w) { return __uint_as_float(w & 0xffff0000u); }
__device__ __forceinline__ float bf1(bf16_t b) { return __uint_as_float(((unsigned)b) << 16); }
__device__ __forceinline__ bf16_t f2bf(float f) { return (bf16_t)(pk2(f, 0.f) & 0xffffu); }
__device__ __forceinline__ float sigm(float x) { return __builtin_amdgcn_rcpf(1.0f + __expf(-x)); }
__device__ __forceinline__ float wsum(float v) { v += __shfl_xor(v, 32); v += __shfl_xor(v, 16); v += __shfl_xor(v, 8); v += __shfl_xor(v, 4); v += __shfl_xor(v, 2); v += __shfl_xor(v, 1); return v; }
__device__ __forceinline__ u32x4 pk8(f32x4 a, f32x4 b) { u32x4 w; w.x = pk2(a[0], a[1]); w.y = pk2(a[2], a[3]); w.z = pk2(b[0], b[1]); w.w = pk2(b[2], b[3]); return w; }
__device__ __forceinline__ u32x2 pk4(f32x4 a) { u32x2 w; w.x = pk2(a[0], a[1]); w.y = pk2(a[2], a[3]); return w; }
__device__ __forceinline__ void unpk8(u32x4 w, float (&f)[8]) { f[0] = bflo(w.x); f[1] = bfhi(w.x); f[2] = bflo(w.y); f[3] = bfhi(w.y); f[4] = bflo(w.z); f[5] = bfhi(w.z); f[6] = bflo(w.w); f[7] = bfhi(w.w); }

struct NoPre {};
template <class F> struct EpiT {
    static constexpr bool PERM = true, AFTER_DRAIN = false; F f;
    __device__ __forceinline__ void operator()(const f32x4 (&acc)[2][2][4][2], const pg8::Unit& u, int wr, int wc, int fr, int fq) const {
        const int row0 = u.pm * 256 + wr * 64 + fr, col0 = u.pn * 256 + wc * 32 + 8 * fq;
        constexpr int MB = F::MB;
#pragma unroll
        for (int a0 = 0; a0 < 8; a0 += MB) {
            typename F::Pre pre[MB][2];
#pragma unroll
            for (int mm = 0; mm < MB; ++mm)
#pragma unroll
                for (int bj = 0; bj < 2; ++bj) pre[mm][bj] = f.load(row0 + ((a0 + mm) >> 2) * 128 + ((a0 + mm) & 3) * 16, col0 + bj * 128);
#pragma unroll
            for (int mm = 0; mm < MB; ++mm)
#pragma unroll
                for (int bj = 0; bj < 2; ++bj) f(row0 + ((a0 + mm) >> 2) * 128 + ((a0 + mm) & 3) * 16, col0 + bj * 128, u.pn, acc[(a0 + mm) >> 2][bj][(a0 + mm) & 3][0], acc[(a0 + mm) >> 2][bj][(a0 + mm) & 3][1], pre[mm][bj]);
        }
    }
};
struct F1 {
    bf16_t* r0; bf16_t* kv; float* out; typedef NoPre Pre; static constexpr int MB = 1;
    __device__ __forceinline__ NoPre load(int, int) const { return NoPre(); }
    __device__ __forceinline__ void operator()(int row, int col, int pn, f32x4 v0, f32x4 v1, NoPre) const {
        const u32x4 w = pk8(v0, v1);
        if (pn < 4) { __builtin_nontemporal_store(w, (u32x4*)(r0 + (size_t)row * 1024 + col)); }
        else if (pn == 4) {
            const int c = col - 1024; *(u32x4*)(kv + (size_t)row * 256 + c) = w;
            float* o = nullptr;
            if (row >= MP) { o = out + (c < 128 ? O_SWK : O_SWV) + (size_t)(row - MP) * 128 + (c & 127); }
            else { const int t = row & 2047; if (t >= 1920) o = out + (c < 128 ? O_PWK : O_PWV) + (size_t)((row >> 11) * 128 + t - 1920) * 128 + (c & 127); }
            if (o) { *(f32x4*)o = v0; *(f32x4*)(o + 4) = v1; }
        } else { const int c2 = col - 1280, seg = c2 >> 10; __builtin_nontemporal_store(w, (u32x4*)(r0 + (size_t)(1 + seg) * (UB / 2) + (size_t)row * 1024 + (c2 & 1023))); }
    }
};
struct F2 {
    const bf16_t* g; bf16_t* o; typedef u32x4 Pre; static constexpr int MB = 8;
    __device__ __forceinline__ u32x4 load(int row, int col) const { return *(const u32x4*)(g + (size_t)row * 1024 + col); }
    __device__ __forceinline__ void operator()(int row, int col, int, f32x4 v0, f32x4 v1, u32x4 gw) const {
        const size_t i = (size_t)row * 1024 + col; float gf[8]; unpk8(gw, gf);
        f32x4 a, b;
#pragma unroll
        for (int j = 0; j < 4; ++j) { a[j] = v0[j] * sigm(gf[j]); b[j] = v1[j] * sigm(gf[4 + j]); }
        *(u32x4*)(o + i) = pk8(a, b);
    }
};
struct F3 {
    const bf16_t* g; const bf16_t* t; bf16_t* o; struct Pre { u32x4 g, t; }; static constexpr int MB = 4;
    __device__ __forceinline__ Pre load(int row, int col) const { const size_t i = (size_t)row * 1024 + col; Pre r; r.g = *(const u32x4*)(g + i); r.t = *(const u32x4*)(t + i); return r; }
    __device__ __forceinline__ void operator()(int row, int col, int, f32x4 v0, f32x4 v1, Pre pr) const {
        const size_t i = (size_t)row * 1024 + col; float gf[8], tf[8]; unpk8(pr.g, gf); unpk8(pr.t, tf);
        f32x4 a, b;
#pragma unroll
        for (int j = 0; j < 4; ++j) { a[j] = tf[j] + v0[j] * sigm(gf[j]); b[j] = tf[4 + j] + v1[j] * sigm(gf[4 + j]); }
        *(u32x4*)(o + i) = pk8(a, b);
    }
};
struct FF32 {
    float* o; typedef NoPre Pre; static constexpr int MB = 1;
    __device__ __forceinline__ NoPre load(int, int) const { return NoPre(); }
    __device__ __forceinline__ void operator()(int row, int col, int, f32x4 v0, f32x4 v1, NoPre) const { float* d = o + (size_t)row * 1024 + col; *(f32x4*)d = v0; *(f32x4*)(d + 4) = v1; }
};
struct FBF {
    bf16_t* o; typedef NoPre Pre; static constexpr int MB = 1;
    __device__ __forceinline__ NoPre load(int, int) const { return NoPre(); }
    __device__ __forceinline__ void operator()(int row, int col, int, f32x4 v0, f32x4 v1, NoPre) const { *(u32x4*)(o + (size_t)row * 1024 + col) = pk8(v0, v1); }
};
struct EpiUp {
    static constexpr bool PERM = true, AFTER_DRAIN = false;
    bf16_t* g; bf16_t* araw; float* out; const float* wcv; const float* bcv;
    __device__ __forceinline__ void operator()(const f32x4 (&acc)[2][2][4][2], const pg8::Unit& u, int wr, int wc, int fr, int fq) const {
        const int c0 = u.pn * 128 + wc * 32 + 8 * fq;
        float w0[8], w1[8], w2[8], bb[8];
        { const f32x4 t0 = *(const f32x4*)(wcv + c0), t1 = *(const f32x4*)(wcv + c0 + 4), t2 = *(const f32x4*)(wcv + DFF + c0), t3 = *(const f32x4*)(wcv + DFF + c0 + 4),
                      t4 = *(const f32x4*)(wcv + 2 * DFF + c0), t5 = *(const f32x4*)(wcv + 2 * DFF + c0 + 4), t6 = *(const f32x4*)(bcv + c0), t7 = *(const f32x4*)(bcv + c0 + 4);
#pragma unroll
          for (int j = 0; j < 4; ++j) { w0[j] = t0[j]; w0[4 + j] = t1[j]; w1[j] = t2[j]; w1[4 + j] = t3[j]; w2[j] = t4[j]; w2[4 + j] = t5[j]; bb[j] = t6[j]; bb[4 + j] = t7[j]; } }
#pragma unroll
        for (int ai = 0; ai < 2; ++ai) {
            float p1[8], p2[8];
#pragma unroll
            for (int j = 0; j < 8; ++j) { p1[j] = 0.f; p2[j] = 0.f; }
#pragma unroll
            for (int m = 0; m < 4; ++m) {
                const int row = u.pm * 256 + ai * 128 + wr * 64 + m * 16 + fr;
                float a[8], uu[8], r1[8], r2[8], gq[8];
#pragma unroll
                for (int j = 0; j < 4; ++j) { a[j] = acc[ai][0][m][0][j]; a[4 + j] = acc[ai][0][m][1][j]; uu[j] = acc[ai][1][m][0][j]; uu[4 + j] = acc[ai][1][m][1][j]; }
#pragma unroll
                for (int j = 0; j < 8; ++j) { r1[j] = __int_as_float(__builtin_amdgcn_mov_dpp(__float_as_int(a[j]), 0x121, 0xf, 0xf, false)); r2[j] = __int_as_float(__builtin_amdgcn_mov_dpp(__float_as_int(a[j]), 0x122, 0xf, 0xf, false)); }
                const bool sample = row >= MP;
                const bool boundary = (m == 0 && fr < 2) || (sample && ((m & 1) == 0) && fr < 2);
                const bool keep_a = boundary || (m == 3 && fr >= 14);
#pragma unroll
                for (int j = 0; j < 8; ++j) {
                    const float am1 = fr >= 1 ? r1[j] : p1[j], am2 = fr >= 2 ? r2[j] : p2[j];
                    const float ac = bb[j] + w0[j] * am2 + w1[j] * am1 + w2[j] * a[j];
                    const float y = 1.5957691216f * (ac + 0.044715f * ac * ac * ac);
                    gq[j] = boundary ? uu[j] : ac * sigm(y) * uu[j];
                    p1[j] = r1[j]; p2[j] = r2[j];
                }
                u32x4 wv; wv.x = pk2(gq[0], gq[1]); wv.y = pk2(gq[2], gq[3]); wv.z = pk2(gq[4], gq[5]); wv.w = pk2(gq[6], gq[7]);
                __builtin_nontemporal_store(wv, (u32x4*)(g + (size_t)row * DFF + c0));
                if (keep_a) { u32x4 av; av.x = pk2(a[0], a[1]); av.y = pk2(a[2], a[3]); av.z = pk2(a[4], a[5]); av.w = pk2(a[6], a[7]); *(u32x4*)(araw + (size_t)row * DFF + c0) = av; }
                float* o = nullptr;
                if (sample) { const int rs = row - MP, t = rs & 31; if (t >= 30) o = out + O_SFC + (size_t)((rs >> 5) * 2 + t - 30) * DFF + c0; }
                else { const int t = row & 2047; if (t >= 2046) o = out + O_PFC + (size_t)((row >> 11) * 2 + t - 2046) * DFF + c0; }
                if (o) { *(f32x4*)o = acc[ai][0][m][0]; *(f32x4*)(o + 4) = acc[ai][0][m][1]; }
            }
        }
    }
};
struct F9 {
    const bf16_t* pe; const bf16_t* xb; float* y; struct Pre { u32x4 p, x; }; static constexpr int MB = 4;
    __device__ __forceinline__ Pre load(int row, int col) const { const size_t i = (size_t)row * 1024 + col; Pre r; r.p = *(const u32x4*)(pe + i); r.x = *(const u32x4*)(xb + i); return r; }
    __device__ __forceinline__ void operator()(int row, int col, int, f32x4 v0, f32x4 v1, Pre pr) const {
        const size_t i = (size_t)row * 1024 + col; float pf[8], xf[8]; unpk8(pr.p, pf); unpk8(pr.x, xf);
        f32x4 a, b;
#pragma unroll
        for (int j = 0; j < 4; ++j) { a[j] = xf[j] + pf[j] * sigm(v0[j]); b[j] = xf[4 + j] + pf[4 + j] * sigm(v1[j]); }
        *(f32x4*)(y + i) = a; *(f32x4*)(y + i + 4) = b;
    }
};
template <class E> __device__ __forceinline__ void run_gemm_epi(unsigned char* lds, const bf16_t* A, const bf16_t* Bt, int N, int K, const E& e) {
    asm volatile("" : "+s"(K)); asm volatile("" : "+s"(N));
    pg8::Gemm g; g.A = A; g.Bt = Bt; g.M = MT; g.N = N; g.K = K;
    pg8::StaticOrder S; S.init(MT, N, (int)gridDim.x, (int)blockIdx.x);
    pg8::gemm_phase<E, pg8::StaticOrder, false>((PG8_LAS unsigned char*)lds, g, S, e, nullptr);
    __syncthreads();
}
struct PairOrder {
    pg8::StaticOrder S; size_t astep, bstep;
    __device__ __forceinline__ bool next(int i, pg8::Unit& u) const { if (!S.next(i >> 1, u)) return false; const int w = i & 1; u.which = w; u.aoff = w ? astep : 0; u.boff = w ? bstep : 0; return true; }
    __device__ __forceinline__ void a_ready(const pg8::Unit&) const {}
    __device__ __forceinline__ void done(const pg8::Unit&) const {}
};
struct Epi34 {
    static constexpr bool PERM = true, AFTER_DRAIN = false; EpiT<F2> e2; EpiT<F3> e3;
    __device__ __forceinline__ void operator()(const f32x4 (&acc)[2][2][4][2], const pg8::Unit& u, int wr, int wc, int fr, int fq) const { if (u.which == 0) e2(acc, u, wr, wc, fr, fq); else e3(acc, u, wr, wc, fr, fq); }
};
template <class F> __device__ __forceinline__ void run_gemm(unsigned char* lds, const bf16_t* A, const bf16_t* Bt, int N, int K, const F& f, int skip = 0) {
    asm volatile("" : "+s"(K)); asm volatile("" : "+s"(N));
    pg8::Gemm g; g.A = A; g.Bt = Bt; g.M = MT; g.N = N; g.K = K;
    pg8::StaticOrder S; S.init(MT, N, (int)gridDim.x - skip, (int)blockIdx.x - skip);
    EpiT<F> E; E.f = f;
    pg8::gemm_phase<EpiT<F>, pg8::StaticOrder, false>((PG8_LAS unsigned char*)lds, g, S, E, nullptr);
    __syncthreads();
}

template <bool ILV = false> __device__ __forceinline__ void transpose_w(const float* W, bf16_t* Bt, int K, int N, const float* gain, float* tile, int& toff, int cid, int G) {
    const int nnt = N / 64, ntiles = (K / 64) * nnt, tid = threadIdx.x;
    const int first = (cid - (toff % G) + G) % G;
    const int r0 = tid >> 6, c = tid & 63;
    float v[8];
#define TR_LOAD(t_) do { const int kt_ = (t_) / nnt, d0_ = ((t_) % nnt) * 64; \
        const int sc0_ = ILV ? (((d0_ & 255) < 128) ? (d0_ >> 8) * 128 + (d0_ & 127) : DFF + (d0_ >> 8) * 128 + (d0_ & 127)) : d0_; \
        _Pragma("unroll") for (int i = 0; i < 8; ++i) { const int r = r0 + 8 * i; float x = W[(size_t)(kt_ * 64 + r) * N + sc0_ + c]; if (gain) x *= gain[kt_ * 64 + r]; v[i] = x; } } while (0)
    if (first < ntiles) TR_LOAD(first);
    for (int t = first; t < ntiles; t += G) {
        const int kt = t / nnt, nt = t % nnt;
#pragma unroll
        for (int i = 0; i < 8; ++i) tile[(r0 + 8 * i) * 65 + c] = v[i];
        __syncthreads();
        if (t + G < ntiles) TR_LOAD(t + G);
        { const int n = tid >> 3, k8 = (tid & 7) * 8; u32x4 wv;
          wv.x = pk2(tile[(k8 + 0) * 65 + n], tile[(k8 + 1) * 65 + n]); wv.y = pk2(tile[(k8 + 2) * 65 + n], tile[(k8 + 3) * 65 + n]);
          wv.z = pk2(tile[(k8 + 4) * 65 + n], tile[(k8 + 5) * 65 + n]); wv.w = pk2(tile[(k8 + 6) * 65 + n], tile[(k8 + 7) * 65 + n]);
          *(u32x4*)(Bt + (size_t)(nt * 64 + n) * K + kt * 64 + k8) = wv; }
        __syncthreads();
    }
#undef TR_LOAD
    toff += ntiles;
}
__device__ __forceinline__ const float* xrow(const Prm& p, int row) { return row < MP ? p.in[I_XP] + (size_t)row * 1024 : p.in[I_XS] + (size_t)(row - MP) * 1024; }

__device__ __forceinline__ void late_weights(const Prm& p, unsigned char* lds) {
    if (blockIdx.x < 16) return;
    float* tile = (float*)lds; int toff = 0; unsigned char* ws = p.ws; const int cid = blockIdx.x - 16, G = gridDim.x - 16;
    transpose_w<true>(p.in[I_WUP], (bf16_t*)(ws + WS_WUP), 1024, 2 * DFF, p.in[I_GPF], tile, toff, cid, G);
    transpose_w(p.in[I_WDOWN], (bf16_t*)(ws + WS_WDOWN), DFF, 1024, nullptr, tile, toff, cid, G);
    transpose_w(p.in[I_WPG], (bf16_t*)(ws + WS_WPG), 1024, 1024, nullptr, tile, toff, cid, G);
    transpose_w(p.in[I_WPLE], (bf16_t*)(ws + WS_WPLE), 256, 1024, nullptr, tile, toff, cid, G);
}
__device__ __forceinline__ void phase0(const Prm& p, unsigned char* lds) {
    float* tile = (float*)lds; int toff = 0; unsigned char* ws = p.ws; const int cid = blockIdx.x, G = gridDim.x;
    transpose_w(p.in[I_WIN], (bf16_t*)(ws + WS_WIN), 1024, NIN, p.in[I_GPM], tile, toff, cid, G);
    transpose_w(p.in[I_WBRA], (bf16_t*)(ws + WS_WBRA), 1024, 1024, nullptr, tile, toff, cid, G);
    transpose_w(p.in[I_WBRB], (bf16_t*)(ws + WS_WBRB), 1024, 1024, nullptr, tile, toff, cid, G);
    transpose_w(p.in[I_WOUT], (bf16_t*)(ws + WS_WOUT), 1024, 1024, nullptr, tile, toff, cid, G);
    bf16_t* xn = (bf16_t*)p.out;
    const int lane = threadIdx.x & 63, gw = blockIdx.x * 8 + (threadIdx.x >> 6), nw = gridDim.x * 8;
    for (int row = gw; row < MT; row += nw) {
        const float* xr = xrow(p, row); f32x4 v[4]; float ss = 0.f;
#pragma unroll
        for (int i = 0; i < 4; ++i) { v[i] = *(const f32x4*)(xr + i * 256 + lane * 4); ss += v[i][0] * v[i][0] + v[i][1] * v[i][1] + v[i][2] * v[i][2] + v[i][3] * v[i][3]; }
        ss = wsum(ss); const float ms = ss * (1.0f / 1024.0f) + EPS, rs = rsqrtf(ms);
        if (lane == 0) ((float*)(p.ws + WS_RS0))[row] = ms * rs;
#pragma unroll
        for (int i = 0; i < 4; ++i) *(u32x2*)(xn + (size_t)row * 1024 + i * 256 + lane * 4) = pk4(v[i] * rs);
    }
}

constexpr int AT_KS = 0, AT_VT = 27648, AT_BT = 53248;
__device__ __forceinline__ void attn_bias_table(const Prm& p, unsigned char* lds) {
    float* bT = (float*)(lds + AT_BT); const float* tab = p.in[I_RB];
    for (int i = threadIdx.x; i < 16 * 256; i += 512) {
        const int head = i >> 8, idx = i & 255, rel = idx - 191, n = rel < 0 ? -rel : rel;
        int bk = n < 8 ? n : min(15, 33 - __clz(n * n)); if (rel > 0) bk += 16;
        bT[i] = idx < 255 ? tab[bk * 16 + head] : 0.f;
    }
}
template <int NKT, int NQT, bool SAMPLE>
__device__ __forceinline__ void attn_item(const Prm& p, unsigned char* lds, int b, int c, int kvh, bf16_t* YA) {
    bf16_t* Ks = (bf16_t*)(lds + AT_KS); bf16_t* Vt = (bf16_t*)(lds + AT_VT); const float* bT = (const float*)(lds + AT_BT);
    const bf16_t* kv = (const bf16_t*)(p.ws + WS_KV); bf16_t* R0 = (bf16_t*)(p.ws + WS_R0);
    const int tid = threadIdx.x, lane = tid & 63, w = tid >> 6, lr = lane & 15, lq = lane >> 4;
    const int head = kvh * 8 + w; const int qrow0 = SAMPLE ? MP + b * 32 : b * 2048 + c * 64;
    const size_t qoff0 = (size_t)(qrow0 + lr) * 1024 + head * 64 + lq * 8;
    bf16x8 qn0 = *(const bf16x8*)(R0 + qoff0), qn1 = *(const bf16x8*)(R0 + qoff0 + 32);
    __syncthreads();
    if (!SAMPLE) {
        const int tok0 = b * 2048 + (c - 2) * 64;
        for (int id = tid; id < 192 * 8; id += 512) {
            const int key = id >> 3, dc = id & 7; u32x4 v = {0u, 0u, 0u, 0u};
            if (c * 64 - 128 + key >= 0) v = *(const u32x4*)(kv + (size_t)(tok0 + key) * 256 + kvh * 64 + dc * 8);
            *(u32x4*)(Ks + key * 72 + dc * 8) = v;
        }
        for (int id = tid; id < 192 * 8; id += 512) {
            const int key = id % 192, dc = id / 192; u32x4 v = {0u, 0u, 0u, 0u};
            if (c * 64 - 128 + key >= 0) v = *(const u32x4*)(kv + (size_t)(tok0 + key) * 256 + 128 + kvh * 64 + dc * 8);
            bf16_t* d = Vt + (dc * 8) * 200 + key;
            d[0] = (bf16_t)(v.x & 0xffffu); d[200] = (bf16_t)(v.x >> 16); d[400] = (bf16_t)(v.y & 0xffffu); d[600] = (bf16_t)(v.y >> 16);
            d[800] = (bf16_t)(v.z & 0xffffu); d[1000] = (bf16_t)(v.z >> 16); d[1200] = (bf16_t)(v.w & 0xffffu); d[1400] = (bf16_t)(v.w >> 16);
        }
    } else {
        const float* ck = p.in[I_CK]; const float* cvp = p.in[I_CV];
        for (int id = tid; id < 160 * 8; id += 512) {
            const int key = id >> 3, dc = id & 7; u32x4 v;
            if (key < 128) { const float* s = ck + (size_t)(b * 128 + key) * 128 + kvh * 64 + dc * 8; v = pk8(*(const f32x4*)s, *(const f32x4*)(s + 4)); }
            else v = *(const u32x4*)(kv + (size_t)(MP + b * 32 + key - 128) * 256 + kvh * 64 + dc * 8);
            *(u32x4*)(Ks + key * 72 + dc * 8) = v;
        }
        for (int id = tid; id < 160 * 8; id += 512) {
            const int key = id % 160, dc = id / 160; u32x4 v;
            if (key < 128) { const float* s = cvp + (size_t)(b * 128 + key) * 128 + kvh * 64 + dc * 8; v = pk8(*(const f32x4*)s, *(const f32x4*)(s + 4)); }
            else v = *(const u32x4*)(kv + (size_t)(MP + b * 32 + key - 128) * 256 + 128 + kvh * 64 + dc * 8);
            bf16_t* d = Vt + (dc * 8) * 200 + key;
            d[0] = (bf16_t)(v.x & 0xffffu); d[200] = (bf16_t)(v.x >> 16); d[400] = (bf16_t)(v.y & 0xffffu); d[600] = (bf16_t)(v.y >> 16);
            d[800] = (bf16_t)(v.z & 0xffffu); d[1000] = (bf16_t)(v.z >> 16); d[1200] = (bf16_t)(v.w & 0xffffu); d[1400] = (bf16_t)(v.w >> 16);
        }
    }
    __syncthreads();
    const float sink = p.in[I_SINK][head];
    const float* bTh = bT + head * 256;
#pragma unroll 1
    for (int qi = 0; qi < NQT; ++qi) {
        const int q = qi * 16 + lr;
        const bf16x8 qf0 = qn0, qf1 = qn1;
        if (qi + 1 < NQT) { qn0 = *(const bf16x8*)(R0 + qoff0 + (size_t)(qi + 1) * 16384); qn1 = *(const bf16x8*)(R0 + qoff0 + (size_t)(qi + 1) * 16384 + 32); }
        f32x4 s[NKT];
#pragma unroll
        for (int kt = 0; kt < NKT; ++kt) {
            const bf16_t* kp = Ks + (kt * 16 + lr) * 72 + lq * 8;
            const bf16x8 k0 = *(const bf16x8*)kp, k1 = *(const bf16x8*)(kp + 32);
            f32x4 a = {0.f, 0.f, 0.f, 0.f}; a = MFMA16(k0, qf0, a); a = MFMA16(k1, qf1, a); s[kt] = a;
        }
        float mx = sink;
#pragma unroll
        for (int kt = 0; kt < NKT; ++kt)
#pragma unroll
            for (int r = 0; r < 4; ++r) {
                const int key = kt * 16 + lq * 4 + r; float v = s[kt][r] * 0.125f + bTh[key - q + 63];
                if (!SAMPLE && (c * 64 - 128 + key < 0)) v = -1e30f;
                s[kt][r] = v; mx = fmaxf(mx, v);
            }
        mx = fmaxf(mx, __shfl_xor(mx, 16)); mx = fmaxf(mx, __shfl_xor(mx, 32));
        float sum = 0.f;
#pragma unroll
        for (int kt = 0; kt < NKT; ++kt)
#pragma unroll
            for (int r = 0; r < 4; ++r) { const float e = __expf(s[kt][r] - mx); s[kt][r] = e; sum += e; }
        sum += __shfl_xor(sum, 16); sum += __shfl_xor(sum, 32);
        const float inv = 1.0f / (sum + __expf(sink - mx));
        f32x4 o[4];
#pragma unroll
        for (int dt = 0; dt < 4; ++dt) o[dt] = (f32x4){0.f, 0.f, 0.f, 0.f};
#pragma unroll
        for (int ks = 0; ks < NKT / 2; ++ks) {
            const u32x4 pw = pk8(s[2 * ks], s[2 * ks + 1]); const bf16x8 pf = __builtin_bit_cast(bf16x8, pw);
#pragma unroll
            for (int dt = 0; dt < 4; ++dt) {
                const bf16_t* vp = Vt + (dt * 16 + lr) * 200 + ks * 32 + lq * 4;
                const u32x2 lo = *(const u32x2*)vp, hi = *(const u32x2*)(vp + 16);
                const u32x4 vw = {lo.x, lo.y, hi.x, hi.y};
                o[dt] = MFMA16(__builtin_bit_cast(bf16x8, vw), pf, o[dt]);
            }
        }
#pragma unroll
        for (int dt = 0; dt < 4; ++dt) *(u32x2*)(YA + (size_t)(qrow0 + q) * 1024 + head * 64 + dt * 16 + lq * 4) = pk4(o[dt] * inv);
    }
}

template <int L, bool SAMPLE>
__device__ __forceinline__ void hgrn_seq(const Prm& p, unsigned char* lds, int b, int h, bf16_t* YB) {
    constexpr int RPG = L / 8, NT = L / 16, NCH = SAMPLE ? 1 : 32, NP = 8 / NT;
    bf16_t* Qd = (bf16_t*)lds; bf16_t* Qm = Qd + 64 * 136; bf16_t* Km = Qm + 64 * 136; bf16_t* KlT = Km + 64 * 136; bf16_t* Vt = KlT + 128 * 72; bf16_t* St = Vt + 128 * 72; bf16_t* Al = St + 128 * 136;
    float* tot = (float*)(Al + 64 * 72); float* first = tot + 1024; float* decay = first + 1024; float* ssq = decay + 128;
    const bf16_t* R1 = (const bf16_t*)(p.ws + WS_R0 + UB); const bf16_t* R2 = (const bf16_t*)(p.ws + WS_R0 + 2 * UB); const bf16_t* R3 = (const bf16_t*)(p.ws + WS_R0 + 3 * UB); const bf16_t* R4 = (const bf16_t*)(p.ws + WS_R0 + 4 * UB);
    const int tid = threadIdx.x, lane = tid & 63, w = tid >> 6, lr = lane & 15, lq = lane >> 4, cp = lane, rg = w, c0 = 2 * cp;
    float lb[2];
#pragma unroll
    for (int c = 0; c < 2; ++c) { const float l0 = p.in[I_LB][h * 128 + c0 + c], l1 = p.in[I_LB][1024 + h * 128 + c0 + c]; lb[c] = 1.0f / (1.0f + __expf(l1 - l0)); }
    f32x4 S[8];
#pragma unroll
    for (int dvt = 0; dvt < 8; ++dvt) {
        if (SAMPLE) {
#pragma unroll
            for (int r = 0; r < 4; ++r) S[dvt][r] = p.in[I_ST][((size_t)(b * 8 + h) * 128 + 16 * w + 4 * lq + r) * 128 + 16 * dvt + lr];
        } else S[dvt] = (f32x4){0.f, 0.f, 0.f, 0.f};
    }
    const int tt = w % NT, dv0 = (w / NT) * NT;
    const int rowbase = SAMPLE ? MP + b * 32 : b * 2048;
    f32x4 ggv[NT];
#pragma unroll
    for (int i = 0; i < NT; ++i) ggv[i] = *(const f32x4*)(p.in[I_GH] + 16 * (dv0 + i) + 4 * lq);
    unsigned qw[RPG], fw[RPG], vw[RPG];
#pragma unroll
    for (int i = 0; i < RPG; ++i) { const size_t idx = (size_t)(rowbase + rg * RPG + i) * 1024 + h * 128 + c0; qw[i] = *(const unsigned*)(R1 + idx); fw[i] = *(const unsigned*)(R2 + idx); vw[i] = *(const unsigned*)(R3 + idx); }
#pragma unroll 1
    for (int ch = 0; ch < NCH; ++ch) {
        const int row0 = rowbase + ch * L;
        float qv[2][RPG], cv[2][RPG], kk[2][RPG]; unsigned vkeep[RPG]; float run[2] = {1.f, 1.f}, lf0[2] = {0.f, 0.f};
#pragma unroll
        for (int i = 0; i < RPG; ++i) {
            vkeep[i] = vw[i];
#pragma unroll
            for (int c = 0; c < 2; ++c) {
                const float q = c ? bfhi(qw[i]) : bflo(qw[i]), fl = c ? bfhi(fw[i]) : bflo(fw[i]);
                const float f = lb[c] + (1.0f - lb[c]) * sigm(fl);
                run[c] *= f; cv[c][i] = run[c]; kk[c][i] = 1.0f - f; qv[c][i] = q * sigm(q); if (i == 0) lf0[c] = __logf(f);
            }
        }
        *(f32x2v*)(tot + rg * 128 + c0) = (f32x2v){__logf(run[0]), __logf(run[1])}; *(f32x2v*)(first + rg * 128 + c0) = (f32x2v){lf0[0], lf0[1]};
        if (ch + 1 < NCH) {
#pragma unroll
            for (int i = 0; i < RPG; ++i) { const size_t idx = (size_t)(row0 + L + rg * RPG + i) * 1024 + h * 128 + c0; qw[i] = *(const unsigned*)(R1 + idx); fw[i] = *(const unsigned*)(R2 + idx); vw[i] = *(const unsigned*)(R3 + idx); }
        }
        const size_t rbase = (size_t)(row0 + tt * 16 + lr) * 1024 + h * 128;
        u32x2 ogw[NT];
#pragma unroll
        for (int i = 0; i < NT; ++i) ogw[i] = *(const u32x2*)(R4 + rbase + 16 * (dv0 + i) + 4 * lq);
        __syncthreads();
        {
            float pre[2] = {0.f, 0.f}, bmid[2], blast[2], emid[2], elm[2], epre[2];
#pragma unroll
            for (int c = 0; c < 2; ++c) {
                float acc = 0.f, half = 0.f;
#pragma unroll
                for (int j = 0; j < 8; ++j) { const float t = tot[j * 128 + c0 + c]; if (j < rg) pre[c] += t; if (j < 4) half += t; acc += t; }
                bmid[c] = half + first[4 * 128 + c0 + c]; blast[c] = acc; emid[c] = __expf(bmid[c]); elm[c] = __expf(blast[c] - bmid[c]); epre[c] = __expf(pre[c] - bmid[c]);
            }
            float kl[2][RPG];
#pragma unroll
            for (int i = 0; i < RPG; ++i) {
                const int r = rg * RPG + i; float qd[2], qm[2], km[2];
#pragma unroll
                for (int c = 0; c < 2; ++c) {
                    const float E = epre[c] * cv[c][i], Ei = __builtin_amdgcn_rcpf(E);
                    qm[c] = qv[c][i] * E; qd[c] = qm[c] * emid[c]; km[c] = kk[c][i] * Ei; kl[c][i] = km[c] * elm[c];
                }
                *(unsigned*)(Qd + r * 136 + c0) = pk2(qd[0], qd[1]); *(unsigned*)(Qm + r * 136 + c0) = pk2(qm[0], qm[1]); *(unsigned*)(Km + r * 136 + c0) = pk2(km[0], km[1]);
            }
#pragma unroll
            for (int c = 0; c < 2; ++c) {
#pragma unroll
                for (int i = 0; i < RPG; i += 4) {
                    u32x2 a, v2; a.x = pk2(kl[c][i], kl[c][i + 1]); a.y = pk2(kl[c][i + 2], kl[c][i + 3]);
                    if (c == 0) { v2.x = (vkeep[i] & 0xffffu) | (vkeep[i + 1] << 16); v2.y = (vkeep[i + 2] & 0xffffu) | (vkeep[i + 3] << 16); }
                    else { v2.x = (vkeep[i] >> 16) | (vkeep[i + 1] & 0xffff0000u); v2.y = (vkeep[i + 2] >> 16) | (vkeep[i + 3] & 0xffff0000u); }
                    *(u32x2*)(KlT + (c0 + c) * 72 + rg * RPG + i) = a; *(u32x2*)(Vt + (c0 + c) * 72 + rg * RPG + i) = v2;
                }
            }
            if (rg == 0) *(f32x2v*)(decay + c0) = (f32x2v){__expf(blast[0]), __expf(blast[1])};
        }
#pragma unroll
        for (int dvt = 0; dvt < 8; ++dvt) *(u32x2*)(St + (16 * dvt + lr) * 136 + 16 * w + 4 * lq) = pk4(S[dvt]);
        __syncthreads();
        for (int id = w; id < NT * NT; id += 8) {
            const int st = id / NT, t2 = id % NT; f32x4 acc = {0.f, 0.f, 0.f, 0.f};
#pragma unroll
            for (int ks = 0; ks < 4; ++ks) acc = MFMA16(*(const bf16x8*)(Km + (st * 16 + lr) * 136 + ks * 32 + lq * 8), *(const bf16x8*)(Qm + (t2 * 16 + lr) * 136 + ks * 32 + lq * 8), acc);
            const int t = t2 * 16 + lr;
#pragma unroll
            for (int r = 0; r < 4; ++r) if (st * 16 + 4 * lq + r > t) acc[r] = 0.f;
            *(u32x2*)(Al + t * 72 + st * 16 + 4 * lq) = pk4(acc);
        }
        f32x4 o[NT];
#pragma unroll
        for (int i = 0; i < NT; ++i) {
            f32x4 acc = {0.f, 0.f, 0.f, 0.f};
#pragma unroll
            for (int ks = 0; ks < 4; ++ks) acc = MFMA16(*(const bf16x8*)(St + (16 * (dv0 + i) + lr) * 136 + ks * 32 + lq * 8), *(const bf16x8*)(Qd + (tt * 16 + lr) * 136 + ks * 32 + lq * 8), acc);
            o[i] = acc;
        }
        __syncthreads();
        float sq = 0.f;
#pragma unroll
        for (int i = 0; i < NT; ++i) {
#pragma unroll
            for (int ks = 0; ks < L / 32; ++ks) o[i] = MFMA16(*(const bf16x8*)(Vt + (16 * (dv0 + i) + lr) * 72 + ks * 32 + lq * 8), *(const bf16x8*)(Al + (tt * 16 + lr) * 72 + ks * 32 + lq * 8), o[i]);
            sq += o[i][0] * o[i][0] + o[i][1] * o[i][1] + o[i][2] * o[i][2] + o[i][3] * o[i][3];
        }
        sq += __shfl_xor(sq, 16); sq += __shfl_xor(sq, 32);
        if (lq == 0) ssq[(w / NT) * 64 + tt * 16 + lr] = sq;
        {
            const f32x4 dc = *(const f32x4*)(decay + 16 * w + 4 * lq);
#pragma unroll
            for (int dvt = 0; dvt < 8; ++dvt) {
                f32x4 acc = S[dvt] * dc;
#pragma unroll
                for (int ks = 0; ks < L / 32; ++ks) acc = MFMA16(*(const bf16x8*)(KlT + (16 * w + lr) * 72 + ks * 32 + lq * 8), *(const bf16x8*)(Vt + (16 * dvt + lr) * 72 + ks * 32 + lq * 8), acc);
                S[dvt] = acc;
            }
        }
        __syncthreads();
        {
            float tsq = 0.f;
#pragma unroll
            for (int j = 0; j < NP; ++j) tsq += ssq[j * 64 + tt * 16 + lr];
            const float rs = rsqrtf(tsq * (1.0f / 128.0f) + EPS);
#pragma unroll
            for (int i = 0; i < NT; ++i) {
                const int dvb = 16 * (dv0 + i) + 4 * lq;
                const f32x4 gg = ggv[i];
                const float og0 = bflo(ogw[i].x), og1 = bfhi(ogw[i].x), og2 = bflo(ogw[i].y), og3 = bfhi(ogw[i].y);
                f32x4 y; y[0] = o[i][0] * rs * gg[0] * og0 * sigm(og0); y[1] = o[i][1] * rs * gg[1] * og1 * sigm(og1); y[2] = o[i][2] * rs * gg[2] * og2 * sigm(og2); y[3] = o[i][3] * rs * gg[3] * og3 * sigm(og3);
                *(u32x2*)(YB + rbase + dvb) = pk4(y);
            }
        }
    }
    float* so = p.out + (SAMPLE ? O_SST : O_PST) + (size_t)(b * 8 + h) * 16384;
#pragma unroll
    for (int dvt = 0; dvt < 8; ++dvt)
#pragma unroll
        for (int r = 0; r < 4; ++r) so[(16 * w + 4 * lq + r) * 128 + 16 * dvt + lr] = S[dvt][r];
    __syncthreads();
}

__device__ __forceinline__ void conv_p(const Prm& p) {
    if (blockIdx.x < 16) return;
    bf16_t* pbf = (bf16_t*)(p.ws + WS_KV);
    for (int id = (blockIdx.x - 16) * 512 + threadIdx.x; id < MT * 32; id += (gridDim.x - 16) * 512) {
        const int row = id >> 5, c = (id & 31) * 8;
        const float* s = (row < MP ? p.in[I_PP] + (size_t)row * 256 : p.in[I_PS] + (size_t)(row - MP) * 256) + c;
        *(u32x4*)(pbf + (size_t)row * 256 + c) = pk8(*(const f32x4*)s, *(const f32x4*)(s + 4));
    }
}
__device__ __forceinline__ void phase_rp5(const Prm& p) {
    const bf16_t* O = (const bf16_t*)(p.ws + WS_R0 + 4 * UB); bf16_t* hf = (bf16_t*)(p.ws + WS_R0); const float* g = p.in[I_GPOST];
    const int lane = threadIdx.x & 63, gw = blockIdx.x * 8 + (threadIdx.x >> 6), nw = gridDim.x * 8;
    for (int row = gw; row < MT; row += nw) {
        const bf16_t* xr = (const bf16_t*)p.out + (size_t)row * 1024; const float xs = ((const float*)(p.ws + WS_RS0))[row]; const bf16_t* orow = O + (size_t)row * 1024; f32x4 v[4], x[4]; float ss = 0.f;
#pragma unroll
        for (int i = 0; i < 4; ++i) { { const u32x2 ow = *(const u32x2*)(orow + i * 256 + lane * 4); v[i] = (f32x4){bflo(ow.x), bfhi(ow.x), bflo(ow.y), bfhi(ow.y)}; } { const u32x2 xw = *(const u32x2*)(xr + i * 256 + lane * 4); x[i] = (f32x4){bflo(xw.x), bfhi(xw.x), bflo(xw.y), bfhi(xw.y)} * xs; } ss += v[i][0] * v[i][0] + v[i][1] * v[i][1] + v[i][2] * v[i][2] + v[i][3] * v[i][3]; }
        ss = wsum(ss); const float rs = rsqrtf(ss * (1.0f / 1024.0f) + EPS); float s2 = 0.f;
#pragma unroll
        for (int i = 0; i < 4; ++i) { const f32x4 gg = *(const f32x4*)(g + i * 256 + lane * 4); x[i] += v[i] * rs * gg; s2 += x[i][0] * x[i][0] + x[i][1] * x[i][1] + x[i][2] * x[i][2] + x[i][3] * x[i][3];
            *(u32x2*)((bf16_t*)p.out + (size_t)row * 1024 + i * 256 + lane * 4) = pk4(x[i]); }
        s2 = wsum(s2); const float r2 = rsqrtf(s2 * (1.0f / 1024.0f) + EPS);
#pragma unroll
        for (int i = 0; i < 4; ++i) *(u32x2*)(hf + (size_t)row * 1024 + i * 256 + lane * 4) = pk4(x[i] * r2);
    }
}
__device__ __forceinline__ void phase_rp8(const Prm& p) {
    const bf16_t* O = (const bf16_t*)(p.ws + WS_R0 + UB); bf16_t* xb = (bf16_t*)(p.ws + WS_R0 + 3 * UB); const float* g = p.in[I_GPFF];
    const int lane = threadIdx.x & 63, gw = blockIdx.x * 8 + (threadIdx.x >> 6), nw = gridDim.x * 8;
    for (int row = gw; row < MT; row += nw) {
        const bf16_t* xr = (const bf16_t*)p.out + (size_t)row * 1024; const bf16_t* orow = O + (size_t)row * 1024; f32x4 v[4], x[4]; float ss = 0.f;
#pragma unroll
        for (int i = 0; i < 4; ++i) { { const u32x2 ow = *(const u32x2*)(orow + i * 256 + lane * 4); v[i] = (f32x4){bflo(ow.x), bfhi(ow.x), bflo(ow.y), bfhi(ow.y)}; } { const u32x2 xw = *(const u32x2*)(xr + i * 256 + lane * 4); x[i] = (f32x4){bflo(xw.x), bfhi(xw.x), bflo(xw.y), bfhi(xw.y)}; } ss += v[i][0] * v[i][0] + v[i][1] * v[i][1] + v[i][2] * v[i][2] + v[i][3] * v[i][3]; }
        ss = wsum(ss); const float rs = rsqrtf(ss * (1.0f / 1024.0f) + EPS);
#pragma unroll
        for (int i = 0; i < 4; ++i) { const f32x4 gg = *(const f32x4*)(g + i * 256 + lane * 4); x[i] += v[i] * rs * gg;
            *(u32x2*)(xb + (size_t)row * 1024 + i * 256 + lane * 4) = pk4(x[i]); }
    }
}
__device__ __forceinline__ void phase_conv(const Prm& p) {
    const bf16_t* A = (const bf16_t*)(p.ws + WS_R0 + UB); bf16_t* Ug = (bf16_t*)(p.ws + WS_R0 + UB + A_BYTES);
    const float* wc = p.in[I_WCONV]; const float* bc = p.in[I_BCONV]; const float* cc = p.in[I_CC];
    for (int id = blockIdx.x * 512 + threadIdx.x; id < 2112 * 352; id += gridDim.x * 512) {
        const int ri = id / 352, c0 = (id % 352) * 8;
        int row; if (ri < 2048) row = (ri >> 1) * 64 + (ri & 1); else { const int j = ri - 2048; row = MP + (j >> 1) * 32 + (j & 1); }
        float am2[8], am1[8], a[8], u[8], gq[8];
#pragma unroll
        for (int j = 0; j < 8; ++j) { am2[j] = 0.f; am1[j] = 0.f; }
        if (row < MP) {
            const int t = row & 2047;
            if (t >= 1) unpk8(*(const u32x4*)(A + (size_t)(row - 1) * DFF + c0), am1);
            if (t >= 2) unpk8(*(const u32x4*)(A + (size_t)(row - 2) * DFF + c0), am2);
        } else {
            const int rs = row - MP, b = rs >> 5, t = rs & 31;
            if (t == 0) {
#pragma unroll
                for (int j = 0; j < 8; ++j) { am2[j] = cc[(size_t)(b * 2) * DFF + c0 + j]; am1[j] = cc[(size_t)(b * 2 + 1) * DFF + c0 + j]; }
            } else {
#pragma unroll
                for (int j = 0; j < 8; ++j) am2[j] = cc[(size_t)(b * 2 + 1) * DFF + c0 + j];
                unpk8(*(const u32x4*)(A + (size_t)(row - 1) * DFF + c0), am1);
            }
        }
        const size_t off = (size_t)row * DFF + c0;
        unpk8(*(const u32x4*)(A + off), a); unpk8(*(const u32x4*)(Ug + off), u);
#pragma unroll
        for (int j = 0; j < 8; ++j) {
            const float ac = bc[c0 + j] + wc[c0 + j] * am2[j] + wc[DFF + c0 + j] * am1[j] + wc[2 * DFF + c0 + j] * a[j];
            const float y = 1.5957691216f * (ac + 0.044715f * ac * ac * ac);
            gq[j] = ac * sigm(y) * u[j];
        }
        u32x4 wv; wv.x = pk2(gq[0], gq[1]); wv.y = pk2(gq[2], gq[3]); wv.z = pk2(gq[4], gq[5]); wv.w = pk2(gq[6], gq[7]);
        *(u32x4*)(Ug + off) = wv;
    }
}

#ifndef PROBE_DUP
#define PROBE_DUP 0
#endif
#ifndef P2M
#define P2M 15
#endif
#ifndef PHM
#define PHM 0xfff
#endif

#define XB_TMO      128
#define XB_XCNT(j)  (256  + 64 * (j))
#define XB_XSUB(j)  (1280 + 64 * (j))
#define XB_XGEN(j)  (2304 + 64 * (j))
#define XB_TOP      3328
#define XB_TOPGEN   3392
#define XCD_BAR_WORDS 3456
#define XB_SPIN_CAP (1u << 18)
#define LAS __attribute__((address_space(3)))

__device__ __forceinline__ unsigned xb_ld(unsigned* p)              { return __hip_atomic_load(p, __ATOMIC_RELAXED, __HIP_MEMORY_SCOPE_AGENT); }
__device__ __forceinline__ unsigned xb_add(unsigned* p, unsigned v) { return __hip_atomic_fetch_add(p, v, __ATOMIC_RELAXED, __HIP_MEMORY_SCOPE_AGENT); }
__device__ __forceinline__ unsigned xb_xcc_id() { return (unsigned)__builtin_amdgcn_s_getreg((3 << 11) | 20) & 0xFu; }
#define XB_SPIN(cond, bar) do { unsigned _sp = 0; while (cond) { __builtin_amdgcn_s_sleep(1); \
    if ((++_sp & 255u) == 0u) { if (xb_ld(&(bar)[XB_TMO])) break; if (_sp > XB_SPIN_CAP) { atomicAdd(&(bar)[XB_TMO], 1u); break; } } } } while (0)
struct XcdBarrier {
    unsigned* bar; unsigned x;
    volatile LAS unsigned* st;
};

__device__ __forceinline__ XcdBarrier xcd_barrier_post(unsigned* bar, volatile LAS unsigned* st) {
    XcdBarrier b; b.bar = bar; b.x = xb_xcc_id(); b.st = st;
    if (threadIdx.x == 0) (void)xb_add(&bar[XB_XCNT(b.x)], 1u);
    return b;
}
__device__ __forceinline__ void xcd_barrier_complete(unsigned* bar, unsigned x, unsigned& nloc, unsigned& nx) {
    const unsigned G = gridDim.x * gridDim.y * gridDim.z;
    unsigned sum, cnt, mine, sp = 0u;
    for (;;) {
        sum = 0u; cnt = 0u; mine = 0u;
#pragma unroll
        for (unsigned j = 0; j < 16; ++j) { const unsigned c = xb_ld(&bar[XB_XCNT(j)]); sum += c; cnt += (c > 0u) ? 1u : 0u; mine = (j == x) ? c : mine; }
        if (sum == G) break;
        __builtin_amdgcn_s_sleep(1);
        if ((++sp & 255u) == 0u) { if (xb_ld(&bar[XB_TMO])) break; if (sp > XB_SPIN_CAP) { atomicAdd(&bar[XB_TMO], 1u); break; } }
    }
    nloc = mine > 0u ? mine : 1u; nx = cnt > 0u ? cnt : 1u;
}

__device__ __forceinline__ void xcd_barrier(const XcdBarrier& b) {
    asm volatile("s_waitcnt vmcnt(0)" ::: "memory");
    __syncthreads();
    if (threadIdx.x == 0) {
        unsigned* bar = b.bar;
        __builtin_amdgcn_s_waitcnt(0);
        unsigned nloc = b.st[0], nx = b.st[1];
        if (nloc == 0u) { xcd_barrier_complete(bar, b.x, nloc, nx); b.st[0] = nloc; b.st[1] = nx; }
        const unsigned old = xb_add(&bar[XB_XSUB(b.x)], 1u);
        const unsigned gen = old / nloc;
        if (old + 1u == (gen + 1u) * nloc) {
            __builtin_amdgcn_fence(__ATOMIC_RELEASE, "agent");
            asm volatile("s_waitcnt vmcnt(0)" ::: "memory");
            const unsigned og = xb_add(&bar[XB_TOP], 1u);
            const unsigned tg = og / nx;
            if (og + 1u == (tg + 1u) * nx) xb_add(&bar[XB_TOPGEN], 1u);
            else XB_SPIN(xb_ld(&bar[XB_TOPGEN]) == tg, bar);
            __builtin_amdgcn_fence(__ATOMIC_ACQUIRE, "agent");
            xb_add(&bar[XB_XGEN(b.x)], 1u);
            asm volatile("s_waitcnt vmcnt(0)" ::: "memory");
        } else {
            XB_SPIN(xb_ld(&bar[XB_XGEN(b.x)]) == gen, bar);
            __builtin_amdgcn_fence(__ATOMIC_ACQUIRE, "agent");
            asm volatile("s_waitcnt vmcnt(0)" ::: "memory");
        }
    }
    __syncthreads();
}

__global__ void __launch_bounds__(512, 2) fwd_mega(Prm p, int ph_lo, int ph_hi) {
    extern __shared__ __attribute__((aligned(16))) unsigned char lds[];
    cg::grid_group grid = cg::this_grid();
    unsigned char* ws = p.ws;
    bf16_t* R0 = (bf16_t*)(ws + WS_R0);
#define REG(i) ((bf16_t*)(ws + WS_R0 + (size_t)(i) * UB))
    unsigned* barw = (unsigned*)(ws + WS_END);
    if (blockIdx.x == 0) for (int i = threadIdx.x; i < XCD_BAR_WORDS; i += 512) barw[i] = 0u;
    volatile LAS unsigned* xst = (volatile LAS unsigned*)((PG8_LAS unsigned char*)lds + (LDS_BYTES - 16));
    if (threadIdx.x < 4) xst[threadIdx.x] = 0u;
    __syncthreads();
    XcdBarrier xb; xb.bar = barw; xb.x = 0u; xb.st = xst;
    unsigned bar_k = 0;
#define GRID_SEAM() do { if (bar_k == 0) { grid.sync(); xb = xcd_barrier_post(barw, xst); } else xcd_barrier(xb); ++bar_k; } while (0)
#define PH_BEGIN(n) if (ph_lo <= (n) && (n) < ph_hi) { if ((n) > ph_lo) GRID_SEAM();
#define PH_END }
#if (PHM >> 0) & 1
        PH_BEGIN(0) phase0(p, lds);
#if PROBE_DUP == 1
        grid.sync(); phase0(p, lds);
#endif
        PH_END
#else
#endif
#if (PHM >> 1) & 1
        PH_BEGIN(1) { F1 f; f.r0 = R0; f.kv = (bf16_t*)(ws + WS_KV); f.out = p.out; run_gemm(lds, (const bf16_t*)p.out, (const bf16_t*)(ws + WS_WIN), NIN, 1024, f);
#if PROBE_DUP == 3
            grid.sync(); run_gemm(lds, (const bf16_t*)p.out, (const bf16_t*)(ws + WS_WIN), NIN, 1024, f);
#endif
        } PH_END
#else
#endif
#if (PHM >> 2) & 1
        PH_BEGIN(2) {
#if PROBE_DUP == 2
            { bf16_t* YA = (bf16_t*)p.out; bf16_t* YB = (bf16_t*)p.out + UB / 2;
            const int G = gridDim.x;
#if P2M & 1
#pragma unroll 1
            for (int s = blockIdx.x; s < 256; s += G) hgrn_seq<64, false>(p, lds, s >> 3, s & 7, YB);
#endif
#if P2M & 2
#pragma unroll 1
            for (int s = blockIdx.x; s < 256; s += G) hgrn_seq<32, true>(p, lds, s >> 3, s & 7, YB);
#endif
            __syncthreads(); attn_bias_table(p, lds); __syncthreads();
#if P2M & 4
#pragma unroll 1
            for (int it = blockIdx.x; it < 2048; it += G) attn_item<12, 4, false>(p, lds, it >> 6, (it >> 1) & 31, it & 1, YA);
#endif
#if P2M & 8
#pragma unroll 1
            for (int it = blockIdx.x; it < 64; it += G) attn_item<10, 2, true>(p, lds, it >> 1, 0, it & 1, YA);
#endif
            __syncthreads(); }
#endif
            { bf16_t* YA = REG(0); bf16_t* YB = REG(1);
            const int G = gridDim.x;
#if P2M & 1
#pragma unroll 1
            for (int s = blockIdx.x; s < 256; s += G) hgrn_seq<64, false>(p, lds, s >> 3, s & 7, YB);
#endif
#if P2M & 2
#pragma unroll 1
            for (int s = blockIdx.x; s < 256; s += G) hgrn_seq<32, true>(p, lds, s >> 3, s & 7, YB);
#endif
            __syncthreads(); attn_bias_table(p, lds); __syncthreads();
#if P2M & 4
#pragma unroll 1
            for (int it = blockIdx.x; it < 2048; it += G) attn_item<12, 4, false>(p, lds, it >> 6, (it >> 1) & 31, it & 1, YA);
#endif
#if P2M & 8
#pragma unroll 1
            for (int it = blockIdx.x; it < 64; it += G) attn_item<10, 2, true>(p, lds, it >> 1, 0, it & 1, YA);
#endif
            }
        } PH_END
#else
#endif
#if (PHM >> 3) & 1
        PH_BEGIN(3) {
            Epi34 E; E.e2.f.g = REG(5); E.e2.f.o = REG(2); E.e3.f.g = REG(6); E.e3.f.t = REG(2); E.e3.f.o = REG(3);
            int K34 = 1024, N34 = 1024; asm volatile("" : "+s"(K34)); asm volatile("" : "+s"(N34));
            pg8::Gemm g; g.A = REG(0); g.Bt = (const bf16_t*)(ws + WS_WBRA); g.M = MT; g.N = N34; g.K = K34;
            PairOrder S; S.S.init(MT, N34, (int)gridDim.x, (int)blockIdx.x); S.astep = UB; S.bstep = WS_WBRB - WS_WBRA;
            pg8::gemm_phase<Epi34, PairOrder, false>((PG8_LAS unsigned char*)lds, g, S, E, nullptr);
            __syncthreads();
            late_weights(p, lds); conv_p(p);
        } PH_END
#endif
#if (PHM >> 5) & 1
        PH_BEGIN(5) { FBF f; f.o = REG(4); run_gemm(lds, REG(3), (const bf16_t*)(ws + WS_WOUT), 1024, 1024, f);
#if PROBE_DUP == 5
            grid.sync(); run_gemm(lds, REG(3), (const bf16_t*)(ws + WS_WOUT), 1024, 1024, f);
#endif
        } PH_END
#else
#endif
#if (PHM >> 6) & 1
        PH_BEGIN(6) phase_rp5(p); PH_END
#else
#endif
#if (PHM >> 7) & 1
        PH_BEGIN(7) { EpiUp e; e.g = (bf16_t*)(ws + WS_R0 + UB + A_BYTES); e.araw = REG(1); e.out = p.out; e.wcv = p.in[I_WCONV]; e.bcv = p.in[I_BCONV]; run_gemm_epi(lds, REG(0), (const bf16_t*)(ws + WS_WUP), 2 * DFF, 1024, e); } PH_END
#else
#endif
#if (PHM >> 8) & 1
        PH_BEGIN(8) phase_conv(p); PH_END
#else
#endif
        PH_BEGIN(9) { FBF f; f.o = REG(1); run_gemm(lds, (const bf16_t*)(ws + WS_R0 + UB + A_BYTES), (const bf16_t*)(ws + WS_WDOWN), 1024, DFF, f);
                  FBF f2; f2.o = REG(0); if (blockIdx.x >= 16) run_gemm(lds, (const bf16_t*)(ws + WS_KV), (const bf16_t*)(ws + WS_WPLE), 1024, 256, f2, 16); } PH_END
#if (PHM >> 10) & 1
        PH_BEGIN(10) phase_rp8(p); PH_END
#else
#endif
#if (PHM >> 11) & 1
        PH_BEGIN(11) { F9 f; f.pe = REG(0); f.xb = REG(3); f.y = p.out; run_gemm(lds, REG(3), (const bf16_t*)(ws + WS_WPG), 1024, 1024, f); } PH_END
#else
#endif
#undef REG
}

extern "C" void kernel_launch(void* const* d_in, const int* in_sizes, int n_in, void* d_out, int out_size, void* d_ws, size_t ws_size, hipStream_t stream) {
    static int grid = 0;
    if (grid == 0) {
        if (n_in != 26 || (size_t)out_size != O_END || ws_size < WS_END) { fprintf(stderr, "kernel_launch: unexpected shapes n_in %d out %d ws %zu (need %zu)\n", n_in, out_size, ws_size, (size_t)WS_END); grid = -1; return; }
        int dev = 0, cus = 0, per_cu = 0;
        hipGetDevice(&dev); hipDeviceGetAttribute(&cus, hipDeviceAttributeMultiprocessorCount, dev);
        if (hipFuncSetAttribute((const void*)fwd_mega, hipFuncAttributeMaxDynamicSharedMemorySize, LDS_BYTES) != hipSuccess) { fprintf(stderr, "kernel_launch: hipFuncSetAttribute failed\n"); grid = -1; return; }
        if (hipOccupancyMaxActiveBlocksPerMultiprocessor(&per_cu, (const void*)fwd_mega, 512, LDS_BYTES) != hipSuccess || per_cu < 1) { fprintf(stderr, "kernel_launch: occupancy query says %d\n", per_cu); per_cu = 1; }
        (void)hipGetLastError();
        grid = cus;
    }
    if (grid < 0) return;
    Prm p{};
    for (int i = 0; i < 26; ++i) p.in[i] = (const float*)d_in[i];
    p.out = (float*)d_out; p.ws = (unsigned char*)d_ws;
    int lo = 0, hi = 12;
    void* args[] = {&p, &lo, &hi};
    hipError_t e = hipLaunchCooperativeKernel((const void*)fwd_mega, dim3(grid), dim3(512), args, LDS_BYTES, stream);
    if (e != hipSuccess) fprintf(stderr, "kernel_launch: cooperative launch failed: %s (grid %d)\n", hipGetErrorString(e), grid);
}
```
